# Optimizing an MI355X kernel written in HIP

```python
import jax, jax.numpy as jnp
from jax import lax
import numpy as np

D_MODEL = 1024
BATCH = 4
SEQ = 4096
DEPTH = 4

MIX_WIDTH = D_MODEL
N_GROUPS = 4
GROUP_WIDTH = MIX_WIDTH // N_GROUPS
EPS = 1e-6
ROPE_THETA = 10000.0

MLA_HEADS = 4
MLA_NOPE = 64
MLA_ROPE = 32
MLA_V = GROUP_WIDTH // MLA_HEADS
MLA_Q_LORA = 256
MLA_KV_LORA = 128
ATTN_BLOCK = 128

SG_HEADS = 4
SG_CHUNK = 128
SG_HALF = GROUP_WIDTH

HG_HEADS = 4
HG_KEY = 128
HG_VAL = GROUP_WIDTH // HG_HEADS
HG_CHUNK = 64

RET_HEADS = 4
RET_QK = 64
RET_V = GROUP_WIDTH // RET_HEADS
RET_CHUNK = 128

D_FF = 2816
PLE_DIM = 256

IN_SPLITS = (MLA_Q_LORA, MLA_KV_LORA, MLA_ROPE,
             SG_HALF, SG_HALF,
             HG_HEADS * HG_KEY, HG_HEADS * HG_KEY, HG_HEADS * HG_VAL, HG_HEADS * HG_VAL,
             RET_HEADS * RET_QK, RET_HEADS * RET_QK, RET_HEADS * RET_V, RET_HEADS * RET_V)
IN_WIDTH = sum(IN_SPLITS)

kernel_name = 'hybrid_parallel_mla_sgu_hgrn2_retention_macaron'


def rmsnorm(x, g):
    xf = x.astype(jnp.float32)
    y = xf * lax.rsqrt(jnp.mean(xf * xf, axis=-1, keepdims=True) + EPS)
    return (y * g.astype(jnp.float32)).astype(x.dtype)


def layernorm(x, g):
    xf = x.astype(jnp.float32)
    xc = xf - jnp.mean(xf, axis=-1, keepdims=True)
    y = xc * lax.rsqrt(jnp.mean(xc * xc, axis=-1, keepdims=True) + EPS)
    return (y * g.astype(jnp.float32)).astype(x.dtype)


def swiglu(x, w_gate, w_up, w_down):
    return (jax.nn.silu(x @ w_gate) * (x @ w_up)) @ w_down


def rope(x, positions):
    d = x.shape[-1]
    inv = ROPE_THETA ** (-jnp.arange(0, d, 2, dtype=jnp.float32) / d)
    ang = positions.astype(jnp.float32)[..., None] * inv
    cos = jnp.cos(ang)[:, :, None, :]
    sin = jnp.sin(ang)[:, :, None, :]
    x1, x2 = jnp.split(x.astype(jnp.float32), 2, axis=-1)
    return jnp.concatenate([x1 * cos - x2 * sin, x1 * sin + x2 * cos], axis=-1).astype(x.dtype)


def mla_mixer(c_q, c_kv, k_pe, positions, q_norm, w_uq, kv_norm, w_ukv):
    B, S, _ = c_q.shape
    q = (rmsnorm(c_q, q_norm) @ w_uq).reshape(B, S, MLA_HEADS, MLA_NOPE + MLA_ROPE)
    q = jnp.concatenate([q[..., :MLA_NOPE], rope(q[..., MLA_NOPE:], positions)], axis=-1)
    kv = (rmsnorm(c_kv, kv_norm) @ w_ukv).reshape(B, S, MLA_HEADS, MLA_NOPE + MLA_V)
    k_rot = rope(k_pe[:, :, None, :], positions)
    k = jnp.concatenate([kv[..., :MLA_NOPE],
                         jnp.broadcast_to(k_rot, (B, S, MLA_HEADS, MLA_ROPE))], axis=-1)
    v = kv[..., MLA_NOPE:]
    scale = (MLA_NOPE + MLA_ROPE) ** -0.5
    nb = S // ATTN_BLOCK
    qb = (q * scale).reshape(B, nb, ATTN_BLOCK, MLA_HEADS, MLA_NOPE + MLA_ROPE).transpose(1, 0, 3, 2, 4)
    kh = k.transpose(0, 2, 1, 3)
    vh = v.transpose(0, 2, 1, 3)
    key_idx = jnp.arange(S)

    def query_block(args):
        q_blk, bi = args
        s = jnp.einsum('bhqd,bhkd->bhqk', q_blk, kh).astype(jnp.float32)
        q_idx = bi * ATTN_BLOCK + jnp.arange(ATTN_BLOCK)
        s = jnp.where(key_idx[None, :] <= q_idx[:, None], s, -jnp.inf)
        pr = jax.nn.softmax(s, axis=-1).astype(vh.dtype)
        return jnp.einsum('bhqk,bhkd->bhqd', pr, vh)

    o = lax.map(query_block, (qb, jnp.arange(nb)))
    return o.transpose(1, 0, 3, 2, 4).reshape(B, S, MLA_HEADS * MLA_V)


def spatial_gating_mixer(z_u, z_v, ln_g, w_s, b_s):
    B, S, _ = z_u.shape
    u = jax.nn.gelu(z_u, approximate=False)
    v = layernorm(jax.nn.gelu(z_v, approximate=False), ln_g)
    n = S // SG_CHUNK
    vh = v.reshape(B, n, SG_CHUNK, SG_HEADS, SG_HALF // SG_HEADS)
    causal = jnp.tril(jnp.ones((SG_CHUNK, SG_CHUNK), dtype=bool))
    w = jnp.where(causal[None], w_s, 0.0).astype(v.dtype)
    mixed = jnp.einsum('hts,bnshd->bnthd', w, vh) + b_s.T[None, None, :, :, None]
    return u * mixed.reshape(B, S, SG_HALF)


def hgrn2_mixer(q, f, i, g, lb, norm_g):
    B, S, _ = q.shape
    f32 = jnp.float32
    forget = lb + (1.0 - lb) * jax.nn.sigmoid(f.astype(f32))
    log_f = jnp.log(forget)
    k = 1.0 - forget
    n = S // HG_CHUNK

    def chunks(t, d):
        return t.astype(f32).reshape(B, n, HG_CHUNK, HG_HEADS, d).transpose(1, 0, 3, 2, 4)

    qc, kc, gc = chunks(q, HG_KEY), chunks(k, HG_KEY), chunks(log_f, HG_KEY)
    vc = chunks(i, HG_VAL)
    causal = jnp.tril(jnp.ones((HG_CHUNK, HG_CHUNK), dtype=bool))[None, None, :, :, None]

    def step(state, inp):
        qt, kt, vt, gt = inp
        b = jnp.cumsum(gt, axis=2)
        diff = jnp.where(causal, b[:, :, :, None, :] - b[:, :, None, :, :], -jnp.inf)
        scores = jnp.einsum('bhtk,bhtsk,bhsk->bhts', qt, jnp.exp(diff), kt)
        o = (jnp.einsum('bhts,bhsv->bhtv', scores, vt)
             + jnp.einsum('bhtk,bhkv->bhtv', qt * jnp.exp(b), state))
        b_last = b[:, :, -1:, :]
        new_state = (jnp.exp(b_last[:, :, 0, :])[..., None] * state
                     + jnp.einsum('bhsk,bhsv->bhkv', kt * jnp.exp(b_last - b), vt))
        return new_state, o

    state0 = jnp.zeros((B, HG_HEADS, HG_KEY, HG_VAL), f32)
    _, o = lax.scan(step, state0, (qc, kc, vc, gc))
    o = o.transpose(1, 0, 3, 2, 4).reshape(B, S, HG_HEADS, HG_VAL)
    o = o * lax.rsqrt(jnp.mean(o * o, axis=-1, keepdims=True) + EPS) * norm_g.astype(f32).reshape(HG_HEADS, HG_VAL)
    gate = jax.nn.silu(g.astype(f32)).reshape(B, S, HG_HEADS, HG_VAL)
    return (o * gate).reshape(B, S, HG_HEADS * HG_VAL).astype(q.dtype)


def retention_mixer(q, k, v, g, positions, norm_g):
    B, S, _ = q.shape
    f32 = jnp.float32
    H, C = RET_HEADS, RET_CHUNK
    n = S // C
    qr = rope(q.reshape(B, S, H, RET_QK), positions).astype(f32)
    kr = rope(k.reshape(B, S, H, RET_QK), positions).astype(f32) * (RET_QK ** -0.5)
    vr = v.reshape(B, S, H, RET_V).astype(f32)

    def chunks(t):
        return t.reshape(B, n, C, H, t.shape[-1]).transpose(0, 3, 1, 2, 4)

    qh, kh, vh = chunks(qr), chunks(kr), chunks(vr)
    lg = jnp.log1p(-jnp.power(2.0, -(5.0 + jnp.arange(H, dtype=f32))))
    pos = jnp.arange(C, dtype=f32)
    rel = pos[:, None] - pos[None, :]
    decay = jnp.where(rel >= 0, jnp.exp(jnp.maximum(rel, 0.0)[None] * lg[:, None, None]), 0.0)
    scores = jnp.einsum('bhntd,bhnsd->bhnts', qh, kh) * decay[None, :, None]
    o = jnp.einsum('bhnts,bhnse->bhnte', scores, vh)
    k_dec = kh * jnp.exp((C - 1.0 - pos)[None, :] * lg[:, None])[None, :, None, :, None]
    kv = jnp.einsum('bhnsd,bhnse->bhnde', k_dec, vh)
    cidx = jnp.arange(n, dtype=f32)
    gap = cidx[:, None] - 1.0 - cidx[None, :]
    cross = jnp.where(gap >= 0, jnp.exp(C * jnp.maximum(gap, 0.0)[None] * lg[:, None, None]), 0.0)
    state = jnp.einsum('hnm,bhmde->bhnde', cross, kv)
    q_dec = qh * jnp.exp((pos + 1.0)[None, :] * lg[:, None])[None, :, None, :, None]
    o = o + jnp.einsum('bhntd,bhnde->bhnte', q_dec, state)
    o = o.transpose(0, 2, 3, 1, 4).reshape(B, S, H, RET_V)
    oc = o - jnp.mean(o, axis=-1, keepdims=True)
    o = oc * lax.rsqrt(jnp.mean(oc * oc, axis=-1, keepdims=True) + EPS) * norm_g.astype(f32).reshape(H, RET_V)
    gate = jax.nn.silu(g.astype(f32)).reshape(B, S, H, RET_V)
    return (o * gate).reshape(B, S, H * RET_V).astype(q.dtype)


def setup_inputs(seed: int = 0) -> dict:
    key = jax.random.key(seed)
    ks = iter(jax.random.split(key, 40))
    f32 = jnp.float32

    def nrm(shape, scale):
        return jax.random.normal(next(ks), shape, f32) * scale

    def gain(shape):
        return 1.0 + 0.01 * jax.random.normal(next(ks), shape, f32)

    L, D = DEPTH, D_MODEL
    return {
        'x': nrm((BATCH, SEQ, D), 1.0),
        'p': nrm((DEPTH, BATCH, SEQ, PLE_DIM), 1.0),
        'positions': jnp.broadcast_to(jnp.arange(SEQ, dtype=jnp.int32), (BATCH, SEQ)),
        'ffn1_norm': gain((L, D)),
        'ffn1_w_gate': nrm((L, D, D_FF), D ** -0.5),
        'ffn1_w_up': nrm((L, D, D_FF), D ** -0.5),
        'ffn1_w_down': nrm((L, D_FF, D), D_FF ** -0.5),
        'mix_norm': gain((L, D)),
        'w_in': nrm((L, D, IN_WIDTH), D ** -0.5),
        'mla_q_norm': gain((L, MLA_Q_LORA)),
        'mla_w_uq': nrm((L, MLA_Q_LORA, MLA_HEADS * (MLA_NOPE + MLA_ROPE)), MLA_Q_LORA ** -0.5),
        'mla_kv_norm': gain((L, MLA_KV_LORA)),
        'mla_w_ukv': nrm((L, MLA_KV_LORA, MLA_HEADS * (MLA_NOPE + MLA_V)), MLA_KV_LORA ** -0.5),
        'sg_ln': gain((L, SG_HALF)),
        'sg_w_s': nrm((L, SG_HEADS, SG_CHUNK, SG_CHUNK), 0.5 * SG_CHUNK ** -0.5),
        'sg_b_s': 1.0 + nrm((L, SG_HEADS, SG_CHUNK), 0.1),
        'hg_lb_logits': nrm((L, HG_HEADS * HG_KEY), 1.0),
        'hg_norm': gain((L, HG_HEADS * HG_VAL)),
        'ret_norm': gain((L, RET_HEADS * RET_V)),
        'w_out': nrm((L, MIX_WIDTH, D), MIX_WIDTH ** -0.5),
        'ffn2_norm': gain((L, D)),
        'ffn2_w_gate': nrm((L, D, D_FF), D ** -0.5),
        'ffn2_w_up': nrm((L, D, D_FF), D ** -0.5),
        'ffn2_w_down': nrm((L, D_FF, D), D_FF ** -0.5),
        'ple_norm': gain((L, D)),
        'ple_w_proj': nrm((L, PLE_DIM, D), PLE_DIM ** -0.5),
        'ple_w_gate': nrm((L, D, D), D ** -0.5),
        'final_norm': gain((D,)),
    }


def reference(x, p, positions, ffn1_norm, ffn1_w_gate, ffn1_w_up, ffn1_w_down,
              mix_norm, w_in, mla_q_norm, mla_w_uq, mla_kv_norm, mla_w_ukv,
              sg_ln, sg_w_s, sg_b_s, hg_lb_logits, hg_norm, ret_norm, w_out,
              ffn2_norm, ffn2_w_gate, ffn2_w_up, ffn2_w_down,
              ple_norm, ple_w_proj, ple_w_gate, final_norm):
    split_points = np.cumsum(IN_SPLITS)[:-1].tolist()
    lb_all = jnp.cumsum(jax.nn.softmax(hg_lb_logits.astype(jnp.float32), axis=0), axis=0)
    lb_all = lb_all - lb_all[0:1]
    h = x
    for l in range(DEPTH):
        h = h + 0.5 * swiglu(rmsnorm(h, ffn1_norm[l]), ffn1_w_gate[l], ffn1_w_up[l], ffn1_w_down[l])
        z = rmsnorm(h, mix_norm[l]) @ w_in[l]
        (c_q, c_kv, k_pe, z_u, z_v, hq, hf, hi, hg,
         rq, rk, rv, rg) = jnp.split(z, split_points, axis=-1)
        y_a = mla_mixer(c_q, c_kv, k_pe, positions, mla_q_norm[l], mla_w_uq[l], mla_kv_norm[l], mla_w_ukv[l])
        y_b = spatial_gating_mixer(z_u, z_v, sg_ln[l], sg_w_s[l], sg_b_s[l])
        y_c = hgrn2_mixer(hq, hf, hi, hg, lb_all[l], hg_norm[l])
        y_d = retention_mixer(rq, rk, rv, rg, positions, ret_norm[l])
        h = h + jnp.concatenate([y_a, y_b, y_c, y_d], axis=-1) @ w_out[l]
        h = h + 0.5 * swiglu(rmsnorm(h, ffn2_norm[l]), ffn2_w_gate[l], ffn2_w_up[l], ffn2_w_down[l])
        gate = jax.nn.sigmoid(rmsnorm(h, ple_norm[l]) @ ple_w_gate[l])
        h = h + (p[l] @ ple_w_proj[l]) * gate
    return rmsnorm(h, final_norm)
```

```cpp
#include <hip/hip_runtime.h>
#include <cstdio>
#include <cstdint>
#include <cmath>
namespace pg8 {
#define PG8_LAS __attribute__((address_space(3)))
typedef unsigned short bf16_t;
typedef short bf16x8 __attribute__((ext_vector_type(8)));
typedef float f32x4 __attribute__((ext_vector_type(4)));
typedef unsigned u32x4 __attribute__((ext_vector_type(4)));
constexpr int BM = 256, BK = 64, HALF = 128, HTB = HALF * BK * 2  , STAGE_BYTES = 8 * HTB, NXCD = 8, WGM = 8;

__host__ __device__ __forceinline__ int lds_byte(int r, int c) { const int st = (r >> 4) * 2 + (c >> 5), rr = r & 15, cc = c & 31, ob = rr * 64 + cc * 2; return st * 1024 + (ob ^ (((ob >> 9) & 1) << 5)); }
__host__ __device__ __forceinline__ void stage_rc(int b, int& R, int& C) { const int st = b / 1024, sb = b % 1024, swz = sb ^ (((sb >> 9) & 1) << 5); R = (st >> 1) * 16 + swz / 64; C = (st & 1) * 32 + (swz % 64) / 2; }
__host__ __device__ __forceinline__ int perm32(int rho) { const int n = rho >> 4, i = rho & 15; return 8 * (i >> 2) + 4 * n + (i & 3); }

struct Unit { int pm, pn; };
struct Gemm { const bf16_t* A; const bf16_t* Bt; int M, N, K, lda; };

struct StaticOrder {
    int nM, nN, nwg, G, c;
    __host__ __device__ void init(int M, int N, int G_, int c_) { nM = M / BM; nN = N / BM; nwg = nM * nN; G = G_; c = c_; }
    __host__ __device__ bool next(int i, Unit& u) const {
        const long L = (long)i * G + c; if (L >= nwg) return false;
        int wgid = (int)L; { const int q = nwg / NXCD, r = nwg % NXCD, xcd = wgid % NXCD, off = wgid / NXCD; wgid = (xcd < r ? xcd * (q + 1) : r * (q + 1) + (xcd - r) * q) + off; }
        const int nig = WGM * nN, gid = wgid / nig, fm = gid * WGM, gsz = (nM - fm) < WGM ? (nM - fm) : WGM;
        u.pm = fm + ((wgid % nig) % gsz); u.pn = (wgid % nig) / gsz; return true;
    }
    __device__ __forceinline__ void a_ready(const Unit&) const {}
    __device__ __forceinline__ void done(const Unit&) const {}
};

__device__ __forceinline__ unsigned cvt_pk_bf16(float lo, float hi) { unsigned r; asm volatile("v_cvt_pk_bf16_f32 %0, %1, %2" : "=v"(r) : "v"(lo), "v"(hi)); return r; }
typedef unsigned u32x2 __attribute__((ext_vector_type(2)));
constexpr float RMS_EPS = 1e-6f, LOG2E = 1.4426950408889634f;
constexpr int DM = 1024, DFF_ = 2816, NZ_ = 3584;
__device__ __forceinline__ float sum4(const f32x4 a) { return (a[0] + a[1]) + (a[2] + a[3]); }
__device__ __forceinline__ float dot4(const f32x4 a) { return (a[0] * a[0] + a[1] * a[1]) + (a[2] * a[2] + a[3] * a[3]); }
__device__ __forceinline__ float row_rstd(const float* ssq, int row) {
    const f32x4* p = (const f32x4*)(ssq + (size_t)row * 16);
    const float s = (sum4(p[0]) + sum4(p[1])) + (sum4(p[2]) + sum4(p[3]));
    return __builtin_amdgcn_rsqf(s * (1.0f / 1024.0f) + RMS_EPS);
}
__device__ __forceinline__ float sigmoid_f(float x) { return __builtin_amdgcn_rcpf(1.0f + __builtin_amdgcn_exp2f(-LOG2E * x)); }

struct EpiSwiGLU {
    static constexpr bool PERM = true, AFTER_DRAIN = false;
    bf16_t* O; const float* ssq;
    __device__ __forceinline__ void operator()(const f32x4 (&acc)[2][2][4][2], const Unit& u, int wr, int wc, int fr, int fq) const {
        const int row0 = u.pm * BM + wr * 64 + fr, col0 = u.pn * 128 + wc * 32 + 8 * fq;
#pragma unroll
        for (int ai = 0; ai < 2; ++ai)
#pragma unroll
            for (int m = 0; m < 4; ++m) { const int row = row0 + ai * HALF + m * 16; const float r = row_rstd(ssq, row);
                float h[8];
#pragma unroll
                for (int n = 0; n < 2; ++n)
#pragma unroll
                    for (int j = 0; j < 4; ++j) { const float g = acc[ai][0][m][n][j] * r, up = acc[ai][1][m][n][j] * r; h[4 * n + j] = g * sigmoid_f(g) * up; }
                u32x4 w; w.x = cvt_pk_bf16(h[0], h[1]); w.y = cvt_pk_bf16(h[2], h[3]); w.z = cvt_pk_bf16(h[4], h[5]); w.w = cvt_pk_bf16(h[6], h[7]);
                *(u32x4*)(O + (size_t)row * DFF_ + col0) = w; }
    }
};
struct EpiRes {
    static constexpr bool PERM = false, AFTER_DRAIN = false;
    const float* base; float* out; bf16_t* hb; float* ssq_out; float alpha;
    __device__ __forceinline__ void operator()(const f32x4 (&acc)[2][2][4][2], const Unit& u, int wr, int wc, int fr, int fq) const {
        const int row0 = u.pm * BM + wr * 64 + fr, col0 = u.pn * BM + wc * 32 + 4 * fq;
#pragma unroll
        for (int ai = 0; ai < 2; ++ai)
#pragma unroll
            for (int m = 0; m < 4; ++m) { const int row = row0 + ai * HALF + m * 16; float s = 0.f;
#pragma unroll
                for (int bj = 0; bj < 2; ++bj)
#pragma unroll
                    for (int n = 0; n < 2; ++n) { const size_t off = (size_t)row * DM + col0 + bj * HALF + n * 16;
                        const f32x4 v = *(const f32x4*)(base + off) + acc[ai][bj][m][n] * alpha; *(f32x4*)(out + off) = v; s += dot4(v);
                        u32x2 w; w.x = cvt_pk_bf16(v[0], v[1]); w.y = cvt_pk_bf16(v[2], v[3]); *(u32x2*)(hb + off) = w; }
                s += __shfl_xor(s, 16); s += __shfl_xor(s, 32);
                if (fq == 0) ssq_out[(size_t)row * 16 + u.pn * 4 + wc] = s;
                asm volatile("" ::: "memory"); }
    }
};
struct EpiZ {
    static constexpr bool PERM = true, AFTER_DRAIN = false;
    bf16_t* Z; const float* ssq; float* ssqq; float* ssqkv;
    __device__ __forceinline__ void operator()(const f32x4 (&acc)[2][2][4][2], const Unit& u, int wr, int wc, int fr, int fq) const {
        const int row0 = u.pm * BM + wr * 64 + fr, col0 = u.pn * BM + wc * 32 + 8 * fq;
#pragma unroll
        for (int ai = 0; ai < 2; ++ai)
#pragma unroll
            for (int m = 0; m < 4; ++m) { const int row = row0 + ai * HALF + m * 16; const float r = row_rstd(ssq, row); float s0 = 0.f, s1 = 0.f;
#pragma unroll
                for (int bj = 0; bj < 2; ++bj) { const f32x4 v0 = acc[ai][bj][m][0] * r, v1 = acc[ai][bj][m][1] * r;
                    if (bj == 0) s0 = dot4(v0) + dot4(v1); else s1 = dot4(v0) + dot4(v1);
                    u32x4 w; w.x = cvt_pk_bf16(v0[0], v0[1]); w.y = cvt_pk_bf16(v0[2], v0[3]); w.z = cvt_pk_bf16(v1[0], v1[1]); w.w = cvt_pk_bf16(v1[2], v1[3]);
                    *(u32x4*)(Z + (size_t)row * NZ_ + col0 + bj * HALF) = w; }
                if (u.pn < 2) { float s = (u.pn == 0) ? s0 + s1 : s0; s += __shfl_xor(s, 16); s += __shfl_xor(s, 32);
                    if (fq == 0) { if (u.pn == 0) ssqq[(size_t)row * 4 + wc] = s; else ssqkv[(size_t)row * 4 + wc] = s; } } }
    }
};
struct EpiMla {
    static constexpr bool PERM = false, AFTER_DRAIN = false;
    bf16_t* O; const float* ssqq; const float* ssqkv; const float* cs; const float* sn;
    __device__ __forceinline__ void operator()(const f32x4 (&acc)[2][2][4][2], const Unit& u, int wr, int wc, int fr, int fq) const {
        const int row0 = u.pm * BM + wr * 64 + fr, col0 = u.pn * BM + wc * 32 + 4 * fq;
        const float QSCALE = 0.10206207261596575f * LOG2E;
#pragma unroll
        for (int ai = 0; ai < 2; ++ai)
#pragma unroll
            for (int m = 0; m < 4; ++m) { const int row = row0 + ai * HALF + m * 16;
                const float rq = __builtin_amdgcn_rsqf(sum4(*(const f32x4*)(ssqq + (size_t)row * 4)) * (1.0f / 256.0f) + RMS_EPS) * QSCALE;
                const float rkv = __builtin_amdgcn_rsqf(sum4(*(const f32x4*)(ssqkv + (size_t)row * 4)) * (1.0f / 128.0f) + RMS_EPS);
#pragma unroll
                for (int bj = 0; bj < 2; ++bj) { const int G = 8 * u.pn + 4 * bj + wc; const float sc = G < 12 ? rq : (G < 28 ? rkv : 1.0f);
                    f32x4 x1 = acc[ai][bj][m][0] * sc, x2 = acc[ai][bj][m][1] * sc;
                    if (G == 2 || G == 5 || G == 8 || G == 11 || G == 28) { const f32x4 c = *(const f32x4*)(cs + (size_t)row * 16 + 4 * fq), s = *(const f32x4*)(sn + (size_t)row * 16 + 4 * fq);
                        const f32x4 y1 = x1 * c - x2 * s, y2 = x1 * s + x2 * c; x1 = y1; x2 = y2; }
                    u32x2 w0, w1; w0.x = cvt_pk_bf16(x1[0], x1[1]); w0.y = cvt_pk_bf16(x1[2], x1[3]); w1.x = cvt_pk_bf16(x2[0], x2[1]); w1.y = cvt_pk_bf16(x2[2], x2[3]);
                    bf16_t* p = O + (size_t)row * DM + col0 + bj * HALF; *(u32x2*)p = w0; *(u32x2*)(p + 16) = w1; } }
    }
};
struct EpiPlain {
    static constexpr bool PERM = true, AFTER_DRAIN = false;
    bf16_t* O; int ldc;
    __device__ __forceinline__ void operator()(const f32x4 (&acc)[2][2][4][2], const Unit& u, int wr, int wc, int fr, int fq) const {
        const int row0 = u.pm * BM + wr * 64 + fr, col0 = u.pn * BM + wc * 32 + 8 * fq;
#pragma unroll
        for (int ai = 0; ai < 2; ++ai)
#pragma unroll
            for (int m = 0; m < 4; ++m) { bf16_t* rowp = O + (size_t)(row0 + ai * HALF + m * 16) * ldc + col0;
#pragma unroll
                for (int bj = 0; bj < 2; ++bj) { const f32x4 v0 = acc[ai][bj][m][0], v1 = acc[ai][bj][m][1];
                    u32x4 w; w.x = cvt_pk_bf16(v0[0], v0[1]); w.y = cvt_pk_bf16(v0[2], v0[3]); w.z = cvt_pk_bf16(v1[0], v1[1]); w.w = cvt_pk_bf16(v1[2], v1[3]);
                    *(u32x4*)(rowp + bj * HALF) = w; } }
    }
};
struct EpiPle {
    static constexpr bool PERM = false, AFTER_DRAIN = false;
    float* h; const bf16_t* pp; bf16_t* hb; const float* ssq_in; float* ssq_out;
    __device__ __forceinline__ void operator()(const f32x4 (&acc)[2][2][4][2], const Unit& u, int wr, int wc, int fr, int fq) const {
        const int row0 = u.pm * BM + wr * 64 + fr, col0 = u.pn * BM + wc * 32 + 4 * fq;
#pragma unroll
        for (int ai = 0; ai < 2; ++ai)
#pragma unroll
            for (int m = 0; m < 4; ++m) { const int row = row0 + ai * HALF + m * 16; const float r = row_rstd(ssq_in, row); float s = 0.f;
#pragma unroll
                for (int bj = 0; bj < 2; ++bj)
#pragma unroll
                    for (int n = 0; n < 2; ++n) { const size_t off = (size_t)row * DM + col0 + bj * HALF + n * 16;
                        const f32x4 hv = *(const f32x4*)(h + off); const u32x2 pw = *(const u32x2*)(pp + off); const f32x4 a = acc[ai][bj][m][n] * r;
                        f32x4 v; v[0] = hv[0] + __uint_as_float(pw.x << 16) * sigmoid_f(a[0]); v[1] = hv[1] + __uint_as_float(pw.x & 0xffff0000u) * sigmoid_f(a[1]);
                        v[2] = hv[2] + __uint_as_float(pw.y << 16) * sigmoid_f(a[2]); v[3] = hv[3] + __uint_as_float(pw.y & 0xffff0000u) * sigmoid_f(a[3]);
                        *(f32x4*)(h + off) = v; s += dot4(v);
                        u32x2 w; w.x = cvt_pk_bf16(v[0], v[1]); w.y = cvt_pk_bf16(v[2], v[3]); *(u32x2*)(hb + off) = w; }
                s += __shfl_xor(s, 16); s += __shfl_xor(s, 32);
                if (fq == 0) ssq_out[(size_t)row * 16 + u.pn * 4 + wc] = s;
                asm volatile("" ::: "memory"); }
    }
};

template <class Epi, class Sched, bool ALIGN_EPI = false, bool SP2 = false>
__device__ __forceinline__ void gemm_phase(PG8_LAS unsigned char* lds, const Gemm g, const Sched& S, const Epi& E) {
    int tid_o = threadIdx.x; asm volatile("" : "+v"(tid_o));
    const int tid = tid_o, wid = __builtin_amdgcn_readfirstlane(tid >> 6), lane = tid & 63, wr = wid >> 2, wc = wid & 3, fr = lane & 15, fq = lane >> 4;
    const int K = g.K, nt = K / BK;
    unsigned voffA[2], voffB[2];
#pragma unroll
    for (int i = 0; i < 2; ++i) { int R, C; stage_rc(tid * 16 + i * 8192, R, C); const int Rb = Epi::PERM ? ((R & ~31) + perm32(R & 31)) : R;
        voffA[i] = (unsigned)(R * g.lda + C) * 2u; voffB[i] = (unsigned)(Rb * K + C) * 2u; }
    const size_t kstep = (size_t)(BK * 2);
    const size_t hstep = (size_t)HALF * K * 2;
    const size_t tstep = 2 * hstep; const size_t hstepA = (size_t)HALF * g.lda * 2, tstepA = 2 * hstepA;
    const unsigned ldsw = (unsigned)wid * 1024u;
    const int aoff = lds_byte(wr * 64 + fr, fq * 8), boff = lds_byte(wc * 32 + fr, fq * 8);
#define PG8_SA(b, h) (((b) * 2 + (h)) * HTB)
#define PG8_SB(b, h) ((4 + (b) * 2 + (h)) * HTB)
#define PG8_STAGE(bufoff, gbase, voff) do { _Pragma("unroll") for (int _i = 0; _i < 2; ++_i) \
        __builtin_amdgcn_global_load_lds((const unsigned*)((const char*)(gbase) + (voff)[_i]), (PG8_LAS unsigned*)(lds + (bufoff) + ldsw + _i * 8192), 16, 0, 0); } while (0)
#define PG8_LDA(dst, b, h) do { _Pragma("unroll") for (int m = 0; m < 4; ++m) _Pragma("unroll") for (int k = 0; k < 2; ++k) dst[m][k] = *(const PG8_LAS bf16x8*)(lds + PG8_SA(b, h) + aoff + m * 2048 + k * 1024); } while (0)
#define PG8_LDB(dst, b, h) do { _Pragma("unroll") for (int n = 0; n < 2; ++n) _Pragma("unroll") for (int k = 0; k < 2; ++k) dst[n][k] = *(const PG8_LAS bf16x8*)(lds + PG8_SB(b, h) + boff + n * 2048 + k * 1024); } while (0)
#define PG8_MMA(ai, bj, At, Bt) do { __builtin_amdgcn_s_setprio(1); _Pragma("unroll") for (int m = 0; m < 4; ++m) _Pragma("unroll") for (int n = 0; n < 2; ++n) _Pragma("unroll") for (int k = 0; k < 2; ++k) \
        acc[ai][bj][m][n] = __builtin_amdgcn_mfma_f32_16x16x32_bf16(Bt[n][k], At[m][k], acc[ai][bj][m][n], 0, 0, 0); __builtin_amdgcn_s_setprio(0); } while (0)
#define PG8_WAIT_V(n) asm volatile("s_waitcnt vmcnt(" #n ")" ::: "memory")
#define PG8_WAIT_L(n) asm volatile("s_waitcnt lgkmcnt(" #n ")" ::: "memory")
#define PG8_BAR __builtin_amdgcn_s_barrier()
#define PG8_SCHED __builtin_amdgcn_sched_barrier(0)
    Unit cur, nxt; int ui = 0;
    if (!S.next(0, cur)) return;
    f32x4 acc[2][2][4][2];
#pragma unroll
    for (int a = 0; a < 2; ++a)
#pragma unroll
        for (int b = 0; b < 2; ++b)
#pragma unroll
            for (int m = 0; m < 4; ++m)
#pragma unroll
                for (int n = 0; n < 2; ++n) acc[a][b][m][n] = (f32x4){0.f, 0.f, 0.f, 0.f};
    bf16x8 At[4][2], B0[2][2], B1[2][2];
    const char* cA = (const char*)g.A + (size_t)cur.pm * tstepA; const char* cB = (const char*)g.Bt + (size_t)cur.pn * tstep;
    S.a_ready(cur);
    if constexpr (SP2) {
        PG8_STAGE(PG8_SB(0, 0), cB, voffB); PG8_STAGE(PG8_SB(0, 1), cB + hstep, voffB); PG8_STAGE(PG8_SA(0, 0), cA, voffA); PG8_STAGE(PG8_SA(0, 1), cA + hstepA, voffA);
        if (wr == 1) PG8_BAR;
        PG8_WAIT_V(2); PG8_BAR;
        PG8_STAGE(PG8_SB(1, 0), cB + kstep, voffB); PG8_STAGE(PG8_SA(1, 0), cA + kstep, voffA); PG8_STAGE(PG8_SB(1, 1), cB + hstep + kstep, voffB);
        PG8_WAIT_V(6); PG8_BAR;
    } else {
        PG8_STAGE(PG8_SB(0, 0), cB, voffB); PG8_STAGE(PG8_SA(0, 0), cA, voffA); PG8_STAGE(PG8_SB(0, 1), cB + hstep, voffB); PG8_STAGE(PG8_SA(0, 1), cA + hstepA, voffA);
        if (wr == 1) PG8_BAR;
        PG8_WAIT_V(4); PG8_BAR;
        PG8_STAGE(PG8_SB(1, 0), cB + kstep, voffB); PG8_STAGE(PG8_SA(1, 0), cA + kstep, voffA); PG8_STAGE(PG8_SB(1, 1), cB + hstep + kstep, voffB);
        PG8_WAIT_V(6); PG8_BAR;
    }
    for (;;) {
        const bool has_next = S.next(ui + 1, nxt);
        const char* nA = has_next ? (const char*)g.A + (size_t)nxt.pm * tstepA : cA; const char* nB = has_next ? (const char*)g.Bt + (size_t)nxt.pn * tstep : cB;
        for (int t = 0; t < nt; t += 2) {
            const bool last = (t == nt - 2);
            const char* a1 = cA + (size_t)(t + 1) * kstep;
            const char* a2 = last ? nA : cA + (size_t)(t + 2) * kstep; const char* b2 = last ? nB : cB + (size_t)(t + 2) * kstep;
            const char* a3 = a2 + kstep; const char* b3 = b2 + kstep;
            if (last && has_next) S.a_ready(nxt);
            if constexpr (SP2) {
            PG8_LDB(B0, 0, 0); PG8_LDB(B1, 0, 1); PG8_SCHED; PG8_LDA(At, 0, 0); PG8_STAGE(PG8_SA(1, 1), a1 + hstepA, voffA);
            PG8_WAIT_V(8); PG8_WAIT_L(0); PG8_BAR; PG8_MMA(0, 0, At, B0); PG8_MMA(0, 1, At, B1); PG8_BAR; PG8_SCHED;
            PG8_LDA(At, 0, 1); PG8_STAGE(PG8_SB(0, 0), b2, voffB); PG8_STAGE(PG8_SB(0, 1), b2 + hstep, voffB); PG8_STAGE(PG8_SA(0, 0), a2, voffA);
            PG8_WAIT_V(8); PG8_WAIT_L(0); PG8_BAR; PG8_MMA(1, 0, At, B0); PG8_MMA(1, 1, At, B1); PG8_BAR; PG8_SCHED;
            PG8_LDB(B0, 1, 0); PG8_LDB(B1, 1, 1); PG8_SCHED; PG8_LDA(At, 1, 0); PG8_STAGE(PG8_SA(0, 1), a2 + hstepA, voffA);
            PG8_WAIT_V(8); PG8_WAIT_L(0); PG8_BAR; PG8_MMA(0, 0, At, B0); PG8_MMA(0, 1, At, B1); PG8_BAR; PG8_SCHED;
            PG8_LDA(At, 1, 1); PG8_STAGE(PG8_SB(1, 0), b3, voffB); PG8_STAGE(PG8_SB(1, 1), b3 + hstep, voffB); PG8_STAGE(PG8_SA(1, 0), a3, voffA);
            PG8_WAIT_V(8); PG8_WAIT_L(0); PG8_BAR; PG8_MMA(1, 0, At, B0); PG8_MMA(1, 1, At, B1); PG8_BAR; PG8_SCHED;
            } else {
            PG8_LDB(B0, 0, 0); PG8_SCHED; PG8_LDA(At, 0, 0); PG8_STAGE(PG8_SA(1, 1), a1 + hstepA, voffA);
            PG8_WAIT_L(8); PG8_BAR; PG8_WAIT_L(0); PG8_MMA(0, 0, At, B0); PG8_BAR; PG8_SCHED;
            PG8_LDB(B1, 0, 1); PG8_STAGE(PG8_SB(0, 0), b2, voffB);
            PG8_BAR; PG8_WAIT_L(0); PG8_MMA(0, 1, At, B1); PG8_BAR;
            PG8_LDA(At, 0, 1); PG8_STAGE(PG8_SA(0, 0), a2, voffA);
            PG8_BAR; PG8_WAIT_L(0); PG8_MMA(1, 0, At, B0); PG8_BAR; PG8_SCHED;
            PG8_STAGE(PG8_SB(0, 1), b2 + hstep, voffB);
            PG8_WAIT_V(6); PG8_BAR; PG8_MMA(1, 1, At, B1); PG8_BAR;
            PG8_LDB(B0, 1, 0); PG8_SCHED; PG8_LDA(At, 1, 0); PG8_STAGE(PG8_SA(0, 1), a2 + hstepA, voffA);
            PG8_WAIT_L(8); PG8_BAR; PG8_WAIT_L(0); PG8_MMA(0, 0, At, B0); PG8_BAR; PG8_SCHED;
            PG8_LDB(B1, 1, 1); PG8_STAGE(PG8_SB(1, 0), b3, voffB);
            PG8_BAR; PG8_WAIT_L(0); PG8_MMA(0, 1, At, B1); PG8_BAR;
            PG8_LDA(At, 1, 1); PG8_STAGE(PG8_SA(1, 0), a3, voffA);
            PG8_BAR; PG8_WAIT_L(0); PG8_MMA(1, 0, At, B0); PG8_BAR; PG8_SCHED;
            PG8_STAGE(PG8_SB(1, 1), b3 + hstep, voffB);
            PG8_WAIT_V(6); PG8_BAR; PG8_MMA(1, 1, At, B1); PG8_BAR;
            }
        }
        if constexpr (ALIGN_EPI) { if (wr == 0) PG8_BAR; }
        if constexpr (!Epi::AFTER_DRAIN) { E(acc, cur, wr, wc, fr, fq); S.done(cur); }
        if (!has_next) break;
#pragma unroll
        for (int a = 0; a < 2; ++a)
#pragma unroll
            for (int b = 0; b < 2; ++b)
#pragma unroll
                for (int m = 0; m < 4; ++m)
#pragma unroll
                    for (int n = 0; n < 2; ++n) acc[a][b][m][n] = (f32x4){0.f, 0.f, 0.f, 0.f};
        cur = nxt; cA = nA; cB = nB; ++ui;
        if constexpr (ALIGN_EPI) { if (wr == 1) PG8_BAR; }
    }
    PG8_WAIT_V(0);
    if constexpr (!ALIGN_EPI) { if (wr == 0) PG8_BAR; }
    PG8_BAR;
    if constexpr (Epi::AFTER_DRAIN) { E.fused(acc, cur, wr, wc, fr, fq, lds, wid, lane); S.done(cur); }
#undef PG8_SA
#undef PG8_SB
#undef PG8_STAGE
#undef PG8_LDA
#undef PG8_LDB
#undef PG8_MMA
#undef PG8_WAIT_V
#undef PG8_WAIT_L
#undef PG8_BAR
#undef PG8_SCHED
}
}

constexpr int NWAVES = 8;
constexpr int M = 16384, SEQ = 4096, NBATCH = 4, DEPTH = 4, D = 1024, DFF = 2816, NGU = 2 * DFF, NZ = 3584, NZSRC = 3488, PLED = 256;
constexpr int ZC_U = 512, ZC_V = 768, ZC_HQ = 1024, ZC_HF = 1536, ZC_HI = 2048, ZC_HG = 2304, ZC_RQ = 2560, ZC_RK = 2816, ZC_RV = 3072, ZC_RG = 3328;
constexpr int QC_Q = 0, QC_KN = 384, QC_V = 640, QC_KR = 896;
constexpr size_t MiB = 1u << 20;
constexpr size_t WS_CTL = 0, CTL_ZERO_BYTES = 1 * MiB;
constexpr size_t WS_WGU = 1 * MiB;
constexpr size_t WS_WD = WS_WGU + 88 * MiB;
constexpr size_t WS_WIN = WS_WD + 44 * MiB;
constexpr size_t WS_WMLA = WS_WIN + 28 * MiB;
constexpr size_t WS_WOUT = WS_WMLA + 4 * MiB;
constexpr size_t WS_WPG = WS_WOUT + 8 * MiB;
constexpr size_t WS_WPP = WS_WPG + 8 * MiB;
constexpr size_t WS_WSG = WS_WPP + 2 * MiB;
constexpr size_t WS_B0 = WS_WSG + 1 * MiB;
constexpr size_t WS_B1 = WS_B0 + 32 * MiB;
constexpr size_t WS_ZH = WS_B1 + 32 * MiB;
constexpr size_t WS_QKV = WS_ZH + 112 * MiB;
constexpr size_t WS_PBF = WS_QKV + 32 * MiB;
constexpr size_t WS_HST = WS_PBF + 8 * MiB;
constexpr size_t WS_HDC = WS_HST + 32 * MiB;
constexpr size_t WS_RST = WS_HDC + 1 * MiB;
constexpr size_t WS_ROPE = WS_RST + 8 * MiB;
constexpr size_t WS_SSQ = WS_ROPE + 6 * MiB;
constexpr size_t WS_SSQ2 = WS_SSQ + 2 * MiB;
constexpr size_t WS_END = WS_SSQ2 + 1 * MiB;
constexpr int CW_TMO = 0, CW_BAR = 4096;
constexpr int MAX_LAUNCHES = 16;
constexpr int RING_OFF = 0, RING_BYTES = 131072, LDSCTL_OFF = RING_BYTES, MISC_OFF = LDSCTL_OFF + 320, LDS_BYTES = 147456;

#define GAS __attribute__((address_space(1)))
#define LAS __attribute__((address_space(3)))
typedef unsigned short bf16;
typedef unsigned v4u __attribute__((ext_vector_type(4)));
typedef unsigned v2u __attribute__((ext_vector_type(2)));
typedef float f32x4 __attribute__((ext_vector_type(4)));
typedef short bf16x8 __attribute__((ext_vector_type(8)));
typedef GAS unsigned gu32;
#define RLX_AGENT __ATOMIC_RELAXED, __HIP_MEMORY_SCOPE_AGENT
#define LDS_WAIT() asm volatile("s_waitcnt lgkmcnt(0)" ::: "memory")
#define VM_WAIT() asm volatile("s_waitcnt vmcnt(0)" ::: "memory")
__device__ __forceinline__ unsigned f2bf(float f) { unsigned u = __builtin_bit_cast(unsigned, f); return (u + 0x7fffu + ((u >> 16) & 1u)) >> 16; }
__device__ __forceinline__ unsigned pk2(float lo, float hi) { return f2bf(lo) | (f2bf(hi) << 16); }
__device__ __forceinline__ float bf2f(bf16 v) { return __uint_as_float((unsigned)v << 16); }
__device__ __forceinline__ float wave_sum(float v) {
#pragma unroll
    for (int o = 1; o < 64; o <<= 1) v += __shfl_xor(v, o);
    return v;
}
__device__ __forceinline__ float wave_max(float v) {
#pragma unroll
    for (int o = 1; o < 64; o <<= 1) v = fmaxf(v, __shfl_xor(v, o));
    return v;
}
__device__ const double ROPE_INVT[48] = {
1.59154943091895346e-01, 8.94994016088910133e-02, 5.03292121044870353e-02, 2.83021958306233987e-02, 1.59154943091895339e-02, 8.94994016088910237e-03, 5.03292121044870370e-03, 2.83021958306233987e-03, 1.59154943091895356e-03, 8.94994016088910237e-04, 5.03292121044870326e-04, 2.83021958306233954e-04, 1.59154943091895351e-04, 8.94994016088910182e-05, 5.03292121044870354e-05, 2.83021958306233961e-05,
1.59154943091895346e-01, 1.19349370211248862e-01, 8.94994016088910133e-02, 6.71150830052272551e-02, 5.03292121044870353e-02, 3.77415847174197711e-02, 2.83021958306233987e-02, 2.12236527647776604e-02, 1.59154943091895339e-02, 1.19349370211248862e-02, 8.94994016088910237e-03, 6.71150830052272534e-03, 5.03292121044870370e-03, 3.77415847174197719e-03, 2.83021958306233987e-03, 2.12236527647776622e-03, 1.59154943091895356e-03, 1.19349370211248849e-03, 8.94994016088910237e-04, 6.71150830052272599e-04, 5.03292121044870326e-04, 3.77415847174197741e-04, 2.83021958306233954e-04, 2.12236527647776605e-04, 1.59154943091895351e-04, 1.19349370211248862e-04, 8.94994016088910182e-05, 6.71150830052272545e-05, 5.03292121044870354e-05, 3.77415847174197768e-05, 2.83021958306233961e-05, 2.12236527647776592e-05 };

#define XB_TMO      128
#define XB_XCNT(j)  (256  + 64 * (j))
#define XB_XSUB(j)  (1280 + 64 * (j))
#define XB_XGEN(j)  (2304 + 64 * (j))
#define XB_TOP      3328
#define XB_TOPGEN   3392
#define XCD_BAR_WORDS 3456
#define XB_SPIN_CAP (1u << 18)

__device__ __forceinline__ unsigned xb_ld(unsigned* p)              { return __hip_atomic_load(p, __ATOMIC_RELAXED, __HIP_MEMORY_SCOPE_AGENT); }
__device__ __forceinline__ unsigned xb_add(unsigned* p, unsigned v) { return __hip_atomic_fetch_add(p, v, __ATOMIC_RELAXED, __HIP_MEMORY_SCOPE_AGENT); }
__device__ __forceinline__ unsigned xb_xcc_id() { return (unsigned)__builtin_amdgcn_s_getreg((3 << 11) | 20) & 0xFu; }
#define XB_SPIN(cond, bar) do { unsigned _sp = 0; while (cond) { __builtin_amdgcn_s_sleep(1); \
    if ((++_sp & 255u) == 0u) { if (xb_ld(&(bar)[XB_TMO])) break; if (_sp > XB_SPIN_CAP) { atomicAdd(&(bar)[XB_TMO], 1u); break; } } } } while (0)

struct XcdBarrier {
    unsigned* bar; unsigned x;
    volatile LAS unsigned* st;
};

__device__ __forceinline__ XcdBarrier xcd_barrier_post(unsigned* bar, volatile LAS unsigned* st) {
    XcdBarrier b; b.bar = bar; b.x = xb_xcc_id(); b.st = st;
    if (threadIdx.x == 0) (void)xb_add(&bar[XB_XCNT(b.x)], 1u);
    return b;
}
__device__ __forceinline__ void xcd_barrier_complete(unsigned* bar, unsigned x, unsigned& nloc, unsigned& nx) {
    const unsigned G = gridDim.x * gridDim.y * gridDim.z;
    unsigned sum, cnt, mine, sp = 0u;
    for (;;) {
        sum = 0u; cnt = 0u; mine = 0u;
#pragma unroll
        for (unsigned j = 0; j < 16; ++j) { const unsigned c = xb_ld(&bar[XB_XCNT(j)]); sum += c; cnt += (c > 0u) ? 1u : 0u; mine = (j == x) ? c : mine; }
        if (sum == G) break;
        __builtin_amdgcn_s_sleep(1);
        if ((++sp & 255u) == 0u) { if (xb_ld(&bar[XB_TMO])) break; if (sp > XB_SPIN_CAP) { atomicAdd(&bar[XB_TMO], 1u); break; } }
    }
    nloc = mine > 0u ? mine : 1u; nx = cnt > 0u ? cnt : 1u;
}

__device__ __forceinline__ void xcd_barrier(const XcdBarrier& b) {
    asm volatile("s_waitcnt vmcnt(0)" ::: "memory");
    __syncthreads();
    if (threadIdx.x == 0) {
        unsigned* bar = b.bar;
        __builtin_amdgcn_s_waitcnt(0);
        unsigned nloc = b.st[0], nx = b.st[1];
        if (nloc == 0u) { xcd_barrier_complete(bar, b.x, nloc, nx); b.st[0] = nloc; b.st[1] = nx; }
        const unsigned old = xb_add(&bar[XB_XSUB(b.x)], 1u);
        const unsigned gen = old / nloc;
        if (old + 1u == (gen + 1u) * nloc) {
            __builtin_amdgcn_fence(__ATOMIC_RELEASE, "agent");
            asm volatile("s_waitcnt vmcnt(0)" ::: "memory");
            const unsigned og = xb_add(&bar[XB_TOP], 1u);
            const unsigned tg = og / nx;
            if (og + 1u == (tg + 1u) * nx) xb_add(&bar[XB_TOPGEN], 1u);
            else XB_SPIN(xb_ld(&bar[XB_TOPGEN]) == tg, bar);
            __builtin_amdgcn_fence(__ATOMIC_ACQUIRE, "agent");
            xb_add(&bar[XB_XGEN(b.x)], 1u);
            asm volatile("s_waitcnt vmcnt(0)" ::: "memory");
        } else {
            XB_SPIN(xb_ld(&bar[XB_XGEN(b.x)]) == gen, bar);
            __builtin_amdgcn_fence(__ATOMIC_ACQUIRE, "agent");
            asm volatile("s_waitcnt vmcnt(0)" ::: "memory");
        }
    }
    __syncthreads();
}

enum { IN_X = 0, IN_P, IN_POS, IN_F1N, IN_F1G, IN_F1U, IN_F1D, IN_MIXN, IN_WIN, IN_QN, IN_WUQ, IN_KVN, IN_WUKV, IN_SGLN, IN_SGW, IN_SGB, IN_HGLB, IN_HGN, IN_RETN, IN_WOUT,
       IN_F2N, IN_F2G, IN_F2U, IN_F2D, IN_PLEN, IN_PLEP, IN_PLEG, IN_FINN, N_IN };
struct Args { const float* in[N_IN]; float* out; unsigned char* ws; int ph_lo, ph_hi, li, pad; };
constexpr int N_PHASES = 42;

__device__ __forceinline__ void conv_item(const float* W, int N, const float* gain, bf16* WT, int ldk, int drow, int k0, int n0, LAS float* scr, int lane) {
#pragma unroll 8
    for (int i = 0; i < 32; ++i) { const int kk = 2 * i + (lane >> 5); float v = W[(size_t)(k0 + kk) * N + n0 + (lane & 31)]; if (gain) v *= gain[k0 + kk]; scr[kk * 33 + (lane & 31)] = v; }
    LDS_WAIT(); asm volatile("" ::: "memory");
    const int c = lane & 7;
#pragma unroll
    for (int j = 0; j < 4; ++j) { const int n = (lane >> 3) + 8 * j; const LAS float* s = scr + (8 * c) * 33 + n;
        v4u o; o.x = pk2(s[0 * 33], s[1 * 33]); o.y = pk2(s[2 * 33], s[3 * 33]); o.z = pk2(s[4 * 33], s[5 * 33]); o.w = pk2(s[6 * 33], s[7 * 33]);
        *(v4u*)(WT + (size_t)(drow + n) * ldk + k0 + 8 * c) = o; }
    LDS_WAIT(); asm volatile("" ::: "memory");
}
constexpr int IT_FF = 1408, IT_WIN = 16 * 109, IT_SQ = 16 * 32, IT_PP = 4 * 32, IT_LAYER = 6 * IT_FF + IT_WIN + 2 * IT_SQ + IT_PP;

__device__ __forceinline__ void prologue(const Args& a, LAS unsigned char* lds, int tid, int lane, int wave, int vcu, int G) {
    unsigned char* ws = a.ws;
    bf16* Wgu = (bf16*)(ws + WS_WGU); bf16* Wd = (bf16*)(ws + WS_WD); bf16* Win = (bf16*)(ws + WS_WIN); bf16* Wmla = (bf16*)(ws + WS_WMLA);
    bf16* Wout = (bf16*)(ws + WS_WOUT); bf16* Wpg = (bf16*)(ws + WS_WPG); bf16* Wpp = (bf16*)(ws + WS_WPP); bf16* Wsg = (bf16*)(ws + WS_WSG);
    LAS float* scr = (LAS float*)(lds + RING_OFF + wave * 16384);
    const int gw = vcu * NWAVES + wave, NGW = G * NWAVES;
    const int gt = (vcu * NWAVES + wave) * 64 + lane, NGT = NGW * 64;
    for (int it = gw; it < DEPTH * IT_LAYER; it += NGW) {
        const int l = it / IT_LAYER; int r = it % IT_LAYER;
        if (r < 6 * IT_FF) { const int f = r / IT_FF; r -= f * IT_FF; const int second = f / 3, kind = f - 3 * second;
            if (kind < 2) { const int kb = r / 88, nb = r - 88 * kb, n0 = 32 * nb;
                const float* W = (second ? (kind ? a.in[IN_F2U] : a.in[IN_F2G]) : (kind ? a.in[IN_F1U] : a.in[IN_F1G])) + (size_t)l * D * DFF;
                const float* gain = (second ? a.in[IN_F2N] : a.in[IN_F1N]) + l * D;
                conv_item(W, DFF, gain, Wgu + (size_t)(2 * l + second) * NGU * D, D, (n0 >> 7) * 256 + (n0 & 127) + 128 * kind, 64 * kb, n0, scr, lane); }
            else { const int kb = r / 32, nb = r - 32 * kb;
                const float* W = (second ? a.in[IN_F2D] : a.in[IN_F1D]) + (size_t)l * DFF * D;
                conv_item(W, D, nullptr, Wd + (size_t)(2 * l + second) * D * DFF, DFF, 32 * nb, 64 * kb, 32 * nb, scr, lane); }
            continue; }
        r -= 6 * IT_FF;
        if (r < IT_WIN) { const int kb = r / 109, nb = r - 109 * kb, n0 = 32 * nb;
            conv_item(a.in[IN_WIN] + (size_t)l * D * NZSRC, NZSRC, a.in[IN_MIXN] + l * D, Win + (size_t)l * NZ * D, D, n0 < 416 ? n0 : n0 + 96, 64 * kb, n0, scr, lane); continue; }
        r -= IT_WIN;
        if (r < IT_SQ) { const int kb = r / 32, nb = r - 32 * kb; conv_item(a.in[IN_WOUT] + (size_t)l * D * D, D, nullptr, Wout + (size_t)l * D * D, D, 32 * nb, 64 * kb, 32 * nb, scr, lane); continue; }
        r -= IT_SQ;
        if (r < IT_SQ) { const int kb = r / 32, nb = r - 32 * kb; conv_item(a.in[IN_PLEG] + (size_t)l * D * D, D, a.in[IN_PLEN] + l * D, Wpg + (size_t)l * D * D, D, 32 * nb, 64 * kb, 32 * nb, scr, lane); continue; }
        r -= IT_SQ;
        { const int kb = r / 32, nb = r - 32 * kb; conv_item(a.in[IN_PLEP] + (size_t)l * PLED * D, D, nullptr, Wpp + (size_t)l * D * PLED, PLED, 32 * nb, 64 * kb, 32 * nb, scr, lane); }
    }
    for (int i = gt; i < DEPTH * 96 * (D / 8); i += NGT) { const int l = i / (96 * 128), r = i - l * 96 * 128; const int row = 416 + r / 128, c8 = r & 127;
        *(v4u*)(Win + ((size_t)l * NZ + row) * D + 8 * c8) = (v4u){0u, 0u, 0u, 0u}; }
    for (int i = gt; i < DEPTH * 1024 * 64; i += NGT) { const int l = i >> 16, r = i & 65535, n = r >> 6, k8 = (r & 63) * 8;
        const float* wuq = a.in[IN_WUQ] + (size_t)l * 256 * 384; const float* wukv = a.in[IN_WUKV] + (size_t)l * 128 * 512;
        const float* qg = a.in[IN_QN] + l * 256; const float* kvg = a.in[IN_KVN] + l * 128;
        float v[8];
#pragma unroll
        for (int j = 0; j < 8; ++j) { const int k = k8 + j; float x = 0.f;
            if (n < 384) { if (k < 256) x = wuq[(size_t)k * 384 + n] * qg[k]; }
            else if (n < 896) { if (k >= 256 && k < 384) { const int nn = (n - 384) & 255, hh = nn >> 6, jj = (nn & 63) + (n >= 640 ? 64 : 0); x = wukv[(size_t)(k - 256) * 512 + hh * 128 + jj] * kvg[k - 256]; } }
            else if (n < 928) { if (k == 384 + (n - 896)) x = 1.0f; }
            v[j] = x; }
        v4u o; o.x = pk2(v[0], v[1]); o.y = pk2(v[2], v[3]); o.z = pk2(v[4], v[5]); o.w = pk2(v[6], v[7]);
        *(v4u*)(Wmla + ((size_t)l * 1024 + n) * 512 + k8) = o; }
    for (int i = gt; i < DEPTH * 4 * 128 * 128 / 2; i += NGT) { const int e = 2 * i, s = e & 127, t = (e >> 7) & 127; const float* w = a.in[IN_SGW];
        const float x0 = s <= t ? w[e] : 0.f, x1 = (s + 1) <= t ? w[e + 1] : 0.f; ((unsigned*)Wsg)[i] = pk2(x0, x1); }
    { const float* x = a.in[IN_X]; bf16* B0 = (bf16*)(ws + WS_B0); float* ssq = (float*)(ws + WS_SSQ);
      for (int m = gw; m < M; m += NGW) { const f32x4* xr = (const f32x4*)(x + (size_t)m * D) + lane; unsigned long long* o8 = (unsigned long long*)(B0 + (size_t)m * D) + lane; float t0, t1, t2, t3;
          { const f32x4 v = xr[0];   t0 = wave_sum(pg8::dot4(v)); o8[0]   = (unsigned long long)pk2(v[0], v[1]) | ((unsigned long long)pk2(v[2], v[3]) << 32); }
          { const f32x4 v = xr[64];  t1 = wave_sum(pg8::dot4(v)); o8[64]  = (unsigned long long)pk2(v[0], v[1]) | ((unsigned long long)pk2(v[2], v[3]) << 32); }
          { const f32x4 v = xr[128]; t2 = wave_sum(pg8::dot4(v)); o8[128] = (unsigned long long)pk2(v[0], v[1]) | ((unsigned long long)pk2(v[2], v[3]) << 32); }
          { const f32x4 v = xr[192]; t3 = wave_sum(pg8::dot4(v)); o8[192] = (unsigned long long)pk2(v[0], v[1]) | ((unsigned long long)pk2(v[2], v[3]) << 32); }
          if (lane < 16) { float val = 0.f; if (lane == 0) val = t0; if (lane == 4) val = t1; if (lane == 8) val = t2; if (lane == 12) val = t3; ssq[(size_t)m * 16 + lane] = val; } } }
    { const int* pos = (const int*)a.in[IN_POS]; float* mcs = (float*)(ws + WS_ROPE); float* msn = mcs + (size_t)M * 16; float* rcs = msn + (size_t)M * 16; float* rsn = rcs + (size_t)M * 32;
      for (int i = gt; i < M * 48; i += NGT) { const int m = i / 48, f = i - 48 * m; const double turns = (double)pos[m] * ROPE_INVT[f]; const float fr = (float)(turns - __builtin_rint(turns));
          const float c = __builtin_amdgcn_cosf(fr), s = __builtin_amdgcn_sinf(fr);
          if (f < 16) { mcs[(size_t)m * 16 + f] = c; msn[(size_t)m * 16 + f] = s; } else { rcs[(size_t)m * 32 + f - 16] = c; rsn[(size_t)m * 32 + f - 16] = s; } } }
}

#define V_WGU ((bf16*)(ws + WS_WGU))
#define V_WD ((bf16*)(ws + WS_WD))
#define V_WIN ((bf16*)(ws + WS_WIN))
#define V_WMLA ((bf16*)(ws + WS_WMLA))
#define V_WOUT ((bf16*)(ws + WS_WOUT))
#define V_WPG ((bf16*)(ws + WS_WPG))
#define V_WPP ((bf16*)(ws + WS_WPP))
#define V_B0 ((bf16*)(ws + WS_B0))
#define V_B1 ((bf16*)(ws + WS_B1))
#define V_ZH ((bf16*)(ws + WS_ZH))
#define V_QKV ((bf16*)(ws + WS_QKV))
#define V_PBF ((bf16*)(ws + WS_PBF))
#define V_SSQ0 ((float*)(ws + WS_SSQ))
#define V_SSQ1 ((float*)(ws + WS_SSQ) + (size_t)M * 16)
#define V_SSQQ ((float*)(ws + WS_SSQ2))
#define V_SSQKV ((float*)(ws + WS_SSQ2) + (size_t)M * 4)
#define V_MCS ((float*)(ws + WS_ROPE))
#define V_MSN ((float*)(ws + WS_ROPE) + (size_t)M * 16)
__global__ void __launch_bounds__(NWAVES * 64, 2) mk_fwd(Args a) {
    extern __shared__ __attribute__((aligned(16))) unsigned char lds_raw[];
    LAS unsigned char* lds = (LAS unsigned char*)lds_raw;
    volatile LAS unsigned* MISC = (volatile LAS unsigned*)(lds + MISC_OFF);
    const int tid = threadIdx.x, lane = tid & 63, wave = __builtin_amdgcn_readfirstlane(tid >> 6);
    const int G = gridDim.x; const int bx = blockIdx.x; const int vcu = (G % 8 == 0) ? (bx % 8) * (G / 8) + bx / 8 : bx;
    unsigned char* ws = a.ws;
    gu32* ctl = (gu32*)(ws + WS_CTL);
    for (int u = tid; u < (LDS_BYTES - LDSCTL_OFF) / 4; u += NWAVES * 64) ((LAS unsigned*)(lds + LDSCTL_OFF))[u] = 0u;
    __syncthreads();
    XcdBarrier bar = xcd_barrier_post((unsigned*)(ctl + CW_BAR) + a.li * XCD_BAR_WORDS, MISC + 8);
    const int lo = a.ph_lo, hi = a.ph_hi;
#define IN(k) (lo <= (k) && (k) < hi)
#define SEAM(k) do { if (IN(k) && IN((k) + 1)) xcd_barrier(bar); } while (0)
    float* out = a.out;

    if (IN(0)) { prologue(a, lds, tid, lane, wave, vcu, G); }
    SEAM(0);

    for (int hl = 0; hl < 2 * DEPTH; ++hl) {
        const int l = hl >> 1, second = hl & 1, pb = 1 + 10 * l + 7 * second;
        if (IN(pb)) {
            pg8::Gemm g{(second == 0 && l > 0) ? V_B1 : V_B0, V_WGU + (size_t)(2 * l + second) * NGU * D, M, NGU, D, D}; pg8::StaticOrder S; S.init(M, NGU, G, bx);
            pg8::EpiSwiGLU E{V_ZH, V_SSQ0};
            pg8::gemm_phase<pg8::EpiSwiGLU, pg8::StaticOrder, true, true>(lds + RING_OFF, g, S, E);
        }
        SEAM(pb);
        if (IN(pb + 1)) {
            pg8::Gemm g{V_ZH, V_WD + (size_t)(2 * l + second) * D * DFF, M, D, DFF, DFF}; pg8::StaticOrder S; S.init(M, D, G, bx);
            pg8::EpiRes E{(hl == 0) ? a.in[IN_X] : (const float*)out, out, V_B0, V_SSQ1, 0.5f};
            pg8::gemm_phase<pg8::EpiRes, pg8::StaticOrder, false, true>(lds + RING_OFF, g, S, E);
        }
        SEAM(pb + 1);
        if (!second) {
            if (IN(pb + 2)) {
                pg8::Gemm g{V_B0, V_WIN + (size_t)l * NZ * D, M, NZ, D, D}; pg8::StaticOrder S; S.init(M, NZ, G, bx);
                pg8::EpiZ E{V_ZH, V_SSQ1, V_SSQQ, V_SSQKV};
                pg8::gemm_phase<pg8::EpiZ, pg8::StaticOrder, true, true>(lds + RING_OFF, g, S, E);
                const f32x4* ps = (const f32x4*)(a.in[IN_P] + (size_t)l * M * PLED); v2u* pd = (v2u*)V_PBF;
                for (int i = bx * (NWAVES * 64) + tid; i < M * PLED / 4; i += G * NWAVES * 64) { const f32x4 v = ps[i]; v2u o; o.x = pk2(v[0], v[1]); o.y = pk2(v[2], v[3]); pd[i] = o; }
            }
            SEAM(pb + 2);
            if (IN(pb + 3)) {
                pg8::Gemm g{V_ZH, V_WMLA + (size_t)l * 1024 * 512, M, 1024, 512, NZ}; pg8::StaticOrder S; S.init(M, 1024, G, bx);
                pg8::EpiMla E{V_QKV, V_SSQQ, V_SSQKV, V_MCS, V_MSN};
                pg8::gemm_phase<pg8::EpiMla, pg8::StaticOrder, false, true>(lds + RING_OFF, g, S, E);
            }
            SEAM(pb + 3);
            if (IN(pb + 4)) { }
            SEAM(pb + 4);
            if (IN(pb + 5)) { }
            SEAM(pb + 5);
            if (IN(pb + 6)) {
                { pg8::Gemm g{V_B1, V_WOUT + (size_t)l * D * D, M, D, D, D}; pg8::StaticOrder S; S.init(M, D, G, bx);
                  pg8::EpiRes E{out, out, V_B0, V_SSQ0, 1.0f};
                  pg8::gemm_phase<pg8::EpiRes, pg8::StaticOrder, false, true>(lds + RING_OFF, g, S, E); }
                { pg8::Gemm g{V_PBF, V_WPP + (size_t)l * D * PLED, M, D, PLED, PLED}; pg8::StaticOrder S; S.init(M, D, G, bx);
                  pg8::EpiPlain E{V_QKV, D};
                  pg8::gemm_phase<pg8::EpiPlain, pg8::StaticOrder, false, true>(lds + RING_OFF, g, S, E); }
            }
            SEAM(pb + 6);
        } else {
            if (IN(pb + 2)) {
                pg8::Gemm g{V_B0, V_WPG + (size_t)l * D * D, M, D, D, D}; pg8::StaticOrder S; S.init(M, D, G, bx);
                pg8::EpiPle E{out, V_QKV, V_B1, V_SSQ1, V_SSQ0};
                pg8::gemm_phase<pg8::EpiPle, pg8::StaticOrder, false, true>(lds + RING_OFF, g, S, E);
            }
            SEAM(pb + 2);
        }
    }
    if (IN(41)) {
        const float* gfin = a.in[IN_FINN];
        for (int m = vcu * NWAVES + wave; m < M; m += G * NWAVES) { f32x4* hr = (f32x4*)(out + (size_t)m * D) + lane; const float r = pg8::row_rstd(V_SSQ0, m);
#pragma unroll
            for (int j = 0; j < 4; ++j) { const f32x4 v = hr[64 * j]; const f32x4 gv = *((const f32x4*)gfin + lane + 64 * j); hr[64 * j] = v * r * gv; } }
    }
#undef IN
#undef SEAM
}

#ifndef MK_MODE
#define MK_MODE 1
#endif
#if MK_MODE != 0
__device__ __forceinline__ float gelu_exact(float x) { return 0.5f * x * (1.0f + erff(x * 0.70710678118654752f)); }
__device__ __forceinline__ float silu_f(float x) { return x / (1.0f + __expf(-x)); }
__global__ void __launch_bounds__(256) nv_mla(const bf16* QKV, bf16* Y) {
    const int lane = threadIdx.x & 63, gw = blockIdx.x * 4 + (threadIdx.x >> 6); const int t = gw & (SEQ - 1), bh = gw >> 12, b = bh >> 2, h = bh & 3;
    const size_t m = (size_t)b * SEQ + t;
    float q[96];
#pragma unroll
    for (int d = 0; d < 96; ++d) q[d] = bf2f(QKV[m * 1024 + QC_Q + 96 * h + d]);
    float mi = -INFINITY, li = 0.f, acc[64];
#pragma unroll
    for (int e = 0; e < 64; ++e) acc[e] = 0.f;
    for (int s = lane; s <= t; s += 64) { const bf16* kr = QKV + ((size_t)b * SEQ + s) * 1024; float dot = 0.f;
#pragma unroll
        for (int d = 0; d < 64; ++d) dot += q[d] * bf2f(kr[QC_KN + 64 * h + d]);
#pragma unroll
        for (int d = 0; d < 32; ++d) dot += q[64 + d] * bf2f(kr[QC_KR + d]);
        const float mn = fmaxf(mi, dot), corr = exp2f(mi - mn), p = exp2f(dot - mn); li = li * corr + p; mi = mn;
#pragma unroll
        for (int e = 0; e < 64; ++e) acc[e] = acc[e] * corr + p * bf2f(kr[QC_V + 64 * h + e]); }
    const float mg = wave_max(mi), w = (mi == -INFINITY) ? 0.f : exp2f(mi - mg); const float L = wave_sum(li * w); float res = 0.f;
#pragma unroll
    for (int e = 0; e < 64; ++e) { const float v = wave_sum(acc[e] * w); if (lane == e) res = v; }
    Y[m * 1024 + 64 * h + lane] = (bf16)f2bf(res / L);
}
__global__ void __launch_bounds__(256) nv_ret_prep(const bf16* Z, const float* rcs, const float* rsn, float* QR, float* KR) {
    const int i = blockIdx.x * 256 + threadIdx.x; if (i >= M * 128) return; const int m = i >> 7, r = i & 127, h = r >> 5, j = r & 31;
    const float c = rcs[(size_t)m * 32 + j], s = rsn[(size_t)m * 32 + j];
    { const float x1 = bf2f(Z[(size_t)m * NZ + ZC_RQ + 64 * h + j]), x2 = bf2f(Z[(size_t)m * NZ + ZC_RQ + 64 * h + 32 + j]); QR[(size_t)m * 256 + 64 * h + j] = x1 * c - x2 * s; QR[(size_t)m * 256 + 64 * h + 32 + j] = x1 * s + x2 * c; }
    { const float x1 = bf2f(Z[(size_t)m * NZ + ZC_RK + 64 * h + j]), x2 = bf2f(Z[(size_t)m * NZ + ZC_RK + 64 * h + 32 + j]); KR[(size_t)m * 256 + 64 * h + j] = 0.125f * (x1 * c - x2 * s); KR[(size_t)m * 256 + 64 * h + 32 + j] = 0.125f * (x1 * s + x2 * c); }
}
__global__ void __launch_bounds__(256) nv_ret(const bf16* Z, const float* QR, const float* KR, const float* normg, bf16* Y) {
    const int lane = threadIdx.x & 63, gw = blockIdx.x * 4 + (threadIdx.x >> 6); const int t = gw & (SEQ - 1), bh = gw >> 12, b = bh >> 2, h = bh & 3;
    const size_t m = (size_t)b * SEQ + t; const float lg2 = log2f(1.0f - exp2f(-(5.0f + (float)h)));
    float q[64], acc[64];
#pragma unroll
    for (int d = 0; d < 64; ++d) { q[d] = QR[m * 256 + 64 * h + d]; acc[d] = 0.f; }
    for (int s = lane; s <= t; s += 64) { const size_t ms = (size_t)b * SEQ + s; float dot = 0.f;
#pragma unroll
        for (int d = 0; d < 64; ++d) dot += q[d] * KR[ms * 256 + 64 * h + d];
        const float p = dot * exp2f((float)(t - s) * lg2);
#pragma unroll
        for (int e = 0; e < 64; ++e) acc[e] += p * bf2f(Z[ms * NZ + ZC_RV + 64 * h + e]); }
    float o = 0.f;
#pragma unroll
    for (int e = 0; e < 64; ++e) { const float v = wave_sum(acc[e]); if (lane == e) o = v; }
    const float mean = wave_sum(o) * (1.0f / 64.0f), oc = o - mean, var = wave_sum(oc * oc) * (1.0f / 64.0f);
    const float gate = silu_f(bf2f(Z[m * NZ + ZC_RG + 64 * h + lane]));
    Y[m * 1024 + 768 + 64 * h + lane] = (bf16)f2bf(oc * rsqrtf(var + 1e-6f) * normg[64 * h + lane] * gate);
}
__global__ void __launch_bounds__(64) nv_hgrn(const bf16* Z, const float* lblog, int l, const float* normg, bf16* Y) {
    __shared__ float sq[128], sf[128], sk[128];
    const int lane = threadIdx.x, bh = blockIdx.x, b = bh >> 2, h = bh & 3;
    float lb[2];
#pragma unroll
    for (int c = 0; c < 2; ++c) { const int ch = 128 * h + lane + 64 * c; const float x0 = lblog[ch], x1 = lblog[512 + ch], x2 = lblog[1024 + ch], x3 = lblog[1536 + ch];
        const float mx = fmaxf(fmaxf(x0, x1), fmaxf(x2, x3)); const float e0 = __expf(x0 - mx), e1 = __expf(x1 - mx), e2 = __expf(x2 - mx), e3 = __expf(x3 - mx); const float inv = 1.0f / (e0 + e1 + e2 + e3);
        lb[c] = (l >= 1 ? e1 : 0.f) * inv + (l >= 2 ? e2 : 0.f) * inv + (l >= 3 ? e3 : 0.f) * inv; }
    float S[128];
#pragma unroll
    for (int k = 0; k < 128; ++k) S[k] = 0.f;
    const float ng = normg[64 * h + lane];
    for (int t = 0; t < SEQ; ++t) { const size_t m = (size_t)b * SEQ + t; const bf16* zr = Z + m * NZ;
        __syncthreads();
#pragma unroll
        for (int c = 0; c < 2; ++c) { const int k = lane + 64 * c; const float f = bf2f(zr[ZC_HF + 128 * h + k]); const float fg = lb[c] + (1.0f - lb[c]) / (1.0f + __expf(-f));
            sq[k] = bf2f(zr[ZC_HQ + 128 * h + k]); sf[k] = fg; sk[k] = 1.0f - fg; }
        __syncthreads();
        const float v = bf2f(zr[ZC_HI + 64 * h + lane]); float o = 0.f;
#pragma unroll
        for (int k = 0; k < 128; ++k) { S[k] = sf[k] * S[k] + sk[k] * v; o += sq[k] * S[k]; }
        const float ms = wave_sum(o * o) * (1.0f / 64.0f); const float gate = silu_f(bf2f(zr[ZC_HG + 64 * h + lane]));
        Y[m * 1024 + 512 + 64 * h + lane] = (bf16)f2bf(o * rsqrtf(ms + 1e-6f) * ng * gate); }
}
__global__ void __launch_bounds__(256) nv_sg_prep(const bf16* Z, const float* lng, bf16* V) {
    const int lane = threadIdx.x & 63, m = blockIdx.x * 4 + (threadIdx.x >> 6); float x[4]; float s = 0.f;
#pragma unroll
    for (int j = 0; j < 4; ++j) { x[j] = gelu_exact(bf2f(Z[(size_t)m * NZ + ZC_V + lane + 64 * j])); s += x[j]; }
    const float mean = wave_sum(s) * (1.0f / 256.0f); float q = 0.f;
#pragma unroll
    for (int j = 0; j < 4; ++j) { x[j] -= mean; q += x[j] * x[j]; }
    const float rstd = rsqrtf(wave_sum(q) * (1.0f / 256.0f) + 1e-6f);
#pragma unroll
    for (int j = 0; j < 4; ++j) V[(size_t)m * 256 + lane + 64 * j] = (bf16)f2bf(x[j] * rstd * lng[lane + 64 * j]);
}
__global__ void __launch_bounds__(256) nv_sg(const bf16* Z, const bf16* V, const float* w, const float* bs, bf16* Y) {
    const int d = threadIdx.x, m = blockIdx.x, t = m & 127, h = d >> 6; const size_t m0 = (size_t)(m - t);
    float acc = bs[h * 128 + t]; const float* wr = w + ((size_t)h * 128 + t) * 128;
    for (int s = 0; s <= t; ++s) acc += wr[s] * bf2f(V[(m0 + s) * 256 + d]);
    Y[(size_t)m * 1024 + 256 + d] = (bf16)f2bf(gelu_exact(bf2f(Z[(size_t)m * NZ + ZC_U + d])) * acc);
}
#endif

extern "C" void kernel_launch(void* const* d_in, const int* in_sizes, int n_in, void* d_out, int out_size, void* d_ws, size_t ws_size, hipStream_t stream) {
    static int grid = 0;
    if (grid == 0) {
        if (n_in != N_IN || in_sizes[0] != M * D || out_size != M * D || ws_size < WS_END) { fprintf(stderr, "kernel_launch: unexpected shapes (n_in %d, in0 %d, out %d, ws %zu < %zu?)\n", n_in, n_in > 0 ? in_sizes[0] : -1, out_size, ws_size, (size_t)WS_END); grid = -1; return; }
        int dev = 0, cus = 0, per_cu = 0;
        if (hipGetDevice(&dev) != hipSuccess || hipDeviceGetAttribute(&cus, hipDeviceAttributeMultiprocessorCount, dev) != hipSuccess) { grid = -1; return; }
        if (hipFuncSetAttribute((const void*)mk_fwd, hipFuncAttributeMaxDynamicSharedMemorySize, LDS_BYTES) != hipSuccess) { fprintf(stderr, "kernel_launch: hipFuncSetAttribute failed\n"); grid = -1; return; }
        if (hipOccupancyMaxActiveBlocksPerMultiprocessor(&per_cu, (const void*)mk_fwd, NWAVES * 64, LDS_BYTES) != hipSuccess || per_cu < 1) { fprintf(stderr, "kernel_launch: occupancy query says %d\n", per_cu); }
        (void)hipGetLastError();
        grid = cus;
    }
    if (grid < 0) return;
    if (hipMemsetAsync((char*)d_ws + WS_CTL, 0, CTL_ZERO_BYTES, stream) != hipSuccess) return;
    Args a{};
    for (int i = 0; i < N_IN; ++i) a.in[i] = (const float*)d_in[i];
    a.out = (float*)d_out; a.ws = (unsigned char*)d_ws;
    auto launch = [&](int lo, int hi, int li) { a.ph_lo = lo; a.ph_hi = hi; a.li = li; hipLaunchKernelGGL(mk_fwd, dim3(grid), dim3(NWAVES * 64), LDS_BYTES, stream, a); };
#if MK_MODE == 0
    launch(0, N_PHASES, 0);
#else
    unsigned char* ws = (unsigned char*)d_ws;
    const bf16* Z = (const bf16*)(ws + WS_ZH); const bf16* QKV = (const bf16*)(ws + WS_QKV); bf16* Y = (bf16*)(ws + WS_B1);
    float* QR = (float*)(ws + WS_HST); float* KR = QR + (size_t)M * 256; bf16* V = (bf16*)(ws + WS_RST);
    const float* rcs = (const float*)(ws + WS_ROPE) + (size_t)M * 32; const float* rsn = rcs + (size_t)M * 32;
    int li = 0, lo = 0;
    for (int l = 0; l < DEPTH; ++l) {
        launch(lo, 1 + 10 * l + 4, li++);
        hipLaunchKernelGGL(nv_mla, dim3(M), dim3(256), 0, stream, QKV, Y);
        hipLaunchKernelGGL(nv_ret_prep, dim3(M * 128 / 256), dim3(256), 0, stream, Z, rcs, rsn, QR, KR);
        hipLaunchKernelGGL(nv_ret, dim3(M), dim3(256), 0, stream, Z, (const float*)QR, (const float*)KR, (const float*)d_in[IN_RETN] + l * 256, Y);
        hipLaunchKernelGGL(nv_hgrn, dim3(16), dim3(64), 0, stream, Z, (const float*)d_in[IN_HGLB], l, (const float*)d_in[IN_HGN] + l * 256, Y);
        hipLaunchKernelGGL(nv_sg_prep, dim3(M / 4), dim3(256), 0, stream, Z, (const float*)d_in[IN_SGLN] + l * 256, V);
        hipLaunchKernelGGL(nv_sg, dim3(M), dim3(256), 0, stream, Z, (const bf16*)V, (const float*)d_in[IN_SGW] + (size_t)l * 4 * 128 * 128, (const float*)d_in[IN_SGB] + l * 512, Y);
        lo = 1 + 10 * l + 6;
    }
    launch(lo, N_PHASES, li++);
#endif
}
```

```cpp
#include <hip/hip_runtime.h>
#include <cstdio>
#include <cstdint>
#include <cmath>
namespace pg8 {
#define PG8_LAS __attribute__((address_space(3)))
typedef unsigned short bf16_t;
typedef short bf16x8 __attribute__((ext_vector_type(8)));
typedef float f32x4 __attribute__((ext_vector_type(4)));
typedef unsigned u32x4 __attribute__((ext_vector_type(4)));
constexpr int BM = 256, BK = 64, HALF = 128, HTB = HALF * BK * 2  , STAGE_BYTES = 8 * HTB, NXCD = 8, WGM = 8;

__host__ __device__ __forceinline__ int lds_byte(int r, int c) { const int st = (r >> 4) * 2 + (c >> 5), rr = r & 15, cc = c & 31, ob = rr * 64 + cc * 2; return st * 1024 + (ob ^ (((ob >> 9) & 1) << 5)); }
__host__ __device__ __forceinline__ void stage_rc(int b, int& R, int& C) { const int st = b / 1024, sb = b % 1024, swz = sb ^ (((sb >> 9) & 1) << 5); R = (st >> 1) * 16 + swz / 64; C = (st & 1) * 32 + (swz % 64) / 2; }
__host__ __device__ __forceinline__ int perm32(int rho) { const int n = rho >> 4, i = rho & 15; return 8 * (i >> 2) + 4 * n + (i & 3); }

struct Unit { int pm, pn; };
struct Gemm { const bf16_t* A; const bf16_t* Bt; int M, N, K, lda; };

struct StaticOrder {
    int nM, nN, nwg, G, c;
    __host__ __device__ void init(int M, int N, int G_, int c_) { nM = M / BM; nN = N / BM; nwg = nM * nN; G = G_; c = c_; }
    __host__ __device__ bool next(int i, Unit& u) const {
        const long L = (long)i * G + c; if (L >= nwg) return false;
        int wgid = (int)L; { const int q = nwg / NXCD, r = nwg % NXCD, xcd = wgid % NXCD, off = wgid / NXCD; wgid = (xcd < r ? xcd * (q + 1) : r * (q + 1) + (xcd - r) * q) + off; }
        const int nig = WGM * nN, gid = wgid / nig, fm = gid * WGM, gsz = (nM - fm) < WGM ? (nM - fm) : WGM;
        u.pm = fm + ((wgid % nig) % gsz); u.pn = (wgid % nig) / gsz; return true;
    }
    __device__ __forceinline__ void a_ready(const Unit&) const {}
    __device__ __forceinline__ void done(const Unit&) const {}
};

__device__ __forceinline__ unsigned cvt_pk_bf16(float lo, float hi) { unsigned r; asm volatile("v_cvt_pk_bf16_f32 %0, %1, %2" : "=v"(r) : "v"(lo), "v"(hi)); return r; }
typedef unsigned u32x2 __attribute__((ext_vector_type(2)));
constexpr float RMS_EPS = 1e-6f, LOG2E = 1.4426950408889634f;
constexpr int DM = 1024, DFF_ = 2816, NZ_ = 3584;
__device__ __forceinline__ float sum4(const f32x4 a) { return (a[0] + a[1]) + (a[2] + a[3]); }
__device__ __forceinline__ float dot4(const f32x4 a) { return (a[0] * a[0] + a[1] * a[1]) + (a[2] * a[2] + a[3] * a[3]); }
__device__ __forceinline__ float row_rstd(const float* ssq, int row) {
    const f32x4* p = (const f32x4*)(ssq + (size_t)row * 16);
    const float s = (sum4(p[0]) + sum4(p[1])) + (sum4(p[2]) + sum4(p[3]));
    return __builtin_amdgcn_rsqf(s * (1.0f / 1024.0f) + RMS_EPS);
}
__device__ __forceinline__ float sigmoid_f(float x) { return __builtin_amdgcn_rcpf(1.0f + __builtin_amdgcn_exp2f(-LOG2E * x)); }

struct EpiSwiGLU {
    static constexpr bool PERM = true, AFTER_DRAIN = false;
    bf16_t* O; const float* ssq;
    __device__ __forceinline__ void operator()(const f32x4 (&acc)[2][2][4][2], const Unit& u, int wr, int wc, int fr, int fq) const {
        const int row0 = u.pm * BM + wr * 64 + fr, col0 = u.pn * 128 + wc * 32 + 8 * fq;
#pragma unroll
        for (int ai = 0; ai < 2; ++ai)
#pragma unroll
            for (int m = 0; m < 4; ++m) { const int row = row0 + ai * HALF + m * 16; const float r = row_rstd(ssq, row);
                float h[8];
#pragma unroll
                for (int n = 0; n < 2; ++n)
#pragma unroll
                    for (int j = 0; j < 4; ++j) { const float g = acc[ai][0][m][n][j] * r, up = acc[ai][1][m][n][j] * r; h[4 * n + j] = g * sigmoid_f(g) * up; }
                u32x4 w; w.x = cvt_pk_bf16(h[0], h[1]); w.y = cvt_pk_bf16(h[2], h[3]); w.z = cvt_pk_bf16(h[4], h[5]); w.w = cvt_pk_bf16(h[6], h[7]);
                *(u32x4*)(O + (size_t)row * DFF_ + col0) = w; }
    }
};
struct EpiRes {
    static constexpr bool PERM = false, AFTER_DRAIN = false;
    const float* base; float* out; bf16_t* hb; float* ssq_out; float alpha;
    __device__ __forceinline__ void operator()(const f32x4 (&acc)[2][2][4][2], const Unit& u, int wr, int wc, int fr, int fq) const {
        const int row0 = u.pm * BM + wr * 64 + fr, col0 = u.pn * BM + wc * 32 + 4 * fq;
#pragma unroll
        for (int ai = 0; ai < 2; ++ai)
#pragma unroll
            for (int m = 0; m < 4; ++m) { const int row = row0 + ai * HALF + m * 16; float s = 0.f;
#pragma unroll
                for (int bj = 0; bj < 2; ++bj)
#pragma unroll
                    for (int n = 0; n < 2; ++n) { const size_t off = (size_t)row * DM + col0 + bj * HALF + n * 16;
                        const f32x4 v = *(const f32x4*)(base + off) + acc[ai][bj][m][n] * alpha; *(f32x4*)(out + off) = v; s += dot4(v);
                        u32x2 w; w.x = cvt_pk_bf16(v[0], v[1]); w.y = cvt_pk_bf16(v[2], v[3]); *(u32x2*)(hb + off) = w; }
                s += __shfl_xor(s, 16); s += __shfl_xor(s, 32);
                if (fq == 0) ssq_out[(size_t)row * 16 + u.pn * 4 + wc] = s;
                asm volatile("" ::: "memory"); }
    }
};
struct EpiZ {
    static constexpr bool PERM = true, AFTER_DRAIN = false;
    bf16_t* Z; const float* ssq; float* ssqq; float* ssqkv;
    __device__ __forceinline__ void operator()(const f32x4 (&acc)[2][2][4][2], const Unit& u, int wr, int wc, int fr, int fq) const {
        const int row0 = u.pm * BM + wr * 64 + fr, col0 = u.pn * BM + wc * 32 + 8 * fq;
#pragma unroll
        for (int ai = 0; ai < 2; ++ai)
#pragma unroll
            for (int m = 0; m < 4; ++m) { const int row = row0 + ai * HALF + m * 16; const float r = row_rstd(ssq, row); float s0 = 0.f, s1 = 0.f;
#pragma unroll
                for (int bj = 0; bj < 2; ++bj) { const f32x4 v0 = acc[ai][bj][m][0] * r, v1 = acc[ai][bj][m][1] * r;
                    if (bj == 0) s0 = dot4(v0) + dot4(v1); else s1 = dot4(v0) + dot4(v1);
                    u32x4 w; w.x = cvt_pk_bf16(v0[0], v0[1]); w.y = cvt_pk_bf16(v0[2], v0[3]); w.z = cvt_pk_bf16(v1[0], v1[1]); w.w = cvt_pk_bf16(v1[2], v1[3]);
                    *(u32x4*)(Z + (size_t)row * NZ_ + col0 + bj * HALF) = w; }
                if (u.pn < 2) { float s = (u.pn == 0) ? s0 + s1 : s0; s += __shfl_xor(s, 16); s += __shfl_xor(s, 32);
                    if (fq == 0) { if (u.pn == 0) ssqq[(size_t)row * 4 + wc] = s; else ssqkv[(size_t)row * 4 + wc] = s; } } }
    }
};
struct EpiMla {
    static constexpr bool PERM = false, AFTER_DRAIN = false;
    bf16_t* O; const float* ssqq; const float* ssqkv; const float* cs; const float* sn;
    __device__ __forceinline__ void operator()(const f32x4 (&acc)[2][2][4][2], const Unit& u, int wr, int wc, int fr, int fq) const {
        const int row0 = u.pm * BM + wr * 64 + fr, col0 = u.pn * BM + wc * 32 + 4 * fq;
        const float QSCALE = 0.10206207261596575f * LOG2E;
#pragma unroll
        for (int ai = 0; ai < 2; ++ai)
#pragma unroll
            for (int m = 0; m < 4; ++m) { const int row = row0 + ai * HALF + m * 16;
                const float rq = __builtin_amdgcn_rsqf(sum4(*(const f32x4*)(ssqq + (size_t)row * 4)) * (1.0f / 256.0f) + RMS_EPS) * QSCALE;
                const float rkv = __builtin_amdgcn_rsqf(sum4(*(const f32x4*)(ssqkv + (size_t)row * 4)) * (1.0f / 128.0f) + RMS_EPS);
#pragma unroll
                for (int bj = 0; bj < 2; ++bj) { const int G = 8 * u.pn + 4 * bj + wc; const float sc = G < 12 ? rq : (G < 28 ? rkv : 1.0f);
                    f32x4 x1 = acc[ai][bj][m][0] * sc, x2 = acc[ai][bj][m][1] * sc;
                    if (G == 2 || G == 5 || G == 8 || G == 11 || G == 28) { const f32x4 c = *(const f32x4*)(cs + (size_t)row * 16 + 4 * fq), s = *(const f32x4*)(sn + (size_t)row * 16 + 4 * fq);
                        const f32x4 y1 = x1 * c - x2 * s, y2 = x1 * s + x2 * c; x1 = y1; x2 = y2; }
                    u32x2 w0, w1; w0.x = cvt_pk_bf16(x1[0], x1[1]); w0.y = cvt_pk_bf16(x1[2], x1[3]); w1.x = cvt_pk_bf16(x2[0], x2[1]); w1.y = cvt_pk_bf16(x2[2], x2[3]);
                    bf16_t* p = O + (size_t)row * DM + col0 + bj * HALF; *(u32x2*)p = w0; *(u32x2*)(p + 16) = w1; } }
    }
};
struct EpiPlain {
    static constexpr bool PERM = true, AFTER_DRAIN = false;
    bf16_t* O; int ldc;
    __device__ __forceinline__ void operator()(const f32x4 (&acc)[2][2][4][2], const Unit& u, int wr, int wc, int fr, int fq) const {
        const int row0 = u.pm * BM + wr * 64 + fr, col0 = u.pn * BM + wc * 32 + 8 * fq;
#pragma unroll
        for (int ai = 0; ai < 2; ++ai)
#pragma unroll
            for (int m = 0; m < 4; ++m) { bf16_t* rowp = O + (size_t)(row0 + ai * HALF + m * 16) * ldc + col0;
#pragma unroll
                for (int bj = 0; bj < 2; ++bj) { const f32x4 v0 = acc[ai][bj][m][0], v1 = acc[ai][bj][m][1];
                    u32x4 w; w.x = cvt_pk_bf16(v0[0], v0[1]); w.y = cvt_pk_bf16(v0[2], v0[3]); w.z = cvt_pk_bf16(v1[0], v1[1]); w.w = cvt_pk_bf16(v1[2], v1[3]);
                    *(u32x4*)(rowp + bj * HALF) = w; } }
    }
};
struct EpiPle {
    static constexpr bool PERM = false, AFTER_DRAIN = false;
    float* h; const bf16_t* pp; bf16_t* hb; const float* ssq_in; float* ssq_out;
    __device__ __forceinline__ void operator()(const f32x4 (&acc)[2][2][4][2], const Unit& u, int wr, int wc, int fr, int fq) const {
        const int row0 = u.pm * BM + wr * 64 + fr, col0 = u.pn * BM + wc * 32 + 4 * fq;
#pragma unroll
        for (int ai = 0; ai < 2; ++ai)
#pragma unroll
            for (int m = 0; m < 4; ++m) { const int row = row0 + ai * HALF + m * 16; const float r = row_rstd(ssq_in, row); float s = 0.f;
#pragma unroll
                for (int bj = 0; bj < 2; ++bj)
#pragma unroll
                    for (int n = 0; n < 2; ++n) { const size_t off = (size_t)row * DM + col0 + bj * HALF + n * 16;
                        const f32x4 hv = *(const f32x4*)(h + off); const u32x2 pw = *(const u32x2*)(pp + off); const f32x4 a = acc[ai][bj][m][n] * r;
                        f32x4 v; v[0] = hv[0] + __uint_as_float(pw.x << 16) * sigmoid_f(a[0]); v[1] = hv[1] + __uint_as_float(pw.x & 0xffff0000u) * sigmoid_f(a[1]);
                        v[2] = hv[2] + __uint_as_float(pw.y << 16) * sigmoid_f(a[2]); v[3] = hv[3] + __uint_as_float(pw.y & 0xffff0000u) * sigmoid_f(a[3]);
                        *(f32x4*)(h + off) = v; s += dot4(v);
                        u32x2 w; w.x = cvt_pk_bf16(v[0], v[1]); w.y = cvt_pk_bf16(v[2], v[3]); *(u32x2*)(hb + off) = w; }
                s += __shfl_xor(s, 16); s += __shfl_xor(s, 32);
                if (fq == 0) ssq_out[(size_t)row * 16 + u.pn * 4 + wc] = s;
                asm volatile("" ::: "memory"); }
    }
};

template <class Epi, class Sched, bool ALIGN_EPI = false, bool SP2 = false>
__device__ __forceinline__ void gemm_phase(PG8_LAS unsigned char* lds, const Gemm g, const Sched& S, const Epi& E) {
    int tid_o = threadIdx.x; asm volatile("" : "+v"(tid_o));
    const int tid = tid_o, wid = __builtin_amdgcn_readfirstlane(tid >> 6), lane = tid & 63, wr = wid >> 2, wc = wid & 3, fr = lane & 15, fq = lane >> 4;
    const int K = g.K, nt = K / BK;
    unsigned voffA[2], voffB[2];
#pragma unroll
    for (int i = 0; i < 2; ++i) { int R, C; stage_rc(tid * 16 + i * 8192, R, C); const int Rb = Epi::PERM ? ((R & ~31) + perm32(R & 31)) : R;
        voffA[i] = (unsigned)(R * g.lda + C) * 2u; voffB[i] = (unsigned)(Rb * K + C) * 2u; }
    const size_t kstep = (size_t)(BK * 2);
    const size_t hstep = (size_t)HALF * K * 2;
    const size_t tstep = 2 * hstep; const size_t hstepA = (size_t)HALF * g.lda * 2, tstepA = 2 * hstepA;
    const unsigned ldsw = (unsigned)wid * 1024u;
    const int aoff = lds_byte(wr * 64 + fr, fq * 8), boff = lds_byte(wc * 32 + fr, fq * 8);
#define PG8_SA(b, h) (((b) * 2 + (h)) * HTB)
#define PG8_SB(b, h) ((4 + (b) * 2 + (h)) * HTB)
#define PG8_STAGE(bufoff, gbase, voff) do { _Pragma("unroll") for (int _i = 0; _i < 2; ++_i) \
        __builtin_amdgcn_global_load_lds((const unsigned*)((const char*)(gbase) + (voff)[_i]), (PG8_LAS unsigned*)(lds + (bufoff) + ldsw + _i * 8192), 16, 0, 0); } while (0)
#define PG8_LDA(dst, b, h) do { _Pragma("unroll") for (int m = 0; m < 4; ++m) _Pragma("unroll") for (int k = 0; k < 2; ++k) dst[m][k] = *(const PG8_LAS bf16x8*)(lds + PG8_SA(b, h) + aoff + m * 2048 + k * 1024); } while (0)
#define PG8_LDB(dst, b, h) do { _Pragma("unroll") for (int n = 0; n < 2; ++n) _Pragma("unroll") for (int k = 0; k < 2; ++k) dst[n][k] = *(const PG8_LAS bf16x8*)(lds + PG8_SB(b, h) + boff + n * 2048 + k * 1024); } while (0)
#define PG8_MMA(ai, bj, At, Bt) do { __builtin_amdgcn_s_setprio(1); _Pragma("unroll") for (int m = 0; m < 4; ++m) _Pragma("unroll") for (int n = 0; n < 2; ++n) _Pragma("unroll") for (int k = 0; k < 2; ++k) \
        acc[ai][bj][m][n] = __builtin_amdgcn_mfma_f32_16x16x32_bf16(Bt[n][k], At[m][k], acc[ai][bj][m][n], 0, 0, 0); __builtin_amdgcn_s_setprio(0); } while (0)
#define PG8_WAIT_V(n) asm volatile("s_waitcnt vmcnt(" #n ")" ::: "memory")
#define PG8_WAIT_L(n) asm volatile("s_waitcnt lgkmcnt(" #n ")" ::: "memory")
#define PG8_BAR __builtin_amdgcn_s_barrier()
#define PG8_SCHED __builtin_amdgcn_sched_barrier(0)
    Unit cur, nxt; int ui = 0;
    if (!S.next(0, cur)) return;
    f32x4 acc[2][2][4][2];
#pragma unroll
    for (int a = 0; a < 2; ++a)
#pragma unroll
        for (int b = 0; b < 2; ++b)
#pragma unroll
            for (int m = 0; m < 4; ++m)
#pragma unroll
                for (int n = 0; n < 2; ++n) acc[a][b][m][n] = (f32x4){0.f, 0.f, 0.f, 0.f};
    bf16x8 At[4][2], B0[2][2], B1[2][2];
    const char* cA = (const char*)g.A + (size_t)cur.pm * tstepA; const char* cB = (const char*)g.Bt + (size_t)cur.pn * tstep;
    S.a_ready(cur);
    if constexpr (SP2) {
        PG8_STAGE(PG8_SB(0, 0), cB, voffB); PG8_STAGE(PG8_SB(0, 1), cB + hstep, voffB); PG8_STAGE(PG8_SA(0, 0), cA, voffA); PG8_STAGE(PG8_SA(0, 1), cA + hstepA, voffA);
        if (wr == 1) PG8_BAR;
        PG8_WAIT_V(2); PG8_BAR;
        PG8_STAGE(PG8_SB(1, 0), cB + kstep, voffB); PG8_STAGE(PG8_SA(1, 0), cA + kstep, voffA); PG8_STAGE(PG8_SB(1, 1), cB + hstep + kstep, voffB);
        PG8_WAIT_V(6); PG8_BAR;
    } else {
        PG8_STAGE(PG8_SB(0, 0), cB, voffB); PG8_STAGE(PG8_SA(0, 0), cA, voffA); PG8_STAGE(PG8_SB(0, 1), cB + hstep, voffB); PG8_STAGE(PG8_SA(0, 1), cA + hstepA, voffA);
        if (wr == 1) PG8_BAR;
        PG8_WAIT_V(4); PG8_BAR;
        PG8_STAGE(PG8_SB(1, 0), cB + kstep, voffB); PG8_STAGE(PG8_SA(1, 0), cA + kstep, voffA); PG8_STAGE(PG8_SB(1, 1), cB + hstep + kstep, voffB);
        PG8_WAIT_V(6); PG8_BAR;
    }
    for (;;) {
        const bool has_next = S.next(ui + 1, nxt);
        const char* nA = has_next ? (const char*)g.A + (size_t)nxt.pm * tstepA : cA; const char* nB = has_next ? (const char*)g.Bt + (size_t)nxt.pn * tstep : cB;
        for (int t = 0; t < nt; t += 2) {
            const bool last = (t == nt - 2);
            const char* a1 = cA + (size_t)(t + 1) * kstep;
            const char* a2 = last ? nA : cA + (size_t)(t + 2) * kstep; const char* b2 = last ? nB : cB + (size_t)(t + 2) * kstep;
            const char* a3 = a2 + kstep; const char* b3 = b2 + kstep;
            if (last && has_next) S.a_ready(nxt);
            if constexpr (SP2) {
            PG8_LDB(B0, 0, 0); PG8_LDB(B1, 0, 1); PG8_SCHED; PG8_LDA(At, 0, 0); PG8_STAGE(PG8_SA(1, 1), a1 + hstepA, voffA);
            PG8_WAIT_V(8); PG8_WAIT_L(0); PG8_BAR; PG8_MMA(0, 0, At, B0); PG8_MMA(0, 1, At, B1); PG8_BAR; PG8_SCHED;
            PG8_LDA(At, 0, 1); PG8_STAGE(PG8_SB(0, 0), b2, voffB); PG8_STAGE(PG8_SB(0, 1), b2 + hstep, voffB); PG8_STAGE(PG8_SA(0, 0), a2, voffA);
            PG8_WAIT_V(8); PG8_WAIT_L(0); PG8_BAR; PG8_MMA(1, 0, At, B0); PG8_MMA(1, 1, At, B1); PG8_BAR; PG8_SCHED;
            PG8_LDB(B0, 1, 0); PG8_LDB(B1, 1, 1); PG8_SCHED; PG8_LDA(At, 1, 0); PG8_STAGE(PG8_SA(0, 1), a2 + hstepA, voffA);
            PG8_WAIT_V(8); PG8_WAIT_L(0); PG8_BAR; PG8_MMA(0, 0, At, B0); PG8_MMA(0, 1, At, B1); PG8_BAR; PG8_SCHED;
            PG8_LDA(At, 1, 1); PG8_STAGE(PG8_SB(1, 0), b3, voffB); PG8_STAGE(PG8_SB(1, 1), b3 + hstep, voffB); PG8_STAGE(PG8_SA(1, 0), a3, voffA);
            PG8_WAIT_V(8); PG8_WAIT_L(0); PG8_BAR; PG8_MMA(1, 0, At, B0); PG8_MMA(1, 1, At, B1); PG8_BAR; PG8_SCHED;
            } else {
            PG8_LDB(B0, 0, 0); PG8_SCHED; PG8_LDA(At, 0, 0); PG8_STAGE(PG8_SA(1, 1), a1 + hstepA, voffA);
            PG8_WAIT_L(8); PG8_BAR; PG8_WAIT_L(0); PG8_MMA(0, 0, At, B0); PG8_BAR; PG8_SCHED;
            PG8_LDB(B1, 0, 1); PG8_STAGE(PG8_SB(0, 0), b2, voffB);
            PG8_BAR; PG8_WAIT_L(0); PG8_MMA(0, 1, At, B1); PG8_BAR;
            PG8_LDA(At, 0, 1); PG8_STAGE(PG8_SA(0, 0), a2, voffA);
            PG8_BAR; PG8_WAIT_L(0); PG8_MMA(1, 0, At, B0); PG8_BAR; PG8_SCHED;
            PG8_STAGE(PG8_SB(0, 1), b2 + hstep, voffB);
            PG8_WAIT_V(6); PG8_BAR; PG8_MMA(1, 1, At, B1); PG8_BAR;
            PG8_LDB(B0, 1, 0); PG8_SCHED; PG8_LDA(At, 1, 0); PG8_STAGE(PG8_SA(0, 1), a2 + hstepA, voffA);
            PG8_WAIT_L(8); PG8_BAR; PG8_WAIT_L(0); PG8_MMA(0, 0, At, B0); PG8_BAR; PG8_SCHED;
            PG8_LDB(B1, 1, 1); PG8_STAGE(PG8_SB(1, 0), b3, voffB);
            PG8_BAR; PG8_WAIT_L(0); PG8_MMA(0, 1, At, B1); PG8_BAR;
            PG8_LDA(At, 1, 1); PG8_STAGE(PG8_SA(1, 0), a3, voffA);
            PG8_BAR; PG8_WAIT_L(0); PG8_MMA(1, 0, At, B0); PG8_BAR; PG8_SCHED;
            PG8_STAGE(PG8_SB(1, 1), b3 + hstep, voffB);
            PG8_WAIT_V(6); PG8_BAR; PG8_MMA(1, 1, At, B1); PG8_BAR;
            }
        }
        if constexpr (ALIGN_EPI) { if (wr == 0) PG8_BAR; }
        if constexpr (!Epi::AFTER_DRAIN) { E(acc, cur, wr, wc, fr, fq); S.done(cur); }
        if (!has_next) break;
#pragma unroll
        for (int a = 0; a < 2; ++a)
#pragma unroll
            for (int b = 0; b < 2; ++b)
#pragma unroll
                for (int m = 0; m < 4; ++m)
#pragma unroll
                    for (int n = 0; n < 2; ++n) acc[a][b][m][n] = (f32x4){0.f, 0.f, 0.f, 0.f};
        cur = nxt; cA = nA; cB = nB; ++ui;
        if constexpr (ALIGN_EPI) { if (wr == 1) PG8_BAR; }
    }
    PG8_WAIT_V(0);
    if constexpr (!ALIGN_EPI) { if (wr == 0) PG8_BAR; }
    PG8_BAR;
    if constexpr (Epi::AFTER_DRAIN) { E.fused(acc, cur, wr, wc, fr, fq, lds, wid, lane); S.done(cur); }
#undef PG8_SA
#undef PG8_SB
#undef PG8_STAGE
#undef PG8_LDA
#undef PG8_LDB
#undef PG8_MMA
#undef PG8_WAIT_V
#undef PG8_WAIT_L
#undef PG8_BAR
#undef PG8_SCHED
}
}

constexpr int NWAVES = 8;
constexpr int M = 16384, SEQ = 4096, NBATCH = 4, DEPTH = 4, D = 1024, DFF = 2816, NGU = 2 * DFF, NZ = 3584, NZSRC = 3488, PLED = 256;
constexpr int ZC_U = 512, ZC_V = 768, ZC_HQ = 1024, ZC_HF = 1536, ZC_HI = 2048, ZC_HG = 2304, ZC_RQ = 2560, ZC_RK = 2816, ZC_RV = 3072, ZC_RG = 3328;
constexpr int QC_Q = 0, QC_KN = 384, QC_V = 640, QC_KR = 896;
constexpr size_t MiB = 1u << 20;
constexpr size_t WS_CTL = 0, CTL_ZERO_BYTES = 1 * MiB;
constexpr size_t WS_WGU = 1 * MiB;
constexpr size_t WS_WD = WS_WGU + 88 * MiB;
constexpr size_t WS_WIN = WS_WD + 44 * MiB;
constexpr size_t WS_WMLA = WS_WIN + 28 * MiB;
constexpr size_t WS_WOUT = WS_WMLA + 4 * MiB;
constexpr size_t WS_WPG = WS_WOUT + 8 * MiB;
constexpr size_t WS_WPP = WS_WPG + 8 * MiB;
constexpr size_t WS_WSG = WS_WPP + 2 * MiB;
constexpr size_t WS_B0 = WS_WSG + 1 * MiB;
constexpr size_t WS_B1 = WS_B0 + 32 * MiB;
constexpr size_t WS_ZH = WS_B1 + 32 * MiB;
constexpr size_t WS_QKV = WS_ZH + 112 * MiB;
constexpr size_t WS_PBF = WS_QKV + 32 * MiB;
constexpr size_t WS_HST = WS_PBF + 8 * MiB;
constexpr size_t WS_HDC = WS_HST + 32 * MiB;
constexpr size_t WS_RST = WS_HDC + 1 * MiB;
constexpr size_t WS_ROPE = WS_RST + 8 * MiB;
constexpr size_t WS_SSQ = WS_ROPE + 6 * MiB;
constexpr size_t WS_SSQ2 = WS_SSQ + 2 * MiB;
constexpr size_t WS_END = WS_SSQ2 + 1 * MiB;
constexpr int CW_TMO = 0, CW_BAR = 4096;
constexpr int MAX_LAUNCHES = 16;
constexpr int RING_OFF = 0, RING_BYTES = 131072, LDSCTL_OFF = RING_BYTES, MISC_OFF = LDSCTL_OFF + 320, LDS_BYTES = 147456;

#define GAS __attribute__((address_space(1)))
#define LAS __attribute__((address_space(3)))
typedef unsigned short bf16;
typedef unsigned v4u __attribute__((ext_vector_type(4)));
typedef unsigned v2u __attribute__((ext_vector_type(2)));
typedef float f32x4 __attribute__((ext_vector_type(4)));
typedef short bf16x8 __attribute__((ext_vector_type(8)));
typedef GAS unsigned gu32;
#define RLX_AGENT __ATOMIC_RELAXED, __HIP_MEMORY_SCOPE_AGENT
#define LDS_WAIT() asm volatile("s_waitcnt lgkmcnt(0)" ::: "memory")
#define VM_WAIT() asm volatile("s_waitcnt vmcnt(0)" ::: "memory")
__device__ __forceinline__ unsigned f2bf(float f) { unsigned u = __builtin_bit_cast(unsigned, f); return (u + 0x7fffu + ((u >> 16) & 1u)) >> 16; }
__device__ __forceinline__ unsigned pk2(float lo, float hi) { return f2bf(lo) | (f2bf(hi) << 16); }
__device__ __forceinline__ float bf2f(bf16 v) { return __uint_as_float((unsigned)v << 16); }
__device__ __forceinline__ float wave_sum(float v) {
#pragma unroll
    for (int o = 1; o < 64; o <<= 1) v += __shfl_xor(v, o);
    return v;
}
__device__ __forceinline__ float wave_max(float v) {
#pragma unroll
    for (int o = 1; o < 64; o <<= 1) v = fmaxf(v, __shfl_xor(v, o));
    return v;
}
__device__ const double ROPE_INVT[48] = {
1.59154943091895346e-01, 8.94994016088910133e-02, 5.03292121044870353e-02, 2.83021958306233987e-02, 1.59154943091895339e-02, 8.94994016088910237e-03, 5.03292121044870370e-03, 2.83021958306233987e-03, 1.59154943091895356e-03, 8.94994016088910237e-04, 5.03292121044870326e-04, 2.83021958306233954e-04, 1.59154943091895351e-04, 8.94994016088910182e-05, 5.03292121044870354e-05, 2.83021958306233961e-05,
1.59154943091895346e-01, 1.19349370211248862e-01, 8.94994016088910133e-02, 6.71150830052272551e-02, 5.03292121044870353e-02, 3.77415847174197711e-02, 2.83021958306233987e-02, 2.12236527647776604e-02, 1.59154943091895339e-02, 1.19349370211248862e-02, 8.94994016088910237e-03, 6.71150830052272534e-03, 5.03292121044870370e-03, 3.77415847174197719e-03, 2.83021958306233987e-03, 2.12236527647776622e-03, 1.59154943091895356e-03, 1.19349370211248849e-03, 8.94994016088910237e-04, 6.71150830052272599e-04, 5.03292121044870326e-04, 3.77415847174197741e-04, 2.83021958306233954e-04, 2.12236527647776605e-04, 1.59154943091895351e-04, 1.19349370211248862e-04, 8.94994016088910182e-05, 6.71150830052272545e-05, 5.03292121044870354e-05, 3.77415847174197768e-05, 2.83021958306233961e-05, 2.12236527647776592e-05 };

#define XB_TMO      128
#define XB_XCNT(j)  (256  + 64 * (j))
#define XB_XSUB(j)  (1280 + 64 * (j))
#define XB_XGEN(j)  (2304 + 64 * (j))
#define XB_TOP      3328
#define XB_TOPGEN   3392
#define XCD_BAR_WORDS 3456
#define XB_SPIN_CAP (1u << 18)

__device__ __forceinline__ unsigned xb_ld(unsigned* p)              { return __hip_atomic_load(p, __ATOMIC_RELAXED, __HIP_MEMORY_SCOPE_AGENT); }
__device__ __forceinline__ unsigned xb_add(unsigned* p, unsigned v) { return __hip_atomic_fetch_add(p, v, __ATOMIC_RELAXED, __HIP_MEMORY_SCOPE_AGENT); }
__device__ __forceinline__ unsigned xb_xcc_id() { return (unsigned)__builtin_amdgcn_s_getreg((3 << 11) | 20) & 0xFu; }
#define XB_SPIN(cond, bar) do { unsigned _sp = 0; while (cond) { __builtin_amdgcn_s_sleep(1); \
    if ((++_sp & 255u) == 0u) { if (xb_ld(&(bar)[XB_TMO])) break; if (_sp > XB_SPIN_CAP) { atomicAdd(&(bar)[XB_TMO], 1u); break; } } } } while (0)

struct XcdBarrier {
    unsigned* bar; unsigned x;
    volatile LAS unsigned* st;
};

__device__ __forceinline__ XcdBarrier xcd_barrier_post(unsigned* bar, volatile LAS unsigned* st) {
    XcdBarrier b; b.bar = bar; b.x = xb_xcc_id(); b.st = st;
    if (threadIdx.x == 0) (void)xb_add(&bar[XB_XCNT(b.x)], 1u);
    return b;
}
__device__ __forceinline__ void xcd_barrier_complete(unsigned* bar, unsigned x, unsigned& nloc, unsigned& nx) {
    const unsigned G = gridDim.x * gridDim.y * gridDim.z;
    unsigned sum, cnt, mine, sp = 0u;
    for (;;) {
        sum = 0u; cnt = 0u; mine = 0u;
#pragma unroll
        for (unsigned j = 0; j < 16; ++j) { const unsigned c = xb_ld(&bar[XB_XCNT(j)]); sum += c; cnt += (c > 0u) ? 1u : 0u; mine = (j == x) ? c : mine; }
        if (sum == G) break;
        __builtin_amdgcn_s_sleep(1);
        if ((++sp & 255u) == 0u) { if (xb_ld(&bar[XB_TMO])) break; if (sp > XB_SPIN_CAP) { atomicAdd(&bar[XB_TMO], 1u); break; } }
    }
    nloc = mine > 0u ? mine : 1u; nx = cnt > 0u ? cnt : 1u;
}

__device__ __forceinline__ void xcd_barrier(const XcdBarrier& b) {
    asm volatile("s_waitcnt vmcnt(0)" ::: "memory");
    __syncthreads();
    if (threadIdx.x == 0) {
        unsigned* bar = b.bar;
        __builtin_amdgcn_s_waitcnt(0);
        unsigned nloc = b.st[0], nx = b.st[1];
        if (nloc == 0u) { xcd_barrier_complete(bar, b.x, nloc, nx); b.st[0] = nloc; b.st[1] = nx; }
        const unsigned old = xb_add(&bar[XB_XSUB(b.x)], 1u);
        const unsigned gen = old / nloc;
        if (old + 1u == (gen + 1u) * nloc) {
            __builtin_amdgcn_fence(__ATOMIC_RELEASE, "agent");
            asm volatile("s_waitcnt vmcnt(0)" ::: "memory");
            const unsigned og = xb_add(&bar[XB_TOP], 1u);
            const unsigned tg = og / nx;
            if (og + 1u == (tg + 1u) * nx) xb_add(&bar[XB_TOPGEN], 1u);
            else XB_SPIN(xb_ld(&bar[XB_TOPGEN]) == tg, bar);
            __builtin_amdgcn_fence(__ATOMIC_ACQUIRE, "agent");
            xb_add(&bar[XB_XGEN(b.x)], 1u);
            asm volatile("s_waitcnt vmcnt(0)" ::: "memory");
        } else {
            XB_SPIN(xb_ld(&bar[XB_XGEN(b.x)]) == gen, bar);
            __builtin_amdgcn_fence(__ATOMIC_ACQUIRE, "agent");
            asm volatile("s_waitcnt vmcnt(0)" ::: "memory");
        }
    }
    __syncthreads();
}

enum { IN_X = 0, IN_P, IN_POS, IN_F1N, IN_F1G, IN_F1U, IN_F1D, IN_MIXN, IN_WIN, IN_QN, IN_WUQ, IN_KVN, IN_WUKV, IN_SGLN, IN_SGW, IN_SGB, IN_HGLB, IN_HGN, IN_RETN, IN_WOUT,
       IN_F2N, IN_F2G, IN_F2U, IN_F2D, IN_PLEN, IN_PLEP, IN_PLEG, IN_FINN, N_IN };
struct Args { const float* in[N_IN]; float* out; unsigned char* ws; int ph_lo, ph_hi, li, pad; };
constexpr int N_PHASES = 42;

__device__ __forceinline__ void conv_item(const float* W, int N, const float* gain, bf16* WT, int ldk, int drow, int k0, int n0, LAS float* scr, int lane) {
#pragma unroll 8
    for (int i = 0; i < 32; ++i) { const int kk = 2 * i + (lane >> 5); float v = W[(size_t)(k0 + kk) * N + n0 + (lane & 31)]; if (gain) v *= gain[k0 + kk]; scr[kk * 33 + (lane & 31)] = v; }
    LDS_WAIT(); asm volatile("" ::: "memory");
    const int c = lane & 7;
#pragma unroll
    for (int j = 0; j < 4; ++j) { const int n = (lane >> 3) + 8 * j; const LAS float* s = scr + (8 * c) * 33 + n;
        v4u o; o.x = pk2(s[0 * 33], s[1 * 33]); o.y = pk2(s[2 * 33], s[3 * 33]); o.z = pk2(s[4 * 33], s[5 * 33]); o.w = pk2(s[6 * 33], s[7 * 33]);
        *(v4u*)(WT + (size_t)(drow + n) * ldk + k0 + 8 * c) = o; }
    LDS_WAIT(); asm volatile("" ::: "memory");
}
constexpr int IT_FF = 1408, IT_WIN = 16 * 109, IT_SQ = 16 * 32, IT_PP = 4 * 32, IT_LAYER = 6 * IT_FF + IT_WIN + 2 * IT_SQ + IT_PP;

__device__ __forceinline__ void prologue(const Args& a, LAS unsigned char* lds, int tid, int lane, int wave, int vcu, int G) {
    unsigned char* ws = a.ws;
    bf16* Wgu = (bf16*)(ws + WS_WGU); bf16* Wd = (bf16*)(ws + WS_WD); bf16* Win = (bf16*)(ws + WS_WIN); bf16* Wmla = (bf16*)(ws + WS_WMLA);
    bf16* Wout = (bf16*)(ws + WS_WOUT); bf16* Wpg = (bf16*)(ws + WS_WPG); bf16* Wpp = (bf16*)(ws + WS_WPP); bf16* Wsg = (bf16*)(ws + WS_WSG);
    LAS float* scr = (LAS float*)(lds + RING_OFF + wave * 16384);
    const int gw = vcu * NWAVES + wave, NGW = G * NWAVES;
    const int gt = (vcu * NWAVES + wave) * 64 + lane, NGT = NGW * 64;
    for (int it = gw; it < DEPTH * IT_LAYER; it += NGW) {
        const int l = it / IT_LAYER; int r = it % IT_LAYER;
        if (r < 6 * IT_FF) { const int f = r / IT_FF; r -= f * IT_FF; const int second = f / 3, kind = f - 3 * second;
            if (kind < 2) { const int kb = r / 88, nb = r - 88 * kb, n0 = 32 * nb;
                const float* W = (second ? (kind ? a.in[IN_F2U] : a.in[IN_F2G]) : (kind ? a.in[IN_F1U] : a.in[IN_F1G])) + (size_t)l * D * DFF;
                const float* gain = (second ? a.in[IN_F2N] : a.in[IN_F1N]) + l * D;
                conv_item(W, DFF, gain, Wgu + (size_t)(2 * l + second) * NGU * D, D, (n0 >> 7) * 256 + (n0 & 127) + 128 * kind, 64 * kb, n0, scr, lane); }
            else { const int kb = r / 32, nb = r - 32 * kb;
                const float* W = (second ? a.in[IN_F2D] : a.in[IN_F1D]) + (size_t)l * DFF * D;
                conv_item(W, D, nullptr, Wd + (size_t)(2 * l + second) * D * DFF, DFF, 32 * nb, 64 * kb, 32 * nb, scr, lane); }
            continue; }
        r -= 6 * IT_FF;
        if (r < IT_WIN) { const int kb = r / 109, nb = r - 109 * kb, n0 = 32 * nb;
            conv_item(a.in[IN_WIN] + (size_t)l * D * NZSRC, NZSRC, a.in[IN_MIXN] + l * D, Win + (size_t)l * NZ * D, D, n0 < 416 ? n0 : n0 + 96, 64 * kb, n0, scr, lane); continue; }
        r -= IT_WIN;
        if (r < IT_SQ) { const int kb = r / 32, nb = r - 32 * kb; conv_item(a.in[IN_WOUT] + (size_t)l * D * D, D, nullptr, Wout + (size_t)l * D * D, D, 32 * nb, 64 * kb, 32 * nb, scr, lane); continue; }
        r -= IT_SQ;
        if (r < IT_SQ) { const int kb = r / 32, nb = r - 32 * kb; conv_item(a.in[IN_PLEG] + (size_t)l * D * D, D, a.in[IN_PLEN] + l * D, Wpg + (size_t)l * D * D, D, 32 * nb, 64 * kb, 32 * nb, scr, lane); continue; }
        r -= IT_SQ;
        { const int kb = r / 32, nb = r - 32 * kb; conv_item(a.in[IN_PLEP] + (size_t)l * PLED * D, D, nullptr, Wpp + (size_t)l * D * PLED, PLED, 32 * nb, 64 * kb, 32 * nb, scr, lane); }
    }
    for (int i = gt; i < DEPTH * 96 * (D / 8); i += NGT) { const int l = i / (96 * 128), r = i - l * 96 * 128; const int row = 416 + r / 128, c8 = r & 127;
        *(v4u*)(Win + ((size_t)l * NZ + row) * D + 8 * c8) = (v4u){0u, 0u, 0u, 0u}; }
    for (int i = gt; i < DEPTH * 1024 * 64; i += NGT) { const int l = i >> 16, r = i & 65535, n = r >> 6, k8 = (r & 63) * 8;
        const float* wuq = a.in[IN_WUQ] + (size_t)l * 256 * 384; const float* wukv = a.in[IN_WUKV] + (size_t)l * 128 * 512;
        const float* qg = a.in[IN_QN] + l * 256; const float* kvg = a.in[IN_KVN] + l * 128;
        float v[8];
#pragma unroll
        for (int j = 0; j < 8; ++j) { const int k = k8 + j; float x = 0.f;
            if (n < 384) { if (k < 256) x = wuq[(size_t)k * 384 + n] * qg[k]; }
            else if (n < 896) { if (k >= 256 && k < 384) { const int nn = (n - 384) & 255, hh = nn >> 6, jj = (nn & 63) + (n >= 640 ? 64 : 0); x = wukv[(size_t)(k - 256) * 512 + hh * 128 + jj] * kvg[k - 256]; } }
            else if (n < 928) { if (k == 384 + (n - 896)) x = 1.0f; }
            v[j] = x; }
        v4u o; o.x = pk2(v[0], v[1]); o.y = pk2(v[2], v[3]); o.z = pk2(v[4], v[5]); o.w = pk2(v[6], v[7]);
        *(v4u*)(Wmla + ((size_t)l * 1024 + n) * 512 + k8) = o; }
    for (int i = gt; i < DEPTH * 4 * 128 * 128 / 2; i += NGT) { const int e = 2 * i, s = e & 127, t = (e >> 7) & 127; const float* w = a.in[IN_SGW];
        const float x0 = s <= t ? w[e] : 0.f, x1 = (s + 1) <= t ? w[e + 1] : 0.f; ((unsigned*)Wsg)[i] = pk2(x0, x1); }
    { const float* x = a.in[IN_X]; bf16* B0 = (bf16*)(ws + WS_B0); float* ssq = (float*)(ws + WS_SSQ);
      for (int m = gw; m < M; m += NGW) { const f32x4* xr = (const f32x4*)(x + (size_t)m * D) + lane; unsigned long long* o8 = (unsigned long long*)(B0 + (size_t)m * D) + lane; float t0, t1, t2, t3;
          { const f32x4 v = xr[0];   t0 = wave_sum(pg8::dot4(v)); o8[0]   = (unsigned long long)pk2(v[0], v[1]) | ((unsigned long long)pk2(v[2], v[3]) << 32); }
          { const f32x4 v = xr[64];  t1 = wave_sum(pg8::dot4(v)); o8[64]  = (unsigned long long)pk2(v[0], v[1]) | ((unsigned long long)pk2(v[2], v[3]) << 32); }
          { const f32x4 v = xr[128]; t2 = wave_sum(pg8::dot4(v)); o8[128] = (unsigned long long)pk2(v[0], v[1]) | ((unsigned long long)pk2(v[2], v[3]) << 32); }
          { const f32x4 v = xr[192]; t3 = wave_sum(pg8::dot4(v)); o8[192] = (unsigned long long)pk2(v[0], v[1]) | ((unsigned long long)pk2(v[2], v[3]) << 32); }
          if (lane < 16) { float val = 0.f; if (lane == 0) val = t0; if (lane == 4) val = t1; if (lane == 8) val = t2; if (lane == 12) val = t3; ssq[(size_t)m * 16 + lane] = val; } } }
    { const int* pos = (const int*)a.in[IN_POS]; float* mcs = (float*)(ws + WS_ROPE); float* msn = mcs + (size_t)M * 16; float* rcs = msn + (size_t)M * 16; float* rsn = rcs + (size_t)M * 32;
      for (int i = gt; i < M * 48; i += NGT) { const int m = i / 48, f = i - 48 * m; const double turns = (double)pos[m] * ROPE_INVT[f]; const float fr = (float)(turns - __builtin_rint(turns));
          const float c = __builtin_amdgcn_cosf(fr), s = __builtin_amdgcn_sinf(fr);
          if (f < 16) { mcs[(size_t)m * 16 + f] = c; msn[(size_t)m * 16 + f] = s; } else { rcs[(size_t)m * 32 + f - 16] = c; rsn[(size_t)m * 32 + f - 16] = s; } } }
}

namespace mx {
typedef const LAS bf16* lcp;
#define MFMA16(a, b, c) __builtin_amdgcn_mfma_f32_16x16x32_bf16((a), (b), (c), 0, 0, 0)
__device__ __forceinline__ bf16x8 frag(lcp base, int row, int stride, int k) { return *(const LAS bf16x8*)(base + row * stride + k); }
__device__ __forceinline__ bf16x8 frag2(lcp base, int row, int stride, int k) {
    typedef short s16x4 __attribute__((ext_vector_type(4)));
    const s16x4 lo = *(const LAS s16x4*)(base + row * stride + k), hi = *(const LAS s16x4*)(base + row * stride + k + 16);
    return (bf16x8){lo[0], lo[1], lo[2], lo[3], hi[0], hi[1], hi[2], hi[3]};
}
__device__ __forceinline__ bf16x8 pack_pair(const f32x4 a, const f32x4 b) {
    v4u w; w.x = pg8::cvt_pk_bf16(a[0], a[1]); w.y = pg8::cvt_pk_bf16(a[2], a[3]); w.z = pg8::cvt_pk_bf16(b[0], b[1]); w.w = pg8::cvt_pk_bf16(b[2], b[3]);
    return __builtin_bit_cast(bf16x8, w);
}
__device__ __forceinline__ float lo16(unsigned w) { return __uint_as_float(w << 16); }
__device__ __forceinline__ float hi16(unsigned w) { return __uint_as_float(w & 0xffff0000u); }
__device__ __forceinline__ void unpack8(const v4u w, float (&x)[8]) { x[0] = lo16(w.x); x[1] = hi16(w.x); x[2] = lo16(w.y); x[3] = hi16(w.y); x[4] = lo16(w.z); x[5] = hi16(w.z); x[6] = lo16(w.w); x[7] = hi16(w.w); }
__device__ __forceinline__ v4u pack8(const float (&x)[8]) { v4u w; w.x = pg8::cvt_pk_bf16(x[0], x[1]); w.y = pg8::cvt_pk_bf16(x[2], x[3]); w.z = pg8::cvt_pk_bf16(x[4], x[5]); w.w = pg8::cvt_pk_bf16(x[6], x[7]); return w; }
__device__ __forceinline__ float silu_fast(float x) { return x * __builtin_amdgcn_rcpf(1.0f + __builtin_amdgcn_exp2f(-1.4426950408889634f * x)); }
#define WG_SYNC() do { asm volatile("s_waitcnt vmcnt(0) lgkmcnt(0)" ::: "memory"); __builtin_amdgcn_s_barrier(); asm volatile("" ::: "memory"); } while (0)

constexpr int RET_C = 128;
__device__ __forceinline__ float ret_lg2(int h) { return __builtin_amdgcn_logf(1.0f - __builtin_amdgcn_exp2f(-(5.0f + (float)h))); }
__device__ __forceinline__ void ret_rope8(const bf16* zrow, const float* cs, const float* sn, int grp, float sc, float (&o1)[8], float (&o2)[8]) {
    float x1[8], x2[8]; unpack8(*(const v4u*)(zrow + 8 * grp), x1); unpack8(*(const v4u*)(zrow + 32 + 8 * grp), x2);
    const f32x4 c0 = *(const f32x4*)(cs + 8 * grp), c1 = *(const f32x4*)(cs + 8 * grp + 4), s0 = *(const f32x4*)(sn + 8 * grp), s1 = *(const f32x4*)(sn + 8 * grp + 4);
#pragma unroll
    for (int j = 0; j < 8; ++j) { const float c = j < 4 ? c0[j & 3] : c1[j & 3], s = j < 4 ? s0[j & 3] : s1[j & 3]; o1[j] = (x1[j] * c - x2[j] * s) * sc; o2[j] = (x1[j] * s + x2[j] * c) * sc; }
}
__device__ __forceinline__ void ret_pass1(int job, const bf16* Z, const float* rcs, const float* rsn, float* RST, LAS unsigned char* lds, int tid) {
    const int lane = tid & 63, w = __builtin_amdgcn_readfirstlane(tid >> 6), r15 = lane & 15, g = lane >> 4;
    const int h = job & 3, n = (job >> 2) & 31, b = job >> 7; const size_t m0 = (size_t)b * SEQ + (size_t)n * RET_C; const float lg2 = ret_lg2(h);
    LAS bf16* kT = (LAS bf16*)lds; LAS bf16* vT = kT + 64 * 136;
    { const int row = tid >> 2, grp = tid & 3; const size_t m = m0 + row; float o1[8], o2[8];
      ret_rope8(Z + m * NZ + ZC_RK + 64 * h, rcs + m * 32, rsn + m * 32, grp, 0.125f * __builtin_amdgcn_exp2f(-(float)(row + 1) * lg2), o1, o2);
#pragma unroll
      for (int j = 0; j < 8; ++j) { kT[(8 * grp + j) * 136 + row] = (bf16)f2bf(o1[j]); kT[(32 + 8 * grp + j) * 136 + row] = (bf16)f2bf(o2[j]); }
      const v4u v0 = *(const v4u*)(Z + m * NZ + ZC_RV + 64 * h + 16 * grp), v1 = *(const v4u*)(Z + m * NZ + ZC_RV + 64 * h + 16 * grp + 8);
      const unsigned vw[8] = {v0.x, v0.y, v0.z, v0.w, v1.x, v1.y, v1.z, v1.w};
#pragma unroll
      for (int j = 0; j < 8; ++j) { vT[(16 * grp + 2 * j) * 136 + row] = (bf16)(vw[j] & 0xffffu); vT[(16 * grp + 2 * j + 1) * 136 + row] = (bf16)(vw[j] >> 16); } }
    WG_SYNC();
    const int et = w & 3, dt0 = (w >> 2) * 2; f32x4 acc0 = {0.f, 0.f, 0.f, 0.f}, acc1 = {0.f, 0.f, 0.f, 0.f};
#pragma unroll
    for (int kk = 0; kk < 4; ++kk) { const bf16x8 a = frag(vT, 16 * et + r15, 136, 32 * kk + 8 * g);
        acc0 = MFMA16(a, frag(kT, 16 * dt0 + r15, 136, 32 * kk + 8 * g), acc0); acc1 = MFMA16(a, frag(kT, 16 * dt0 + 16 + r15, 136, 32 * kk + 8 * g), acc1); }
    const float gc = __builtin_amdgcn_exp2f((float)RET_C * lg2); float* dst = RST + ((size_t)((b * 4 + h) * 32 + n) * 64 + 16 * et + 4 * g) * 64 + 16 * dt0 + r15;
#pragma unroll
    for (int j = 0; j < 4; ++j) { dst[j * 64] = acc0[j] * gc; dst[j * 64 + 16] = acc1[j] * gc; }
    WG_SYNC();
}
__device__ __forceinline__ void ret_scan(float* RST, int gt) {
    if (gt >= 16 * 4096) return;
    const int bh = gt >> 12, idx = gt & 4095, h = bh & 3; const float gc = __builtin_amdgcn_exp2f((float)RET_C * ret_lg2(h)); float* p = RST + (size_t)bh * 32 * 4096 + idx; float run = 0.f;
#pragma unroll 1
    for (int n0 = 0; n0 < 32; n0 += 8) { float t[8];
#pragma unroll
        for (int i = 0; i < 8; ++i) t[i] = p[(size_t)(n0 + i) * 4096];
#pragma unroll
        for (int i = 0; i < 8; ++i) { p[(size_t)(n0 + i) * 4096] = run; run = gc * run + t[i]; } }
}
__device__ __forceinline__ void ret_pass3(int job, const bf16* Z, const float* rcs, const float* rsn, const float* RST, const float* normg, bf16* Y, LAS unsigned char* lds, int tid) {
    const int lane = tid & 63, w = __builtin_amdgcn_readfirstlane(tid >> 6), r15 = lane & 15, g = lane >> 4;
    const int h = job & 3, n = (job >> 2) & 31, b = job >> 7; const size_t m0 = (size_t)b * SEQ + (size_t)n * RET_C; const float lg2 = ret_lg2(h);
    LAS bf16* qs = (LAS bf16*)lds; LAS bf16* ks = qs + 128 * 72; LAS bf16* vT = ks + 128 * 72; LAS bf16* sT = vT + 64 * 136;
    { const int row = tid >> 2, grp = tid & 3; const size_t m = m0 + row; float o1[8], o2[8];
      ret_rope8(Z + m * NZ + ZC_RQ + 64 * h, rcs + m * 32, rsn + m * 32, grp, __builtin_amdgcn_exp2f((float)(row + 1) * lg2), o1, o2);
      *(LAS v4u*)(qs + row * 72 + 8 * grp) = pack8(o1); *(LAS v4u*)(qs + row * 72 + 32 + 8 * grp) = pack8(o2);
      ret_rope8(Z + m * NZ + ZC_RK + 64 * h, rcs + m * 32, rsn + m * 32, grp, 0.125f * __builtin_amdgcn_exp2f(-(float)(row + 1) * lg2), o1, o2);
      *(LAS v4u*)(ks + row * 72 + 8 * grp) = pack8(o1); *(LAS v4u*)(ks + row * 72 + 32 + 8 * grp) = pack8(o2);
      const v4u v0 = *(const v4u*)(Z + m * NZ + ZC_RV + 64 * h + 16 * grp), v1 = *(const v4u*)(Z + m * NZ + ZC_RV + 64 * h + 16 * grp + 8);
      const unsigned vw[8] = {v0.x, v0.y, v0.z, v0.w, v1.x, v1.y, v1.z, v1.w};
#pragma unroll
      for (int j = 0; j < 8; ++j) { vT[(16 * grp + 2 * j) * 136 + row] = (bf16)(vw[j] & 0xffffu); vT[(16 * grp + 2 * j + 1) * 136 + row] = (bf16)(vw[j] >> 16); }
      const int e = tid >> 3, d8 = (tid & 7) * 8; const float* sp = RST + ((size_t)((b * 4 + h) * 32 + n) * 64 + e) * 64 + d8; const f32x4 a0 = *(const f32x4*)sp, a1 = *(const f32x4*)(sp + 4);
      const float sv[8] = {a0[0], a0[1], a0[2], a0[3], a1[0], a1[1], a1[2], a1[3]}; *(LAS v4u*)(sT + e * 72 + d8) = pack8(sv); }
    WG_SYNC();
    bf16x8 qf[2]; qf[0] = frag(qs, 16 * w + r15, 72, 8 * g); qf[1] = frag(qs, 16 * w + r15, 72, 32 + 8 * g);
    f32x4 Dt[8];
#pragma unroll
    for (int sb = 0; sb < 8; ++sb) { f32x4 acc = {0.f, 0.f, 0.f, 0.f};
        if (sb <= w) { acc = MFMA16(frag(ks, 16 * sb + r15, 72, 8 * g), qf[0], acc); acc = MFMA16(frag(ks, 16 * sb + r15, 72, 32 + 8 * g), qf[1], acc);
            if (sb == w) {
#pragma unroll
                for (int j = 0; j < 4; ++j) if (4 * g + j > r15) acc[j] = 0.f; } }
        Dt[sb] = acc; }
    f32x4 O[4];
#pragma unroll
    for (int et = 0; et < 4; ++et) O[et] = (f32x4){0.f, 0.f, 0.f, 0.f};
#pragma unroll
    for (int k2 = 0; k2 < 4; ++k2) if (2 * k2 <= w) { const bf16x8 pb = pack_pair(Dt[2 * k2], Dt[2 * k2 + 1]);
#pragma unroll
        for (int et = 0; et < 4; ++et) O[et] = MFMA16(frag2(vT, 16 * et + r15, 136, 32 * k2 + 4 * g), pb, O[et]); }
#pragma unroll
    for (int kk = 0; kk < 2; ++kk)
#pragma unroll
        for (int et = 0; et < 4; ++et) O[et] = MFMA16(frag(sT, 16 * et + r15, 72, 32 * kk + 8 * g), qf[kk], O[et]);
    float s1 = 0.f;
#pragma unroll
    for (int et = 0; et < 4; ++et) s1 += pg8::sum4(O[et]);
    s1 += __shfl_xor(s1, 16); s1 += __shfl_xor(s1, 32); const float mean = s1 * (1.0f / 64.0f); float s2 = 0.f;
#pragma unroll
    for (int et = 0; et < 4; ++et) { O[et] = O[et] - mean; s2 += pg8::dot4(O[et]); }
    s2 += __shfl_xor(s2, 16); s2 += __shfl_xor(s2, 32); const float rstd = __builtin_amdgcn_rsqf(s2 * (1.0f / 64.0f) + 1e-6f);
    const size_t m = m0 + 16 * w + r15;
#pragma unroll
    for (int et = 0; et < 4; ++et) { const int e = 16 * et + 4 * g; const v2u gw = *(const v2u*)(Z + m * NZ + ZC_RG + 64 * h + e); const f32x4 ng = *(const f32x4*)(normg + 64 * h + e);
        v2u o; o.x = pg8::cvt_pk_bf16(O[et][0] * rstd * ng[0] * silu_fast(lo16(gw.x)), O[et][1] * rstd * ng[1] * silu_fast(hi16(gw.x)));
        o.y = pg8::cvt_pk_bf16(O[et][2] * rstd * ng[2] * silu_fast(lo16(gw.y)), O[et][3] * rstd * ng[3] * silu_fast(hi16(gw.y)));
        *(v2u*)(Y + m * 1024 + 768 + 64 * h + e) = o; }
    WG_SYNC();
}

__device__ __forceinline__ float hg_lb(const float* lblog, int l, int ch) {
    const float x0 = lblog[ch], x1 = lblog[512 + ch], x2 = lblog[1024 + ch], x3 = lblog[1536 + ch]; const float mx_ = fmaxf(fmaxf(x0, x1), fmaxf(x2, x3));
    const float e0 = __expf(x0 - mx_), e1 = __expf(x1 - mx_), e2 = __expf(x2 - mx_), e3 = __expf(x3 - mx_);
    return ((l >= 1 ? e1 : 0.f) + (l >= 2 ? e2 : 0.f) + (l >= 3 ? e3 : 0.f)) / (e0 + e1 + e2 + e3);
}
__device__ __forceinline__ void hg_gates(const bf16* Z, size_t m0, int h, int k, int seg, float lb, LAS float* tot, int half, float (&bc)[32], float (&kk)[32]) {
    const bf16* fp = Z + (m0 + 32 * seg) * NZ + ZC_HF + 128 * h + k; float cum = 0.f;
#pragma unroll
    for (int i = 0; i < 32; ++i) { const float f = bf2f(fp[(size_t)i * NZ]); const float fg = lb + (1.0f - lb) * __builtin_amdgcn_rcpf(1.0f + __builtin_amdgcn_exp2f(-1.4426950408889634f * f));
        kk[i] = 1.0f - fg; cum += __builtin_amdgcn_logf(fg) * 0.6931471805599453f; bc[i] = cum; }
    tot[(half * 2 + seg) * 128 + k] = cum;
    WG_SYNC();
    if (seg == 1) { const float o = tot[(half * 2) * 128 + k];
#pragma unroll
        for (int i = 0; i < 32; ++i) bc[i] += o; }
}
__device__ __forceinline__ void hg_stage_vT(const bf16* Z, size_t m0, int h, int u, LAS bf16* vT) {
    const int row = u >> 2, grp = u & 3; const bf16* p = Z + (m0 + row) * NZ + ZC_HI + 64 * h + 16 * grp; const v4u v0 = *(const v4u*)p, v1 = *(const v4u*)(p + 8);
    const unsigned vw[8] = {v0.x, v0.y, v0.z, v0.w, v1.x, v1.y, v1.z, v1.w};
#pragma unroll
    for (int j = 0; j < 8; ++j) { vT[(16 * grp + 2 * j) * 72 + row] = (bf16)(vw[j] & 0xffffu); vT[(16 * grp + 2 * j + 1) * 72 + row] = (bf16)(vw[j] >> 16); }
}
__device__ __forceinline__ void hg_pass1(int pair, const bf16* Z, const float* lblog, int l, float* HST, float* HDC, LAS unsigned char* lds, int tid) {
    const int lane = tid & 63, w = __builtin_amdgcn_readfirstlane(tid >> 6), r15 = lane & 15, g = lane >> 4, half = w >> 2, wq = w & 3, u = tid & 255, k = u & 127, seg = u >> 7;
    const int job = 2 * pair + half, h = job & 3, c = (job >> 2) & 63, b = job >> 8; const size_t m0 = (size_t)b * SEQ + (size_t)c * 64;
    LAS float* tot = (LAS float*)lds; LAS bf16* koT = (LAS bf16*)(lds + 2048) + half * (128 * 72 + 64 * 72); LAS bf16* vT = koT + 128 * 72;
    float bc[32], kk[32]; hg_gates(Z, m0, h, k, seg, hg_lb(lblog, l, 128 * h + k), tot, half, bc, kk);
    const float blast = tot[(half * 2) * 128 + k] + tot[(half * 2 + 1) * 128 + k];
#pragma unroll
    for (int q4 = 0; q4 < 4; ++q4) { float x[8];
#pragma unroll
        for (int j = 0; j < 8; ++j) x[j] = kk[8 * q4 + j] * __expf(blast - bc[8 * q4 + j]);
        *(LAS v4u*)(koT + k * 72 + 32 * seg + 8 * q4) = pack8(x); }
    if (seg == 0) HDC[(size_t)((b * 4 + h) * 64 + c) * 128 + k] = __expf(blast);
    hg_stage_vT(Z, m0, h, u, vT);
    WG_SYNC();
    f32x4 acc[4][2];
#pragma unroll
    for (int et = 0; et < 4; ++et) { acc[et][0] = (f32x4){0.f, 0.f, 0.f, 0.f}; acc[et][1] = (f32x4){0.f, 0.f, 0.f, 0.f}; }
#pragma unroll
    for (int k2 = 0; k2 < 2; ++k2) { const bf16x8 b0 = frag(koT, 32 * wq + r15, 72, 32 * k2 + 8 * g), b1 = frag(koT, 32 * wq + 16 + r15, 72, 32 * k2 + 8 * g);
#pragma unroll
        for (int et = 0; et < 4; ++et) { const bf16x8 a = frag(vT, 16 * et + r15, 72, 32 * k2 + 8 * g); acc[et][0] = MFMA16(a, b0, acc[et][0]); acc[et][1] = MFMA16(a, b1, acc[et][1]); } }
    float* dst = HST + (size_t)((b * 4 + h) * 64 + c) * 8192 + 32 * wq + r15;
#pragma unroll
    for (int et = 0; et < 4; ++et)
#pragma unroll
        for (int j = 0; j < 4; ++j) { dst[(16 * et + 4 * g + j) * 128] = acc[et][0][j]; dst[(16 * et + 4 * g + j) * 128 + 16] = acc[et][1][j]; }
    WG_SYNC();
}
__device__ __forceinline__ void hg_scan(float* HST, const float* HDC, int gt) {
    const int bh = gt >> 13, idx = gt & 8191, k = idx & 127; float* p = HST + (size_t)bh * 64 * 8192 + idx; const float* dp = HDC + (size_t)bh * 64 * 128 + k; float run = 0.f;
#pragma unroll 1
    for (int c0 = 0; c0 < 64; c0 += 8) { float t[8], d[8];
#pragma unroll
        for (int i = 0; i < 8; ++i) { t[i] = p[(size_t)(c0 + i) * 8192]; d[i] = dp[(c0 + i) * 128]; }
#pragma unroll
        for (int i = 0; i < 8; ++i) { p[(size_t)(c0 + i) * 8192] = run; run = d[i] * run + t[i]; } }
}
__device__ __forceinline__ void hg_pass3(int pair, const bf16* Z, const float* lblog, int l, const float* HST, const float* normg, bf16* Y, LAS unsigned char* lds, int tid) {
    const int lane = tid & 63, w = __builtin_amdgcn_readfirstlane(tid >> 6), r15 = lane & 15, g = lane >> 4, half = w >> 2, tb = w & 3, u = tid & 255, k = u & 127, seg = u >> 7;
    const int job = 2 * pair + half, h = job & 3, c = (job >> 2) & 63, b = job >> 8; const size_t m0 = (size_t)b * SEQ + (size_t)c * 64;
    LAS float* tot = (LAS float*)lds; LAS bf16* qs = (LAS bf16*)(lds + 2048) + half * (3 * 64 * 136 + 64 * 72); LAS bf16* ks = qs + 64 * 136; LAS bf16* sT = ks + 64 * 136; LAS bf16* vT = sT + 64 * 136;
    { float bc[32], kk[32]; hg_gates(Z, m0, h, k, seg, hg_lb(lblog, l, 128 * h + k), tot, half, bc, kk);
      const float bmid = tot[(half * 2) * 128 + k]; const bf16* qp = Z + (m0 + 32 * seg) * NZ + ZC_HQ + 128 * h + k;
#pragma unroll
      for (int i = 0; i < 32; ++i) { const float q = bf2f(qp[(size_t)i * NZ]); qs[(32 * seg + i) * 136 + k] = (bf16)f2bf(q * __expf(bc[i] - bmid)); ks[(32 * seg + i) * 136 + k] = (bf16)f2bf(kk[i] * __expf(bmid - bc[i])); } }
    hg_stage_vT(Z, m0, h, u, vT);
    { const int k8 = (u & 15) * 8; float em[8];
#pragma unroll
      for (int j = 0; j < 8; ++j) em[j] = __expf(tot[(half * 2) * 128 + k8 + j]);
#pragma unroll
      for (int i = 0; i < 4; ++i) { const int e = (u >> 4) + 16 * i; const float* sp = HST + (size_t)((b * 4 + h) * 64 + c) * 8192 + e * 128 + k8; const f32x4 a0 = *(const f32x4*)sp, a1 = *(const f32x4*)(sp + 4);
          const float sv[8] = {a0[0] * em[0], a0[1] * em[1], a0[2] * em[2], a0[3] * em[3], a1[0] * em[4], a1[1] * em[5], a1[2] * em[6], a1[3] * em[7]}; *(LAS v4u*)(sT + e * 136 + k8) = pack8(sv); } }
    WG_SYNC();
    bf16x8 qf[4];
#pragma unroll
    for (int kq = 0; kq < 4; ++kq) qf[kq] = frag(qs, 16 * tb + r15, 136, 32 * kq + 8 * g);
    f32x4 Dt[4];
#pragma unroll
    for (int sb = 0; sb < 4; ++sb) { f32x4 acc = {0.f, 0.f, 0.f, 0.f};
        if (sb <= tb) {
#pragma unroll
            for (int kq = 0; kq < 4; ++kq) acc = MFMA16(frag(ks, 16 * sb + r15, 136, 32 * kq + 8 * g), qf[kq], acc);
            if (sb == tb) {
#pragma unroll
                for (int j = 0; j < 4; ++j) if (4 * g + j > r15) acc[j] = 0.f; } }
        Dt[sb] = acc; }
    f32x4 O[4];
#pragma unroll
    for (int et = 0; et < 4; ++et) O[et] = (f32x4){0.f, 0.f, 0.f, 0.f};
#pragma unroll
    for (int k2 = 0; k2 < 2; ++k2) if (2 * k2 <= tb) { const bf16x8 pb = pack_pair(Dt[2 * k2], Dt[2 * k2 + 1]);
#pragma unroll
        for (int et = 0; et < 4; ++et) O[et] = MFMA16(frag2(vT, 16 * et + r15, 72, 32 * k2 + 4 * g), pb, O[et]); }
#pragma unroll
    for (int kq = 0; kq < 4; ++kq)
#pragma unroll
        for (int et = 0; et < 4; ++et) O[et] = MFMA16(frag(sT, 16 * et + r15, 136, 32 * kq + 8 * g), qf[kq], O[et]);
    float s2 = 0.f;
#pragma unroll
    for (int et = 0; et < 4; ++et) s2 += pg8::dot4(O[et]);
    s2 += __shfl_xor(s2, 16); s2 += __shfl_xor(s2, 32); const float rstd = __builtin_amdgcn_rsqf(s2 * (1.0f / 64.0f) + 1e-6f);
    const size_t m = m0 + 16 * tb + r15;
#pragma unroll
    for (int et = 0; et < 4; ++et) { const int e = 16 * et + 4 * g; const v2u gw = *(const v2u*)(Z + m * NZ + ZC_HG + 64 * h + e); const f32x4 ng = *(const f32x4*)(normg + 64 * h + e);
        v2u o; o.x = pg8::cvt_pk_bf16(O[et][0] * rstd * ng[0] * silu_fast(lo16(gw.x)), O[et][1] * rstd * ng[1] * silu_fast(hi16(gw.x)));
        o.y = pg8::cvt_pk_bf16(O[et][2] * rstd * ng[2] * silu_fast(lo16(gw.y)), O[et][3] * rstd * ng[3] * silu_fast(hi16(gw.y)));
        *(v2u*)(Y + m * 1024 + 512 + 64 * h + e) = o; }
    WG_SYNC();
}
}

#define V_WGU ((bf16*)(ws + WS_WGU))
#define V_WD ((bf16*)(ws + WS_WD))
#define V_WIN ((bf16*)(ws + WS_WIN))
#define V_WMLA ((bf16*)(ws + WS_WMLA))
#define V_WOUT ((bf16*)(ws + WS_WOUT))
#define V_WPG ((bf16*)(ws + WS_WPG))
#define V_WPP ((bf16*)(ws + WS_WPP))
#define V_B0 ((bf16*)(ws + WS_B0))
#define V_B1 ((bf16*)(ws + WS_B1))
#define V_ZH ((bf16*)(ws + WS_ZH))
#define V_QKV ((bf16*)(ws + WS_QKV))
#define V_PBF ((bf16*)(ws + WS_PBF))
#define V_SSQ0 ((float*)(ws + WS_SSQ))
#define V_SSQ1 ((float*)(ws + WS_SSQ) + (size_t)M * 16)
#define V_SSQQ ((float*)(ws + WS_SSQ2))
#define V_SSQKV ((float*)(ws + WS_SSQ2) + (size_t)M * 4)
#define V_MCS ((float*)(ws + WS_ROPE))
#define V_MSN ((float*)(ws + WS_ROPE) + (size_t)M * 16)
#define V_RCS ((float*)(ws + WS_ROPE) + (size_t)M * 32)
#define V_RSN ((float*)(ws + WS_ROPE) + (size_t)M * 64)
#define V_HST ((float*)(ws + WS_HST))
#define V_HDC ((float*)(ws + WS_HDC))
#define V_RST ((float*)(ws + WS_RST))
#ifndef MIX_RET
#define MIX_RET 1
#endif
#ifndef MIX_HG
#define MIX_HG 1
#endif
#ifndef MIX_SG
#define MIX_SG 0
#endif
#ifndef MIX_MLA
#define MIX_MLA 0
#endif
__global__ void __launch_bounds__(NWAVES * 64, 2) mk_fwd(Args a) {
    extern __shared__ __attribute__((aligned(16))) unsigned char lds_raw[];
    LAS unsigned char* lds = (LAS unsigned char*)lds_raw;
    volatile LAS unsigned* MISC = (volatile LAS unsigned*)(lds + MISC_OFF);
    const int tid = threadIdx.x, lane = tid & 63, wave = __builtin_amdgcn_readfirstlane(tid >> 6);
    const int G = gridDim.x; const int bx = blockIdx.x; const int vcu = (G % 8 == 0) ? (bx % 8) * (G / 8) + bx / 8 : bx;
    unsigned char* ws = a.ws;
    gu32* ctl = (gu32*)(ws + WS_CTL);
    for (int u = tid; u < (LDS_BYTES - LDSCTL_OFF) / 4; u += NWAVES * 64) ((LAS unsigned*)(lds + LDSCTL_OFF))[u] = 0u;
    __syncthreads();
    XcdBarrier bar = xcd_barrier_post((unsigned*)(ctl + CW_BAR) + a.li * XCD_BAR_WORDS, MISC + 8);
    const int lo = a.ph_lo, hi = a.ph_hi;
#define IN(k) (lo <= (k) && (k) < hi)
#define SEAM(k) do { if (IN(k) && IN((k) + 1)) xcd_barrier(bar); } while (0)
    float* out = a.out;

    if (IN(0)) { prologue(a, lds, tid, lane, wave, vcu, G); }
    SEAM(0);

    for (int hl = 0; hl < 2 * DEPTH; ++hl) {
        const int l = hl >> 1, second = hl & 1, pb = 1 + 10 * l + 7 * second;
        if (IN(pb)) {
            pg8::Gemm g{(second == 0 && l > 0) ? V_B1 : V_B0, V_WGU + (size_t)(2 * l + second) * NGU * D, M, NGU, D, D}; pg8::StaticOrder S; S.init(M, NGU, G, bx);
            pg8::EpiSwiGLU E{V_ZH, V_SSQ0};
            pg8::gemm_phase<pg8::EpiSwiGLU, pg8::StaticOrder, true, true>(lds + RING_OFF, g, S, E);
        }
        SEAM(pb);
        if (IN(pb + 1)) {
            pg8::Gemm g{V_ZH, V_WD + (size_t)(2 * l + second) * D * DFF, M, D, DFF, DFF}; pg8::StaticOrder S; S.init(M, D, G, bx);
            pg8::EpiRes E{(hl == 0) ? a.in[IN_X] : (const float*)out, out, V_B0, V_SSQ1, 0.5f};
            pg8::gemm_phase<pg8::EpiRes, pg8::StaticOrder, false, true>(lds + RING_OFF, g, S, E);
        }
        SEAM(pb + 1);
        if (!second) {
            if (IN(pb + 2)) {
                pg8::Gemm g{V_B0, V_WIN + (size_t)l * NZ * D, M, NZ, D, D}; pg8::StaticOrder S; S.init(M, NZ, G, bx);
                pg8::EpiZ E{V_ZH, V_SSQ1, V_SSQQ, V_SSQKV};
                pg8::gemm_phase<pg8::EpiZ, pg8::StaticOrder, true, true>(lds + RING_OFF, g, S, E);
                const f32x4* ps = (const f32x4*)(a.in[IN_P] + (size_t)l * M * PLED); v2u* pd = (v2u*)V_PBF;
                for (int i = bx * (NWAVES * 64) + tid; i < M * PLED / 4; i += G * NWAVES * 64) { const f32x4 v = ps[i]; v2u o; o.x = pk2(v[0], v[1]); o.y = pk2(v[2], v[3]); pd[i] = o; }
            }
            SEAM(pb + 2);
            if (IN(pb + 3)) {
                pg8::Gemm g{V_ZH, V_WMLA + (size_t)l * 1024 * 512, M, 1024, 512, NZ}; pg8::StaticOrder S; S.init(M, 1024, G, bx);
                pg8::EpiMla E{V_QKV, V_SSQQ, V_SSQKV, V_MCS, V_MSN};
                pg8::gemm_phase<pg8::EpiMla, pg8::StaticOrder, false, true>(lds + RING_OFF, g, S, E);
                int tid_o = tid; asm volatile("" : "+v"(tid_o));
#if MIX_RET
                for (int j = bx; j < 512; j += G) mx::ret_pass1(j, V_ZH, V_RCS, V_RSN, V_RST, lds + RING_OFF, tid_o);
#endif
#if MIX_HG
                for (int pr = bx; pr < 512; pr += G) mx::hg_pass1(pr, V_ZH, a.in[IN_HGLB], l, V_HST, V_HDC, lds + RING_OFF, tid_o);
#endif
            }
            SEAM(pb + 3);
            if (IN(pb + 4)) {
                int tid_o = tid; asm volatile("" : "+v"(tid_o));
#if MIX_RET
                for (int gt = bx * (NWAVES * 64) + tid_o; gt < 16 * 4096; gt += G * NWAVES * 64) mx::ret_scan(V_RST, gt);
#endif
#if MIX_HG
                for (int gt = bx * (NWAVES * 64) + tid_o; gt < 16 * 8192; gt += G * NWAVES * 64) mx::hg_scan(V_HST, V_HDC, gt);
#endif
            }
            SEAM(pb + 4);
            if (IN(pb + 5)) {
                int tid_o = tid; asm volatile("" : "+v"(tid_o));
#if MIX_RET
                for (int j = bx; j < 512; j += G) mx::ret_pass3(j, V_ZH, V_RCS, V_RSN, V_RST, a.in[IN_RETN] + l * 256, V_B1, lds + RING_OFF, tid_o);
#endif
#if MIX_HG
                for (int pr = bx; pr < 512; pr += G) mx::hg_pass3(pr, V_ZH, a.in[IN_HGLB], l, V_HST, a.in[IN_HGN] + l * 256, V_B1, lds + RING_OFF, tid_o);
#endif
            }
            SEAM(pb + 5);
            if (IN(pb + 6)) {
                { pg8::Gemm g{V_B1, V_WOUT + (size_t)l * D * D, M, D, D, D}; pg8::StaticOrder S; S.init(M, D, G, bx);
                  pg8::EpiRes E{out, out, V_B0, V_SSQ0, 1.0f};
                  pg8::gemm_phase<pg8::EpiRes, pg8::StaticOrder, false, true>(lds + RING_OFF, g, S, E); }
                { pg8::Gemm g{V_PBF, V_WPP + (size_t)l * D * PLED, M, D, PLED, PLED}; pg8::StaticOrder S; S.init(M, D, G, bx);
                  pg8::EpiPlain E{V_QKV, D};
                  pg8::gemm_phase<pg8::EpiPlain, pg8::StaticOrder, false, true>(lds + RING_OFF, g, S, E); }
            }
            SEAM(pb + 6);
        } else {
            if (IN(pb + 2)) {
                pg8::Gemm g{V_B0, V_WPG + (size_t)l * D * D, M, D, D, D}; pg8::StaticOrder S; S.init(M, D, G, bx);
                pg8::EpiPle E{out, V_QKV, V_B1, V_SSQ1, V_SSQ0};
                pg8::gemm_phase<pg8::EpiPle, pg8::StaticOrder, false, true>(lds + RING_OFF, g, S, E);
            }
            SEAM(pb + 2);
        }
    }
    if (IN(41)) {
        const float* gfin = a.in[IN_FINN];
        for (int m = vcu * NWAVES + wave; m < M; m += G * NWAVES) { f32x4* hr = (f32x4*)(out + (size_t)m * D) + lane; const float r = pg8::row_rstd(V_SSQ0, m);
#pragma unroll
            for (int j = 0; j < 4; ++j) { const f32x4 v = hr[64 * j]; const f32x4 gv = *((const f32x4*)gfin + lane + 64 * j); hr[64 * j] = v * r * gv; } }
    }
#undef IN
#undef SEAM
}

#ifndef MK_MODE
#define MK_MODE 1
#endif
#if MK_MODE != 0
__device__ __forceinline__ float gelu_exact(float x) { return 0.5f * x * (1.0f + erff(x * 0.70710678118654752f)); }
__device__ __forceinline__ float silu_f(float x) { return x / (1.0f + __expf(-x)); }
__global__ void __launch_bounds__(256) nv_mla(const bf16* QKV, bf16* Y) {
    const int lane = threadIdx.x & 63, gw = blockIdx.x * 4 + (threadIdx.x >> 6); const int t = gw & (SEQ - 1), bh = gw >> 12, b = bh >> 2, h = bh & 3;
    const size_t m = (size_t)b * SEQ + t;
    float q[96];
#pragma unroll
    for (int d = 0; d < 96; ++d) q[d] = bf2f(QKV[m * 1024 + QC_Q + 96 * h + d]);
    float mi = -INFINITY, li = 0.f, acc[64];
#pragma unroll
    for (int e = 0; e < 64; ++e) acc[e] = 0.f;
    for (int s = lane; s <= t; s += 64) { const bf16* kr = QKV + ((size_t)b * SEQ + s) * 1024; float dot = 0.f;
#pragma unroll
        for (int d = 0; d < 64; ++d) dot += q[d] * bf2f(kr[QC_KN + 64 * h + d]);
#pragma unroll
        for (int d = 0; d < 32; ++d) dot += q[64 + d] * bf2f(kr[QC_KR + d]);
        const float mn = fmaxf(mi, dot), corr = exp2f(mi - mn), p = exp2f(dot - mn); li = li * corr + p; mi = mn;
#pragma unroll
        for (int e = 0; e < 64; ++e) acc[e] = acc[e] * corr + p * bf2f(kr[QC_V + 64 * h + e]); }
    const float mg = wave_max(mi), w = (mi == -INFINITY) ? 0.f : exp2f(mi - mg); const float L = wave_sum(li * w); float res = 0.f;
#pragma unroll
    for (int e = 0; e < 64; ++e) { const float v = wave_sum(acc[e] * w); if (lane == e) res = v; }
    Y[m * 1024 + 64 * h + lane] = (bf16)f2bf(res / L);
}
__global__ void __launch_bounds__(256) nv_ret_prep(const bf16* Z, const float* rcs, const float* rsn, float* QR, float* KR) {
    const int i = blockIdx.x * 256 + threadIdx.x; if (i >= M * 128) return; const int m = i >> 7, r = i & 127, h = r >> 5, j = r & 31;
    const float c = rcs[(size_t)m * 32 + j], s = rsn[(size_t)m * 32 + j];
    { const float x1 = bf2f(Z[(size_t)m * NZ + ZC_RQ + 64 * h + j]), x2 = bf2f(Z[(size_t)m * NZ + ZC_RQ + 64 * h + 32 + j]); QR[(size_t)m * 256 + 64 * h + j] = x1 * c - x2 * s; QR[(size_t)m * 256 + 64 * h + 32 + j] = x1 * s + x2 * c; }
    { const float x1 = bf2f(Z[(size_t)m * NZ + ZC_RK + 64 * h + j]), x2 = bf2f(Z[(size_t)m * NZ + ZC_RK + 64 * h + 32 + j]); KR[(size_t)m * 256 + 64 * h + j] = 0.125f * (x1 * c - x2 * s); KR[(size_t)m * 256 + 64 * h + 32 + j] = 0.125f * (x1 * s + x2 * c); }
}
__global__ void __launch_bounds__(256) nv_ret(const bf16* Z, const float* QR, const float* KR, const float* normg, bf16* Y) {
    const int lane = threadIdx.x & 63, gw = blockIdx.x * 4 + (threadIdx.x >> 6); const int t = gw & (SEQ - 1), bh = gw >> 12, b = bh >> 2, h = bh & 3;
    const size_t m = (size_t)b * SEQ + t; const float lg2 = log2f(1.0f - exp2f(-(5.0f + (float)h)));
    float q[64], acc[64];
#pragma unroll
    for (int d = 0; d < 64; ++d) { q[d] = QR[m * 256 + 64 * h + d]; acc[d] = 0.f; }
    for (int s = lane; s <= t; s += 64) { const size_t ms = (size_t)b * SEQ + s; float dot = 0.f;
#pragma unroll
        for (int d = 0; d < 64; ++d) dot += q[d] * KR[ms * 256 + 64 * h + d];
        const float p = dot * exp2f((float)(t - s) * lg2);
#pragma unroll
        for (int e = 0; e < 64; ++e) acc[e] += p * bf2f(Z[ms * NZ + ZC_RV + 64 * h + e]); }
    float o = 0.f;
#pragma unroll
    for (int e = 0; e < 64; ++e) { const float v = wave_sum(acc[e]); if (lane == e) o = v; }
    const float mean = wave_sum(o) * (1.0f / 64.0f), oc = o - mean, var = wave_sum(oc * oc) * (1.0f / 64.0f);
    const float gate = silu_f(bf2f(Z[m * NZ + ZC_RG + 64 * h + lane]));
    Y[m * 1024 + 768 + 64 * h + lane] = (bf16)f2bf(oc * rsqrtf(var + 1e-6f) * normg[64 * h + lane] * gate);
}
__global__ void __launch_bounds__(64) nv_hgrn(const bf16* Z, const float* lblog, int l, const float* normg, bf16* Y) {
    __shared__ float sq[128], sf[128], sk[128];
    const int lane = threadIdx.x, bh = blockIdx.x, b = bh >> 2, h = bh & 3;
    float lb[2];
#pragma unroll
    for (int c = 0; c < 2; ++c) { const int ch = 128 * h + lane + 64 * c; const float x0 = lblog[ch], x1 = lblog[512 + ch], x2 = lblog[1024 + ch], x3 = lblog[1536 + ch];
        const float mx = fmaxf(fmaxf(x0, x1), fmaxf(x2, x3)); const float e0 = __expf(x0 - mx), e1 = __expf(x1 - mx), e2 = __expf(x2 - mx), e3 = __expf(x3 - mx); const float inv = 1.0f / (e0 + e1 + e2 + e3);
        lb[c] = (l >= 1 ? e1 : 0.f) * inv + (l >= 2 ? e2 : 0.f) * inv + (l >= 3 ? e3 : 0.f) * inv; }
    float S[128];
#pragma unroll
    for (int k = 0; k < 128; ++k) S[k] = 0.f;
    const float ng = normg[64 * h + lane];
    for (int t = 0; t < SEQ; ++t) { const size_t m = (size_t)b * SEQ + t; const bf16* zr = Z + m * NZ;
        __syncthreads();
#pragma unroll
        for (int c = 0; c < 2; ++c) { const int k = lane + 64 * c; const float f = bf2f(zr[ZC_HF + 128 * h + k]); const float fg = lb[c] + (1.0f - lb[c]) / (1.0f + __expf(-f));
            sq[k] = bf2f(zr[ZC_HQ + 128 * h + k]); sf[k] = fg; sk[k] = 1.0f - fg; }
        __syncthreads();
        const float v = bf2f(zr[ZC_HI + 64 * h + lane]); float o = 0.f;
#pragma unroll
        for (int k = 0; k < 128; ++k) { S[k] = sf[k] * S[k] + sk[k] * v; o += sq[k] * S[k]; }
        const float ms = wave_sum(o * o) * (1.0f / 64.0f); const float gate = silu_f(bf2f(zr[ZC_HG + 64 * h + lane]));
        Y[m * 1024 + 512 + 64 * h + lane] = (bf16)f2bf(o * rsqrtf(ms + 1e-6f) * ng * gate); }
}
__global__ void __launch_bounds__(256) nv_sg_prep(const bf16* Z, const float* lng, bf16* V) {
    const int lane = threadIdx.x & 63, m = blockIdx.x * 4 + (threadIdx.x >> 6); float x[4]; float s = 0.f;
#pragma unroll
    for (int j = 0; j < 4; ++j) { x[j] = gelu_exact(bf2f(Z[(size_t)m * NZ + ZC_V + lane + 64 * j])); s += x[j]; }
    const float mean = wave_sum(s) * (1.0f / 256.0f); float q = 0.f;
#pragma unroll
    for (int j = 0; j < 4; ++j) { x[j] -= mean; q += x[j] * x[j]; }
    const float rstd = rsqrtf(wave_sum(q) * (1.0f / 256.0f) + 1e-6f);
#pragma unroll
    for (int j = 0; j < 4; ++j) V[(size_t)m * 256 + lane + 64 * j] = (bf16)f2bf(x[j] * rstd * lng[lane + 64 * j]);
}
__global__ void __launch_bounds__(256) nv_sg(const bf16* Z, const bf16* V, const float* w, const float* bs, bf16* Y) {
    const int d = threadIdx.x, m = blockIdx.x, t = m & 127, h = d >> 6; const size_t m0 = (size_t)(m - t);
    float acc = bs[h * 128 + t]; const float* wr = w + ((size_t)h * 128 + t) * 128;
    for (int s = 0; s <= t; ++s) acc += wr[s] * bf2f(V[(m0 + s) * 256 + d]);
    Y[(size_t)m * 1024 + 256 + d] = (bf16)f2bf(gelu_exact(bf2f(Z[(size_t)m * NZ + ZC_U + d])) * acc);
}
#endif

extern "C" void kernel_launch(void* const* d_in, const int* in_sizes, int n_in, void* d_out, int out_size, void* d_ws, size_t ws_size, hipStream_t stream) {
    static int grid = 0;
    if (grid == 0) {
        if (n_in != N_IN || in_sizes[0] != M * D || out_size != M * D || ws_size < WS_END) { fprintf(stderr, "kernel_launch: unexpected shapes (n_in %d, in0 %d, out %d, ws %zu < %zu?)\n", n_in, n_in > 0 ? in_sizes[0] : -1, out_size, ws_size, (size_t)WS_END); grid = -1; return; }
        int dev = 0, cus = 0, per_cu = 0;
        if (hipGetDevice(&dev) != hipSuccess || hipDeviceGetAttribute(&cus, hipDeviceAttributeMultiprocessorCount, dev) != hipSuccess) { grid = -1; return; }
        if (hipFuncSetAttribute((const void*)mk_fwd, hipFuncAttributeMaxDynamicSharedMemorySize, LDS_BYTES) != hipSuccess) { fprintf(stderr, "kernel_launch: hipFuncSetAttribute failed\n"); grid = -1; return; }
        if (hipOccupancyMaxActiveBlocksPerMultiprocessor(&per_cu, (const void*)mk_fwd, NWAVES * 64, LDS_BYTES) != hipSuccess || per_cu < 1) { fprintf(stderr, "kernel_launch: occupancy query says %d\n", per_cu); }
        (void)hipGetLastError();
        grid = cus;
    }
    if (grid < 0) return;
    if (hipMemsetAsync((char*)d_ws + WS_CTL, 0, CTL_ZERO_BYTES, stream) != hipSuccess) return;
    Args a{};
    for (int i = 0; i < N_IN; ++i) a.in[i] = (const float*)d_in[i];
    a.out = (float*)d_out; a.ws = (unsigned char*)d_ws;
    auto launch = [&](int lo, int hi, int li) { a.ph_lo = lo; a.ph_hi = hi; a.li = li; hipLaunchKernelGGL(mk_fwd, dim3(grid), dim3(NWAVES * 64), LDS_BYTES, stream, a); };
#if MK_MODE == 0
    launch(0, N_PHASES, 0);
#else
    unsigned char* ws = (unsigned char*)d_ws;
    const bf16* Z = (const bf16*)(ws + WS_ZH); const bf16* QKV = (const bf16*)(ws + WS_QKV); bf16* Y = (bf16*)(ws + WS_B1);
    float* QR = (float*)(ws + WS_HST); float* KR = QR + (size_t)M * 256; bf16* V = (bf16*)(ws + WS_RST);
    const float* rcs = (const float*)(ws + WS_ROPE) + (size_t)M * 32; const float* rsn = rcs + (size_t)M * 32;
    int li = 0, lo = 0;
    for (int l = 0; l < DEPTH; ++l) {
        launch(lo, 1 + 10 * l + 3, li++);
#if !MIX_RET
        hipLaunchKernelGGL(nv_ret_prep, dim3(M * 128 / 256), dim3(256), 0, stream, Z, rcs, rsn, QR, KR);
        hipLaunchKernelGGL(nv_ret, dim3(M), dim3(256), 0, stream, Z, (const float*)QR, (const float*)KR, (const float*)d_in[IN_RETN] + l * 256, Y);
#endif
#if !MIX_HG
        hipLaunchKernelGGL(nv_hgrn, dim3(16), dim3(64), 0, stream, Z, (const float*)d_in[IN_HGLB], l, (const float*)d_in[IN_HGN] + l * 256, Y);
#endif
#if !MIX_SG
        hipLaunchKernelGGL(nv_sg_prep, dim3(M / 4), dim3(256), 0, stream, Z, (const float*)d_in[IN_SGLN] + l * 256, V);
        hipLaunchKernelGGL(nv_sg, dim3(M), dim3(256), 0, stream, Z, (const bf16*)V, (const float*)d_in[IN_SGW] + (size_t)l * 4 * 128 * 128, (const float*)d_in[IN_SGB] + l * 512, Y);
#endif
        launch(1 + 10 * l + 3, 1 + 10 * l + 6, li++);
#if !MIX_MLA
        hipLaunchKernelGGL(nv_mla, dim3(M), dim3(256), 0, stream, QKV, Y);
#endif
        lo = 1 + 10 * l + 6;
    }
    launch(lo, N_PHASES, li++);
#endif
}
```

```cpp
#include <hip/hip_runtime.h>
#include <cstdio>
#include <cstdint>
#include <cmath>
namespace pg8 {
#define PG8_LAS __attribute__((address_space(3)))
typedef unsigned short bf16_t;
typedef short bf16x8 __attribute__((ext_vector_type(8)));
typedef float f32x4 __attribute__((ext_vector_type(4)));
typedef unsigned u32x4 __attribute__((ext_vector_type(4)));
constexpr int BM = 256, BK = 64, HALF = 128, HTB = HALF * BK * 2  , STAGE_BYTES = 8 * HTB, NXCD = 8, WGM = 8;

__host__ __device__ __forceinline__ int lds_byte(int r, int c) { const int st = (r >> 4) * 2 + (c >> 5), rr = r & 15, cc = c & 31, ob = rr * 64 + cc * 2; return st * 1024 + (ob ^ (((ob >> 9) & 1) << 5)); }
__host__ __device__ __forceinline__ void stage_rc(int b, int& R, int& C) { const int st = b / 1024, sb = b % 1024, swz = sb ^ (((sb >> 9) & 1) << 5); R = (st >> 1) * 16 + swz / 64; C = (st & 1) * 32 + (swz % 64) / 2; }
__host__ __device__ __forceinline__ int perm32(int rho) { const int n = rho >> 4, i = rho & 15; return 8 * (i >> 2) + 4 * n + (i & 3); }

struct Unit { int pm, pn; };
struct Gemm { const bf16_t* A; const bf16_t* Bt; int M, N, K, lda; };

struct StaticOrder {
    int nM, nN, nwg, G, c;
    __host__ __device__ void init(int M, int N, int G_, int c_) { nM = M / BM; nN = N / BM; nwg = nM * nN; G = G_; c = c_; }
    __host__ __device__ bool next(int i, Unit& u) const {
        const long L = (long)i * G + c; if (L >= nwg) return false;
        int wgid = (int)L; { const int q = nwg / NXCD, r = nwg % NXCD, xcd = wgid % NXCD, off = wgid / NXCD; wgid = (xcd < r ? xcd * (q + 1) : r * (q + 1) + (xcd - r) * q) + off; }
        const int nig = WGM * nN, gid = wgid / nig, fm = gid * WGM, gsz = (nM - fm) < WGM ? (nM - fm) : WGM;
        u.pm = fm + ((wgid % nig) % gsz); u.pn = (wgid % nig) / gsz; return true;
    }
    __device__ __forceinline__ void a_ready(const Unit&) const {}
    __device__ __forceinline__ void done(const Unit&) const {}
};

__device__ __forceinline__ unsigned cvt_pk_bf16(float lo, float hi) { unsigned r; asm volatile("v_cvt_pk_bf16_f32 %0, %1, %2" : "=v"(r) : "v"(lo), "v"(hi)); return r; }
typedef unsigned u32x2 __attribute__((ext_vector_type(2)));
constexpr float RMS_EPS = 1e-6f, LOG2E = 1.4426950408889634f;
constexpr int DM = 1024, DFF_ = 2816, NZ_ = 3584;
__device__ __forceinline__ float sum4(const f32x4 a) { return (a[0] + a[1]) + (a[2] + a[3]); }
__device__ __forceinline__ float dot4(const f32x4 a) { return (a[0] * a[0] + a[1] * a[1]) + (a[2] * a[2] + a[3] * a[3]); }
__device__ __forceinline__ float row_rstd(const float* ssq, int row) {
    const f32x4* p = (const f32x4*)(ssq + (size_t)row * 16);
    const float s = (sum4(p[0]) + sum4(p[1])) + (sum4(p[2]) + sum4(p[3]));
    return __builtin_amdgcn_rsqf(s * (1.0f / 1024.0f) + RMS_EPS);
}
__device__ __forceinline__ float sigmoid_f(float x) { return __builtin_amdgcn_rcpf(1.0f + __builtin_amdgcn_exp2f(-LOG2E * x)); }

struct EpiSwiGLU {
    static constexpr bool PERM = true, AFTER_DRAIN = false;
    bf16_t* O; const float* ssq;
    __device__ __forceinline__ void operator()(const f32x4 (&acc)[2][2][4][2], const Unit& u, int wr, int wc, int fr, int fq) const {
        const int row0 = u.pm * BM + wr * 64 + fr, col0 = u.pn * 128 + wc * 32 + 8 * fq;
#pragma unroll
        for (int ai = 0; ai < 2; ++ai)
#pragma unroll
            for (int m = 0; m < 4; ++m) { const int row = row0 + ai * HALF + m * 16; const float r = row_rstd(ssq, row);
                float h[8];
#pragma unroll
                for (int n = 0; n < 2; ++n)
#pragma unroll
                    for (int j = 0; j < 4; ++j) { const float g = acc[ai][0][m][n][j] * r, up = acc[ai][1][m][n][j] * r; h[4 * n + j] = g * sigmoid_f(g) * up; }
                u32x4 w; w.x = cvt_pk_bf16(h[0], h[1]); w.y = cvt_pk_bf16(h[2], h[3]); w.z = cvt_pk_bf16(h[4], h[5]); w.w = cvt_pk_bf16(h[6], h[7]);
                *(u32x4*)(O + (size_t)row * DFF_ + col0) = w; }
    }
};
struct EpiRes {
    static constexpr bool PERM = false, AFTER_DRAIN = false;
    const float* base; float* out; bf16_t* hb; float* ssq_out; float alpha;
    __device__ __forceinline__ void operator()(const f32x4 (&acc)[2][2][4][2], const Unit& u, int wr, int wc, int fr, int fq) const {
        const int row0 = u.pm * BM + wr * 64 + fr, col0 = u.pn * BM + wc * 32 + 4 * fq;
#pragma unroll
        for (int ai = 0; ai < 2; ++ai)
#pragma unroll
            for (int m = 0; m < 4; ++m) { const int row = row0 + ai * HALF + m * 16; float s = 0.f;
#pragma unroll
                for (int bj = 0; bj < 2; ++bj)
#pragma unroll
                    for (int n = 0; n < 2; ++n) { const size_t off = (size_t)row * DM + col0 + bj * HALF + n * 16;
                        const f32x4 v = *(const f32x4*)(base + off) + acc[ai][bj][m][n] * alpha; *(f32x4*)(out + off) = v; s += dot4(v);
                        u32x2 w; w.x = cvt_pk_bf16(v[0], v[1]); w.y = cvt_pk_bf16(v[2], v[3]); *(u32x2*)(hb + off) = w; }
                s += __shfl_xor(s, 16); s += __shfl_xor(s, 32);
                if (fq == 0) ssq_out[(size_t)row * 16 + u.pn * 4 + wc] = s;
                asm volatile("" ::: "memory"); }
    }
};
struct EpiZ {
    static constexpr bool PERM = true, AFTER_DRAIN = false;
    bf16_t* Z; const float* ssq; float* ssqq; float* ssqkv;
    __device__ __forceinline__ void operator()(const f32x4 (&acc)[2][2][4][2], const Unit& u, int wr, int wc, int fr, int fq) const {
        const int row0 = u.pm * BM + wr * 64 + fr, col0 = u.pn * BM + wc * 32 + 8 * fq;
#pragma unroll
        for (int ai = 0; ai < 2; ++ai)
#pragma unroll
            for (int m = 0; m < 4; ++m) { const int row = row0 + ai * HALF + m * 16; const float r = row_rstd(ssq, row); float s0 = 0.f, s1 = 0.f;
#pragma unroll
                for (int bj = 0; bj < 2; ++bj) { const f32x4 v0 = acc[ai][bj][m][0] * r, v1 = acc[ai][bj][m][1] * r;
                    if (bj == 0) s0 = dot4(v0) + dot4(v1); else s1 = dot4(v0) + dot4(v1);
                    u32x4 w; w.x = cvt_pk_bf16(v0[0], v0[1]); w.y = cvt_pk_bf16(v0[2], v0[3]); w.z = cvt_pk_bf16(v1[0], v1[1]); w.w = cvt_pk_bf16(v1[2], v1[3]);
                    *(u32x4*)(Z + (size_t)row * NZ_ + col0 + bj * HALF) = w; }
                if (u.pn < 2) { float s = (u.pn == 0) ? s0 + s1 : s0; s += __shfl_xor(s, 16); s += __shfl_xor(s, 32);
                    if (fq == 0) { if (u.pn == 0) ssqq[(size_t)row * 4 + wc] = s; else ssqkv[(size_t)row * 4 + wc] = s; } } }
    }
};
struct EpiMla {
    static constexpr bool PERM = false, AFTER_DRAIN = false;
    bf16_t* O; const float* ssqq; const float* ssqkv; const float* cs; const float* sn;
    __device__ __forceinline__ void operator()(const f32x4 (&acc)[2][2][4][2], const Unit& u, int wr, int wc, int fr, int fq) const {
        const int row0 = u.pm * BM + wr * 64 + fr, col0 = u.pn * BM + wc * 32 + 4 * fq;
        const float QSCALE = 0.10206207261596575f * LOG2E;
#pragma unroll
        for (int ai = 0; ai < 2; ++ai)
#pragma unroll
            for (int m = 0; m < 4; ++m) { const int row = row0 + ai * HALF + m * 16;
                const float rq = __builtin_amdgcn_rsqf(sum4(*(const f32x4*)(ssqq + (size_t)row * 4)) * (1.0f / 256.0f) + RMS_EPS) * QSCALE;
                const float rkv = __builtin_amdgcn_rsqf(sum4(*(const f32x4*)(ssqkv + (size_t)row * 4)) * (1.0f / 128.0f) + RMS_EPS);
#pragma unroll
                for (int bj = 0; bj < 2; ++bj) { const int G = 8 * u.pn + 4 * bj + wc; const float sc = G < 12 ? rq : (G < 28 ? rkv : 1.0f);
                    f32x4 x1 = acc[ai][bj][m][0] * sc, x2 = acc[ai][bj][m][1] * sc;
                    if (G == 2 || G == 5 || G == 8 || G == 11 || G == 28) { const f32x4 c = *(const f32x4*)(cs + (size_t)row * 16 + 4 * fq), s = *(const f32x4*)(sn + (size_t)row * 16 + 4 * fq);
                        const f32x4 y1 = x1 * c - x2 * s, y2 = x1 * s + x2 * c; x1 = y1; x2 = y2; }
                    u32x2 w0, w1; w0.x = cvt_pk_bf16(x1[0], x1[1]); w0.y = cvt_pk_bf16(x1[2], x1[3]); w1.x = cvt_pk_bf16(x2[0], x2[1]); w1.y = cvt_pk_bf16(x2[2], x2[3]);
                    bf16_t* p = O + (size_t)row * DM + col0 + bj * HALF; *(u32x2*)p = w0; *(u32x2*)(p + 16) = w1; } }
    }
};
struct EpiPlain {
    static constexpr bool PERM = true, AFTER_DRAIN = false;
    bf16_t* O; int ldc;
    __device__ __forceinline__ void operator()(const f32x4 (&acc)[2][2][4][2], const Unit& u, int wr, int wc, int fr, int fq) const {
        const int row0 = u.pm * BM + wr * 64 + fr, col0 = u.pn * BM + wc * 32 + 8 * fq;
#pragma unroll
        for (int ai = 0; ai < 2; ++ai)
#pragma unroll
            for (int m = 0; m < 4; ++m) { bf16_t* rowp = O + (size_t)(row0 + ai * HALF + m * 16) * ldc + col0;
#pragma unroll
                for (int bj = 0; bj < 2; ++bj) { const f32x4 v0 = acc[ai][bj][m][0], v1 = acc[ai][bj][m][1];
                    u32x4 w; w.x = cvt_pk_bf16(v0[0], v0[1]); w.y = cvt_pk_bf16(v0[2], v0[3]); w.z = cvt_pk_bf16(v1[0], v1[1]); w.w = cvt_pk_bf16(v1[2], v1[3]);
                    *(u32x4*)(rowp + bj * HALF) = w; } }
    }
};
struct EpiPle {
    static constexpr bool PERM = false, AFTER_DRAIN = false;
    float* h; const bf16_t* pp; bf16_t* hb; const float* ssq_in; float* ssq_out;
    __device__ __forceinline__ void operator()(const f32x4 (&acc)[2][2][4][2], const Unit& u, int wr, int wc, int fr, int fq) const {
        const int row0 = u.pm * BM + wr * 64 + fr, col0 = u.pn * BM + wc * 32 + 4 * fq;
#pragma unroll
        for (int ai = 0; ai < 2; ++ai)
#pragma unroll
            for (int m = 0; m < 4; ++m) { const int row = row0 + ai * HALF + m * 16; const float r = row_rstd(ssq_in, row); float s = 0.f;
#pragma unroll
                for (int bj = 0; bj < 2; ++bj)
#pragma unroll
                    for (int n = 0; n < 2; ++n) { const size_t off = (size_t)row * DM + col0 + bj * HALF + n * 16;
                        const f32x4 hv = *(const f32x4*)(h + off); const u32x2 pw = *(const u32x2*)(pp + off); const f32x4 a = acc[ai][bj][m][n] * r;
                        f32x4 v; v[0] = hv[0] + __uint_as_float(pw.x << 16) * sigmoid_f(a[0]); v[1] = hv[1] + __uint_as_float(pw.x & 0xffff0000u) * sigmoid_f(a[1]);
                        v[2] = hv[2] + __uint_as_float(pw.y << 16) * sigmoid_f(a[2]); v[3] = hv[3] + __uint_as_float(pw.y & 0xffff0000u) * sigmoid_f(a[3]);
                        *(f32x4*)(h + off) = v; s += dot4(v);
                        u32x2 w; w.x = cvt_pk_bf16(v[0], v[1]); w.y = cvt_pk_bf16(v[2], v[3]); *(u32x2*)(hb + off) = w; }
                s += __shfl_xor(s, 16); s += __shfl_xor(s, 32);
                if (fq == 0) ssq_out[(size_t)row * 16 + u.pn * 4 + wc] = s;
                asm volatile("" ::: "memory"); }
    }
};

template <class Epi, class Sched, bool ALIGN_EPI = false, bool SP2 = false>
__device__ __forceinline__ void gemm_phase(PG8_LAS unsigned char* lds, const Gemm g, const Sched& S, const Epi& E) {
    int tid_o = threadIdx.x; asm volatile("" : "+v"(tid_o));
    const int tid = tid_o, wid = __builtin_amdgcn_readfirstlane(tid >> 6), lane = tid & 63, wr = wid >> 2, wc = wid & 3, fr = lane & 15, fq = lane >> 4;
    const int K = g.K, nt = K / BK;
    unsigned voffA[2], voffB[2];
#pragma unroll
    for (int i = 0; i < 2; ++i) { int R, C; stage_rc(tid * 16 + i * 8192, R, C); const int Rb = Epi::PERM ? ((R & ~31) + perm32(R & 31)) : R;
        voffA[i] = (unsigned)(R * g.lda + C) * 2u; voffB[i] = (unsigned)(Rb * K + C) * 2u; }
    const size_t kstep = (size_t)(BK * 2);
    const size_t hstep = (size_t)HALF * K * 2;
    const size_t tstep = 2 * hstep; const size_t hstepA = (size_t)HALF * g.lda * 2, tstepA = 2 * hstepA;
    const unsigned ldsw = (unsigned)wid * 1024u;
    const int aoff = lds_byte(wr * 64 + fr, fq * 8), boff = lds_byte(wc * 32 + fr, fq * 8);
#define PG8_SA(b, h) (((b) * 2 + (h)) * HTB)
#define PG8_SB(b, h) ((4 + (b) * 2 + (h)) * HTB)
#define PG8_STAGE(bufoff, gbase, voff) do { _Pragma("unroll") for (int _i = 0; _i < 2; ++_i) \
        __builtin_amdgcn_global_load_lds((const unsigned*)((const char*)(gbase) + (voff)[_i]), (PG8_LAS unsigned*)(lds + (bufoff) + ldsw + _i * 8192), 16, 0, 0); } while (0)
#define PG8_LDA(dst, b, h) do { _Pragma("unroll") for (int m = 0; m < 4; ++m) _Pragma("unroll") for (int k = 0; k < 2; ++k) dst[m][k] = *(const PG8_LAS bf16x8*)(lds + PG8_SA(b, h) + aoff + m * 2048 + k * 1024); } while (0)
#define PG8_LDB(dst, b, h) do { _Pragma("unroll") for (int n = 0; n < 2; ++n) _Pragma("unroll") for (int k = 0; k < 2; ++k) dst[n][k] = *(const PG8_LAS bf16x8*)(lds + PG8_SB(b, h) + boff + n * 2048 + k * 1024); } while (0)
#define PG8_MMA(ai, bj, At, Bt) do { __builtin_amdgcn_s_setprio(1); _Pragma("unroll") for (int m = 0; m < 4; ++m) _Pragma("unroll") for (int n = 0; n < 2; ++n) _Pragma("unroll") for (int k = 0; k < 2; ++k) \
        acc[ai][bj][m][n] = __builtin_amdgcn_mfma_f32_16x16x32_bf16(Bt[n][k], At[m][k], acc[ai][bj][m][n], 0, 0, 0); __builtin_amdgcn_s_setprio(0); } while (0)
#define PG8_WAIT_V(n) asm volatile("s_waitcnt vmcnt(" #n ")" ::: "memory")
#define PG8_WAIT_L(n) asm volatile("s_waitcnt lgkmcnt(" #n ")" ::: "memory")
#define PG8_BAR __builtin_amdgcn_s_barrier()
#define PG8_SCHED __builtin_amdgcn_sched_barrier(0)
    Unit cur, nxt; int ui = 0;
    if (!S.next(0, cur)) return;
    f32x4 acc[2][2][4][2];
#pragma unroll
    for (int a = 0; a < 2; ++a)
#pragma unroll
        for (int b = 0; b < 2; ++b)
#pragma unroll
            for (int m = 0; m < 4; ++m)
#pragma unroll
                for (int n = 0; n < 2; ++n) acc[a][b][m][n] = (f32x4){0.f, 0.f, 0.f, 0.f};
    bf16x8 At[4][2], B0[2][2], B1[2][2];
    const char* cA = (const char*)g.A + (size_t)cur.pm * tstepA; const char* cB = (const char*)g.Bt + (size_t)cur.pn * tstep;
    S.a_ready(cur);
    if constexpr (SP2) {
        PG8_STAGE(PG8_SB(0, 0), cB, voffB); PG8_STAGE(PG8_SB(0, 1), cB + hstep, voffB); PG8_STAGE(PG8_SA(0, 0), cA, voffA); PG8_STAGE(PG8_SA(0, 1), cA + hstepA, voffA);
        if (wr == 1) PG8_BAR;
        PG8_WAIT_V(2); PG8_BAR;
        PG8_STAGE(PG8_SB(1, 0), cB + kstep, voffB); PG8_STAGE(PG8_SA(1, 0), cA + kstep, voffA); PG8_STAGE(PG8_SB(1, 1), cB + hstep + kstep, voffB);
        PG8_WAIT_V(6); PG8_BAR;
    } else {
        PG8_STAGE(PG8_SB(0, 0), cB, voffB); PG8_STAGE(PG8_SA(0, 0), cA, voffA); PG8_STAGE(PG8_SB(0, 1), cB + hstep, voffB); PG8_STAGE(PG8_SA(0, 1), cA + hstepA, voffA);
        if (wr == 1) PG8_BAR;
        PG8_WAIT_V(4); PG8_BAR;
        PG8_STAGE(PG8_SB(1, 0), cB + kstep, voffB); PG8_STAGE(PG8_SA(1, 0), cA + kstep, voffA); PG8_STAGE(PG8_SB(1, 1), cB + hstep + kstep, voffB);
        PG8_WAIT_V(6); PG8_BAR;
    }
    for (;;) {
        const bool has_next = S.next(ui + 1, nxt);
        const char* nA = has_next ? (const char*)g.A + (size_t)nxt.pm * tstepA : cA; const char* nB = has_next ? (const char*)g.Bt + (size_t)nxt.pn * tstep : cB;
        for (int t = 0; t < nt; t += 2) {
            const bool last = (t == nt - 2);
            const char* a1 = cA + (size_t)(t + 1) * kstep;
            const char* a2 = last ? nA : cA + (size_t)(t + 2) * kstep; const char* b2 = last ? nB : cB + (size_t)(t + 2) * kstep;
            const char* a3 = a2 + kstep; const char* b3 = b2 + kstep;
            if (last && has_next) S.a_ready(nxt);
            if constexpr (SP2) {
            PG8_LDB(B0, 0, 0); PG8_LDB(B1, 0, 1); PG8_SCHED; PG8_LDA(At, 0, 0); PG8_STAGE(PG8_SA(1, 1), a1 + hstepA, voffA);
            PG8_WAIT_V(8); PG8_WAIT_L(0); PG8_BAR; PG8_MMA(0, 0, At, B0); PG8_MMA(0, 1, At, B1); PG8_BAR; PG8_SCHED;
            PG8_LDA(At, 0, 1); PG8_STAGE(PG8_SB(0, 0), b2, voffB); PG8_STAGE(PG8_SB(0, 1), b2 + hstep, voffB); PG8_STAGE(PG8_SA(0, 0), a2, voffA);
            PG8_WAIT_V(8); PG8_WAIT_L(0); PG8_BAR; PG8_MMA(1, 0, At, B0); PG8_MMA(1, 1, At, B1); PG8_BAR; PG8_SCHED;
            PG8_LDB(B0, 1, 0); PG8_LDB(B1, 1, 1); PG8_SCHED; PG8_LDA(At, 1, 0); PG8_STAGE(PG8_SA(0, 1), a2 + hstepA, voffA);
            PG8_WAIT_V(8); PG8_WAIT_L(0); PG8_BAR; PG8_MMA(0, 0, At, B0); PG8_MMA(0, 1, At, B1); PG8_BAR; PG8_SCHED;
            PG8_LDA(At, 1, 1); PG8_STAGE(PG8_SB(1, 0), b3, voffB); PG8_STAGE(PG8_SB(1, 1), b3 + hstep, voffB); PG8_STAGE(PG8_SA(1, 0), a3, voffA);
            PG8_WAIT_V(8); PG8_WAIT_L(0); PG8_BAR; PG8_MMA(1, 0, At, B0); PG8_MMA(1, 1, At, B1); PG8_BAR; PG8_SCHED;
            } else {
            PG8_LDB(B0, 0, 0); PG8_SCHED; PG8_LDA(At, 0, 0); PG8_STAGE(PG8_SA(1, 1), a1 + hstepA, voffA);
            PG8_WAIT_L(8); PG8_BAR; PG8_WAIT_L(0); PG8_MMA(0, 0, At, B0); PG8_BAR; PG8_SCHED;
            PG8_LDB(B1, 0, 1); PG8_STAGE(PG8_SB(0, 0), b2, voffB);
            PG8_BAR; PG8_WAIT_L(0); PG8_MMA(0, 1, At, B1); PG8_BAR;
            PG8_LDA(At, 0, 1); PG8_STAGE(PG8_SA(0, 0), a2, voffA);
            PG8_BAR; PG8_WAIT_L(0); PG8_MMA(1, 0, At, B0); PG8_BAR; PG8_SCHED;
            PG8_STAGE(PG8_SB(0, 1), b2 + hstep, voffB);
            PG8_WAIT_V(6); PG8_BAR; PG8_MMA(1, 1, At, B1); PG8_BAR;
            PG8_LDB(B0, 1, 0); PG8_SCHED; PG8_LDA(At, 1, 0); PG8_STAGE(PG8_SA(0, 1), a2 + hstepA, voffA);
            PG8_WAIT_L(8); PG8_BAR; PG8_WAIT_L(0); PG8_MMA(0, 0, At, B0); PG8_BAR; PG8_SCHED;
            PG8_LDB(B1, 1, 1); PG8_STAGE(PG8_SB(1, 0), b3, voffB);
            PG8_BAR; PG8_WAIT_L(0); PG8_MMA(0, 1, At, B1); PG8_BAR;
            PG8_LDA(At, 1, 1); PG8_STAGE(PG8_SA(1, 0), a3, voffA);
            PG8_BAR; PG8_WAIT_L(0); PG8_MMA(1, 0, At, B0); PG8_BAR; PG8_SCHED;
            PG8_STAGE(PG8_SB(1, 1), b3 + hstep, voffB);
            PG8_WAIT_V(6); PG8_BAR; PG8_MMA(1, 1, At, B1); PG8_BAR;
            }
        }
        if constexpr (ALIGN_EPI) { if (wr == 0) PG8_BAR; }
        if constexpr (!Epi::AFTER_DRAIN) { E(acc, cur, wr, wc, fr, fq); S.done(cur); }
        if (!has_next) break;
#pragma unroll
        for (int a = 0; a < 2; ++a)
#pragma unroll
            for (int b = 0; b < 2; ++b)
#pragma unroll
                for (int m = 0; m < 4; ++m)
#pragma unroll
                    for (int n = 0; n < 2; ++n) acc[a][b][m][n] = (f32x4){0.f, 0.f, 0.f, 0.f};
        cur = nxt; cA = nA; cB = nB; ++ui;
        if constexpr (ALIGN_EPI) { if (wr == 1) PG8_BAR; }
    }
    PG8_WAIT_V(0);
    if constexpr (!ALIGN_EPI) { if (wr == 0) PG8_BAR; }
    PG8_BAR;
    if constexpr (Epi::AFTER_DRAIN) { E.fused(acc, cur, wr, wc, fr, fq, lds, wid, lane); S.done(cur); }
#undef PG8_SA
#undef PG8_SB
#undef PG8_STAGE
#undef PG8_LDA
#undef PG8_LDB
#undef PG8_MMA
#undef PG8_WAIT_V
#undef PG8_WAIT_L
#undef PG8_BAR
#undef PG8_SCHED
}
}

constexpr int NWAVES = 8;
constexpr int M = 16384, SEQ = 4096, NBATCH = 4, DEPTH = 4, D = 1024, DFF = 2816, NGU = 2 * DFF, NZ = 3584, NZSRC = 3488, PLED = 256;
constexpr int ZC_U = 512, ZC_V = 768, ZC_HQ = 1024, ZC_HF = 1536, ZC_HI = 2048, ZC_HG = 2304, ZC_RQ = 2560, ZC_RK = 2816, ZC_RV = 3072, ZC_RG = 3328;
constexpr int QC_Q = 0, QC_KN = 384, QC_V = 640, QC_KR = 896;
constexpr size_t MiB = 1u << 20;
constexpr size_t WS_CTL = 0, CTL_ZERO_BYTES = 1 * MiB;
constexpr size_t WS_WGU = 1 * MiB;
constexpr size_t WS_WD = WS_WGU + 88 * MiB;
constexpr size_t WS_WIN = WS_WD + 44 * MiB;
constexpr size_t WS_WMLA = WS_WIN + 28 * MiB;
constexpr size_t WS_WOUT = WS_WMLA + 4 * MiB;
constexpr size_t WS_WPG = WS_WOUT + 8 * MiB;
constexpr size_t WS_WPP = WS_WPG + 8 * MiB;
constexpr size_t WS_WSG = WS_WPP + 2 * MiB;
constexpr size_t WS_B0 = WS_WSG + 1 * MiB;
constexpr size_t WS_B1 = WS_B0 + 32 * MiB;
constexpr size_t WS_ZH = WS_B1 + 32 * MiB;
constexpr size_t WS_QKV = WS_ZH + 112 * MiB;
constexpr size_t WS_PBF = WS_QKV + 32 * MiB;
constexpr size_t WS_HST = WS_PBF + 8 * MiB;
constexpr size_t WS_HDC = WS_HST + 32 * MiB;
constexpr size_t WS_RST = WS_HDC + 1 * MiB;
constexpr size_t WS_ROPE = WS_RST + 8 * MiB;
constexpr size_t WS_SSQ = WS_ROPE + 6 * MiB;
constexpr size_t WS_SSQ2 = WS_SSQ + 2 * MiB;
constexpr size_t WS_END = WS_SSQ2 + 1 * MiB;
constexpr int CW_TMO = 0, CW_BAR = 4096;
constexpr int MAX_LAUNCHES = 16;
constexpr int RING_OFF = 0, RING_BYTES = 131072, LDSCTL_OFF = RING_BYTES, MISC_OFF = LDSCTL_OFF + 320, LDS_BYTES = 147456;

#define GAS __attribute__((address_space(1)))
#define LAS __attribute__((address_space(3)))
typedef unsigned short bf16;
typedef unsigned v4u __attribute__((ext_vector_type(4)));
typedef unsigned v2u __attribute__((ext_vector_type(2)));
typedef float f32x4 __attribute__((ext_vector_type(4)));
typedef short bf16x8 __attribute__((ext_vector_type(8)));
typedef GAS unsigned gu32;
#define RLX_AGENT __ATOMIC_RELAXED, __HIP_MEMORY_SCOPE_AGENT
#define LDS_WAIT() asm volatile("s_waitcnt lgkmcnt(0)" ::: "memory")
#define VM_WAIT() asm volatile("s_waitcnt vmcnt(0)" ::: "memory")
__device__ __forceinline__ unsigned f2bf(float f) { unsigned u = __builtin_bit_cast(unsigned, f); return (u + 0x7fffu + ((u >> 16) & 1u)) >> 16; }
__device__ __forceinline__ unsigned pk2(float lo, float hi) { return f2bf(lo) | (f2bf(hi) << 16); }
__device__ __forceinline__ float bf2f(bf16 v) { return __uint_as_float((unsigned)v << 16); }
__device__ __forceinline__ float wave_sum(float v) {
#pragma unroll
    for (int o = 1; o < 64; o <<= 1) v += __shfl_xor(v, o);
    return v;
}
__device__ __forceinline__ float wave_max(float v) {
#pragma unroll
    for (int o = 1; o < 64; o <<= 1) v = fmaxf(v, __shfl_xor(v, o));
    return v;
}
__device__ const double ROPE_INVT[48] = {
1.59154943091895346e-01, 8.94994016088910133e-02, 5.03292121044870353e-02, 2.83021958306233987e-02, 1.59154943091895339e-02, 8.94994016088910237e-03, 5.03292121044870370e-03, 2.83021958306233987e-03, 1.59154943091895356e-03, 8.94994016088910237e-04, 5.03292121044870326e-04, 2.83021958306233954e-04, 1.59154943091895351e-04, 8.94994016088910182e-05, 5.03292121044870354e-05, 2.83021958306233961e-05,
1.59154943091895346e-01, 1.19349370211248862e-01, 8.94994016088910133e-02, 6.71150830052272551e-02, 5.03292121044870353e-02, 3.77415847174197711e-02, 2.83021958306233987e-02, 2.12236527647776604e-02, 1.59154943091895339e-02, 1.19349370211248862e-02, 8.94994016088910237e-03, 6.71150830052272534e-03, 5.03292121044870370e-03, 3.77415847174197719e-03, 2.83021958306233987e-03, 2.12236527647776622e-03, 1.59154943091895356e-03, 1.19349370211248849e-03, 8.94994016088910237e-04, 6.71150830052272599e-04, 5.03292121044870326e-04, 3.77415847174197741e-04, 2.83021958306233954e-04, 2.12236527647776605e-04, 1.59154943091895351e-04, 1.19349370211248862e-04, 8.94994016088910182e-05, 6.71150830052272545e-05, 5.03292121044870354e-05, 3.77415847174197768e-05, 2.83021958306233961e-05, 2.12236527647776592e-05 };

#define XB_TMO      128
#define XB_XCNT(j)  (256  + 64 * (j))
#define XB_XSUB(j)  (1280 + 64 * (j))
#define XB_XGEN(j)  (2304 + 64 * (j))
#define XB_TOP      3328
#define XB_TOPGEN   3392
#define XCD_BAR_WORDS 3456
#define XB_SPIN_CAP (1u << 18)

__device__ __forceinline__ unsigned xb_ld(unsigned* p)              { return __hip_atomic_load(p, __ATOMIC_RELAXED, __HIP_MEMORY_SCOPE_AGENT); }
__device__ __forceinline__ unsigned xb_add(unsigned* p, unsigned v) { return __hip_atomic_fetch_add(p, v, __ATOMIC_RELAXED, __HIP_MEMORY_SCOPE_AGENT); }
__device__ __forceinline__ unsigned xb_xcc_id() { return (unsigned)__builtin_amdgcn_s_getreg((3 << 11) | 20) & 0xFu; }
#define XB_SPIN(cond, bar) do { unsigned _sp = 0; while (cond) { __builtin_amdgcn_s_sleep(1); \
    if ((++_sp & 255u) == 0u) { if (xb_ld(&(bar)[XB_TMO])) break; if (_sp > XB_SPIN_CAP) { atomicAdd(&(bar)[XB_TMO], 1u); break; } } } } while (0)

struct XcdBarrier {
    unsigned* bar; unsigned x;
    volatile LAS unsigned* st;
};

__device__ __forceinline__ XcdBarrier xcd_barrier_post(unsigned* bar, volatile LAS unsigned* st) {
    XcdBarrier b; b.bar = bar; b.x = xb_xcc_id(); b.st = st;
    if (threadIdx.x == 0) (void)xb_add(&bar[XB_XCNT(b.x)], 1u);
    return b;
}
__device__ __forceinline__ void xcd_barrier_complete(unsigned* bar, unsigned x, unsigned& nloc, unsigned& nx) {
    const unsigned G = gridDim.x * gridDim.y * gridDim.z;
    unsigned sum, cnt, mine, sp = 0u;
    for (;;) {
        sum = 0u; cnt = 0u; mine = 0u;
#pragma unroll
        for (unsigned j = 0; j < 16; ++j) { const unsigned c = xb_ld(&bar[XB_XCNT(j)]); sum += c; cnt += (c > 0u) ? 1u : 0u; mine = (j == x) ? c : mine; }
        if (sum == G) break;
        __builtin_amdgcn_s_sleep(1);
        if ((++sp & 255u) == 0u) { if (xb_ld(&bar[XB_TMO])) break; if (sp > XB_SPIN_CAP) { atomicAdd(&bar[XB_TMO], 1u); break; } }
    }
    nloc = mine > 0u ? mine : 1u; nx = cnt > 0u ? cnt : 1u;
}

__device__ __forceinline__ void xcd_barrier(const XcdBarrier& b) {
    asm volatile("s_waitcnt vmcnt(0)" ::: "memory");
    __syncthreads();
    if (threadIdx.x == 0) {
        unsigned* bar = b.bar;
        __builtin_amdgcn_s_waitcnt(0);
        unsigned nloc = b.st[0], nx = b.st[1];
        if (nloc == 0u) { xcd_barrier_complete(bar, b.x, nloc, nx); b.st[0] = nloc; b.st[1] = nx; }
        const unsigned old = xb_add(&bar[XB_XSUB(b.x)], 1u);
        const unsigned gen = old / nloc;
        if (old + 1u == (gen + 1u) * nloc) {
            __builtin_amdgcn_fence(__ATOMIC_RELEASE, "agent");
            asm volatile("s_waitcnt vmcnt(0)" ::: "memory");
            const unsigned og = xb_add(&bar[XB_TOP], 1u);
            const unsigned tg = og / nx;
            if (og + 1u == (tg + 1u) * nx) xb_add(&bar[XB_TOPGEN], 1u);
            else XB_SPIN(xb_ld(&bar[XB_TOPGEN]) == tg, bar);
            __builtin_amdgcn_fence(__ATOMIC_ACQUIRE, "agent");
            xb_add(&bar[XB_XGEN(b.x)], 1u);
            asm volatile("s_waitcnt vmcnt(0)" ::: "memory");
        } else {
            XB_SPIN(xb_ld(&bar[XB_XGEN(b.x)]) == gen, bar);
            __builtin_amdgcn_fence(__ATOMIC_ACQUIRE, "agent");
            asm volatile("s_waitcnt vmcnt(0)" ::: "memory");
        }
    }
    __syncthreads();
}

enum { IN_X = 0, IN_P, IN_POS, IN_F1N, IN_F1G, IN_F1U, IN_F1D, IN_MIXN, IN_WIN, IN_QN, IN_WUQ, IN_KVN, IN_WUKV, IN_SGLN, IN_SGW, IN_SGB, IN_HGLB, IN_HGN, IN_RETN, IN_WOUT,
       IN_F2N, IN_F2G, IN_F2U, IN_F2D, IN_PLEN, IN_PLEP, IN_PLEG, IN_FINN, N_IN };
struct Args { const float* in[N_IN]; float* out; unsigned char* ws; int ph_lo, ph_hi, li, pad; };
constexpr int N_PHASES = 42;

__device__ __forceinline__ void conv_item(const float* W, int N, const float* gain, bf16* WT, int ldk, int drow, int k0, int n0, LAS float* scr, int lane) {
#pragma unroll 8
    for (int i = 0; i < 32; ++i) { const int kk = 2 * i + (lane >> 5); float v = W[(size_t)(k0 + kk) * N + n0 + (lane & 31)]; if (gain) v *= gain[k0 + kk]; scr[kk * 33 + (lane & 31)] = v; }
    LDS_WAIT(); asm volatile("" ::: "memory");
    const int c = lane & 7;
#pragma unroll
    for (int j = 0; j < 4; ++j) { const int n = (lane >> 3) + 8 * j; const LAS float* s = scr + (8 * c) * 33 + n;
        v4u o; o.x = pk2(s[0 * 33], s[1 * 33]); o.y = pk2(s[2 * 33], s[3 * 33]); o.z = pk2(s[4 * 33], s[5 * 33]); o.w = pk2(s[6 * 33], s[7 * 33]);
        *(v4u*)(WT + (size_t)(drow + n) * ldk + k0 + 8 * c) = o; }
    LDS_WAIT(); asm volatile("" ::: "memory");
}
constexpr int IT_FF = 1408, IT_WIN = 16 * 109, IT_SQ = 16 * 32, IT_PP = 4 * 32, IT_LAYER = 6 * IT_FF + IT_WIN + 2 * IT_SQ + IT_PP;

__device__ __forceinline__ void prologue(const Args& a, LAS unsigned char* lds, int tid, int lane, int wave, int vcu, int G) {
    unsigned char* ws = a.ws;
    bf16* Wgu = (bf16*)(ws + WS_WGU); bf16* Wd = (bf16*)(ws + WS_WD); bf16* Win = (bf16*)(ws + WS_WIN); bf16* Wmla = (bf16*)(ws + WS_WMLA);
    bf16* Wout = (bf16*)(ws + WS_WOUT); bf16* Wpg = (bf16*)(ws + WS_WPG); bf16* Wpp = (bf16*)(ws + WS_WPP); bf16* Wsg = (bf16*)(ws + WS_WSG);
    LAS float* scr = (LAS float*)(lds + RING_OFF + wave * 16384);
    const int gw = vcu * NWAVES + wave, NGW = G * NWAVES;
    const int gt = (vcu * NWAVES + wave) * 64 + lane, NGT = NGW * 64;
    for (int it = gw; it < DEPTH * IT_LAYER; it += NGW) {
        const int l = it / IT_LAYER; int r = it % IT_LAYER;
        if (r < 6 * IT_FF) { const int f = r / IT_FF; r -= f * IT_FF; const int second = f / 3, kind = f - 3 * second;
            if (kind < 2) { const int kb = r / 88, nb = r - 88 * kb, n0 = 32 * nb;
                const float* W = (second ? (kind ? a.in[IN_F2U] : a.in[IN_F2G]) : (kind ? a.in[IN_F1U] : a.in[IN_F1G])) + (size_t)l * D * DFF;
                const float* gain = (second ? a.in[IN_F2N] : a.in[IN_F1N]) + l * D;
                conv_item(W, DFF, gain, Wgu + (size_t)(2 * l + second) * NGU * D, D, (n0 >> 7) * 256 + (n0 & 127) + 128 * kind, 64 * kb, n0, scr, lane); }
            else { const int kb = r / 32, nb = r - 32 * kb;
                const float* W = (second ? a.in[IN_F2D] : a.in[IN_F1D]) + (size_t)l * DFF * D;
                conv_item(W, D, nullptr, Wd + (size_t)(2 * l + second) * D * DFF, DFF, 32 * nb, 64 * kb, 32 * nb, scr, lane); }
            continue; }
        r -= 6 * IT_FF;
        if (r < IT_WIN) { const int kb = r / 109, nb = r - 109 * kb, n0 = 32 * nb;
            conv_item(a.in[IN_WIN] + (size_t)l * D * NZSRC, NZSRC, a.in[IN_MIXN] + l * D, Win + (size_t)l * NZ * D, D, n0 < 416 ? n0 : n0 + 96, 64 * kb, n0, scr, lane); continue; }
        r -= IT_WIN;
        if (r < IT_SQ) { const int kb = r / 32, nb = r - 32 * kb; conv_item(a.in[IN_WOUT] + (size_t)l * D * D, D, nullptr, Wout + (size_t)l * D * D, D, 32 * nb, 64 * kb, 32 * nb, scr, lane); continue; }
        r -= IT_SQ;
        if (r < IT_SQ) { const int kb = r / 32, nb = r - 32 * kb; conv_item(a.in[IN_PLEG] + (size_t)l * D * D, D, a.in[IN_PLEN] + l * D, Wpg + (size_t)l * D * D, D, 32 * nb, 64 * kb, 32 * nb, scr, lane); continue; }
        r -= IT_SQ;
        { const int kb = r / 32, nb = r - 32 * kb; conv_item(a.in[IN_PLEP] + (size_t)l * PLED * D, D, nullptr, Wpp + (size_t)l * D * PLED, PLED, 32 * nb, 64 * kb, 32 * nb, scr, lane); }
    }
    for (int i = gt; i < DEPTH * 96 * (D / 8); i += NGT) { const int l = i / (96 * 128), r = i - l * 96 * 128; const int row = 416 + r / 128, c8 = r & 127;
        *(v4u*)(Win + ((size_t)l * NZ + row) * D + 8 * c8) = (v4u){0u, 0u, 0u, 0u}; }
    for (int i = gt; i < DEPTH * 1024 * 64; i += NGT) { const int l = i >> 16, r = i & 65535, n = r >> 6, k8 = (r & 63) * 8;
        const float* wuq = a.in[IN_WUQ] + (size_t)l * 256 * 384; const float* wukv = a.in[IN_WUKV] + (size_t)l * 128 * 512;
        const float* qg = a.in[IN_QN] + l * 256; const float* kvg = a.in[IN_KVN] + l * 128;
        float v[8];
#pragma unroll
        for (int j = 0; j < 8; ++j) { const int k = k8 + j; float x = 0.f;
            if (n < 384) { if (k < 256) x = wuq[(size_t)k * 384 + n] * qg[k]; }
            else if (n < 896) { if (k >= 256 && k < 384) { const int nn = (n - 384) & 255, hh = nn >> 6, jj = (nn & 63) + (n >= 640 ? 64 : 0); x = wukv[(size_t)(k - 256) * 512 + hh * 128 + jj] * kvg[k - 256]; } }
            else if (n < 928) { if (k == 384 + (n - 896)) x = 1.0f; }
            v[j] = x; }
        v4u o; o.x = pk2(v[0], v[1]); o.y = pk2(v[2], v[3]); o.z = pk2(v[4], v[5]); o.w = pk2(v[6], v[7]);
        *(v4u*)(Wmla + ((size_t)l * 1024 + n) * 512 + k8) = o; }
    for (int i = gt; i < DEPTH * 4 * 128 * 128 / 2; i += NGT) { const int e = 2 * i, s = e & 127, t = (e >> 7) & 127; const float* w = a.in[IN_SGW];
        const float x0 = s <= t ? w[e] : 0.f, x1 = (s + 1) <= t ? w[e + 1] : 0.f; ((unsigned*)Wsg)[i] = pk2(x0, x1); }
    { const float* x = a.in[IN_X]; bf16* B0 = (bf16*)(ws + WS_B0); float* ssq = (float*)(ws + WS_SSQ);
      for (int m = gw; m < M; m += NGW) { const f32x4* xr = (const f32x4*)(x + (size_t)m * D) + lane; unsigned long long* o8 = (unsigned long long*)(B0 + (size_t)m * D) + lane; float t0, t1, t2, t3;
          { const f32x4 v = xr[0];   t0 = wave_sum(pg8::dot4(v)); o8[0]   = (unsigned long long)pk2(v[0], v[1]) | ((unsigned long long)pk2(v[2], v[3]) << 32); }
          { const f32x4 v = xr[64];  t1 = wave_sum(pg8::dot4(v)); o8[64]  = (unsigned long long)pk2(v[0], v[1]) | ((unsigned long long)pk2(v[2], v[3]) << 32); }
          { const f32x4 v = xr[128]; t2 = wave_sum(pg8::dot4(v)); o8[128] = (unsigned long long)pk2(v[0], v[1]) | ((unsigned long long)pk2(v[2], v[3]) << 32); }
          { const f32x4 v = xr[192]; t3 = wave_sum(pg8::dot4(v)); o8[192] = (unsigned long long)pk2(v[0], v[1]) | ((unsigned long long)pk2(v[2], v[3]) << 32); }
          if (lane < 16) { float val = 0.f; if (lane == 0) val = t0; if (lane == 4) val = t1; if (lane == 8) val = t2; if (lane == 12) val = t3; ssq[(size_t)m * 16 + lane] = val; } } }
    { const int* pos = (const int*)a.in[IN_POS]; float* mcs = (float*)(ws + WS_ROPE); float* msn = mcs + (size_t)M * 16; float* rcs = msn + (size_t)M * 16; float* rsn = rcs + (size_t)M * 32;
      for (int i = gt; i < M * 48; i += NGT) { const int m = i / 48, f = i - 48 * m; const double turns = (double)pos[m] * ROPE_INVT[f]; const float fr = (float)(turns - __builtin_rint(turns));
          const float c = __builtin_amdgcn_cosf(fr), s = __builtin_amdgcn_sinf(fr);
          if (f < 16) { mcs[(size_t)m * 16 + f] = c; msn[(size_t)m * 16 + f] = s; } else { rcs[(size_t)m * 32 + f - 16] = c; rsn[(size_t)m * 32 + f - 16] = s; } } }
}

namespace mx {
typedef const LAS bf16* lcp;
#define MFMA16(a, b, c) __builtin_amdgcn_mfma_f32_16x16x32_bf16((a), (b), (c), 0, 0, 0)
__device__ __forceinline__ bf16x8 frag(lcp base, int row, int stride, int k) { return *(const LAS bf16x8*)(base + row * stride + k); }
__device__ __forceinline__ bf16x8 frag2(lcp base, int row, int stride, int k) {
    typedef short s16x4 __attribute__((ext_vector_type(4)));
    const s16x4 lo = *(const LAS s16x4*)(base + row * stride + k), hi = *(const LAS s16x4*)(base + row * stride + k + 16);
    return (bf16x8){lo[0], lo[1], lo[2], lo[3], hi[0], hi[1], hi[2], hi[3]};
}
__device__ __forceinline__ bf16x8 pack_pair(const f32x4 a, const f32x4 b) {
    v4u w; w.x = pg8::cvt_pk_bf16(a[0], a[1]); w.y = pg8::cvt_pk_bf16(a[2], a[3]); w.z = pg8::cvt_pk_bf16(b[0], b[1]); w.w = pg8::cvt_pk_bf16(b[2], b[3]);
    return __builtin_bit_cast(bf16x8, w);
}
__device__ __forceinline__ float lo16(unsigned w) { return __uint_as_float(w << 16); }
__device__ __forceinline__ float hi16(unsigned w) { return __uint_as_float(w & 0xffff0000u); }
__device__ __forceinline__ void unpack8(const v4u w, float (&x)[8]) { x[0] = lo16(w.x); x[1] = hi16(w.x); x[2] = lo16(w.y); x[3] = hi16(w.y); x[4] = lo16(w.z); x[5] = hi16(w.z); x[6] = lo16(w.w); x[7] = hi16(w.w); }
__device__ __forceinline__ v4u pack8(const float (&x)[8]) { v4u w; w.x = pg8::cvt_pk_bf16(x[0], x[1]); w.y = pg8::cvt_pk_bf16(x[2], x[3]); w.z = pg8::cvt_pk_bf16(x[4], x[5]); w.w = pg8::cvt_pk_bf16(x[6], x[7]); return w; }
__device__ __forceinline__ float silu_fast(float x) { return x * __builtin_amdgcn_rcpf(1.0f + __builtin_amdgcn_exp2f(-1.4426950408889634f * x)); }
#define WG_SYNC() do { asm volatile("s_waitcnt vmcnt(0) lgkmcnt(0)" ::: "memory"); __builtin_amdgcn_s_barrier(); asm volatile("" ::: "memory"); } while (0)

constexpr int RET_C = 128;
__device__ __forceinline__ float ret_lg2(int h) { return __builtin_amdgcn_logf(1.0f - __builtin_amdgcn_exp2f(-(5.0f + (float)h))); }
__device__ __forceinline__ void ret_rope8(const bf16* zrow, const float* cs, const float* sn, int grp, float sc, float (&o1)[8], float (&o2)[8]) {
    float x1[8], x2[8]; unpack8(*(const v4u*)(zrow + 8 * grp), x1); unpack8(*(const v4u*)(zrow + 32 + 8 * grp), x2);
    const f32x4 c0 = *(const f32x4*)(cs + 8 * grp), c1 = *(const f32x4*)(cs + 8 * grp + 4), s0 = *(const f32x4*)(sn + 8 * grp), s1 = *(const f32x4*)(sn + 8 * grp + 4);
#pragma unroll
    for (int j = 0; j < 8; ++j) { const float c = j < 4 ? c0[j & 3] : c1[j & 3], s = j < 4 ? s0[j & 3] : s1[j & 3]; o1[j] = (x1[j] * c - x2[j] * s) * sc; o2[j] = (x1[j] * s + x2[j] * c) * sc; }
}
__device__ __forceinline__ void ret_pass1(int job, const bf16* Z, const float* rcs, const float* rsn, float* RST, LAS unsigned char* lds, int tid) {
    const int lane = tid & 63, w = __builtin_amdgcn_readfirstlane(tid >> 6), r15 = lane & 15, g = lane >> 4;
    const int h = job & 3, n = (job >> 2) & 31, b = job >> 7; const size_t m0 = (size_t)b * SEQ + (size_t)n * RET_C; const float lg2 = ret_lg2(h);
    LAS bf16* kT = (LAS bf16*)lds; LAS bf16* vT = kT + 64 * 136;
    { const int row = tid >> 2, grp = tid & 3; const size_t m = m0 + row; float o1[8], o2[8];
      ret_rope8(Z + m * NZ + ZC_RK + 64 * h, rcs + m * 32, rsn + m * 32, grp, 0.125f * __builtin_amdgcn_exp2f(-(float)(row + 1) * lg2), o1, o2);
#pragma unroll
      for (int j = 0; j < 8; ++j) { kT[(8 * grp + j) * 136 + row] = (bf16)f2bf(o1[j]); kT[(32 + 8 * grp + j) * 136 + row] = (bf16)f2bf(o2[j]); }
      const v4u v0 = *(const v4u*)(Z + m * NZ + ZC_RV + 64 * h + 16 * grp), v1 = *(const v4u*)(Z + m * NZ + ZC_RV + 64 * h + 16 * grp + 8);
      const unsigned vw[8] = {v0.x, v0.y, v0.z, v0.w, v1.x, v1.y, v1.z, v1.w};
#pragma unroll
      for (int j = 0; j < 8; ++j) { vT[(16 * grp + 2 * j) * 136 + row] = (bf16)(vw[j] & 0xffffu); vT[(16 * grp + 2 * j + 1) * 136 + row] = (bf16)(vw[j] >> 16); } }
    WG_SYNC();
    const int et = w & 3, dt0 = (w >> 2) * 2; f32x4 acc0 = {0.f, 0.f, 0.f, 0.f}, acc1 = {0.f, 0.f, 0.f, 0.f};
#pragma unroll
    for (int kk = 0; kk < 4; ++kk) { const bf16x8 a = frag(vT, 16 * et + r15, 136, 32 * kk + 8 * g);
        acc0 = MFMA16(a, frag(kT, 16 * dt0 + r15, 136, 32 * kk + 8 * g), acc0); acc1 = MFMA16(a, frag(kT, 16 * dt0 + 16 + r15, 136, 32 * kk + 8 * g), acc1); }
    const float gc = __builtin_amdgcn_exp2f((float)RET_C * lg2); float* dst = RST + ((size_t)((b * 4 + h) * 32 + n) * 64 + 16 * et + 4 * g) * 64 + 16 * dt0 + r15;
#pragma unroll
    for (int j = 0; j < 4; ++j) { dst[j * 64] = acc0[j] * gc; dst[j * 64 + 16] = acc1[j] * gc; }
    WG_SYNC();
}
__device__ __forceinline__ void ret_scan(float* RST, int gt) {
    if (gt >= 16 * 4096) return;
    const int bh = gt >> 12, idx = gt & 4095, h = bh & 3; const float gc = __builtin_amdgcn_exp2f((float)RET_C * ret_lg2(h)); float* p = RST + (size_t)bh * 32 * 4096 + idx; float run = 0.f;
#pragma unroll 1
    for (int n0 = 0; n0 < 32; n0 += 8) { float t[8];
#pragma unroll
        for (int i = 0; i < 8; ++i) t[i] = p[(size_t)(n0 + i) * 4096];
#pragma unroll
        for (int i = 0; i < 8; ++i) { p[(size_t)(n0 + i) * 4096] = run; run = gc * run + t[i]; } }
}
__device__ __forceinline__ void ret_pass3(int job, const bf16* Z, const float* rcs, const float* rsn, const float* RST, const float* normg, bf16* Y, LAS unsigned char* lds, int tid) {
    const int lane = tid & 63, w = __builtin_amdgcn_readfirstlane(tid >> 6), r15 = lane & 15, g = lane >> 4;
    const int h = job & 3, n = (job >> 2) & 31, b = job >> 7; const size_t m0 = (size_t)b * SEQ + (size_t)n * RET_C; const float lg2 = ret_lg2(h);
    LAS bf16* qs = (LAS bf16*)lds; LAS bf16* ks = qs + 128 * 72; LAS bf16* vT = ks + 128 * 72; LAS bf16* sT = vT + 64 * 136;
    { const int row = tid >> 2, grp = tid & 3; const size_t m = m0 + row; float o1[8], o2[8];
      ret_rope8(Z + m * NZ + ZC_RQ + 64 * h, rcs + m * 32, rsn + m * 32, grp, __builtin_amdgcn_exp2f((float)(row + 1) * lg2), o1, o2);
      *(LAS v4u*)(qs + row * 72 + 8 * grp) = pack8(o1); *(LAS v4u*)(qs + row * 72 + 32 + 8 * grp) = pack8(o2);
      ret_rope8(Z + m * NZ + ZC_RK + 64 * h, rcs + m * 32, rsn + m * 32, grp, 0.125f * __builtin_amdgcn_exp2f(-(float)(row + 1) * lg2), o1, o2);
      *(LAS v4u*)(ks + row * 72 + 8 * grp) = pack8(o1); *(LAS v4u*)(ks + row * 72 + 32 + 8 * grp) = pack8(o2);
      const v4u v0 = *(const v4u*)(Z + m * NZ + ZC_RV + 64 * h + 16 * grp), v1 = *(const v4u*)(Z + m * NZ + ZC_RV + 64 * h + 16 * grp + 8);
      const unsigned vw[8] = {v0.x, v0.y, v0.z, v0.w, v1.x, v1.y, v1.z, v1.w};
#pragma unroll
      for (int j = 0; j < 8; ++j) { vT[(16 * grp + 2 * j) * 136 + row] = (bf16)(vw[j] & 0xffffu); vT[(16 * grp + 2 * j + 1) * 136 + row] = (bf16)(vw[j] >> 16); }
      const int e = tid >> 3, d8 = (tid & 7) * 8; const float* sp = RST + ((size_t)((b * 4 + h) * 32 + n) * 64 + e) * 64 + d8; const f32x4 a0 = *(const f32x4*)sp, a1 = *(const f32x4*)(sp + 4);
      const float sv[8] = {a0[0], a0[1], a0[2], a0[3], a1[0], a1[1], a1[2], a1[3]}; *(LAS v4u*)(sT + e * 72 + d8) = pack8(sv); }
    WG_SYNC();
    bf16x8 qf[2]; qf[0] = frag(qs, 16 * w + r15, 72, 8 * g); qf[1] = frag(qs, 16 * w + r15, 72, 32 + 8 * g);
    f32x4 Dt[8];
#pragma unroll
    for (int sb = 0; sb < 8; ++sb) { f32x4 acc = {0.f, 0.f, 0.f, 0.f};
        if (sb <= w) { acc = MFMA16(frag(ks, 16 * sb + r15, 72, 8 * g), qf[0], acc); acc = MFMA16(frag(ks, 16 * sb + r15, 72, 32 + 8 * g), qf[1], acc);
            if (sb == w) {
#pragma unroll
                for (int j = 0; j < 4; ++j) if (4 * g + j > r15) acc[j] = 0.f; } }
        Dt[sb] = acc; }
    f32x4 O[4];
#pragma unroll
    for (int et = 0; et < 4; ++et) O[et] = (f32x4){0.f, 0.f, 0.f, 0.f};
#pragma unroll
    for (int k2 = 0; k2 < 4; ++k2) if (2 * k2 <= w) { const bf16x8 pb = pack_pair(Dt[2 * k2], Dt[2 * k2 + 1]);
#pragma unroll
        for (int et = 0; et < 4; ++et) O[et] = MFMA16(frag2(vT, 16 * et + r15, 136, 32 * k2 + 4 * g), pb, O[et]); }
#pragma unroll
    for (int kk = 0; kk < 2; ++kk)
#pragma unroll
        for (int et = 0; et < 4; ++et) O[et] = MFMA16(frag(sT, 16 * et + r15, 72, 32 * kk + 8 * g), qf[kk], O[et]);
    float s1 = 0.f;
#pragma unroll
    for (int et = 0; et < 4; ++et) s1 += pg8::sum4(O[et]);
    s1 += __shfl_xor(s1, 16); s1 += __shfl_xor(s1, 32); const float mean = s1 * (1.0f / 64.0f); float s2 = 0.f;
#pragma unroll
    for (int et = 0; et < 4; ++et) { O[et] = O[et] - mean; s2 += pg8::dot4(O[et]); }
    s2 += __shfl_xor(s2, 16); s2 += __shfl_xor(s2, 32); const float rstd = __builtin_amdgcn_rsqf(s2 * (1.0f / 64.0f) + 1e-6f);
    const size_t m = m0 + 16 * w + r15;
#pragma unroll
    for (int et = 0; et < 4; ++et) { const int e = 16 * et + 4 * g; const v2u gw = *(const v2u*)(Z + m * NZ + ZC_RG + 64 * h + e); const f32x4 ng = *(const f32x4*)(normg + 64 * h + e);
        v2u o; o.x = pg8::cvt_pk_bf16(O[et][0] * rstd * ng[0] * silu_fast(lo16(gw.x)), O[et][1] * rstd * ng[1] * silu_fast(hi16(gw.x)));
        o.y = pg8::cvt_pk_bf16(O[et][2] * rstd * ng[2] * silu_fast(lo16(gw.y)), O[et][3] * rstd * ng[3] * silu_fast(hi16(gw.y)));
        *(v2u*)(Y + m * 1024 + 768 + 64 * h + e) = o; }
    WG_SYNC();
}

__device__ __forceinline__ float hg_lb(const float* lblog, int l, int ch) {
    const float x0 = lblog[ch], x1 = lblog[512 + ch], x2 = lblog[1024 + ch], x3 = lblog[1536 + ch]; const float mx_ = fmaxf(fmaxf(x0, x1), fmaxf(x2, x3));
    const float e0 = __expf(x0 - mx_), e1 = __expf(x1 - mx_), e2 = __expf(x2 - mx_), e3 = __expf(x3 - mx_);
    return ((l >= 1 ? e1 : 0.f) + (l >= 2 ? e2 : 0.f) + (l >= 3 ? e3 : 0.f)) / (e0 + e1 + e2 + e3);
}
__device__ __forceinline__ void hg_gates(const bf16* Z, size_t m0, int h, int k, int seg, float lb, LAS float* tot, int half, float (&bc)[32], float (&kk)[32]) {
    const bf16* fp = Z + (m0 + 32 * seg) * NZ + ZC_HF + 128 * h + k; float cum = 0.f;
#pragma unroll
    for (int i = 0; i < 32; ++i) { const float f = bf2f(fp[(size_t)i * NZ]); const float fg = lb + (1.0f - lb) * __builtin_amdgcn_rcpf(1.0f + __builtin_amdgcn_exp2f(-1.4426950408889634f * f));
        kk[i] = 1.0f - fg; cum += __builtin_amdgcn_logf(fg) * 0.6931471805599453f; bc[i] = cum; }
    tot[(half * 2 + seg) * 128 + k] = cum;
    WG_SYNC();
    if (seg == 1) { const float o = tot[(half * 2) * 128 + k];
#pragma unroll
        for (int i = 0; i < 32; ++i) bc[i] += o; }
}
__device__ __forceinline__ void hg_stage_vT(const bf16* Z, size_t m0, int h, int u, LAS bf16* vT) {
    const int row = u >> 2, grp = u & 3; const bf16* p = Z + (m0 + row) * NZ + ZC_HI + 64 * h + 16 * grp; const v4u v0 = *(const v4u*)p, v1 = *(const v4u*)(p + 8);
    const unsigned vw[8] = {v0.x, v0.y, v0.z, v0.w, v1.x, v1.y, v1.z, v1.w};
#pragma unroll
    for (int j = 0; j < 8; ++j) { vT[(16 * grp + 2 * j) * 72 + row] = (bf16)(vw[j] & 0xffffu); vT[(16 * grp + 2 * j + 1) * 72 + row] = (bf16)(vw[j] >> 16); }
}
__device__ __forceinline__ void hg_pass1(int pair, const bf16* Z, const float* lblog, int l, float* HST, float* HDC, LAS unsigned char* lds, int tid) {
    const int lane = tid & 63, w = __builtin_amdgcn_readfirstlane(tid >> 6), r15 = lane & 15, g = lane >> 4, half = w >> 2, wq = w & 3, u = tid & 255, k = u & 127, seg = u >> 7;
    const int job = 2 * pair + half, h = job & 3, c = (job >> 2) & 63, b = job >> 8; const size_t m0 = (size_t)b * SEQ + (size_t)c * 64;
    LAS float* tot = (LAS float*)lds; LAS bf16* koT = (LAS bf16*)(lds + 2048) + half * (128 * 72 + 64 * 72); LAS bf16* vT = koT + 128 * 72;
    float bc[32], kk[32]; hg_gates(Z, m0, h, k, seg, hg_lb(lblog, l, 128 * h + k), tot, half, bc, kk);
    const float blast = tot[(half * 2) * 128 + k] + tot[(half * 2 + 1) * 128 + k];
#pragma unroll
    for (int q4 = 0; q4 < 4; ++q4) { float x[8];
#pragma unroll
        for (int j = 0; j < 8; ++j) x[j] = kk[8 * q4 + j] * __expf(blast - bc[8 * q4 + j]);
        *(LAS v4u*)(koT + k * 72 + 32 * seg + 8 * q4) = pack8(x); }
    if (seg == 0) HDC[(size_t)((b * 4 + h) * 64 + c) * 128 + k] = __expf(blast);
    hg_stage_vT(Z, m0, h, u, vT);
    WG_SYNC();
    f32x4 acc[4][2];
#pragma unroll
    for (int et = 0; et < 4; ++et) { acc[et][0] = (f32x4){0.f, 0.f, 0.f, 0.f}; acc[et][1] = (f32x4){0.f, 0.f, 0.f, 0.f}; }
#pragma unroll
    for (int k2 = 0; k2 < 2; ++k2) { const bf16x8 b0 = frag(koT, 32 * wq + r15, 72, 32 * k2 + 8 * g), b1 = frag(koT, 32 * wq + 16 + r15, 72, 32 * k2 + 8 * g);
#pragma unroll
        for (int et = 0; et < 4; ++et) { const bf16x8 a = frag(vT, 16 * et + r15, 72, 32 * k2 + 8 * g); acc[et][0] = MFMA16(a, b0, acc[et][0]); acc[et][1] = MFMA16(a, b1, acc[et][1]); } }
    float* dst = HST + (size_t)((b * 4 + h) * 64 + c) * 8192 + 32 * wq + r15;
#pragma unroll
    for (int et = 0; et < 4; ++et)
#pragma unroll
        for (int j = 0; j < 4; ++j) { dst[(16 * et + 4 * g + j) * 128] = acc[et][0][j]; dst[(16 * et + 4 * g + j) * 128 + 16] = acc[et][1][j]; }
    WG_SYNC();
}
__device__ __forceinline__ void hg_scan(float* HST, const float* HDC, int gt) {
    const int bh = gt >> 13, idx = gt & 8191, k = idx & 127; float* p = HST + (size_t)bh * 64 * 8192 + idx; const float* dp = HDC + (size_t)bh * 64 * 128 + k; float run = 0.f;
#pragma unroll 1
    for (int c0 = 0; c0 < 64; c0 += 8) { float t[8], d[8];
#pragma unroll
        for (int i = 0; i < 8; ++i) { t[i] = p[(size_t)(c0 + i) * 8192]; d[i] = dp[(c0 + i) * 128]; }
#pragma unroll
        for (int i = 0; i < 8; ++i) { p[(size_t)(c0 + i) * 8192] = run; run = d[i] * run + t[i]; } }
}
__device__ __forceinline__ void hg_pass3(int pair, const bf16* Z, const float* lblog, int l, const float* HST, const float* normg, bf16* Y, LAS unsigned char* lds, int tid) {
    const int lane = tid & 63, w = __builtin_amdgcn_readfirstlane(tid >> 6), r15 = lane & 15, g = lane >> 4, half = w >> 2, tb = w & 3, u = tid & 255, k = u & 127, seg = u >> 7;
    const int job = 2 * pair + half, h = job & 3, c = (job >> 2) & 63, b = job >> 8; const size_t m0 = (size_t)b * SEQ + (size_t)c * 64;
    LAS float* tot = (LAS float*)lds; LAS bf16* qs = (LAS bf16*)(lds + 2048) + half * (3 * 64 * 136 + 64 * 72); LAS bf16* ks = qs + 64 * 136; LAS bf16* sT = ks + 64 * 136; LAS bf16* vT = sT + 64 * 136;
    { float bc[32], kk[32]; hg_gates(Z, m0, h, k, seg, hg_lb(lblog, l, 128 * h + k), tot, half, bc, kk);
      const float bmid = tot[(half * 2) * 128 + k]; const bf16* qp = Z + (m0 + 32 * seg) * NZ + ZC_HQ + 128 * h + k;
#pragma unroll
      for (int i = 0; i < 32; ++i) { const float q = bf2f(qp[(size_t)i * NZ]); qs[(32 * seg + i) * 136 + k] = (bf16)f2bf(q * __expf(bc[i] - bmid)); ks[(32 * seg + i) * 136 + k] = (bf16)f2bf(kk[i] * __expf(bmid - bc[i])); } }
    hg_stage_vT(Z, m0, h, u, vT);
    { const int k8 = (u & 15) * 8; float em[8];
#pragma unroll
      for (int j = 0; j < 8; ++j) em[j] = __expf(tot[(half * 2) * 128 + k8 + j]);
#pragma unroll
      for (int i = 0; i < 4; ++i) { const int e = (u >> 4) + 16 * i; const float* sp = HST + (size_t)((b * 4 + h) * 64 + c) * 8192 + e * 128 + k8; const f32x4 a0 = *(const f32x4*)sp, a1 = *(const f32x4*)(sp + 4);
          const float sv[8] = {a0[0] * em[0], a0[1] * em[1], a0[2] * em[2], a0[3] * em[3], a1[0] * em[4], a1[1] * em[5], a1[2] * em[6], a1[3] * em[7]}; *(LAS v4u*)(sT + e * 136 + k8) = pack8(sv); } }
    WG_SYNC();
    bf16x8 qf[4];
#pragma unroll
    for (int kq = 0; kq < 4; ++kq) qf[kq] = frag(qs, 16 * tb + r15, 136, 32 * kq + 8 * g);
    f32x4 Dt[4];
#pragma unroll
    for (int sb = 0; sb < 4; ++sb) { f32x4 acc = {0.f, 0.f, 0.f, 0.f};
        if (sb <= tb) {
#pragma unroll
            for (int kq = 0; kq < 4; ++kq) acc = MFMA16(frag(ks, 16 * sb + r15, 136, 32 * kq + 8 * g), qf[kq], acc);
            if (sb == tb) {
#pragma unroll
                for (int j = 0; j < 4; ++j) if (4 * g + j > r15) acc[j] = 0.f; } }
        Dt[sb] = acc; }
    f32x4 O[4];
#pragma unroll
    for (int et = 0; et < 4; ++et) O[et] = (f32x4){0.f, 0.f, 0.f, 0.f};
#pragma unroll
    for (int k2 = 0; k2 < 2; ++k2) if (2 * k2 <= tb) { const bf16x8 pb = pack_pair(Dt[2 * k2], Dt[2 * k2 + 1]);
#pragma unroll
        for (int et = 0; et < 4; ++et) O[et] = MFMA16(frag2(vT, 16 * et + r15, 72, 32 * k2 + 4 * g), pb, O[et]); }
#pragma unroll
    for (int kq = 0; kq < 4; ++kq)
#pragma unroll
        for (int et = 0; et < 4; ++et) O[et] = MFMA16(frag(sT, 16 * et + r15, 136, 32 * kq + 8 * g), qf[kq], O[et]);
    float s2 = 0.f;
#pragma unroll
    for (int et = 0; et < 4; ++et) s2 += pg8::dot4(O[et]);
    s2 += __shfl_xor(s2, 16); s2 += __shfl_xor(s2, 32); const float rstd = __builtin_amdgcn_rsqf(s2 * (1.0f / 64.0f) + 1e-6f);
    const size_t m = m0 + 16 * tb + r15;
#pragma unroll
    for (int et = 0; et < 4; ++et) { const int e = 16 * et + 4 * g; const v2u gw = *(const v2u*)(Z + m * NZ + ZC_HG + 64 * h + e); const f32x4 ng = *(const f32x4*)(normg + 64 * h + e);
        v2u o; o.x = pg8::cvt_pk_bf16(O[et][0] * rstd * ng[0] * silu_fast(lo16(gw.x)), O[et][1] * rstd * ng[1] * silu_fast(hi16(gw.x)));
        o.y = pg8::cvt_pk_bf16(O[et][2] * rstd * ng[2] * silu_fast(lo16(gw.y)), O[et][3] * rstd * ng[3] * silu_fast(hi16(gw.y)));
        *(v2u*)(Y + m * 1024 + 512 + 64 * h + e) = o; }
    WG_SYNC();
}

__device__ __forceinline__ float gelu_erf(float x) { return 0.5f * x * (1.0f + erff(x * 0.70710678118654752f)); }
__device__ __forceinline__ void sg_job(int job, const bf16* Z, const float* lng, const bf16* Wsg  , const float* bs  , bf16* Y, LAS unsigned char* lds, int tid) {
    const int lane = tid & 63, w = __builtin_amdgcn_readfirstlane(tid >> 6), r15 = lane & 15, g = lane >> 4;
    const int hh = job & 1; const size_t m0 = (size_t)(job >> 1) * 128;
    LAS bf16* vT = (LAS bf16*)lds;
    { const f32x4 gv = *(const f32x4*)(lng + 4 * lane);
#pragma unroll 2
      for (int i = 0; i < 16; ++i) { const int row = 16 * w + i; const v2u zw = *(const v2u*)(Z + (m0 + row) * NZ + ZC_V + 4 * lane);
          float x0 = gelu_erf(lo16(zw.x)), x1 = gelu_erf(hi16(zw.x)), x2 = gelu_erf(lo16(zw.y)), x3 = gelu_erf(hi16(zw.y));
          const float mean = wave_sum((x0 + x1) + (x2 + x3)) * (1.0f / 256.0f); x0 -= mean; x1 -= mean; x2 -= mean; x3 -= mean;
          const float rstd = __builtin_amdgcn_rsqf(wave_sum((x0 * x0 + x1 * x1) + (x2 * x2 + x3 * x3)) * (1.0f / 256.0f) + 1e-6f);
          if ((lane >> 5) == hh) { const int dl = 4 * (lane & 31);
              vT[(dl + 0) * 136 + row] = (bf16)f2bf(x0 * rstd * gv[0]); vT[(dl + 1) * 136 + row] = (bf16)f2bf(x1 * rstd * gv[1]);
              vT[(dl + 2) * 136 + row] = (bf16)f2bf(x2 * rstd * gv[2]); vT[(dl + 3) * 136 + row] = (bf16)f2bf(x3 * rstd * gv[3]); } } }
    WG_SYNC();
    const int hl = w >> 2, tq = w & 3, h = 2 * hh + hl; const bf16* Wh = Wsg + (size_t)h * 128 * 128;
    f32x4 acc[2][4];
#pragma unroll
    for (int i = 0; i < 2; ++i)
#pragma unroll
        for (int dt = 0; dt < 4; ++dt) acc[i][dt] = (f32x4){0.f, 0.f, 0.f, 0.f};
#pragma unroll
    for (int i = 0; i < 2; ++i) { const int tb = 2 * tq + i;
#pragma unroll
        for (int kk = 0; kk < 4; ++kk) if (2 * kk <= tb) { const bf16x8 bfr = *(const bf16x8*)(Wh + (size_t)(16 * tb + r15) * 128 + 32 * kk + 8 * g);
#pragma unroll
            for (int dt = 0; dt < 4; ++dt) acc[i][dt] = MFMA16(frag(vT, 64 * hl + 16 * dt + r15, 136, 32 * kk + 8 * g), bfr, acc[i][dt]); } }
#pragma unroll
    for (int i = 0; i < 2; ++i) { const int t = 16 * (2 * tq + i) + r15; const size_t m = m0 + t; const float bias = bs[h * 128 + t];
#pragma unroll
        for (int dt = 0; dt < 4; ++dt) { const int d = 128 * hh + 64 * hl + 16 * dt + 4 * g; const v2u uw = *(const v2u*)(Z + m * NZ + ZC_U + d);
            v2u o; o.x = pg8::cvt_pk_bf16(gelu_erf(lo16(uw.x)) * (acc[i][dt][0] + bias), gelu_erf(hi16(uw.x)) * (acc[i][dt][1] + bias));
            o.y = pg8::cvt_pk_bf16(gelu_erf(lo16(uw.y)) * (acc[i][dt][2] + bias), gelu_erf(hi16(uw.y)) * (acc[i][dt][3] + bias));
            *(v2u*)(Y + m * 1024 + 256 + d) = o; } }
    WG_SYNC();
}

__device__ __forceinline__ void mla_qblock(int b, int h, int qb, const bf16* QKV, bf16* Y, LAS unsigned char* lds, int tid) {
    const int lane = tid & 63, w = __builtin_amdgcn_readfirstlane(tid >> 6), r15 = lane & 15, g = lane >> 4;
    LAS bf16* Kb = (LAS bf16*)lds; LAS bf16* Vt = Kb + 2 * 64 * 104;
    const size_t mb = (size_t)b * SEQ; const int t_row = 128 * qb + 16 * w + r15;
    const int ntile = 2 * (qb + 1);
    bf16x8 qf[3];
#pragma unroll
    for (int kk = 0; kk < 3; ++kk) qf[kk] = *(const bf16x8*)(QKV + (mb + t_row) * 1024 + QC_Q + 96 * h + 32 * kk + 8 * g);
    const int srow = tid >> 3, spc = tid & 7, rrow = (tid >> 2) & 63, rpc = tid & 3;
    v4u ldk, ldr, ldv;
#define MLA_LOAD(kt) do { const bf16* kp = QKV + (mb + 64 * (kt) + srow) * 1024; ldk = *(const v4u*)(kp + QC_KN + 64 * h + 8 * spc); ldv = *(const v4u*)(kp + QC_V + 64 * h + 8 * spc); \
        if (tid < 256) ldr = *(const v4u*)(QKV + (mb + 64 * (kt) + rrow) * 1024 + QC_KR + 8 * rpc); } while (0)
#define MLA_STORE(buf) do { LAS bf16* kd = Kb + (buf) * 64 * 104; LAS bf16* vd = Vt + (buf) * 64 * 72; *(LAS v4u*)(kd + srow * 104 + 8 * spc) = ldk; if (tid < 256) *(LAS v4u*)(kd + rrow * 104 + 64 + 8 * rpc) = ldr; \
        const unsigned vw_[4] = {ldv.x, ldv.y, ldv.z, ldv.w}; _Pragma("unroll") for (int j_ = 0; j_ < 4; ++j_) { vd[(8 * spc + 2 * j_) * 72 + srow] = (bf16)(vw_[j_] & 0xffffu); vd[(8 * spc + 2 * j_ + 1) * 72 + srow] = (bf16)(vw_[j_] >> 16); } } while (0)
    MLA_LOAD(0); MLA_STORE(0); WG_SYNC();
    float m_run = -INFINITY, l_run = 0.f; f32x4 O[4];
#pragma unroll
    for (int et = 0; et < 4; ++et) O[et] = (f32x4){0.f, 0.f, 0.f, 0.f};
    const int t_lo = 128 * qb + 16 * w;
    for (int kt = 0; kt < ntile; ++kt) {
        if (kt + 1 < ntile) MLA_LOAD(kt + 1);
        if (64 * kt <= t_lo + 15) {
            lcp kb = Kb + (kt & 1) * 64 * 104; lcp vb = Vt + (kt & 1) * 64 * 72;
            f32x4 S[4];
#pragma unroll
            for (int sb = 0; sb < 4; ++sb) { f32x4 acc = {0.f, 0.f, 0.f, 0.f};
#pragma unroll
                for (int kk = 0; kk < 3; ++kk) acc = MFMA16(frag(kb, 16 * sb + r15, 104, 32 * kk + 8 * g), qf[kk], acc);
                S[sb] = acc; }
            if (64 * kt + 63 > t_lo) {
#pragma unroll
                for (int sb = 0; sb < 4; ++sb)
#pragma unroll
                    for (int j = 0; j < 4; ++j) if (64 * kt + 16 * sb + 4 * g + j > t_row) S[sb][j] = -INFINITY; }
            float mx_ = fmaxf(fmaxf(fmaxf(S[0][0], S[0][1]), fmaxf(S[0][2], S[0][3])), fmaxf(fmaxf(S[1][0], S[1][1]), fmaxf(S[1][2], S[1][3])));
            mx_ = fmaxf(mx_, fmaxf(fmaxf(fmaxf(S[2][0], S[2][1]), fmaxf(S[2][2], S[2][3])), fmaxf(fmaxf(S[3][0], S[3][1]), fmaxf(S[3][2], S[3][3]))));
            mx_ = fmaxf(mx_, __shfl_xor(mx_, 16)); mx_ = fmaxf(mx_, __shfl_xor(mx_, 32));
            const float m_new = fmaxf(m_run, mx_), corr = __builtin_amdgcn_exp2f(m_run - m_new); m_run = m_new; float ps = 0.f;
#pragma unroll
            for (int sb = 0; sb < 4; ++sb)
#pragma unroll
                for (int j = 0; j < 4; ++j) { const float p = __builtin_amdgcn_exp2f(S[sb][j] - m_new); S[sb][j] = p; ps += p; }
            l_run = l_run * corr + ps;
#pragma unroll
            for (int et = 0; et < 4; ++et) O[et] = O[et] * corr;
#pragma unroll
            for (int k2 = 0; k2 < 2; ++k2) { const bf16x8 pb = pack_pair(S[2 * k2], S[2 * k2 + 1]);
#pragma unroll
                for (int et = 0; et < 4; ++et) O[et] = MFMA16(frag2(vb, 16 * et + r15, 72, 32 * k2 + 4 * g), pb, O[et]); }
        }
        if (kt + 1 < ntile) MLA_STORE((kt + 1) & 1);
        WG_SYNC();
    }
#undef MLA_LOAD
#undef MLA_STORE
    l_run += __shfl_xor(l_run, 16); l_run += __shfl_xor(l_run, 32); const float inv = 1.0f / l_run;
#pragma unroll
    for (int et = 0; et < 4; ++et) { v2u o; o.x = pg8::cvt_pk_bf16(O[et][0] * inv, O[et][1] * inv); o.y = pg8::cvt_pk_bf16(O[et][2] * inv, O[et][3] * inv);
        *(v2u*)(Y + (mb + t_row) * 1024 + 64 * h + 16 * et + 4 * g) = o; }
}
}

#define V_WGU ((bf16*)(ws + WS_WGU))
#define V_WD ((bf16*)(ws + WS_WD))
#define V_WIN ((bf16*)(ws + WS_WIN))
#define V_WMLA ((bf16*)(ws + WS_WMLA))
#define V_WOUT ((bf16*)(ws + WS_WOUT))
#define V_WPG ((bf16*)(ws + WS_WPG))
#define V_WPP ((bf16*)(ws + WS_WPP))
#define V_B0 ((bf16*)(ws + WS_B0))
#define V_B1 ((bf16*)(ws + WS_B1))
#define V_ZH ((bf16*)(ws + WS_ZH))
#define V_QKV ((bf16*)(ws + WS_QKV))
#define V_PBF ((bf16*)(ws + WS_PBF))
#define V_SSQ0 ((float*)(ws + WS_SSQ))
#define V_SSQ1 ((float*)(ws + WS_SSQ) + (size_t)M * 16)
#define V_SSQQ ((float*)(ws + WS_SSQ2))
#define V_SSQKV ((float*)(ws + WS_SSQ2) + (size_t)M * 4)
#define V_MCS ((float*)(ws + WS_ROPE))
#define V_MSN ((float*)(ws + WS_ROPE) + (size_t)M * 16)
#define V_RCS ((float*)(ws + WS_ROPE) + (size_t)M * 32)
#define V_RSN ((float*)(ws + WS_ROPE) + (size_t)M * 64)
#define V_HST ((float*)(ws + WS_HST))
#define V_HDC ((float*)(ws + WS_HDC))
#define V_RST ((float*)(ws + WS_RST))
#ifndef MIX_RET
#define MIX_RET 1
#endif
#ifndef MIX_HG
#define MIX_HG 1
#endif
#ifndef MIX_SG
#define MIX_SG 1
#endif
#ifndef MIX_MLA
#define MIX_MLA 1
#endif
__global__ void __launch_bounds__(NWAVES * 64, 2) mk_fwd(Args a) {
    extern __shared__ __attribute__((aligned(16))) unsigned char lds_raw[];
    LAS unsigned char* lds = (LAS unsigned char*)lds_raw;
    volatile LAS unsigned* MISC = (volatile LAS unsigned*)(lds + MISC_OFF);
    const int tid = threadIdx.x, lane = tid & 63, wave = __builtin_amdgcn_readfirstlane(tid >> 6);
    const int G = gridDim.x; const int bx = blockIdx.x; const int vcu = (G % 8 == 0) ? (bx % 8) * (G / 8) + bx / 8 : bx;
    unsigned char* ws = a.ws;
    gu32* ctl = (gu32*)(ws + WS_CTL);
    for (int u = tid; u < (LDS_BYTES - LDSCTL_OFF) / 4; u += NWAVES * 64) ((LAS unsigned*)(lds + LDSCTL_OFF))[u] = 0u;
    __syncthreads();
    XcdBarrier bar = xcd_barrier_post((unsigned*)(ctl + CW_BAR) + a.li * XCD_BAR_WORDS, MISC + 8);
    const int lo = a.ph_lo, hi = a.ph_hi;
#define IN(k) (lo <= (k) && (k) < hi)
#define SEAM(k) do { if (IN(k) && IN((k) + 1)) xcd_barrier(bar); } while (0)
    float* out = a.out;

    if (IN(0)) { prologue(a, lds, tid, lane, wave, vcu, G); }
    SEAM(0);

    for (int hl = 0; hl < 2 * DEPTH; ++hl) {
        const int l = hl >> 1, second = hl & 1, pb = 1 + 10 * l + 7 * second;
        int tid_o = tid; asm volatile("" : "+v"(tid_o));
        if (IN(pb)) {
            pg8::Gemm g{(second == 0 && l > 0) ? V_B1 : V_B0, V_WGU + (size_t)(2 * l + second) * NGU * D, M, NGU, D, D}; pg8::StaticOrder S; S.init(M, NGU, G, bx);
            pg8::EpiSwiGLU E{V_ZH, V_SSQ0};
            pg8::gemm_phase<pg8::EpiSwiGLU, pg8::StaticOrder, true, true>(lds + RING_OFF, g, S, E);
        }
        SEAM(pb);
        if (IN(pb + 1)) {
            pg8::Gemm g{V_ZH, V_WD + (size_t)(2 * l + second) * D * DFF, M, D, DFF, DFF}; pg8::StaticOrder S; S.init(M, D, G, bx);
            pg8::EpiRes E{(hl == 0) ? a.in[IN_X] : (const float*)out, out, V_B0, V_SSQ1, 0.5f};
            pg8::gemm_phase<pg8::EpiRes, pg8::StaticOrder, false, true>(lds + RING_OFF, g, S, E);
        }
        SEAM(pb + 1);
        if (!second) {
            if (IN(pb + 2)) {
                pg8::Gemm g{V_B0, V_WIN + (size_t)l * NZ * D, M, NZ, D, D}; pg8::StaticOrder S; S.init(M, NZ, G, bx);
                pg8::EpiZ E{V_ZH, V_SSQ1, V_SSQQ, V_SSQKV};
                pg8::gemm_phase<pg8::EpiZ, pg8::StaticOrder, true, true>(lds + RING_OFF, g, S, E);
                const f32x4* ps = (const f32x4*)(a.in[IN_P] + (size_t)l * M * PLED); v2u* pd = (v2u*)V_PBF;
                for (int i = bx * (NWAVES * 64) + tid_o; i < M * PLED / 4; i += G * NWAVES * 64) { const f32x4 v = ps[i]; v2u o; o.x = pk2(v[0], v[1]); o.y = pk2(v[2], v[3]); pd[i] = o; }
            }
            SEAM(pb + 2);
            if (IN(pb + 3)) {
                pg8::Gemm g{V_ZH, V_WMLA + (size_t)l * 1024 * 512, M, 1024, 512, NZ}; pg8::StaticOrder S; S.init(M, 1024, G, bx);
                pg8::EpiMla E{V_QKV, V_SSQQ, V_SSQKV, V_MCS, V_MSN};
                pg8::gemm_phase<pg8::EpiMla, pg8::StaticOrder, false, true>(lds + RING_OFF, g, S, E);
#if MIX_RET
                for (int j = bx; j < 512; j += G) mx::ret_pass1(j, V_ZH, V_RCS, V_RSN, V_RST, lds + RING_OFF, tid_o);
#endif
#if MIX_HG
                for (int pr = bx; pr < 512; pr += G) mx::hg_pass1(pr, V_ZH, a.in[IN_HGLB], l, V_HST, V_HDC, lds + RING_OFF, tid_o);
#endif
#if MIX_SG
                for (int j = bx; j < 256; j += G) mx::sg_job(j, V_ZH, a.in[IN_SGLN] + l * 256, (const bf16*)(ws + WS_WSG) + (size_t)l * 4 * 128 * 128, a.in[IN_SGB] + l * 512, V_B1, lds + RING_OFF, tid_o);
#endif
            }
            SEAM(pb + 3);
            if (IN(pb + 4)) {
#if MIX_RET
                for (int gt = bx * (NWAVES * 64) + tid_o; gt < 16 * 4096; gt += G * NWAVES * 64) mx::ret_scan(V_RST, gt);
#endif
#if MIX_HG
                for (int gt = bx * (NWAVES * 64) + tid_o; gt < 16 * 8192; gt += G * NWAVES * 64) mx::hg_scan(V_HST, V_HDC, gt);
#endif
            }
            SEAM(pb + 4);
            if (IN(pb + 5)) {
#if MIX_RET
                for (int j = bx; j < 512; j += G) mx::ret_pass3(j, V_ZH, V_RCS, V_RSN, V_RST, a.in[IN_RETN] + l * 256, V_B1, lds + RING_OFF, tid_o);
#endif
#if MIX_HG
                for (int pr = bx; pr < 512; pr += G) mx::hg_pass3(pr, V_ZH, a.in[IN_HGLB], l, V_HST, a.in[IN_HGN] + l * 256, V_B1, lds + RING_OFF, tid_o);
#endif
#if MIX_MLA
                for (int j = bx; j < 256; j += G) { const int bh = j >> 4, sq = j & 15;
                    mx::mla_qblock(bh >> 2, bh & 3, 31 - sq, V_QKV, V_B1, lds + RING_OFF, tid_o); mx::mla_qblock(bh >> 2, bh & 3, sq, V_QKV, V_B1, lds + RING_OFF, tid_o); }
#endif
            }
            SEAM(pb + 5);
            if (IN(pb + 6)) {
                { pg8::Gemm g{V_B1, V_WOUT + (size_t)l * D * D, M, D, D, D}; pg8::StaticOrder S; S.init(M, D, G, bx);
                  pg8::EpiRes E{out, out, V_B0, V_SSQ0, 1.0f};
                  pg8::gemm_phase<pg8::EpiRes, pg8::StaticOrder, false, true>(lds + RING_OFF, g, S, E); }
                { pg8::Gemm g{V_PBF, V_WPP + (size_t)l * D * PLED, M, D, PLED, PLED}; pg8::StaticOrder S; S.init(M, D, G, bx);
                  pg8::EpiPlain E{V_QKV, D};
                  pg8::gemm_phase<pg8::EpiPlain, pg8::StaticOrder, false, true>(lds + RING_OFF, g, S, E); }
            }
            SEAM(pb + 6);
        } else {
            if (IN(pb + 2)) {
                pg8::Gemm g{V_B0, V_WPG + (size_t)l * D * D, M, D, D, D}; pg8::StaticOrder S; S.init(M, D, G, bx);
                pg8::EpiPle E{out, V_QKV, V_B1, V_SSQ1, V_SSQ0};
                pg8::gemm_phase<pg8::EpiPle, pg8::StaticOrder, false, true>(lds + RING_OFF, g, S, E);
            }
            SEAM(pb + 2);
        }
    }
    if (IN(41)) {
        const float* gfin = a.in[IN_FINN];
        for (int m = vcu * NWAVES + wave; m < M; m += G * NWAVES) { f32x4* hr = (f32x4*)(out + (size_t)m * D) + lane; const float r = pg8::row_rstd(V_SSQ0, m);
#pragma unroll
            for (int j = 0; j < 4; ++j) { const f32x4 v = hr[64 * j]; const f32x4 gv = *((const f32x4*)gfin + lane + 64 * j); hr[64 * j] = v * r * gv; } }
    }
#undef IN
#undef SEAM
}

#ifndef MK_MODE
#define MK_MODE 1
#endif
#if MK_MODE != 0
__device__ __forceinline__ float gelu_exact(float x) { return 0.5f * x * (1.0f + erff(x * 0.70710678118654752f)); }
__device__ __forceinline__ float silu_f(float x) { return x / (1.0f + __expf(-x)); }
__global__ void __launch_bounds__(256) nv_mla(const bf16* QKV, bf16* Y) {
    const int lane = threadIdx.x & 63, gw = blockIdx.x * 4 + (threadIdx.x >> 6); const int t = gw & (SEQ - 1), bh = gw >> 12, b = bh >> 2, h = bh & 3;
    const size_t m = (size_t)b * SEQ + t;
    float q[96];
#pragma unroll
    for (int d = 0; d < 96; ++d) q[d] = bf2f(QKV[m * 1024 + QC_Q + 96 * h + d]);
    float mi = -INFINITY, li = 0.f, acc[64];
#pragma unroll
    for (int e = 0; e < 64; ++e) acc[e] = 0.f;
    for (int s = lane; s <= t; s += 64) { const bf16* kr = QKV + ((size_t)b * SEQ + s) * 1024; float dot = 0.f;
#pragma unroll
        for (int d = 0; d < 64; ++d) dot += q[d] * bf2f(kr[QC_KN + 64 * h + d]);
#pragma unroll
        for (int d = 0; d < 32; ++d) dot += q[64 + d] * bf2f(kr[QC_KR + d]);
        const float mn = fmaxf(mi, dot), corr = exp2f(mi - mn), p = exp2f(dot - mn); li = li * corr + p; mi = mn;
#pragma unroll
        for (int e = 0; e < 64; ++e) acc[e] = acc[e] * corr + p * bf2f(kr[QC_V + 64 * h + e]); }
    const float mg = wave_max(mi), w = (mi == -INFINITY) ? 0.f : exp2f(mi - mg); const float L = wave_sum(li * w); float res = 0.f;
#pragma unroll
    for (int e = 0; e < 64; ++e) { const float v = wave_sum(acc[e] * w); if (lane == e) res = v; }
    Y[m * 1024 + 64 * h + lane] = (bf16)f2bf(res / L);
}
__global__ void __launch_bounds__(256) nv_ret_prep(const bf16* Z, const float* rcs, const float* rsn, float* QR, float* KR) {
    const int i = blockIdx.x * 256 + threadIdx.x; if (i >= M * 128) return; const int m = i >> 7, r = i & 127, h = r >> 5, j = r & 31;
    const float c = rcs[(size_t)m * 32 + j], s = rsn[(size_t)m * 32 + j];
    { const float x1 = bf2f(Z[(size_t)m * NZ + ZC_RQ + 64 * h + j]), x2 = bf2f(Z[(size_t)m * NZ + ZC_RQ + 64 * h + 32 + j]); QR[(size_t)m * 256 + 64 * h + j] = x1 * c - x2 * s; QR[(size_t)m * 256 + 64 * h + 32 + j] = x1 * s + x2 * c; }
    { const float x1 = bf2f(Z[(size_t)m * NZ + ZC_RK + 64 * h + j]), x2 = bf2f(Z[(size_t)m * NZ + ZC_RK + 64 * h + 32 + j]); KR[(size_t)m * 256 + 64 * h + j] = 0.125f * (x1 * c - x2 * s); KR[(size_t)m * 256 + 64 * h + 32 + j] = 0.125f * (x1 * s + x2 * c); }
}
__global__ void __launch_bounds__(256) nv_ret(const bf16* Z, const float* QR, const float* KR, const float* normg, bf16* Y) {
    const int lane = threadIdx.x & 63, gw = blockIdx.x * 4 + (threadIdx.x >> 6); const int t = gw & (SEQ - 1), bh = gw >> 12, b = bh >> 2, h = bh & 3;
    const size_t m = (size_t)b * SEQ + t; const float lg2 = log2f(1.0f - exp2f(-(5.0f + (float)h)));
    float q[64], acc[64];
#pragma unroll
    for (int d = 0; d < 64; ++d) { q[d] = QR[m * 256 + 64 * h + d]; acc[d] = 0.f; }
    for (int s = lane; s <= t; s += 64) { const size_t ms = (size_t)b * SEQ + s; float dot = 0.f;
#pragma unroll
        for (int d = 0; d < 64; ++d) dot += q[d] * KR[ms * 256 + 64 * h + d];
        const float p = dot * exp2f((float)(t - s) * lg2);
#pragma unroll
        for (int e = 0; e < 64; ++e) acc[e] += p * bf2f(Z[ms * NZ + ZC_RV + 64 * h + e]); }
    float o = 0.f;
#pragma unroll
    for (int e = 0; e < 64; ++e) { const float v = wave_sum(acc[e]); if (lane == e) o = v; }
    const float mean = wave_sum(o) * (1.0f / 64.0f), oc = o - mean, var = wave_sum(oc * oc) * (1.0f / 64.0f);
    const float gate = silu_f(bf2f(Z[m * NZ + ZC_RG + 64 * h + lane]));
    Y[m * 1024 + 768 + 64 * h + lane] = (bf16)f2bf(oc * rsqrtf(var + 1e-6f) * normg[64 * h + lane] * gate);
}
__global__ void __launch_bounds__(64) nv_hgrn(const bf16* Z, const float* lblog, int l, const float* normg, bf16* Y) {
    __shared__ float sq[128], sf[128], sk[128];
    const int lane = threadIdx.x, bh = blockIdx.x, b = bh >> 2, h = bh & 3;
    float lb[2];
#pragma unroll
    for (int c = 0; c < 2; ++c) { const int ch = 128 * h + lane + 64 * c; const float x0 = lblog[ch], x1 = lblog[512 + ch], x2 = lblog[1024 + ch], x3 = lblog[1536 + ch];
        const float mx = fmaxf(fmaxf(x0, x1), fmaxf(x2, x3)); const float e0 = __expf(x0 - mx), e1 = __expf(x1 - mx), e2 = __expf(x2 - mx), e3 = __expf(x3 - mx); const float inv = 1.0f / (e0 + e1 + e2 + e3);
        lb[c] = (l >= 1 ? e1 : 0.f) * inv + (l >= 2 ? e2 : 0.f) * inv + (l >= 3 ? e3 : 0.f) * inv; }
    float S[128];
#pragma unroll
    for (int k = 0; k < 128; ++k) S[k] = 0.f;
    const float ng = normg[64 * h + lane];
    for (int t = 0; t < SEQ; ++t) { const size_t m = (size_t)b * SEQ + t; const bf16* zr = Z + m * NZ;
        __syncthreads();
#pragma unroll
        for (int c = 0; c < 2; ++c) { const int k = lane + 64 * c; const float f = bf2f(zr[ZC_HF + 128 * h + k]); const float fg = lb[c] + (1.0f - lb[c]) / (1.0f + __expf(-f));
            sq[k] = bf2f(zr[ZC_HQ + 128 * h + k]); sf[k] = fg; sk[k] = 1.0f - fg; }
        __syncthreads();
        const float v = bf2f(zr[ZC_HI + 64 * h + lane]); float o = 0.f;
#pragma unroll
        for (int k = 0; k < 128; ++k) { S[k] = sf[k] * S[k] + sk[k] * v; o += sq[k] * S[k]; }
        const float ms = wave_sum(o * o) * (1.0f / 64.0f); const float gate = silu_f(bf2f(zr[ZC_HG + 64 * h + lane]));
        Y[m * 1024 + 512 + 64 * h + lane] = (bf16)f2bf(o * rsqrtf(ms + 1e-6f) * ng * gate); }
}
__global__ void __launch_bounds__(256) nv_sg_prep(const bf16* Z, const float* lng, bf16* V) {
    const int lane = threadIdx.x & 63, m = blockIdx.x * 4 + (threadIdx.x >> 6); float x[4]; float s = 0.f;
#pragma unroll
    for (int j = 0; j < 4; ++j) { x[j] = gelu_exact(bf2f(Z[(size_t)m * NZ + ZC_V + lane + 64 * j])); s += x[j]; }
    const float mean = wave_sum(s) * (1.0f / 256.0f); float q = 0.f;
#pragma unroll
    for (int j = 0; j < 4; ++j) { x[j] -= mean; q += x[j] * x[j]; }
    const float rstd = rsqrtf(wave_sum(q) * (1.0f / 256.0f) + 1e-6f);
#pragma unroll
    for (int j = 0; j < 4; ++j) V[(size_t)m * 256 + lane + 64 * j] = (bf16)f2bf(x[j] * rstd * lng[lane + 64 * j]);
}
__global__ void __launch_bounds__(256) nv_sg(const bf16* Z, const bf16* V, const float* w, const float* bs, bf16* Y) {
    const int d = threadIdx.x, m = blockIdx.x, t = m & 127, h = d >> 6; const size_t m0 = (size_t)(m - t);
    float acc = bs[h * 128 + t]; const float* wr = w + ((size_t)h * 128 + t) * 128;
    for (int s = 0; s <= t; ++s) acc += wr[s] * bf2f(V[(m0 + s) * 256 + d]);
    Y[(size_t)m * 1024 + 256 + d] = (bf16)f2bf(gelu_exact(bf2f(Z[(size_t)m * NZ + ZC_U + d])) * acc);
}
#endif

extern "C" void kernel_launch(void* const* d_in, const int* in_sizes, int n_in, void* d_out, int out_size, void* d_ws, size_t ws_size, hipStream_t stream) {
    static int grid = 0;
    if (grid == 0) {
        if (n_in != N_IN || in_sizes[0] != M * D || out_size != M * D || ws_size < WS_END) { fprintf(stderr, "kernel_launch: unexpected shapes (n_in %d, in0 %d, out %d, ws %zu < %zu?)\n", n_in, n_in > 0 ? in_sizes[0] : -1, out_size, ws_size, (size_t)WS_END); grid = -1; return; }
        int dev = 0, cus = 0, per_cu = 0;
        if (hipGetDevice(&dev) != hipSuccess || hipDeviceGetAttribute(&cus, hipDeviceAttributeMultiprocessorCount, dev) != hipSuccess) { grid = -1; return; }
        if (hipFuncSetAttribute((const void*)mk_fwd, hipFuncAttributeMaxDynamicSharedMemorySize, LDS_BYTES) != hipSuccess) { fprintf(stderr, "kernel_launch: hipFuncSetAttribute failed\n"); grid = -1; return; }
        if (hipOccupancyMaxActiveBlocksPerMultiprocessor(&per_cu, (const void*)mk_fwd, NWAVES * 64, LDS_BYTES) != hipSuccess || per_cu < 1) { fprintf(stderr, "kernel_launch: occupancy query says %d\n", per_cu); }
        (void)hipGetLastError();
        grid = cus;
    }
    if (grid < 0) return;
    if (hipMemsetAsync((char*)d_ws + WS_CTL, 0, CTL_ZERO_BYTES, stream) != hipSuccess) return;
    Args a{};
    for (int i = 0; i < N_IN; ++i) a.in[i] = (const float*)d_in[i];
    a.out = (float*)d_out; a.ws = (unsigned char*)d_ws;
    auto launch = [&](int lo, int hi, int li) { a.ph_lo = lo; a.ph_hi = hi; a.li = li; hipLaunchKernelGGL(mk_fwd, dim3(grid), dim3(NWAVES * 64), LDS_BYTES, stream, a); };
#if MK_MODE == 0
    launch(0, N_PHASES, 0);
#else
    unsigned char* ws = (unsigned char*)d_ws;
    const bf16* Z = (const bf16*)(ws + WS_ZH); const bf16* QKV = (const bf16*)(ws + WS_QKV); bf16* Y = (bf16*)(ws + WS_B1);
    float* QR = (float*)(ws + WS_HST); float* KR = QR + (size_t)M * 256; bf16* V = (bf16*)(ws + WS_RST);
    const float* rcs = (const float*)(ws + WS_ROPE) + (size_t)M * 32; const float* rsn = rcs + (size_t)M * 32;
    int li = 0, lo = 0;
    for (int l = 0; l < DEPTH; ++l) {
        launch(lo, 1 + 10 * l + 3, li++);
#if !MIX_RET
        hipLaunchKernelGGL(nv_ret_prep, dim3(M * 128 / 256), dim3(256), 0, stream, Z, rcs, rsn, QR, KR);
        hipLaunchKernelGGL(nv_ret, dim3(M), dim3(256), 0, stream, Z, (const float*)QR, (const float*)KR, (const float*)d_in[IN_RETN] + l * 256, Y);
#endif
#if !MIX_HG
        hipLaunchKernelGGL(nv_hgrn, dim3(16), dim3(64), 0, stream, Z, (const float*)d_in[IN_HGLB], l, (const float*)d_in[IN_HGN] + l * 256, Y);
#endif
#if !MIX_SG
        hipLaunchKernelGGL(nv_sg_prep, dim3(M / 4), dim3(256), 0, stream, Z, (const float*)d_in[IN_SGLN] + l * 256, V);
        hipLaunchKernelGGL(nv_sg, dim3(M), dim3(256), 0, stream, Z, (const bf16*)V, (const float*)d_in[IN_SGW] + (size_t)l * 4 * 128 * 128, (const float*)d_in[IN_SGB] + l * 512, Y);
#endif
        launch(1 + 10 * l + 3, 1 + 10 * l + 6, li++);
#if !MIX_MLA
        hipLaunchKernelGGL(nv_mla, dim3(M), dim3(256), 0, stream, QKV, Y);
#endif
        lo = 1 + 10 * l + 6;
    }
    launch(lo, N_PHASES, li++);
#endif
}
```

```cpp
#include <hip/hip_runtime.h>
#include <cstdio>
#include <cstdint>
#include <cmath>
namespace pg8 {
#define PG8_LAS __attribute__((address_space(3)))
typedef unsigned short bf16_t;
typedef short bf16x8 __attribute__((ext_vector_type(8)));
typedef float f32x4 __attribute__((ext_vector_type(4)));
typedef unsigned u32x4 __attribute__((ext_vector_type(4)));
constexpr int BM = 256, BK = 64, HALF = 128, HTB = HALF * BK * 2  , STAGE_BYTES = 8 * HTB, NXCD = 8, WGM = 8;

__host__ __device__ __forceinline__ int lds_byte(int r, int c) { const int st = (r >> 4) * 2 + (c >> 5), rr = r & 15, cc = c & 31, ob = rr * 64 + cc * 2; return st * 1024 + (ob ^ (((ob >> 9) & 1) << 5)); }
__host__ __device__ __forceinline__ void stage_rc(int b, int& R, int& C) { const int st = b / 1024, sb = b % 1024, swz = sb ^ (((sb >> 9) & 1) << 5); R = (st >> 1) * 16 + swz / 64; C = (st & 1) * 32 + (swz % 64) / 2; }
__host__ __device__ __forceinline__ int perm32(int rho) { const int n = rho >> 4, i = rho & 15; return 8 * (i >> 2) + 4 * n + (i & 3); }

struct Unit { int pm, pn; };
struct Gemm { const bf16_t* A; const bf16_t* Bt; int M, N, K, lda; };

struct StaticOrder {
    int nM, nN, nwg, G, c;
    __host__ __device__ void init(int M, int N, int G_, int c_) { nM = M / BM; nN = N / BM; nwg = nM * nN; G = G_; c = c_; }
    __host__ __device__ bool next(int i, Unit& u) const {
        const long L = (long)i * G + c; if (L >= nwg) return false;
        int wgid = (int)L; { const int q = nwg / NXCD, r = nwg % NXCD, xcd = wgid % NXCD, off = wgid / NXCD; wgid = (xcd < r ? xcd * (q + 1) : r * (q + 1) + (xcd - r) * q) + off; }
        const int nig = WGM * nN, gid = wgid / nig, fm = gid * WGM, gsz = (nM - fm) < WGM ? (nM - fm) : WGM;
        u.pm = fm + ((wgid % nig) % gsz); u.pn = (wgid % nig) / gsz; return true;
    }
    __device__ __forceinline__ void a_ready(const Unit&) const {}
    __device__ __forceinline__ void done(const Unit&) const {}
};

__device__ __forceinline__ unsigned cvt_pk_bf16(float lo, float hi) { unsigned r; asm volatile("v_cvt_pk_bf16_f32 %0, %1, %2" : "=v"(r) : "v"(lo), "v"(hi)); return r; }
typedef unsigned u32x2 __attribute__((ext_vector_type(2)));
constexpr float RMS_EPS = 1e-6f, LOG2E = 1.4426950408889634f;
constexpr int DM = 1024, DFF_ = 2816, NZ_ = 3584;
__device__ __forceinline__ float sum4(const f32x4 a) { return (a[0] + a[1]) + (a[2] + a[3]); }
__device__ __forceinline__ float dot4(const f32x4 a) { return (a[0] * a[0] + a[1] * a[1]) + (a[2] * a[2] + a[3] * a[3]); }
__device__ __forceinline__ float row_rstd(const float* ssq, int row) {
    const f32x4* p = (const f32x4*)(ssq + (size_t)row * 16);
    const float s = (sum4(p[0]) + sum4(p[1])) + (sum4(p[2]) + sum4(p[3]));
    return __builtin_amdgcn_rsqf(s * (1.0f / 1024.0f) + RMS_EPS);
}
__device__ __forceinline__ float sigmoid_f(float x) { return __builtin_amdgcn_rcpf(1.0f + __builtin_amdgcn_exp2f(-LOG2E * x)); }

struct EpiSwiGLU {
    static constexpr bool PERM = true, AFTER_DRAIN = false;
    bf16_t* O; const float* ssq;
    __device__ __forceinline__ void operator()(const f32x4 (&acc)[2][2][4][2], const Unit& u, int wr, int wc, int fr, int fq) const {
        const int row0 = u.pm * BM + wr * 64 + fr, col0 = u.pn * 128 + wc * 32 + 8 * fq;
#pragma unroll
        for (int ai = 0; ai < 2; ++ai)
#pragma unroll
            for (int m = 0; m < 4; ++m) { const int row = row0 + ai * HALF + m * 16; const float r = row_rstd(ssq, row);
                float h[8];
#pragma unroll
                for (int n = 0; n < 2; ++n)
#pragma unroll
                    for (int j = 0; j < 4; ++j) { const float g = acc[ai][0][m][n][j] * r, up = acc[ai][1][m][n][j] * r; h[4 * n + j] = g * sigmoid_f(g) * up; }
                u32x4 w; w.x = cvt_pk_bf16(h[0], h[1]); w.y = cvt_pk_bf16(h[2], h[3]); w.z = cvt_pk_bf16(h[4], h[5]); w.w = cvt_pk_bf16(h[6], h[7]);
                *(u32x4*)(O + (size_t)row * DFF_ + col0) = w; }
    }
};
struct EpiRes {
    static constexpr bool PERM = false, AFTER_DRAIN = false;
    const float* base; float* out; bf16_t* hb; float* ssq_out; float alpha;
    __device__ __forceinline__ void operator()(const f32x4 (&acc)[2][2][4][2], const Unit& u, int wr, int wc, int fr, int fq) const {
        const int row0 = u.pm * BM + wr * 64 + fr, col0 = u.pn * BM + wc * 32 + 4 * fq;
#pragma unroll
        for (int ai = 0; ai < 2; ++ai)
#pragma unroll
            for (int m = 0; m < 4; ++m) { const int row = row0 + ai * HALF + m * 16; float s = 0.f;
#pragma unroll
                for (int bj = 0; bj < 2; ++bj)
#pragma unroll
                    for (int n = 0; n < 2; ++n) { const size_t off = (size_t)row * DM + col0 + bj * HALF + n * 16;
                        const f32x4 v = *(const f32x4*)(base + off) + acc[ai][bj][m][n] * alpha; *(f32x4*)(out + off) = v; s += dot4(v);
                        u32x2 w; w.x = cvt_pk_bf16(v[0], v[1]); w.y = cvt_pk_bf16(v[2], v[3]); *(u32x2*)(hb + off) = w; }
                s += __shfl_xor(s, 16); s += __shfl_xor(s, 32);
                if (fq == 0) ssq_out[(size_t)row * 16 + u.pn * 4 + wc] = s;
                asm volatile("" ::: "memory"); }
    }
};
struct EpiZ {
    static constexpr bool PERM = true, AFTER_DRAIN = false;
    bf16_t* Z; const float* ssq; float* ssqq; float* ssqkv;
    __device__ __forceinline__ void operator()(const f32x4 (&acc)[2][2][4][2], const Unit& u, int wr, int wc, int fr, int fq) const {
        const int row0 = u.pm * BM + wr * 64 + fr, col0 = u.pn * BM + wc * 32 + 8 * fq;
#pragma unroll
        for (int ai = 0; ai < 2; ++ai)
#pragma unroll
            for (int m = 0; m < 4; ++m) { const int row = row0 + ai * HALF + m * 16; const float r = row_rstd(ssq, row); float s0 = 0.f, s1 = 0.f;
#pragma unroll
                for (int bj = 0; bj < 2; ++bj) { const f32x4 v0 = acc[ai][bj][m][0] * r, v1 = acc[ai][bj][m][1] * r;
                    if (bj == 0) s0 = dot4(v0) + dot4(v1); else s1 = dot4(v0) + dot4(v1);
                    u32x4 w; w.x = cvt_pk_bf16(v0[0], v0[1]); w.y = cvt_pk_bf16(v0[2], v0[3]); w.z = cvt_pk_bf16(v1[0], v1[1]); w.w = cvt_pk_bf16(v1[2], v1[3]);
                    *(u32x4*)(Z + (size_t)row * NZ_ + col0 + bj * HALF) = w; }
                if (u.pn < 2) { float s = (u.pn == 0) ? s0 + s1 : s0; s += __shfl_xor(s, 16); s += __shfl_xor(s, 32);
                    if (fq == 0) { if (u.pn == 0) ssqq[(size_t)row * 4 + wc] = s; else ssqkv[(size_t)row * 4 + wc] = s; } } }
    }
};
struct EpiMla {
    static constexpr bool PERM = false, AFTER_DRAIN = false;
    bf16_t* O; const float* ssqq; const float* ssqkv; const float* cs; const float* sn;
    __device__ __forceinline__ void operator()(const f32x4 (&acc)[2][2][4][2], const Unit& u, int wr, int wc, int fr, int fq) const {
        const int row0 = u.pm * BM + wr * 64 + fr, col0 = u.pn * BM + wc * 32 + 4 * fq;
        const float QSCALE = 0.10206207261596575f * LOG2E;
#pragma unroll
        for (int ai = 0; ai < 2; ++ai)
#pragma unroll
            for (int m = 0; m < 4; ++m) { const int row = row0 + ai * HALF + m * 16;
                const float rq = __builtin_amdgcn_rsqf(sum4(*(const f32x4*)(ssqq + (size_t)row * 4)) * (1.0f / 256.0f) + RMS_EPS) * QSCALE;
                const float rkv = __builtin_amdgcn_rsqf(sum4(*(const f32x4*)(ssqkv + (size_t)row * 4)) * (1.0f / 128.0f) + RMS_EPS);
#pragma unroll
                for (int bj = 0; bj < 2; ++bj) { const int G = 8 * u.pn + 4 * bj + wc; const float sc = G < 12 ? rq : (G < 28 ? rkv : 1.0f);
                    f32x4 x1 = acc[ai][bj][m][0] * sc, x2 = acc[ai][bj][m][1] * sc;
                    if (G == 2 || G == 5 || G == 8 || G == 11 || G == 28) { const f32x4 c = *(const f32x4*)(cs + (size_t)row * 16 + 4 * fq), s = *(const f32x4*)(sn + (size_t)row * 16 + 4 * fq);
                        const f32x4 y1 = x1 * c - x2 * s, y2 = x1 * s + x2 * c; x1 = y1; x2 = y2; }
                    u32x2 w0, w1; w0.x = cvt_pk_bf16(x1[0], x1[1]); w0.y = cvt_pk_bf16(x1[2], x1[3]); w1.x = cvt_pk_bf16(x2[0], x2[1]); w1.y = cvt_pk_bf16(x2[2], x2[3]);
                    bf16_t* p = O + (size_t)row * DM + col0 + bj * HALF; *(u32x2*)p = w0; *(u32x2*)(p + 16) = w1; } }
    }
};
struct EpiPlain {
    static constexpr bool PERM = true, AFTER_DRAIN = false;
    bf16_t* O; int ldc;
    __device__ __forceinline__ void operator()(const f32x4 (&acc)[2][2][4][2], const Unit& u, int wr, int wc, int fr, int fq) const {
        const int row0 = u.pm * BM + wr * 64 + fr, col0 = u.pn * BM + wc * 32 + 8 * fq;
#pragma unroll
        for (int ai = 0; ai < 2; ++ai)
#pragma unroll
            for (int m = 0; m < 4; ++m) { bf16_t* rowp = O + (size_t)(row0 + ai * HALF + m * 16) * ldc + col0;
#pragma unroll
                for (int bj = 0; bj < 2; ++bj) { const f32x4 v0 = acc[ai][bj][m][0], v1 = acc[ai][bj][m][1];
                    u32x4 w; w.x = cvt_pk_bf16(v0[0], v0[1]); w.y = cvt_pk_bf16(v0[2], v0[3]); w.z = cvt_pk_bf16(v1[0], v1[1]); w.w = cvt_pk_bf16(v1[2], v1[3]);
                    *(u32x4*)(rowp + bj * HALF) = w; } }
    }
};
struct EpiPle {
    static constexpr bool PERM = false, AFTER_DRAIN = false;
    float* h; const bf16_t* pp; bf16_t* hb; const float* ssq_in; float* ssq_out;
    __device__ __forceinline__ void operator()(const f32x4 (&acc)[2][2][4][2], const Unit& u, int wr, int wc, int fr, int fq) const {
        const int row0 = u.pm * BM + wr * 64 + fr, col0 = u.pn * BM + wc * 32 + 4 * fq;
#pragma unroll
        for (int ai = 0; ai < 2; ++ai)
#pragma unroll
            for (int m = 0; m < 4; ++m) { const int row = row0 + ai * HALF + m * 16; const float r = row_rstd(ssq_in, row); float s = 0.f;
#pragma unroll
                for (int bj = 0; bj < 2; ++bj)
#pragma unroll
                    for (int n = 0; n < 2; ++n) { const size_t off = (size_t)row * DM + col0 + bj * HALF + n * 16;
                        const f32x4 hv = *(const f32x4*)(h + off); const u32x2 pw = *(const u32x2*)(pp + off); const f32x4 a = acc[ai][bj][m][n] * r;
                        f32x4 v; v[0] = hv[0] + __uint_as_float(pw.x << 16) * sigmoid_f(a[0]); v[1] = hv[1] + __uint_as_float(pw.x & 0xffff0000u) * sigmoid_f(a[1]);
                        v[2] = hv[2] + __uint_as_float(pw.y << 16) * sigmoid_f(a[2]); v[3] = hv[3] + __uint_as_float(pw.y & 0xffff0000u) * sigmoid_f(a[3]);
                        *(f32x4*)(h + off) = v; s += dot4(v);
                        u32x2 w; w.x = cvt_pk_bf16(v[0], v[1]); w.y = cvt_pk_bf16(v[2], v[3]); *(u32x2*)(hb + off) = w; }
                s += __shfl_xor(s, 16); s += __shfl_xor(s, 32);
                if (fq == 0) ssq_out[(size_t)row * 16 + u.pn * 4 + wc] = s;
                asm volatile("" ::: "memory"); }
    }
};

template <class Epi, class Sched, bool ALIGN_EPI = false, bool SP2 = false>
__device__ __forceinline__ void gemm_phase(PG8_LAS unsigned char* lds, const Gemm g, const Sched& S, const Epi& E) {
    int tid_o = threadIdx.x; asm volatile("" : "+v"(tid_o));
    const int tid = tid_o, wid = __builtin_amdgcn_readfirstlane(tid >> 6), lane = tid & 63, wr = wid >> 2, wc = wid & 3, fr = lane & 15, fq = lane >> 4;
    const int K = g.K, nt = K / BK;
    unsigned voffA[2], voffB[2];
#pragma unroll
    for (int i = 0; i < 2; ++i) { int R, C; stage_rc(tid * 16 + i * 8192, R, C); const int Rb = Epi::PERM ? ((R & ~31) + perm32(R & 31)) : R;
        voffA[i] = (unsigned)(R * g.lda + C) * 2u; voffB[i] = (unsigned)(Rb * K + C) * 2u; }
    const size_t kstep = (size_t)(BK * 2);
    const size_t hstep = (size_t)HALF * K * 2;
    const size_t tstep = 2 * hstep; const size_t hstepA = (size_t)HALF * g.lda * 2, tstepA = 2 * hstepA;
    const unsigned ldsw = (unsigned)wid * 1024u;
    const int aoff = lds_byte(wr * 64 + fr, fq * 8), boff = lds_byte(wc * 32 + fr, fq * 8);
#define PG8_SA(b, h) (((b) * 2 + (h)) * HTB)
#define PG8_SB(b, h) ((4 + (b) * 2 + (h)) * HTB)
#define PG8_STAGE(bufoff, gbase, voff) do { _Pragma("unroll") for (int _i = 0; _i < 2; ++_i) \
        __builtin_amdgcn_global_load_lds((const unsigned*)((const char*)(gbase) + (voff)[_i]), (PG8_LAS unsigned*)(lds + (bufoff) + ldsw + _i * 8192), 16, 0, 0); } while (0)
#define PG8_LDA(dst, b, h) do { _Pragma("unroll") for (int m = 0; m < 4; ++m) _Pragma("unroll") for (int k = 0; k < 2; ++k) dst[m][k] = *(const PG8_LAS bf16x8*)(lds + PG8_SA(b, h) + aoff + m * 2048 + k * 1024); } while (0)
#define PG8_LDB(dst, b, h) do { _Pragma("unroll") for (int n = 0; n < 2; ++n) _Pragma("unroll") for (int k = 0; k < 2; ++k) dst[n][k] = *(const PG8_LAS bf16x8*)(lds + PG8_SB(b, h) + boff + n * 2048 + k * 1024); } while (0)
#define PG8_MMA(ai, bj, At, Bt) do { __builtin_amdgcn_s_setprio(1); _Pragma("unroll") for (int m = 0; m < 4; ++m) _Pragma("unroll") for (int n = 0; n < 2; ++n) _Pragma("unroll") for (int k = 0; k < 2; ++k) \
        acc[ai][bj][m][n] = __builtin_amdgcn_mfma_f32_16x16x32_bf16(Bt[n][k], At[m][k], acc[ai][bj][m][n], 0, 0, 0); __builtin_amdgcn_s_setprio(0); } while (0)
#define PG8_WAIT_V(n) asm volatile("s_waitcnt vmcnt(" #n ")" ::: "memory")
#define PG8_WAIT_L(n) asm volatile("s_waitcnt lgkmcnt(" #n ")" ::: "memory")
#define PG8_BAR __builtin_amdgcn_s_barrier()
#define PG8_SCHED __builtin_amdgcn_sched_barrier(0)
    Unit cur, nxt; int ui = 0;
    if (!S.next(0, cur)) return;
    f32x4 acc[2][2][4][2];
#pragma unroll
    for (int a = 0; a < 2; ++a)
#pragma unroll
        for (int b = 0; b < 2; ++b)
#pragma unroll
            for (int m = 0; m < 4; ++m)
#pragma unroll
                for (int n = 0; n < 2; ++n) acc[a][b][m][n] = (f32x4){0.f, 0.f, 0.f, 0.f};
    bf16x8 At[4][2], B0[2][2], B1[2][2];
    const char* cA = (const char*)g.A + (size_t)cur.pm * tstepA; const char* cB = (const char*)g.Bt + (size_t)cur.pn * tstep;
    S.a_ready(cur);
    if constexpr (SP2) {
        PG8_STAGE(PG8_SB(0, 0), cB, voffB); PG8_STAGE(PG8_SB(0, 1), cB + hstep, voffB); PG8_STAGE(PG8_SA(0, 0), cA, voffA); PG8_STAGE(PG8_SA(0, 1), cA + hstepA, voffA);
        if (wr == 1) PG8_BAR;
        PG8_WAIT_V(2); PG8_BAR;
        PG8_STAGE(PG8_SB(1, 0), cB + kstep, voffB); PG8_STAGE(PG8_SA(1, 0), cA + kstep, voffA); PG8_STAGE(PG8_SB(1, 1), cB + hstep + kstep, voffB);
        PG8_WAIT_V(6); PG8_BAR;
    } else {
        PG8_STAGE(PG8_SB(0, 0), cB, voffB); PG8_STAGE(PG8_SA(0, 0), cA, voffA); PG8_STAGE(PG8_SB(0, 1), cB + hstep, voffB); PG8_STAGE(PG8_SA(0, 1), cA + hstepA, voffA);
        if (wr == 1) PG8_BAR;
        PG8_WAIT_V(4); PG8_BAR;
        PG8_STAGE(PG8_SB(1, 0), cB + kstep, voffB); PG8_STAGE(PG8_SA(1, 0), cA + kstep, voffA); PG8_STAGE(PG8_SB(1, 1), cB + hstep + kstep, voffB);
        PG8_WAIT_V(6); PG8_BAR;
    }
    for (;;) {
        const bool has_next = S.next(ui + 1, nxt);
        const char* nA = has_next ? (const char*)g.A + (size_t)nxt.pm * tstepA : cA; const char* nB = has_next ? (const char*)g.Bt + (size_t)nxt.pn * tstep : cB;
        for (int t = 0; t < nt; t += 2) {
            const bool last = (t == nt - 2);
            const char* a1 = cA + (size_t)(t + 1) * kstep;
            const char* a2 = last ? nA : cA + (size_t)(t + 2) * kstep; const char* b2 = last ? nB : cB + (size_t)(t + 2) * kstep;
            const char* a3 = a2 + kstep; const char* b3 = b2 + kstep;
            if (last && has_next) S.a_ready(nxt);
            if constexpr (SP2) {
            PG8_LDB(B0, 0, 0); PG8_LDB(B1, 0, 1); PG8_SCHED; PG8_LDA(At, 0, 0); PG8_STAGE(PG8_SA(1, 1), a1 + hstepA, voffA);
            PG8_WAIT_V(8); PG8_WAIT_L(0); PG8_BAR; PG8_MMA(0, 0, At, B0); PG8_MMA(0, 1, At, B1); PG8_BAR; PG8_SCHED;
            PG8_LDA(At, 0, 1); PG8_STAGE(PG8_SB(0, 0), b2, voffB); PG8_STAGE(PG8_SB(0, 1), b2 + hstep, voffB); PG8_STAGE(PG8_SA(0, 0), a2, voffA);
            PG8_WAIT_V(8); PG8_WAIT_L(0); PG8_BAR; PG8_MMA(1, 0, At, B0); PG8_MMA(1, 1, At, B1); PG8_BAR; PG8_SCHED;
            PG8_LDB(B0, 1, 0); PG8_LDB(B1, 1, 1); PG8_SCHED; PG8_LDA(At, 1, 0); PG8_STAGE(PG8_SA(0, 1), a2 + hstepA, voffA);
            PG8_WAIT_V(8); PG8_WAIT_L(0); PG8_BAR; PG8_MMA(0, 0, At, B0); PG8_MMA(0, 1, At, B1); PG8_BAR; PG8_SCHED;
            PG8_LDA(At, 1, 1); PG8_STAGE(PG8_SB(1, 0), b3, voffB); PG8_STAGE(PG8_SB(1, 1), b3 + hstep, voffB); PG8_STAGE(PG8_SA(1, 0), a3, voffA);
            PG8_WAIT_V(8); PG8_WAIT_L(0); PG8_BAR; PG8_MMA(1, 0, At, B0); PG8_MMA(1, 1, At, B1); PG8_BAR; PG8_SCHED;
            } else {
            PG8_LDB(B0, 0, 0); PG8_SCHED; PG8_LDA(At, 0, 0); PG8_STAGE(PG8_SA(1, 1), a1 + hstepA, voffA);
            PG8_WAIT_L(8); PG8_BAR; PG8_WAIT_L(0); PG8_MMA(0, 0, At, B0); PG8_BAR; PG8_SCHED;
            PG8_LDB(B1, 0, 1); PG8_STAGE(PG8_SB(0, 0), b2, voffB);
            PG8_BAR; PG8_WAIT_L(0); PG8_MMA(0, 1, At, B1); PG8_BAR;
            PG8_LDA(At, 0, 1); PG8_STAGE(PG8_SA(0, 0), a2, voffA);
            PG8_BAR; PG8_WAIT_L(0); PG8_MMA(1, 0, At, B0); PG8_BAR; PG8_SCHED;
            PG8_STAGE(PG8_SB(0, 1), b2 + hstep, voffB);
            PG8_WAIT_V(6); PG8_BAR; PG8_MMA(1, 1, At, B1); PG8_BAR;
            PG8_LDB(B0, 1, 0); PG8_SCHED; PG8_LDA(At, 1, 0); PG8_STAGE(PG8_SA(0, 1), a2 + hstepA, voffA);
            PG8_WAIT_L(8); PG8_BAR; PG8_WAIT_L(0); PG8_MMA(0, 0, At, B0); PG8_BAR; PG8_SCHED;
            PG8_LDB(B1, 1, 1); PG8_STAGE(PG8_SB(1, 0), b3, voffB);
            PG8_BAR; PG8_WAIT_L(0); PG8_MMA(0, 1, At, B1); PG8_BAR;
            PG8_LDA(At, 1, 1); PG8_STAGE(PG8_SA(1, 0), a3, voffA);
            PG8_BAR; PG8_WAIT_L(0); PG8_MMA(1, 0, At, B0); PG8_BAR; PG8_SCHED;
            PG8_STAGE(PG8_SB(1, 1), b3 + hstep, voffB);
            PG8_WAIT_V(6); PG8_BAR; PG8_MMA(1, 1, At, B1); PG8_BAR;
            }
        }
        if constexpr (ALIGN_EPI) { if (wr == 0) PG8_BAR; }
        if constexpr (!Epi::AFTER_DRAIN) { E(acc, cur, wr, wc, fr, fq); S.done(cur); }
        if (!has_next) break;
#pragma unroll
        for (int a = 0; a < 2; ++a)
#pragma unroll
            for (int b = 0; b < 2; ++b)
#pragma unroll
                for (int m = 0; m < 4; ++m)
#pragma unroll
                    for (int n = 0; n < 2; ++n) acc[a][b][m][n] = (f32x4){0.f, 0.f, 0.f, 0.f};
        cur = nxt; cA = nA; cB = nB; ++ui;
        if constexpr (ALIGN_EPI) { if (wr == 1) PG8_BAR; }
    }
    PG8_WAIT_V(0);
    if constexpr (!ALIGN_EPI) { if (wr == 0) PG8_BAR; }
    PG8_BAR;
    if constexpr (Epi::AFTER_DRAIN) { E.fused(acc, cur, wr, wc, fr, fq, lds, wid, lane); S.done(cur); }
#undef PG8_SA
#undef PG8_SB
#undef PG8_STAGE
#undef PG8_LDA
#undef PG8_LDB
#undef PG8_MMA
#undef PG8_WAIT_V
#undef PG8_WAIT_L
#undef PG8_BAR
#undef PG8_SCHED
}
}

constexpr int NWAVES = 8;
constexpr int M = 16384, SEQ = 4096, NBATCH = 4, DEPTH = 4, D = 1024, DFF = 2816, NGU = 2 * DFF, NZ = 3584, NZSRC = 3488, PLED = 256;
constexpr int ZC_U = 512, ZC_V = 768, ZC_HQ = 1024, ZC_HF = 1536, ZC_HI = 2048, ZC_HG = 2304, ZC_RQ = 2560, ZC_RK = 2816, ZC_RV = 3072, ZC_RG = 3328;
constexpr int QC_Q = 0, QC_KN = 384, QC_V = 640, QC_KR = 896;
constexpr size_t MiB = 1u << 20;
constexpr size_t WS_CTL = 0, CTL_ZERO_BYTES = 1 * MiB;
constexpr size_t WS_WGU = 1 * MiB;
constexpr size_t WS_WD = WS_WGU + 88 * MiB;
constexpr size_t WS_WIN = WS_WD + 44 * MiB;
constexpr size_t WS_WMLA = WS_WIN + 28 * MiB;
constexpr size_t WS_WOUT = WS_WMLA + 4 * MiB;
constexpr size_t WS_WPG = WS_WOUT + 8 * MiB;
constexpr size_t WS_WPP = WS_WPG + 8 * MiB;
constexpr size_t WS_WSG = WS_WPP + 2 * MiB;
constexpr size_t WS_B0 = WS_WSG + 1 * MiB;
constexpr size_t WS_B1 = WS_B0 + 32 * MiB;
constexpr size_t WS_ZH = WS_B1 + 32 * MiB;
constexpr size_t WS_QKV = WS_ZH + 112 * MiB;
constexpr size_t WS_PBF = WS_QKV + 32 * MiB;
constexpr size_t WS_HST = WS_PBF + 8 * MiB;
constexpr size_t WS_HDC = WS_HST + 32 * MiB;
constexpr size_t WS_RST = WS_HDC + 1 * MiB;
constexpr size_t WS_ROPE = WS_RST + 8 * MiB;
constexpr size_t WS_SSQ = WS_ROPE + 6 * MiB;
constexpr size_t WS_SSQ2 = WS_SSQ + 2 * MiB;
constexpr size_t WS_END = WS_SSQ2 + 1 * MiB;
constexpr int CW_TMO = 0, CW_BAR = 4096;
constexpr int MAX_LAUNCHES = 16;
constexpr int RING_OFF = 0, RING_BYTES = 131072, LDSCTL_OFF = RING_BYTES, MISC_OFF = LDSCTL_OFF + 320, LDS_BYTES = 147456;

#define GAS __attribute__((address_space(1)))
#define LAS __attribute__((address_space(3)))
typedef unsigned short bf16;
typedef unsigned v4u __attribute__((ext_vector_type(4)));
typedef unsigned v2u __attribute__((ext_vector_type(2)));
typedef float f32x4 __attribute__((ext_vector_type(4)));
typedef short bf16x8 __attribute__((ext_vector_type(8)));
typedef GAS unsigned gu32;
#define RLX_AGENT __ATOMIC_RELAXED, __HIP_MEMORY_SCOPE_AGENT
#define LDS_WAIT() asm volatile("s_waitcnt lgkmcnt(0)" ::: "memory")
#define VM_WAIT() asm volatile("s_waitcnt vmcnt(0)" ::: "memory")
__device__ __forceinline__ unsigned f2bf(float f) { unsigned u = __builtin_bit_cast(unsigned, f); return (u + 0x7fffu + ((u >> 16) & 1u)) >> 16; }
__device__ __forceinline__ unsigned pk2(float lo, float hi) { return f2bf(lo) | (f2bf(hi) << 16); }
__device__ __forceinline__ float bf2f(bf16 v) { return __uint_as_float((unsigned)v << 16); }
__device__ __forceinline__ float wave_sum(float v) {
#pragma unroll
    for (int o = 1; o < 64; o <<= 1) v += __shfl_xor(v, o);
    return v;
}
__device__ __forceinline__ float wave_max(float v) {
#pragma unroll
    for (int o = 1; o < 64; o <<= 1) v = fmaxf(v, __shfl_xor(v, o));
    return v;
}
__device__ const double ROPE_INVT[48] = {
1.59154943091895346e-01, 8.94994016088910133e-02, 5.03292121044870353e-02, 2.83021958306233987e-02, 1.59154943091895339e-02, 8.94994016088910237e-03, 5.03292121044870370e-03, 2.83021958306233987e-03, 1.59154943091895356e-03, 8.94994016088910237e-04, 5.03292121044870326e-04, 2.83021958306233954e-04, 1.59154943091895351e-04, 8.94994016088910182e-05, 5.03292121044870354e-05, 2.83021958306233961e-05,
1.59154943091895346e-01, 1.19349370211248862e-01, 8.94994016088910133e-02, 6.71150830052272551e-02, 5.03292121044870353e-02, 3.77415847174197711e-02, 2.83021958306233987e-02, 2.12236527647776604e-02, 1.59154943091895339e-02, 1.19349370211248862e-02, 8.94994016088910237e-03, 6.71150830052272534e-03, 5.03292121044870370e-03, 3.77415847174197719e-03, 2.83021958306233987e-03, 2.12236527647776622e-03, 1.59154943091895356e-03, 1.19349370211248849e-03, 8.94994016088910237e-04, 6.71150830052272599e-04, 5.03292121044870326e-04, 3.77415847174197741e-04, 2.83021958306233954e-04, 2.12236527647776605e-04, 1.59154943091895351e-04, 1.19349370211248862e-04, 8.94994016088910182e-05, 6.71150830052272545e-05, 5.03292121044870354e-05, 3.77415847174197768e-05, 2.83021958306233961e-05, 2.12236527647776592e-05 };

#define XB_TMO      128
#define XB_XCNT(j)  (256  + 64 * (j))
#define XB_XSUB(j)  (1280 + 64 * (j))
#define XB_XGEN(j)  (2304 + 64 * (j))
#define XB_TOP      3328
#define XB_TOPGEN   3392
#define XCD_BAR_WORDS 3456
#define XB_SPIN_CAP (1u << 18)

__device__ __forceinline__ unsigned xb_ld(unsigned* p)              { return __hip_atomic_load(p, __ATOMIC_RELAXED, __HIP_MEMORY_SCOPE_AGENT); }
__device__ __forceinline__ unsigned xb_add(unsigned* p, unsigned v) { return __hip_atomic_fetch_add(p, v, __ATOMIC_RELAXED, __HIP_MEMORY_SCOPE_AGENT); }
__device__ __forceinline__ unsigned xb_xcc_id() { return (unsigned)__builtin_amdgcn_s_getreg((3 << 11) | 20) & 0xFu; }
#define XB_SPIN(cond, bar) do { unsigned _sp = 0; while (cond) { __builtin_amdgcn_s_sleep(1); \
    if ((++_sp & 255u) == 0u) { if (xb_ld(&(bar)[XB_TMO])) break; if (_sp > XB_SPIN_CAP) { atomicAdd(&(bar)[XB_TMO], 1u); break; } } } } while (0)

struct XcdBarrier {
    unsigned* bar; unsigned x;
    volatile LAS unsigned* st;
};

__device__ __forceinline__ XcdBarrier xcd_barrier_post(unsigned* bar, volatile LAS unsigned* st) {
    XcdBarrier b; b.bar = bar; b.x = xb_xcc_id(); b.st = st;
    if (threadIdx.x == 0) (void)xb_add(&bar[XB_XCNT(b.x)], 1u);
    return b;
}
__device__ __forceinline__ void xcd_barrier_complete(unsigned* bar, unsigned x, unsigned& nloc, unsigned& nx) {
    const unsigned G = gridDim.x * gridDim.y * gridDim.z;
    unsigned sum, cnt, mine, sp = 0u;
    for (;;) {
        sum = 0u; cnt = 0u; mine = 0u;
#pragma unroll
        for (unsigned j = 0; j < 16; ++j) { const unsigned c = xb_ld(&bar[XB_XCNT(j)]); sum += c; cnt += (c > 0u) ? 1u : 0u; mine = (j == x) ? c : mine; }
        if (sum == G) break;
        __builtin_amdgcn_s_sleep(1);
        if ((++sp & 255u) == 0u) { if (xb_ld(&bar[XB_TMO])) break; if (sp > XB_SPIN_CAP) { atomicAdd(&bar[XB_TMO], 1u); break; } }
    }
    nloc = mine > 0u ? mine : 1u; nx = cnt > 0u ? cnt : 1u;
}

__device__ __forceinline__ void xcd_barrier(const XcdBarrier& b) {
    asm volatile("s_waitcnt vmcnt(0)" ::: "memory");
    __syncthreads();
    if (threadIdx.x == 0) {
        unsigned* bar = b.bar;
        __builtin_amdgcn_s_waitcnt(0);
        unsigned nloc = b.st[0], nx = b.st[1];
        if (nloc == 0u) { xcd_barrier_complete(bar, b.x, nloc, nx); b.st[0] = nloc; b.st[1] = nx; }
        const unsigned old = xb_add(&bar[XB_XSUB(b.x)], 1u);
        const unsigned gen = old / nloc;
        if (old + 1u == (gen + 1u) * nloc) {
            __builtin_amdgcn_fence(__ATOMIC_RELEASE, "agent");
            asm volatile("s_waitcnt vmcnt(0)" ::: "memory");
            const unsigned og = xb_add(&bar[XB_TOP], 1u);
            const unsigned tg = og / nx;
            if (og + 1u == (tg + 1u) * nx) xb_add(&bar[XB_TOPGEN], 1u);
            else XB_SPIN(xb_ld(&bar[XB_TOPGEN]) == tg, bar);
            __builtin_amdgcn_fence(__ATOMIC_ACQUIRE, "agent");
            xb_add(&bar[XB_XGEN(b.x)], 1u);
            asm volatile("s_waitcnt vmcnt(0)" ::: "memory");
        } else {
            XB_SPIN(xb_ld(&bar[XB_XGEN(b.x)]) == gen, bar);
            __builtin_amdgcn_fence(__ATOMIC_ACQUIRE, "agent");
            asm volatile("s_waitcnt vmcnt(0)" ::: "memory");
        }
    }
    __syncthreads();
}

enum { IN_X = 0, IN_P, IN_POS, IN_F1N, IN_F1G, IN_F1U, IN_F1D, IN_MIXN, IN_WIN, IN_QN, IN_WUQ, IN_KVN, IN_WUKV, IN_SGLN, IN_SGW, IN_SGB, IN_HGLB, IN_HGN, IN_RETN, IN_WOUT,
       IN_F2N, IN_F2G, IN_F2U, IN_F2D, IN_PLEN, IN_PLEP, IN_PLEG, IN_FINN, N_IN };
struct Args { const float* in[N_IN]; float* out; unsigned char* ws; int ph_lo, ph_hi, li, pad; };
constexpr int N_PHASES = 42;

__device__ __forceinline__ void conv_item(const float* W, int N, const float* gain, bf16* WT, int ldk, int drow, int k0, int n0, LAS float* scr, int lane) {
#pragma unroll 8
    for (int i = 0; i < 32; ++i) { const int kk = 2 * i + (lane >> 5); float v = W[(size_t)(k0 + kk) * N + n0 + (lane & 31)]; if (gain) v *= gain[k0 + kk]; scr[kk * 33 + (lane & 31)] = v; }
    LDS_WAIT(); asm volatile("" ::: "memory");
    const int c = lane & 7;
#pragma unroll
    for (int j = 0; j < 4; ++j) { const int n = (lane >> 3) + 8 * j; const LAS float* s = scr + (8 * c) * 33 + n;
        v4u o; o.x = pk2(s[0 * 33], s[1 * 33]); o.y = pk2(s[2 * 33], s[3 * 33]); o.z = pk2(s[4 * 33], s[5 * 33]); o.w = pk2(s[6 * 33], s[7 * 33]);
        *(v4u*)(WT + (size_t)(drow + n) * ldk + k0 + 8 * c) = o; }
    LDS_WAIT(); asm volatile("" ::: "memory");
}
constexpr int IT_FF = 1408, IT_WIN = 16 * 109, IT_SQ = 16 * 32, IT_PP = 4 * 32, IT_LAYER = 6 * IT_FF + IT_WIN + 2 * IT_SQ + IT_PP;

__device__ __forceinline__ void prologue(const Args& a, LAS unsigned char* lds, int tid, int lane, int wave, int vcu, int G) {
    unsigned char* ws = a.ws;
    bf16* Wgu = (bf16*)(ws + WS_WGU); bf16* Wd = (bf16*)(ws + WS_WD); bf16* Win = (bf16*)(ws + WS_WIN); bf16* Wmla = (bf16*)(ws + WS_WMLA);
    bf16* Wout = (bf16*)(ws + WS_WOUT); bf16* Wpg = (bf16*)(ws + WS_WPG); bf16* Wpp = (bf16*)(ws + WS_WPP); bf16* Wsg = (bf16*)(ws + WS_WSG);
    LAS float* scr = (LAS float*)(lds + RING_OFF + wave * 16384);
    const int gw = vcu * NWAVES + wave, NGW = G * NWAVES;
    const int gt = (vcu * NWAVES + wave) * 64 + lane, NGT = NGW * 64;
    for (int it = gw; it < DEPTH * IT_LAYER; it += NGW) {
        const int l = it / IT_LAYER; int r = it % IT_LAYER;
        if (r < 6 * IT_FF) { const int f = r / IT_FF; r -= f * IT_FF; const int second = f / 3, kind = f - 3 * second;
            if (kind < 2) { const int kb = r / 88, nb = r - 88 * kb, n0 = 32 * nb;
                const float* W = (second ? (kind ? a.in[IN_F2U] : a.in[IN_F2G]) : (kind ? a.in[IN_F1U] : a.in[IN_F1G])) + (size_t)l * D * DFF;
                const float* gain = (second ? a.in[IN_F2N] : a.in[IN_F1N]) + l * D;
                conv_item(W, DFF, gain, Wgu + (size_t)(2 * l + second) * NGU * D, D, (n0 >> 7) * 256 + (n0 & 127) + 128 * kind, 64 * kb, n0, scr, lane); }
            else { const int kb = r / 32, nb = r - 32 * kb;
                const float* W = (second ? a.in[IN_F2D] : a.in[IN_F1D]) + (size_t)l * DFF * D;
                conv_item(W, D, nullptr, Wd + (size_t)(2 * l + second) * D * DFF, DFF, 32 * nb, 64 * kb, 32 * nb, scr, lane); }
            continue; }
        r -= 6 * IT_FF;
        if (r < IT_WIN) { const int kb = r / 109, nb = r - 109 * kb, n0 = 32 * nb;
            conv_item(a.in[IN_WIN] + (size_t)l * D * NZSRC, NZSRC, a.in[IN_MIXN] + l * D, Win + (size_t)l * NZ * D, D, n0 < 416 ? n0 : n0 + 96, 64 * kb, n0, scr, lane); continue; }
        r -= IT_WIN;
        if (r < IT_SQ) { const int kb = r / 32, nb = r - 32 * kb; conv_item(a.in[IN_WOUT] + (size_t)l * D * D, D, nullptr, Wout + (size_t)l * D * D, D, 32 * nb, 64 * kb, 32 * nb, scr, lane); continue; }
        r -= IT_SQ;
        if (r < IT_SQ) { const int kb = r / 32, nb = r - 32 * kb; conv_item(a.in[IN_PLEG] + (size_t)l * D * D, D, a.in[IN_PLEN] + l * D, Wpg + (size_t)l * D * D, D, 32 * nb, 64 * kb, 32 * nb, scr, lane); continue; }
        r -= IT_SQ;
        { const int kb = r / 32, nb = r - 32 * kb; conv_item(a.in[IN_PLEP] + (size_t)l * PLED * D, D, nullptr, Wpp + (size_t)l * D * PLED, PLED, 32 * nb, 64 * kb, 32 * nb, scr, lane); }
    }
    for (int i = gt; i < DEPTH * 96 * (D / 8); i += NGT) { const int l = i / (96 * 128), r = i - l * 96 * 128; const int row = 416 + r / 128, c8 = r & 127;
        *(v4u*)(Win + ((size_t)l * NZ + row) * D + 8 * c8) = (v4u){0u, 0u, 0u, 0u}; }
    for (int i = gt; i < DEPTH * 1024 * 64; i += NGT) { const int l = i >> 16, r = i & 65535, n = r >> 6, k8 = (r & 63) * 8;
        const float* wuq = a.in[IN_WUQ] + (size_t)l * 256 * 384; const float* wukv = a.in[IN_WUKV] + (size_t)l * 128 * 512;
        const float* qg = a.in[IN_QN] + l * 256; const float* kvg = a.in[IN_KVN] + l * 128;
        float v[8];
#pragma unroll
        for (int j = 0; j < 8; ++j) { const int k = k8 + j; float x = 0.f;
            if (n < 384) { if (k < 256) x = wuq[(size_t)k * 384 + n] * qg[k]; }
            else if (n < 896) { if (k >= 256 && k < 384) { const int nn = (n - 384) & 255, hh = nn >> 6, jj = (nn & 63) + (n >= 640 ? 64 : 0); x = wukv[(size_t)(k - 256) * 512 + hh * 128 + jj] * kvg[k - 256]; } }
            else if (n < 928) { if (k == 384 + (n - 896)) x = 1.0f; }
            v[j] = x; }
        v4u o; o.x = pk2(v[0], v[1]); o.y = pk2(v[2], v[3]); o.z = pk2(v[4], v[5]); o.w = pk2(v[6], v[7]);
        *(v4u*)(Wmla + ((size_t)l * 1024 + n) * 512 + k8) = o; }
    for (int i = gt; i < DEPTH * 4 * 128 * 128 / 2; i += NGT) { const int e = 2 * i, s = e & 127, t = (e >> 7) & 127; const float* w = a.in[IN_SGW];
        const float x0 = s <= t ? w[e] : 0.f, x1 = (s + 1) <= t ? w[e + 1] : 0.f; ((unsigned*)Wsg)[i] = pk2(x0, x1); }
    { const float* x = a.in[IN_X]; bf16* B0 = (bf16*)(ws + WS_B0); float* ssq = (float*)(ws + WS_SSQ);
      for (int m = gw; m < M; m += NGW) { const f32x4* xr = (const f32x4*)(x + (size_t)m * D) + lane; unsigned long long* o8 = (unsigned long long*)(B0 + (size_t)m * D) + lane; float t0, t1, t2, t3;
          { const f32x4 v = xr[0];   t0 = wave_sum(pg8::dot4(v)); o8[0]   = (unsigned long long)pk2(v[0], v[1]) | ((unsigned long long)pk2(v[2], v[3]) << 32); }
          { const f32x4 v = xr[64];  t1 = wave_sum(pg8::dot4(v)); o8[64]  = (unsigned long long)pk2(v[0], v[1]) | ((unsigned long long)pk2(v[2], v[3]) << 32); }
          { const f32x4 v = xr[128]; t2 = wave_sum(pg8::dot4(v)); o8[128] = (unsigned long long)pk2(v[0], v[1]) | ((unsigned long long)pk2(v[2], v[3]) << 32); }
          { const f32x4 v = xr[192]; t3 = wave_sum(pg8::dot4(v)); o8[192] = (unsigned long long)pk2(v[0], v[1]) | ((unsigned long long)pk2(v[2], v[3]) << 32); }
          if (lane < 16) { float val = 0.f; if (lane == 0) val = t0; if (lane == 4) val = t1; if (lane == 8) val = t2; if (lane == 12) val = t3; ssq[(size_t)m * 16 + lane] = val; } } }
    { const int* pos = (const int*)a.in[IN_POS]; float* mcs = (float*)(ws + WS_ROPE); float* msn = mcs + (size_t)M * 16; float* rcs = msn + (size_t)M * 16; float* rsn = rcs + (size_t)M * 32;
      for (int i = gt; i < M * 48; i += NGT) { const int m = i / 48, f = i - 48 * m; const double turns = (double)pos[m] * ROPE_INVT[f]; const float fr = (float)(turns - __builtin_rint(turns));
          const float c = __builtin_amdgcn_cosf(fr), s = __builtin_amdgcn_sinf(fr);
          if (f < 16) { mcs[(size_t)m * 16 + f] = c; msn[(size_t)m * 16 + f] = s; } else { rcs[(size_t)m * 32 + f - 16] = c; rsn[(size_t)m * 32 + f - 16] = s; } } }
}

namespace mx {
typedef const LAS bf16* lcp;
#define MFMA16(a, b, c) __builtin_amdgcn_mfma_f32_16x16x32_bf16((a), (b), (c), 0, 0, 0)
__device__ __forceinline__ bf16x8 frag(lcp base, int row, int stride, int k) { return *(const LAS bf16x8*)(base + row * stride + k); }
__device__ __forceinline__ bf16x8 frag2(lcp base, int row, int stride, int k) {
    typedef short s16x4 __attribute__((ext_vector_type(4)));
    const s16x4 lo = *(const LAS s16x4*)(base + row * stride + k), hi = *(const LAS s16x4*)(base + row * stride + k + 16);
    return (bf16x8){lo[0], lo[1], lo[2], lo[3], hi[0], hi[1], hi[2], hi[3]};
}
__device__ __forceinline__ bf16x8 pack_pair(const f32x4 a, const f32x4 b) {
    v4u w; w.x = pg8::cvt_pk_bf16(a[0], a[1]); w.y = pg8::cvt_pk_bf16(a[2], a[3]); w.z = pg8::cvt_pk_bf16(b[0], b[1]); w.w = pg8::cvt_pk_bf16(b[2], b[3]);
    return __builtin_bit_cast(bf16x8, w);
}
__device__ __forceinline__ float lo16(unsigned w) { return __uint_as_float(w << 16); }
__device__ __forceinline__ float hi16(unsigned w) { return __uint_as_float(w & 0xffff0000u); }
__device__ __forceinline__ void unpack8(const v4u w, float (&x)[8]) { x[0] = lo16(w.x); x[1] = hi16(w.x); x[2] = lo16(w.y); x[3] = hi16(w.y); x[4] = lo16(w.z); x[5] = hi16(w.z); x[6] = lo16(w.w); x[7] = hi16(w.w); }
__device__ __forceinline__ v4u pack8(const float (&x)[8]) { v4u w; w.x = pg8::cvt_pk_bf16(x[0], x[1]); w.y = pg8::cvt_pk_bf16(x[2], x[3]); w.z = pg8::cvt_pk_bf16(x[4], x[5]); w.w = pg8::cvt_pk_bf16(x[6], x[7]); return w; }
__device__ __forceinline__ float silu_fast(float x) { return x * __builtin_amdgcn_rcpf(1.0f + __builtin_amdgcn_exp2f(-1.4426950408889634f * x)); }
#define WG_SYNC() do { asm volatile("s_waitcnt vmcnt(0) lgkmcnt(0)" ::: "memory"); __builtin_amdgcn_s_barrier(); asm volatile("" ::: "memory"); } while (0)

constexpr int RET_C = 128;
__device__ __forceinline__ float ret_lg2(int h) { return __builtin_amdgcn_logf(1.0f - __builtin_amdgcn_exp2f(-(5.0f + (float)h))); }
__device__ __forceinline__ void ret_rope8(const bf16* zrow, const float* cs, const float* sn, int grp, float sc, float (&o1)[8], float (&o2)[8]) {
    float x1[8], x2[8]; unpack8(*(const v4u*)(zrow + 8 * grp), x1); unpack8(*(const v4u*)(zrow + 32 + 8 * grp), x2);
    const f32x4 c0 = *(const f32x4*)(cs + 8 * grp), c1 = *(const f32x4*)(cs + 8 * grp + 4), s0 = *(const f32x4*)(sn + 8 * grp), s1 = *(const f32x4*)(sn + 8 * grp + 4);
#pragma unroll
    for (int j = 0; j < 8; ++j) { const float c = j < 4 ? c0[j & 3] : c1[j & 3], s = j < 4 ? s0[j & 3] : s1[j & 3]; o1[j] = (x1[j] * c - x2[j] * s) * sc; o2[j] = (x1[j] * s + x2[j] * c) * sc; }
}
__device__ __forceinline__ void ret_pass1(int job, const bf16* Z, const float* rcs, const float* rsn, float* RST, LAS unsigned char* lds, int tid) {
    const int lane = tid & 63, w = __builtin_amdgcn_readfirstlane(tid >> 6), r15 = lane & 15, g = lane >> 4;
    const int h = job & 3, n = (job >> 2) & 31, b = job >> 7; const size_t m0 = (size_t)b * SEQ + (size_t)n * RET_C; const float lg2 = ret_lg2(h);
    LAS bf16* kT = (LAS bf16*)lds; LAS bf16* vT = kT + 64 * 136;
    { const int row = tid >> 2, grp = tid & 3; const size_t m = m0 + row; float o1[8], o2[8];
      ret_rope8(Z + m * NZ + ZC_RK + 64 * h, rcs + m * 32, rsn + m * 32, grp, 0.125f * __builtin_amdgcn_exp2f(-(float)(row + 1) * lg2), o1, o2);
#pragma unroll
      for (int j = 0; j < 8; ++j) { kT[(8 * grp + j) * 136 + row] = (bf16)f2bf(o1[j]); kT[(32 + 8 * grp + j) * 136 + row] = (bf16)f2bf(o2[j]); }
      const v4u v0 = *(const v4u*)(Z + m * NZ + ZC_RV + 64 * h + 16 * grp), v1 = *(const v4u*)(Z + m * NZ + ZC_RV + 64 * h + 16 * grp + 8);
      const unsigned vw[8] = {v0.x, v0.y, v0.z, v0.w, v1.x, v1.y, v1.z, v1.w};
#pragma unroll
      for (int j = 0; j < 8; ++j) { vT[(16 * grp + 2 * j) * 136 + row] = (bf16)(vw[j] & 0xffffu); vT[(16 * grp + 2 * j + 1) * 136 + row] = (bf16)(vw[j] >> 16); } }
    WG_SYNC();
    const int et = w & 3, dt0 = (w >> 2) * 2; f32x4 acc0 = {0.f, 0.f, 0.f, 0.f}, acc1 = {0.f, 0.f, 0.f, 0.f};
#pragma unroll
    for (int kk = 0; kk < 4; ++kk) { const bf16x8 a = frag(vT, 16 * et + r15, 136, 32 * kk + 8 * g);
        acc0 = MFMA16(a, frag(kT, 16 * dt0 + r15, 136, 32 * kk + 8 * g), acc0); acc1 = MFMA16(a, frag(kT, 16 * dt0 + 16 + r15, 136, 32 * kk + 8 * g), acc1); }
    const float gc = __builtin_amdgcn_exp2f((float)RET_C * lg2); float* dst = RST + ((size_t)((b * 4 + h) * 32 + n) * 64 + 16 * et + 4 * g) * 64 + 16 * dt0 + r15;
#pragma unroll
    for (int j = 0; j < 4; ++j) { dst[j * 64] = acc0[j] * gc; dst[j * 64 + 16] = acc1[j] * gc; }
    WG_SYNC();
}
__device__ __forceinline__ void ret_scan(float* RST, int gt) {
    if (gt >= 16 * 4096) return;
    const int bh = gt >> 12, idx = gt & 4095, h = bh & 3; const float gc = __builtin_amdgcn_exp2f((float)RET_C * ret_lg2(h)); float* p = RST + (size_t)bh * 32 * 4096 + idx; float run = 0.f;
#pragma unroll 1
    for (int n0 = 0; n0 < 32; n0 += 8) { float t[8];
#pragma unroll
        for (int i = 0; i < 8; ++i) t[i] = p[(size_t)(n0 + i) * 4096];
#pragma unroll
        for (int i = 0; i < 8; ++i) { p[(size_t)(n0 + i) * 4096] = run; run = gc * run + t[i]; } }
}
__device__ __forceinline__ void ret_pass3(int job, const bf16* Z, const float* rcs, const float* rsn, const float* RST, const float* normg, bf16* Y, LAS unsigned char* lds, int tid) {
    const int lane = tid & 63, w = __builtin_amdgcn_readfirstlane(tid >> 6), r15 = lane & 15, g = lane >> 4;
    const int h = job & 3, n = (job >> 2) & 31, b = job >> 7; const size_t m0 = (size_t)b * SEQ + (size_t)n * RET_C; const float lg2 = ret_lg2(h);
    LAS bf16* qs = (LAS bf16*)lds; LAS bf16* ks = qs + 128 * 72; LAS bf16* vT = ks + 128 * 72; LAS bf16* sT = vT + 64 * 136;
    { const int row = tid >> 2, grp = tid & 3; const size_t m = m0 + row; float o1[8], o2[8];
      ret_rope8(Z + m * NZ + ZC_RQ + 64 * h, rcs + m * 32, rsn + m * 32, grp, __builtin_amdgcn_exp2f((float)(row + 1) * lg2), o1, o2);
      *(LAS v4u*)(qs + row * 72 + 8 * grp) = pack8(o1); *(LAS v4u*)(qs + row * 72 + 32 + 8 * grp) = pack8(o2);
      ret_rope8(Z + m * NZ + ZC_RK + 64 * h, rcs + m * 32, rsn + m * 32, grp, 0.125f * __builtin_amdgcn_exp2f(-(float)(row + 1) * lg2), o1, o2);
      *(LAS v4u*)(ks + row * 72 + 8 * grp) = pack8(o1); *(LAS v4u*)(ks + row * 72 + 32 + 8 * grp) = pack8(o2);
      const v4u v0 = *(const v4u*)(Z + m * NZ + ZC_RV + 64 * h + 16 * grp), v1 = *(const v4u*)(Z + m * NZ + ZC_RV + 64 * h + 16 * grp + 8);
      const unsigned vw[8] = {v0.x, v0.y, v0.z, v0.w, v1.x, v1.y, v1.z, v1.w};
#pragma unroll
      for (int j = 0; j < 8; ++j) { vT[(16 * grp + 2 * j) * 136 + row] = (bf16)(vw[j] & 0xffffu); vT[(16 * grp + 2 * j + 1) * 136 + row] = (bf16)(vw[j] >> 16); }
      const int e = tid >> 3, d8 = (tid & 7) * 8; const float* sp = RST + ((size_t)((b * 4 + h) * 32 + n) * 64 + e) * 64 + d8; const f32x4 a0 = *(const f32x4*)sp, a1 = *(const f32x4*)(sp + 4);
      const float sv[8] = {a0[0], a0[1], a0[2], a0[3], a1[0], a1[1], a1[2], a1[3]}; *(LAS v4u*)(sT + e * 72 + d8) = pack8(sv); }
    WG_SYNC();
    bf16x8 qf[2]; qf[0] = frag(qs, 16 * w + r15, 72, 8 * g); qf[1] = frag(qs, 16 * w + r15, 72, 32 + 8 * g);
    f32x4 Dt[8];
#pragma unroll
    for (int sb = 0; sb < 8; ++sb) { f32x4 acc = {0.f, 0.f, 0.f, 0.f};
        if (sb <= w) { acc = MFMA16(frag(ks, 16 * sb + r15, 72, 8 * g), qf[0], acc); acc = MFMA16(frag(ks, 16 * sb + r15, 72, 32 + 8 * g), qf[1], acc);
            if (sb == w) {
#pragma unroll
                for (int j = 0; j < 4; ++j) if (4 * g + j > r15) acc[j] = 0.f; } }
        Dt[sb] = acc; }
    f32x4 O[4];
#pragma unroll
    for (int et = 0; et < 4; ++et) O[et] = (f32x4){0.f, 0.f, 0.f, 0.f};
#pragma unroll
    for (int k2 = 0; k2 < 4; ++k2) if (2 * k2 <= w) { const bf16x8 pb = pack_pair(Dt[2 * k2], Dt[2 * k2 + 1]);
#pragma unroll
        for (int et = 0; et < 4; ++et) O[et] = MFMA16(frag2(vT, 16 * et + r15, 136, 32 * k2 + 4 * g), pb, O[et]); }
#pragma unroll
    for (int kk = 0; kk < 2; ++kk)
#pragma unroll
        for (int et = 0; et < 4; ++et) O[et] = MFMA16(frag(sT, 16 * et + r15, 72, 32 * kk + 8 * g), qf[kk], O[et]);
    float s1 = 0.f;
#pragma unroll
    for (int et = 0; et < 4; ++et) s1 += pg8::sum4(O[et]);
    s1 += __shfl_xor(s1, 16); s1 += __shfl_xor(s1, 32); const float mean = s1 * (1.0f / 64.0f); float s2 = 0.f;
#pragma unroll
    for (int et = 0; et < 4; ++et) { O[et] = O[et] - mean; s2 += pg8::dot4(O[et]); }
    s2 += __shfl_xor(s2, 16); s2 += __shfl_xor(s2, 32); const float rstd = __builtin_amdgcn_rsqf(s2 * (1.0f / 64.0f) + 1e-6f);
    const size_t m = m0 + 16 * w + r15;
#pragma unroll
    for (int et = 0; et < 4; ++et) { const int e = 16 * et + 4 * g; const v2u gw = *(const v2u*)(Z + m * NZ + ZC_RG + 64 * h + e); const f32x4 ng = *(const f32x4*)(normg + 64 * h + e);
        v2u o; o.x = pg8::cvt_pk_bf16(O[et][0] * rstd * ng[0] * silu_fast(lo16(gw.x)), O[et][1] * rstd * ng[1] * silu_fast(hi16(gw.x)));
        o.y = pg8::cvt_pk_bf16(O[et][2] * rstd * ng[2] * silu_fast(lo16(gw.y)), O[et][3] * rstd * ng[3] * silu_fast(hi16(gw.y)));
        *(v2u*)(Y + m * 1024 + 768 + 64 * h + e) = o; }
    WG_SYNC();
}

__device__ __forceinline__ float hg_lb(const float* lblog, int l, int ch) {
    const float x0 = lblog[ch], x1 = lblog[512 + ch], x2 = lblog[1024 + ch], x3 = lblog[1536 + ch]; const float mx_ = fmaxf(fmaxf(x0, x1), fmaxf(x2, x3));
    const float e0 = __expf(x0 - mx_), e1 = __expf(x1 - mx_), e2 = __expf(x2 - mx_), e3 = __expf(x3 - mx_);
    return ((l >= 1 ? e1 : 0.f) + (l >= 2 ? e2 : 0.f) + (l >= 3 ? e3 : 0.f)) / (e0 + e1 + e2 + e3);
}
__device__ __forceinline__ void hg_gates(const bf16* Z, size_t m0, int h, int k, int seg, float lb, LAS float* tot, int half, float (&bc)[32], float (&kk)[32]) {
    const bf16* fp = Z + (m0 + 32 * seg) * NZ + ZC_HF + 128 * h + k; float cum = 0.f;
#pragma unroll
    for (int i = 0; i < 32; ++i) { const float f = bf2f(fp[(size_t)i * NZ]); const float fg = lb + (1.0f - lb) * __builtin_amdgcn_rcpf(1.0f + __builtin_amdgcn_exp2f(-1.4426950408889634f * f));
        kk[i] = 1.0f - fg; cum += __builtin_amdgcn_logf(fg) * 0.6931471805599453f; bc[i] = cum; }
    tot[(half * 2 + seg) * 128 + k] = cum;
    WG_SYNC();
    if (seg == 1) { const float o = tot[(half * 2) * 128 + k];
#pragma unroll
        for (int i = 0; i < 32; ++i) bc[i] += o; }
}
__device__ __forceinline__ void hg_stage_vT(const bf16* Z, size_t m0, int h, int u, LAS bf16* vT) {
    const int row = u >> 2, grp = u & 3; const bf16* p = Z + (m0 + row) * NZ + ZC_HI + 64 * h + 16 * grp; const v4u v0 = *(const v4u*)p, v1 = *(const v4u*)(p + 8);
    const unsigned vw[8] = {v0.x, v0.y, v0.z, v0.w, v1.x, v1.y, v1.z, v1.w};
#pragma unroll
    for (int j = 0; j < 8; ++j) { vT[(16 * grp + 2 * j) * 72 + row] = (bf16)(vw[j] & 0xffffu); vT[(16 * grp + 2 * j + 1) * 72 + row] = (bf16)(vw[j] >> 16); }
}
__device__ __forceinline__ void hg_pass1(int pair, const bf16* Z, const float* lblog, int l, float* HST, float* HDC, LAS unsigned char* lds, int tid) {
    const int lane = tid & 63, w = __builtin_amdgcn_readfirstlane(tid >> 6), r15 = lane & 15, g = lane >> 4, half = w >> 2, wq = w & 3, u = tid & 255, k = u & 127, seg = u >> 7;
    const int job = 2 * pair + half, h = job & 3, c = (job >> 2) & 63, b = job >> 8; const size_t m0 = (size_t)b * SEQ + (size_t)c * 64;
    LAS float* tot = (LAS float*)lds; LAS bf16* koT = (LAS bf16*)(lds + 2048) + half * (128 * 72 + 64 * 72); LAS bf16* vT = koT + 128 * 72;
    float bc[32], kk[32]; hg_gates(Z, m0, h, k, seg, hg_lb(lblog, l, 128 * h + k), tot, half, bc, kk);
    const float blast = tot[(half * 2) * 128 + k] + tot[(half * 2 + 1) * 128 + k];
#pragma unroll
    for (int q4 = 0; q4 < 4; ++q4) { float x[8];
#pragma unroll
        for (int j = 0; j < 8; ++j) x[j] = kk[8 * q4 + j] * __expf(blast - bc[8 * q4 + j]);
        *(LAS v4u*)(koT + k * 72 + 32 * seg + 8 * q4) = pack8(x); }
    if (seg == 0) HDC[(size_t)((b * 4 + h) * 64 + c) * 128 + k] = __expf(blast);
    hg_stage_vT(Z, m0, h, u, vT);
    WG_SYNC();
    f32x4 acc[4][2];
#pragma unroll
    for (int et = 0; et < 4; ++et) { acc[et][0] = (f32x4){0.f, 0.f, 0.f, 0.f}; acc[et][1] = (f32x4){0.f, 0.f, 0.f, 0.f}; }
#pragma unroll
    for (int k2 = 0; k2 < 2; ++k2) { const bf16x8 b0 = frag(koT, 32 * wq + r15, 72, 32 * k2 + 8 * g), b1 = frag(koT, 32 * wq + 16 + r15, 72, 32 * k2 + 8 * g);
#pragma unroll
        for (int et = 0; et < 4; ++et) { const bf16x8 a = frag(vT, 16 * et + r15, 72, 32 * k2 + 8 * g); acc[et][0] = MFMA16(a, b0, acc[et][0]); acc[et][1] = MFMA16(a, b1, acc[et][1]); } }
    float* dst = HST + (size_t)((b * 4 + h) * 64 + c) * 8192 + 32 * wq + r15;
#pragma unroll
    for (int et = 0; et < 4; ++et)
#pragma unroll
        for (int j = 0; j < 4; ++j) { dst[(16 * et + 4 * g + j) * 128] = acc[et][0][j]; dst[(16 * et + 4 * g + j) * 128 + 16] = acc[et][1][j]; }
    WG_SYNC();
}
__device__ __forceinline__ void hg_scan(float* HST, const float* HDC, int gt) {
    const int bh = gt >> 13, idx = gt & 8191, k = idx & 127; float* p = HST + (size_t)bh * 64 * 8192 + idx; const float* dp = HDC + (size_t)bh * 64 * 128 + k; float run = 0.f;
#pragma unroll 1
    for (int c0 = 0; c0 < 64; c0 += 8) { float t[8], d[8];
#pragma unroll
        for (int i = 0; i < 8; ++i) { t[i] = p[(size_t)(c0 + i) * 8192]; d[i] = dp[(c0 + i) * 128]; }
#pragma unroll
        for (int i = 0; i < 8; ++i) { p[(size_t)(c0 + i) * 8192] = run; run = d[i] * run + t[i]; } }
}
__device__ __forceinline__ void hg_pass3(int pair, const bf16* Z, const float* lblog, int l, const float* HST, const float* normg, bf16* Y, LAS unsigned char* lds, int tid) {
    const int lane = tid & 63, w = __builtin_amdgcn_readfirstlane(tid >> 6), r15 = lane & 15, g = lane >> 4, half = w >> 2, tb = w & 3, u = tid & 255, k = u & 127, seg = u >> 7;
    const int job = 2 * pair + half, h = job & 3, c = (job >> 2) & 63, b = job >> 8; const size_t m0 = (size_t)b * SEQ + (size_t)c * 64;
    LAS float* tot = (LAS float*)lds; LAS bf16* qs = (LAS bf16*)(lds + 2048) + half * (3 * 64 * 136 + 64 * 72); LAS bf16* ks = qs + 64 * 136; LAS bf16* sT = ks + 64 * 136; LAS bf16* vT = sT + 64 * 136;
    { float bc[32], kk[32]; hg_gates(Z, m0, h, k, seg, hg_lb(lblog, l, 128 * h + k), tot, half, bc, kk);
      const float bmid = tot[(half * 2) * 128 + k]; const bf16* qp = Z + (m0 + 32 * seg) * NZ + ZC_HQ + 128 * h + k;
#pragma unroll
      for (int i = 0; i < 32; ++i) { const float q = bf2f(qp[(size_t)i * NZ]); qs[(32 * seg + i) * 136 + k] = (bf16)f2bf(q * __expf(bc[i] - bmid)); ks[(32 * seg + i) * 136 + k] = (bf16)f2bf(kk[i] * __expf(bmid - bc[i])); } }
    hg_stage_vT(Z, m0, h, u, vT);
    { const int k8 = (u & 15) * 8; float em[8];
#pragma unroll
      for (int j = 0; j < 8; ++j) em[j] = __expf(tot[(half * 2) * 128 + k8 + j]);
#pragma unroll
      for (int i = 0; i < 4; ++i) { const int e = (u >> 4) + 16 * i; const float* sp = HST + (size_t)((b * 4 + h) * 64 + c) * 8192 + e * 128 + k8; const f32x4 a0 = *(const f32x4*)sp, a1 = *(const f32x4*)(sp + 4);
          const float sv[8] = {a0[0] * em[0], a0[1] * em[1], a0[2] * em[2], a0[3] * em[3], a1[0] * em[4], a1[1] * em[5], a1[2] * em[6], a1[3] * em[7]}; *(LAS v4u*)(sT + e * 136 + k8) = pack8(sv); } }
    WG_SYNC();
    bf16x8 qf[4];
#pragma unroll
    for (int kq = 0; kq < 4; ++kq) qf[kq] = frag(qs, 16 * tb + r15, 136, 32 * kq + 8 * g);
    f32x4 Dt[4];
#pragma unroll
    for (int sb = 0; sb < 4; ++sb) { f32x4 acc = {0.f, 0.f, 0.f, 0.f};
        if (sb <= tb) {
#pragma unroll
            for (int kq = 0; kq < 4; ++kq) acc = MFMA16(frag(ks, 16 * sb + r15, 136, 32 * kq + 8 * g), qf[kq], acc);
            if (sb == tb) {
#pragma unroll
                for (int j = 0; j < 4; ++j) if (4 * g + j > r15) acc[j] = 0.f; } }
        Dt[sb] = acc; }
    f32x4 O[4];
#pragma unroll
    for (int et = 0; et < 4; ++et) O[et] = (f32x4){0.f, 0.f, 0.f, 0.f};
#pragma unroll
    for (int k2 = 0; k2 < 2; ++k2) if (2 * k2 <= tb) { const bf16x8 pb = pack_pair(Dt[2 * k2], Dt[2 * k2 + 1]);
#pragma unroll
        for (int et = 0; et < 4; ++et) O[et] = MFMA16(frag2(vT, 16 * et + r15, 72, 32 * k2 + 4 * g), pb, O[et]); }
#pragma unroll
    for (int kq = 0; kq < 4; ++kq)
#pragma unroll
        for (int et = 0; et < 4; ++et) O[et] = MFMA16(frag(sT, 16 * et + r15, 136, 32 * kq + 8 * g), qf[kq], O[et]);
    float s2 = 0.f;
#pragma unroll
    for (int et = 0; et < 4; ++et) s2 += pg8::dot4(O[et]);
    s2 += __shfl_xor(s2, 16); s2 += __shfl_xor(s2, 32); const float rstd = __builtin_amdgcn_rsqf(s2 * (1.0f / 64.0f) + 1e-6f);
    const size_t m = m0 + 16 * tb + r15;
#pragma unroll
    for (int et = 0; et < 4; ++et) { const int e = 16 * et + 4 * g; const v2u gw = *(const v2u*)(Z + m * NZ + ZC_HG + 64 * h + e); const f32x4 ng = *(const f32x4*)(normg + 64 * h + e);
        v2u o; o.x = pg8::cvt_pk_bf16(O[et][0] * rstd * ng[0] * silu_fast(lo16(gw.x)), O[et][1] * rstd * ng[1] * silu_fast(hi16(gw.x)));
        o.y = pg8::cvt_pk_bf16(O[et][2] * rstd * ng[2] * silu_fast(lo16(gw.y)), O[et][3] * rstd * ng[3] * silu_fast(hi16(gw.y)));
        *(v2u*)(Y + m * 1024 + 512 + 64 * h + e) = o; }
    WG_SYNC();
}

__device__ __forceinline__ float gelu_erf(float x) { return 0.5f * x * (1.0f + erff(x * 0.70710678118654752f)); }
__device__ __forceinline__ void sg_job(int job, const bf16* Z, const float* lng, const bf16* Wsg  , const float* bs  , bf16* Y, LAS unsigned char* lds, int tid) {
    const int lane = tid & 63, w = __builtin_amdgcn_readfirstlane(tid >> 6), r15 = lane & 15, g = lane >> 4;
    const int hh = job & 1; const size_t m0 = (size_t)(job >> 1) * 128;
    LAS bf16* vT = (LAS bf16*)lds;
    { const f32x4 gv = *(const f32x4*)(lng + 4 * lane);
#pragma unroll 2
      for (int i = 0; i < 16; ++i) { const int row = 16 * w + i; const v2u zw = *(const v2u*)(Z + (m0 + row) * NZ + ZC_V + 4 * lane);
          float x0 = gelu_erf(lo16(zw.x)), x1 = gelu_erf(hi16(zw.x)), x2 = gelu_erf(lo16(zw.y)), x3 = gelu_erf(hi16(zw.y));
          const float mean = wave_sum((x0 + x1) + (x2 + x3)) * (1.0f / 256.0f); x0 -= mean; x1 -= mean; x2 -= mean; x3 -= mean;
          const float rstd = __builtin_amdgcn_rsqf(wave_sum((x0 * x0 + x1 * x1) + (x2 * x2 + x3 * x3)) * (1.0f / 256.0f) + 1e-6f);
          if ((lane >> 5) == hh) { const int dl = 4 * (lane & 31);
              vT[(dl + 0) * 136 + row] = (bf16)f2bf(x0 * rstd * gv[0]); vT[(dl + 1) * 136 + row] = (bf16)f2bf(x1 * rstd * gv[1]);
              vT[(dl + 2) * 136 + row] = (bf16)f2bf(x2 * rstd * gv[2]); vT[(dl + 3) * 136 + row] = (bf16)f2bf(x3 * rstd * gv[3]); } } }
    WG_SYNC();
    const int hl = w >> 2, tq = w & 3, h = 2 * hh + hl; const bf16* Wh = Wsg + (size_t)h * 128 * 128;
    f32x4 acc[2][4];
#pragma unroll
    for (int i = 0; i < 2; ++i)
#pragma unroll
        for (int dt = 0; dt < 4; ++dt) acc[i][dt] = (f32x4){0.f, 0.f, 0.f, 0.f};
#pragma unroll
    for (int i = 0; i < 2; ++i) { const int tb = 2 * tq + i;
#pragma unroll
        for (int kk = 0; kk < 4; ++kk) if (2 * kk <= tb) { const bf16x8 bfr = *(const bf16x8*)(Wh + (size_t)(16 * tb + r15) * 128 + 32 * kk + 8 * g);
#pragma unroll
            for (int dt = 0; dt < 4; ++dt) acc[i][dt] = MFMA16(frag(vT, 64 * hl + 16 * dt + r15, 136, 32 * kk + 8 * g), bfr, acc[i][dt]); } }
#pragma unroll
    for (int i = 0; i < 2; ++i) { const int t = 16 * (2 * tq + i) + r15; const size_t m = m0 + t; const float bias = bs[h * 128 + t];
#pragma unroll
        for (int dt = 0; dt < 4; ++dt) { const int d = 128 * hh + 64 * hl + 16 * dt + 4 * g; const v2u uw = *(const v2u*)(Z + m * NZ + ZC_U + d);
            v2u o; o.x = pg8::cvt_pk_bf16(gelu_erf(lo16(uw.x)) * (acc[i][dt][0] + bias), gelu_erf(hi16(uw.x)) * (acc[i][dt][1] + bias));
            o.y = pg8::cvt_pk_bf16(gelu_erf(lo16(uw.y)) * (acc[i][dt][2] + bias), gelu_erf(hi16(uw.y)) * (acc[i][dt][3] + bias));
            *(v2u*)(Y + m * 1024 + 256 + d) = o; } }
    WG_SYNC();
}

__device__ __forceinline__ void mla_qblock(int b, int h, int qb, const bf16* QKV, bf16* Y, LAS unsigned char* lds, int tid) {
    const int lane = tid & 63, w = __builtin_amdgcn_readfirstlane(tid >> 6), r15 = lane & 15, g = lane >> 4;
    LAS bf16* Kb = (LAS bf16*)lds; LAS bf16* Vt = Kb + 2 * 64 * 104;
    const size_t mb = (size_t)b * SEQ; const int t_row = 128 * qb + 16 * w + r15;
    const int ntile = 2 * (qb + 1);
    bf16x8 qf[3];
#pragma unroll
    for (int kk = 0; kk < 3; ++kk) qf[kk] = *(const bf16x8*)(QKV + (mb + t_row) * 1024 + QC_Q + 96 * h + 32 * kk + 8 * g);
    const int srow = tid >> 3, spc = tid & 7, rrow = (tid >> 2) & 63, rpc = tid & 3;
    v4u ldk, ldr, ldv;
#define MLA_LOAD(kt) do { const bf16* kp = QKV + (mb + 64 * (kt) + srow) * 1024; ldk = *(const v4u*)(kp + QC_KN + 64 * h + 8 * spc); ldv = *(const v4u*)(kp + QC_V + 64 * h + 8 * spc); \
        if (tid < 256) ldr = *(const v4u*)(QKV + (mb + 64 * (kt) + rrow) * 1024 + QC_KR + 8 * rpc); } while (0)
#define MLA_STORE(buf) do { LAS bf16* kd = Kb + (buf) * 64 * 104; LAS bf16* vd = Vt + (buf) * 64 * 72; *(LAS v4u*)(kd + srow * 104 + 8 * spc) = ldk; if (tid < 256) *(LAS v4u*)(kd + rrow * 104 + 64 + 8 * rpc) = ldr; \
        const unsigned vw_[4] = {ldv.x, ldv.y, ldv.z, ldv.w}; _Pragma("unroll") for (int j_ = 0; j_ < 4; ++j_) { vd[(8 * spc + 2 * j_) * 72 + srow] = (bf16)(vw_[j_] & 0xffffu); vd[(8 * spc + 2 * j_ + 1) * 72 + srow] = (bf16)(vw_[j_] >> 16); } } while (0)
    MLA_LOAD(0); MLA_STORE(0); WG_SYNC();
    float m_run = -INFINITY, l_run = 0.f; f32x4 O[4];
#pragma unroll
    for (int et = 0; et < 4; ++et) O[et] = (f32x4){0.f, 0.f, 0.f, 0.f};
    const int t_lo = 128 * qb + 16 * w;
    for (int kt = 0; kt < ntile; ++kt) {
        if (kt + 1 < ntile) MLA_LOAD(kt + 1);
        if (64 * kt <= t_lo + 15) {
            lcp kb = Kb + (kt & 1) * 64 * 104; lcp vb = Vt + (kt & 1) * 64 * 72;
            f32x4 S[4];
#pragma unroll
            for (int sb = 0; sb < 4; ++sb) { f32x4 acc = {0.f, 0.f, 0.f, 0.f};
#pragma unroll
                for (int kk = 0; kk < 3; ++kk) acc = MFMA16(frag(kb, 16 * sb + r15, 104, 32 * kk + 8 * g), qf[kk], acc);
                S[sb] = acc; }
            if (64 * kt + 63 > t_lo) {
#pragma unroll
                for (int sb = 0; sb < 4; ++sb)
#pragma unroll
                    for (int j = 0; j < 4; ++j) if (64 * kt + 16 * sb + 4 * g + j > t_row) S[sb][j] = -INFINITY; }
            float mx_ = fmaxf(fmaxf(fmaxf(S[0][0], S[0][1]), fmaxf(S[0][2], S[0][3])), fmaxf(fmaxf(S[1][0], S[1][1]), fmaxf(S[1][2], S[1][3])));
            mx_ = fmaxf(mx_, fmaxf(fmaxf(fmaxf(S[2][0], S[2][1]), fmaxf(S[2][2], S[2][3])), fmaxf(fmaxf(S[3][0], S[3][1]), fmaxf(S[3][2], S[3][3]))));
            mx_ = fmaxf(mx_, __shfl_xor(mx_, 16)); mx_ = fmaxf(mx_, __shfl_xor(mx_, 32));
            const float m_new = fmaxf(m_run, mx_), corr = __builtin_amdgcn_exp2f(m_run - m_new); m_run = m_new; float ps = 0.f;
#pragma unroll
            for (int sb = 0; sb < 4; ++sb)
#pragma unroll
                for (int j = 0; j < 4; ++j) { const float p = __builtin_amdgcn_exp2f(S[sb][j] - m_new); S[sb][j] = p; ps += p; }
            l_run = l_run * corr + ps;
#pragma unroll
            for (int et = 0; et < 4; ++et) O[et] = O[et] * corr;
#pragma unroll
            for (int k2 = 0; k2 < 2; ++k2) { const bf16x8 pb = pack_pair(S[2 * k2], S[2 * k2 + 1]);
#pragma unroll
                for (int et = 0; et < 4; ++et) O[et] = MFMA16(frag2(vb, 16 * et + r15, 72, 32 * k2 + 4 * g), pb, O[et]); }
        }
        if (kt + 1 < ntile) MLA_STORE((kt + 1) & 1);
        WG_SYNC();
    }
#undef MLA_LOAD
#undef MLA_STORE
    l_run += __shfl_xor(l_run, 16); l_run += __shfl_xor(l_run, 32); const float inv = 1.0f / l_run;
#pragma unroll
    for (int et = 0; et < 4; ++et) { v2u o; o.x = pg8::cvt_pk_bf16(O[et][0] * inv, O[et][1] * inv); o.y = pg8::cvt_pk_bf16(O[et][2] * inv, O[et][3] * inv);
        *(v2u*)(Y + (mb + t_row) * 1024 + 64 * h + 16 * et + 4 * g) = o; }
}
}

#define V_WGU ((bf16*)(ws + WS_WGU))
#define V_WD ((bf16*)(ws + WS_WD))
#define V_WIN ((bf16*)(ws + WS_WIN))
#define V_WMLA ((bf16*)(ws + WS_WMLA))
#define V_WOUT ((bf16*)(ws + WS_WOUT))
#define V_WPG ((bf16*)(ws + WS_WPG))
#define V_WPP ((bf16*)(ws + WS_WPP))
#define V_B0 ((bf16*)(ws + WS_B0))
#define V_B1 ((bf16*)(ws + WS_B1))
#define V_ZH ((bf16*)(ws + WS_ZH))
#define V_QKV ((bf16*)(ws + WS_QKV))
#define V_PBF ((bf16*)(ws + WS_PBF))
#define V_SSQ0 ((float*)(ws + WS_SSQ))
#define V_SSQ1 ((float*)(ws + WS_SSQ) + (size_t)M * 16)
#define V_SSQQ ((float*)(ws + WS_SSQ2))
#define V_SSQKV ((float*)(ws + WS_SSQ2) + (size_t)M * 4)
#define V_MCS ((float*)(ws + WS_ROPE))
#define V_MSN ((float*)(ws + WS_ROPE) + (size_t)M * 16)
#define V_RCS ((float*)(ws + WS_ROPE) + (size_t)M * 32)
#define V_RSN ((float*)(ws + WS_ROPE) + (size_t)M * 64)
#define V_HST ((float*)(ws + WS_HST))
#define V_HDC ((float*)(ws + WS_HDC))
#define V_RST ((float*)(ws + WS_RST))
#ifndef MIX_RET
#define MIX_RET 1
#endif
#ifndef MIX_HG
#define MIX_HG 1
#endif
#ifndef MIX_SG
#define MIX_SG 1
#endif
#ifndef MIX_MLA
#define MIX_MLA 1
#endif
__global__ void __launch_bounds__(NWAVES * 64, 2) mk_fwd(Args a) {
    extern __shared__ __attribute__((aligned(16))) unsigned char lds_raw[];
    LAS unsigned char* lds = (LAS unsigned char*)lds_raw;
    volatile LAS unsigned* MISC = (volatile LAS unsigned*)(lds + MISC_OFF);
    const int tid = threadIdx.x, lane = tid & 63, wave = __builtin_amdgcn_readfirstlane(tid >> 6);
    const int G = gridDim.x; const int bx = blockIdx.x; const int vcu = (G % 8 == 0) ? (bx % 8) * (G / 8) + bx / 8 : bx;
    unsigned char* ws = a.ws;
    gu32* ctl = (gu32*)(ws + WS_CTL);
    for (int u = tid; u < (LDS_BYTES - LDSCTL_OFF) / 4; u += NWAVES * 64) ((LAS unsigned*)(lds + LDSCTL_OFF))[u] = 0u;
    __syncthreads();
    XcdBarrier bar = xcd_barrier_post((unsigned*)(ctl + CW_BAR) + a.li * XCD_BAR_WORDS, MISC + 8);
    const int lo = a.ph_lo, hi = a.ph_hi;
#define IN(k) (lo <= (k) && (k) < hi)
#define SEAM(k) do { if (IN(k) && IN((k) + 1)) xcd_barrier(bar); } while (0)
    float* out = a.out;

    if (IN(0)) { prologue(a, lds, tid, lane, wave, vcu, G); }
    SEAM(0);

    for (int hl = 0; hl < 2 * DEPTH; ++hl) {
        const int l = hl >> 1, second = hl & 1, pb = 1 + 10 * l + 7 * second;
        int tid_o = tid; asm volatile("" : "+v"(tid_o));
        if (IN(pb)) {
            pg8::Gemm g{(second == 0 && l > 0) ? V_B1 : V_B0, V_WGU + (size_t)(2 * l + second) * NGU * D, M, NGU, D, D}; pg8::StaticOrder S; S.init(M, NGU, G, bx);
            pg8::EpiSwiGLU E{V_ZH, V_SSQ0};
            pg8::gemm_phase<pg8::EpiSwiGLU, pg8::StaticOrder, true, true>(lds + RING_OFF, g, S, E);
        }
        SEAM(pb);
        if (IN(pb + 1)) {
            pg8::Gemm g{V_ZH, V_WD + (size_t)(2 * l + second) * D * DFF, M, D, DFF, DFF}; pg8::StaticOrder S; S.init(M, D, G, bx);
            pg8::EpiRes E{(hl == 0) ? a.in[IN_X] : (const float*)out, out, V_B0, V_SSQ1, 0.5f};
            pg8::gemm_phase<pg8::EpiRes, pg8::StaticOrder, false, true>(lds + RING_OFF, g, S, E);
        }
        SEAM(pb + 1);
        if (!second) {
            if (IN(pb + 2)) {
                pg8::Gemm g{V_B0, V_WIN + (size_t)l * NZ * D, M, NZ, D, D}; pg8::StaticOrder S; S.init(M, NZ, G, bx);
                pg8::EpiZ E{V_ZH, V_SSQ1, V_SSQQ, V_SSQKV};
                pg8::gemm_phase<pg8::EpiZ, pg8::StaticOrder, true, true>(lds + RING_OFF, g, S, E);
                const f32x4* ps = (const f32x4*)(a.in[IN_P] + (size_t)l * M * PLED); v2u* pd = (v2u*)V_PBF;
                for (int i = bx * (NWAVES * 64) + tid_o; i < M * PLED / 4; i += G * NWAVES * 64) { const f32x4 v = ps[i]; v2u o; o.x = pk2(v[0], v[1]); o.y = pk2(v[2], v[3]); pd[i] = o; }
            }
            SEAM(pb + 2);
            if (IN(pb + 3)) {
                pg8::Gemm g{V_ZH, V_WMLA + (size_t)l * 1024 * 512, M, 1024, 512, NZ}; pg8::StaticOrder S; S.init(M, 1024, G, bx);
                pg8::EpiMla E{V_QKV, V_SSQQ, V_SSQKV, V_MCS, V_MSN};
                pg8::gemm_phase<pg8::EpiMla, pg8::StaticOrder, false, true>(lds + RING_OFF, g, S, E);
#if MIX_RET
                for (int j = bx; j < 512; j += G) mx::ret_pass1(j, V_ZH, V_RCS, V_RSN, V_RST, lds + RING_OFF, tid_o);
#endif
#if MIX_HG
                for (int pr = bx; pr < 512; pr += G) mx::hg_pass1(pr, V_ZH, a.in[IN_HGLB], l, V_HST, V_HDC, lds + RING_OFF, tid_o);
#endif
#if MIX_SG
                for (int j = bx; j < 256; j += G) mx::sg_job(j, V_ZH, a.in[IN_SGLN] + l * 256, (const bf16*)(ws + WS_WSG) + (size_t)l * 4 * 128 * 128, a.in[IN_SGB] + l * 512, V_B1, lds + RING_OFF, tid_o);
#endif
            }
            SEAM(pb + 3);
            if (IN(pb + 4)) {
#if MIX_RET
                for (int gt = bx * (NWAVES * 64) + tid_o; gt < 16 * 4096; gt += G * NWAVES * 64) mx::ret_scan(V_RST, gt);
#endif
#if MIX_HG
                for (int gt = bx * (NWAVES * 64) + tid_o; gt < 16 * 8192; gt += G * NWAVES * 64) mx::hg_scan(V_HST, V_HDC, gt);
#endif
            }
            SEAM(pb + 4);
            if (IN(pb + 5)) {
#if MIX_RET
                for (int j = bx; j < 512; j += G) mx::ret_pass3(j, V_ZH, V_RCS, V_RSN, V_RST, a.in[IN_RETN] + l * 256, V_B1, lds + RING_OFF, tid_o);
#endif
#if MIX_HG
                for (int pr = bx; pr < 512; pr += G) mx::hg_pass3(pr, V_ZH, a.in[IN_HGLB], l, V_HST, a.in[IN_HGN] + l * 256, V_B1, lds + RING_OFF, tid_o);
#endif
#if MIX_MLA
                for (int j = bx; j < 256; j += G) { const int bh = j >> 4, sq = j & 15;
                    mx::mla_qblock(bh >> 2, bh & 3, 31 - sq, V_QKV, V_B1, lds + RING_OFF, tid_o); mx::mla_qblock(bh >> 2, bh & 3, sq, V_QKV, V_B1, lds + RING_OFF, tid_o); }
#endif
            }
            SEAM(pb + 5);
            if (IN(pb + 6)) {
                { pg8::Gemm g{V_B1, V_WOUT + (size_t)l * D * D, M, D, D, D}; pg8::StaticOrder S; S.init(M, D, G, bx);
                  pg8::EpiRes E{out, out, V_B0, V_SSQ0, 1.0f};
                  pg8::gemm_phase<pg8::EpiRes, pg8::StaticOrder, false, true>(lds + RING_OFF, g, S, E); }
                { pg8::Gemm g{V_PBF, V_WPP + (size_t)l * D * PLED, M, D, PLED, PLED}; pg8::StaticOrder S; S.init(M, D, G, bx);
                  pg8::EpiPlain E{V_QKV, D};
                  pg8::gemm_phase<pg8::EpiPlain, pg8::StaticOrder, false, true>(lds + RING_OFF, g, S, E); }
            }
            SEAM(pb + 6);
        } else {
            if (IN(pb + 2)) {
                pg8::Gemm g{V_B0, V_WPG + (size_t)l * D * D, M, D, D, D}; pg8::StaticOrder S; S.init(M, D, G, bx);
                pg8::EpiPle E{out, V_QKV, V_B1, V_SSQ1, V_SSQ0};
                pg8::gemm_phase<pg8::EpiPle, pg8::StaticOrder, false, true>(lds + RING_OFF, g, S, E);
            }
            SEAM(pb + 2);
        }
    }
    if (IN(41)) {
        const float* gfin = a.in[IN_FINN];
        for (int m = vcu * NWAVES + wave; m < M; m += G * NWAVES) { f32x4* hr = (f32x4*)(out + (size_t)m * D) + lane; const float r = pg8::row_rstd(V_SSQ0, m);
#pragma unroll
            for (int j = 0; j < 4; ++j) { const f32x4 v = hr[64 * j]; const f32x4 gv = *((const f32x4*)gfin + lane + 64 * j); hr[64 * j] = v * r * gv; } }
    }
#undef IN
#undef SEAM
}

#ifndef MK_MODE
#define MK_MODE 0
#endif
#if MK_MODE != 0
__device__ __forceinline__ float gelu_exact(float x) { return 0.5f * x * (1.0f + erff(x * 0.70710678118654752f)); }
__device__ __forceinline__ float silu_f(float x) { return x / (1.0f + __expf(-x)); }
__global__ void __launch_bounds__(256) nv_mla(const bf16* QKV, bf16* Y) {
    const int lane = threadIdx.x & 63, gw = blockIdx.x * 4 + (threadIdx.x >> 6); const int t = gw & (SEQ - 1), bh = gw >> 12, b = bh >> 2, h = bh & 3;
    const size_t m = (size_t)b * SEQ + t;
    float q[96];
#pragma unroll
    for (int d = 0; d < 96; ++d) q[d] = bf2f(QKV[m * 1024 + QC_Q + 96 * h + d]);
    float mi = -INFINITY, li = 0.f, acc[64];
#pragma unroll
    for (int e = 0; e < 64; ++e) acc[e] = 0.f;
    for (int s = lane; s <= t; s += 64) { const bf16* kr = QKV + ((size_t)b * SEQ + s) * 1024; float dot = 0.f;
#pragma unroll
        for (int d = 0; d < 64; ++d) dot += q[d] * bf2f(kr[QC_KN + 64 * h + d]);
#pragma unroll
        for (int d = 0; d < 32; ++d) dot += q[64 + d] * bf2f(kr[QC_KR + d]);
        const float mn = fmaxf(mi, dot), corr = exp2f(mi - mn), p = exp2f(dot - mn); li = li * corr + p; mi = mn;
#pragma unroll
        for (int e = 0; e < 64; ++e) acc[e] = acc[e] * corr + p * bf2f(kr[QC_V + 64 * h + e]); }
    const float mg = wave_max(mi), w = (mi == -INFINITY) ? 0.f : exp2f(mi - mg); const float L = wave_sum(li * w); float res = 0.f;
#pragma unroll
    for (int e = 0; e < 64; ++e) { const float v = wave_sum(acc[e] * w); if (lane == e) res = v; }
    Y[m * 1024 + 64 * h + lane] = (bf16)f2bf(res / L);
}
__global__ void __launch_bounds__(256) nv_ret_prep(const bf16* Z, const float* rcs, const float* rsn, float* QR, float* KR) {
    const int i = blockIdx.x * 256 + threadIdx.x; if (i >= M * 128) return; const int m = i >> 7, r = i & 127, h = r >> 5, j = r & 31;
    const float c = rcs[(size_t)m * 32 + j], s = rsn[(size_t)m * 32 + j];
    { const float x1 = bf2f(Z[(size_t)m * NZ + ZC_RQ + 64 * h + j]), x2 = bf2f(Z[(size_t)m * NZ + ZC_RQ + 64 * h + 32 + j]); QR[(size_t)m * 256 + 64 * h + j] = x1 * c - x2 * s; QR[(size_t)m * 256 + 64 * h + 32 + j] = x1 * s + x2 * c; }
    { const float x1 = bf2f(Z[(size_t)m * NZ + ZC_RK + 64 * h + j]), x2 = bf2f(Z[(size_t)m * NZ + ZC_RK + 64 * h + 32 + j]); KR[(size_t)m * 256 + 64 * h + j] = 0.125f * (x1 * c - x2 * s); KR[(size_t)m * 256 + 64 * h + 32 + j] = 0.125f * (x1 * s + x2 * c); }
}
__global__ void __launch_bounds__(256) nv_ret(const bf16* Z, const float* QR, const float* KR, const float* normg, bf16* Y) {
    const int lane = threadIdx.x & 63, gw = blockIdx.x * 4 + (threadIdx.x >> 6); const int t = gw & (SEQ - 1), bh = gw >> 12, b = bh >> 2, h = bh & 3;
    const size_t m = (size_t)b * SEQ + t; const float lg2 = log2f(1.0f - exp2f(-(5.0f + (float)h)));
    float q[64], acc[64];
#pragma unroll
    for (int d = 0; d < 64; ++d) { q[d] = QR[m * 256 + 64 * h + d]; acc[d] = 0.f; }
    for (int s = lane; s <= t; s += 64) { const size_t ms = (size_t)b * SEQ + s; float dot = 0.f;
#pragma unroll
        for (int d = 0; d < 64; ++d) dot += q[d] * KR[ms * 256 + 64 * h + d];
        const float p = dot * exp2f((float)(t - s) * lg2);
#pragma unroll
        for (int e = 0; e < 64; ++e) acc[e] += p * bf2f(Z[ms * NZ + ZC_RV + 64 * h + e]); }
    float o = 0.f;
#pragma unroll
    for (int e = 0; e < 64; ++e) { const float v = wave_sum(acc[e]); if (lane == e) o = v; }
    const float mean = wave_sum(o) * (1.0f / 64.0f), oc = o - mean, var = wave_sum(oc * oc) * (1.0f / 64.0f);
    const float gate = silu_f(bf2f(Z[m * NZ + ZC_RG + 64 * h + lane]));
    Y[m * 1024 + 768 + 64 * h + lane] = (bf16)f2bf(oc * rsqrtf(var + 1e-6f) * normg[64 * h + lane] * gate);
}
__global__ void __launch_bounds__(64) nv_hgrn(const bf16* Z, const float* lblog, int l, const float* normg, bf16* Y) {
    __shared__ float sq[128], sf[128], sk[128];
    const int lane = threadIdx.x, bh = blockIdx.x, b = bh >> 2, h = bh & 3;
    float lb[2];
#pragma unroll
    for (int c = 0; c < 2; ++c) { const int ch = 128 * h + lane + 64 * c; const float x0 = lblog[ch], x1 = lblog[512 + ch], x2 = lblog[1024 + ch], x3 = lblog[1536 + ch];
        const float mx = fmaxf(fmaxf(x0, x1), fmaxf(x2, x3)); const float e0 = __expf(x0 - mx), e1 = __expf(x1 - mx), e2 = __expf(x2 - mx), e3 = __expf(x3 - mx); const float inv = 1.0f / (e0 + e1 + e2 + e3);
        lb[c] = (l >= 1 ? e1 : 0.f) * inv + (l >= 2 ? e2 : 0.f) * inv + (l >= 3 ? e3 : 0.f) * inv; }
    float S[128];
#pragma unroll
    for (int k = 0; k < 128; ++k) S[k] = 0.f;
    const float ng = normg[64 * h + lane];
    for (int t = 0; t < SEQ; ++t) { const size_t m = (size_t)b * SEQ + t; const bf16* zr = Z + m * NZ;
        __syncthreads();
#pragma unroll
        for (int c = 0; c < 2; ++c) { const int k = lane + 64 * c; const float f = bf2f(zr[ZC_HF + 128 * h + k]); const float fg = lb[c] + (1.0f - lb[c]) / (1.0f + __expf(-f));
            sq[k] = bf2f(zr[ZC_HQ + 128 * h + k]); sf[k] = fg; sk[k] = 1.0f - fg; }
        __syncthreads();
        const float v = bf2f(zr[ZC_HI + 64 * h + lane]); float o = 0.f;
#pragma unroll
        for (int k = 0; k < 128; ++k) { S[k] = sf[k] * S[k] + sk[k] * v; o += sq[k] * S[k]; }
        const float ms = wave_sum(o * o) * (1.0f / 64.0f); const float gate = silu_f(bf2f(zr[ZC_HG + 64 * h + lane]));
        Y[m * 1024 + 512 + 64 * h + lane] = (bf16)f2bf(o * rsqrtf(ms + 1e-6f) * ng * gate); }
}
__global__ void __launch_bounds__(256) nv_sg_prep(const bf16* Z, const float* lng, bf16* V) {
    const int lane = threadIdx.x & 63, m = blockIdx.x * 4 + (threadIdx.x >> 6); float x[4]; float s = 0.f;
#pragma unroll
    for (int j = 0; j < 4; ++j) { x[j] = gelu_exact(bf2f(Z[(size_t)m * NZ + ZC_V + lane + 64 * j])); s += x[j]; }
    const float mean = wave_sum(s) * (1.0f / 256.0f); float q = 0.f;
#pragma unroll
    for (int j = 0; j < 4; ++j) { x[j] -= mean; q += x[j] * x[j]; }
    const float rstd = rsqrtf(wave_sum(q) * (1.0f / 256.0f) + 1e-6f);
#pragma unroll
    for (int j = 0; j < 4; ++j) V[(size_t)m * 256 + lane + 64 * j] = (bf16)f2bf(x[j] * rstd * lng[lane + 64 * j]);
}
__global__ void __launch_bounds__(256) nv_sg(const bf16* Z, const bf16* V, const float* w, const float* bs, bf16* Y) {
    const int d = threadIdx.x, m = blockIdx.x, t = m & 127, h = d >> 6; const size_t m0 = (size_t)(m - t);
    float acc = bs[h * 128 + t]; const float* wr = w + ((size_t)h * 128 + t) * 128;
    for (int s = 0; s <= t; ++s) acc += wr[s] * bf2f(V[(m0 + s) * 256 + d]);
    Y[(size_t)m * 1024 + 256 + d] = (bf16)f2bf(gelu_exact(bf2f(Z[(size_t)m * NZ + ZC_U + d])) * acc);
}
#endif

extern "C" void kernel_launch(void* const* d_in, const int* in_sizes, int n_in, void* d_out, int out_size, void* d_ws, size_t ws_size, hipStream_t stream) {
    static int grid = 0;
    if (grid == 0) {
        if (n_in != N_IN || in_sizes[0] != M * D || out_size != M * D || ws_size < WS_END) { fprintf(stderr, "kernel_launch: unexpected shapes (n_in %d, in0 %d, out %d, ws %zu < %zu?)\n", n_in, n_in > 0 ? in_sizes[0] : -1, out_size, ws_size, (size_t)WS_END); grid = -1; return; }
        int dev = 0, cus = 0, per_cu = 0;
        if (hipGetDevice(&dev) != hipSuccess || hipDeviceGetAttribute(&cus, hipDeviceAttributeMultiprocessorCount, dev) != hipSuccess) { grid = -1; return; }
        if (hipFuncSetAttribute((const void*)mk_fwd, hipFuncAttributeMaxDynamicSharedMemorySize, LDS_BYTES) != hipSuccess) { fprintf(stderr, "kernel_launch: hipFuncSetAttribute failed\n"); grid = -1; return; }
        if (hipOccupancyMaxActiveBlocksPerMultiprocessor(&per_cu, (const void*)mk_fwd, NWAVES * 64, LDS_BYTES) != hipSuccess || per_cu < 1) { fprintf(stderr, "kernel_launch: occupancy query says %d\n", per_cu); }
        (void)hipGetLastError();
        grid = cus;
    }
    if (grid < 0) return;
    if (hipMemsetAsync((char*)d_ws + WS_CTL, 0, CTL_ZERO_BYTES, stream) != hipSuccess) return;
    Args a{};
    for (int i = 0; i < N_IN; ++i) a.in[i] = (const float*)d_in[i];
    a.out = (float*)d_out; a.ws = (unsigned char*)d_ws;
    auto launch = [&](int lo, int hi, int li) { a.ph_lo = lo; a.ph_hi = hi; a.li = li; hipLaunchKernelGGL(mk_fwd, dim3(grid), dim3(NWAVES * 64), LDS_BYTES, stream, a); };
#if MK_MODE == 0
    launch(0, N_PHASES, 0);
#else
    unsigned char* ws = (unsigned char*)d_ws;
    const bf16* Z = (const bf16*)(ws + WS_ZH); const bf16* QKV = (const bf16*)(ws + WS_QKV); bf16* Y = (bf16*)(ws + WS_B1);
    float* QR = (float*)(ws + WS_HST); float* KR = QR + (size_t)M * 256; bf16* V = (bf16*)(ws + WS_RST);
    const float* rcs = (const float*)(ws + WS_ROPE) + (size_t)M * 32; const float* rsn = rcs + (size_t)M * 32;
    int li = 0, lo = 0;
    for (int l = 0; l < DEPTH; ++l) {
        launch(lo, 1 + 10 * l + 3, li++);
#if !MIX_RET
        hipLaunchKernelGGL(nv_ret_prep, dim3(M * 128 / 256), dim3(256), 0, stream, Z, rcs, rsn, QR, KR);
        hipLaunchKernelGGL(nv_ret, dim3(M), dim3(256), 0, stream, Z, (const float*)QR, (const float*)KR, (const float*)d_in[IN_RETN] + l * 256, Y);
#endif
#if !MIX_HG
        hipLaunchKernelGGL(nv_hgrn, dim3(16), dim3(64), 0, stream, Z, (const float*)d_in[IN_HGLB], l, (const float*)d_in[IN_HGN] + l * 256, Y);
#endif
#if !MIX_SG
        hipLaunchKernelGGL(nv_sg_prep, dim3(M / 4), dim3(256), 0, stream, Z, (const float*)d_in[IN_SGLN] + l * 256, V);
        hipLaunchKernelGGL(nv_sg, dim3(M), dim3(256), 0, stream, Z, (const bf16*)V, (const float*)d_in[IN_SGW] + (size_t)l * 4 * 128 * 128, (const float*)d_in[IN_SGB] + l * 512, Y);
#endif
        launch(1 + 10 * l + 3, 1 + 10 * l + 6, li++);
#if !MIX_MLA
        hipLaunchKernelGGL(nv_mla, dim3(M), dim3(256), 0, stream, QKV, Y);
#endif
        lo = 1 + 10 * l + 6;
    }
    launch(lo, N_PHASES, li++);
#endif
}
```

```cpp
#include <hip/hip_runtime.h>
#include <cstdio>
#include <cstdint>
#include <cmath>
namespace pg8 {
#define PG8_LAS __attribute__((address_space(3)))
typedef unsigned short bf16_t;
typedef short bf16x8 __attribute__((ext_vector_type(8)));
typedef float f32x4 __attribute__((ext_vector_type(4)));
typedef unsigned u32x4 __attribute__((ext_vector_type(4)));
constexpr int BM = 256, BK = 64, HALF = 128, HTB = HALF * BK * 2  , STAGE_BYTES = 8 * HTB, NXCD = 8, WGM = 8;

__host__ __device__ __forceinline__ int lds_byte(int r, int c) { const int st = (r >> 4) * 2 + (c >> 5), rr = r & 15, cc = c & 31, ob = rr * 64 + cc * 2; return st * 1024 + (ob ^ (((ob >> 9) & 1) << 5)); }
__host__ __device__ __forceinline__ void stage_rc(int b, int& R, int& C) { const int st = b / 1024, sb = b % 1024, swz = sb ^ (((sb >> 9) & 1) << 5); R = (st >> 1) * 16 + swz / 64; C = (st & 1) * 32 + (swz % 64) / 2; }
__host__ __device__ __forceinline__ int perm32(int rho) { const int n = rho >> 4, i = rho & 15; return 8 * (i >> 2) + 4 * n + (i & 3); }

struct Unit { int pm, pn; };
struct Gemm { const bf16_t* A; const bf16_t* Bt; int M, N, K, lda; };

struct StaticOrder {
    int nM, nN, nwg, G, c;
    __host__ __device__ void init(int M, int N, int G_, int c_) { nM = M / BM; nN = N / BM; nwg = nM * nN; G = G_; c = c_; }
    __host__ __device__ bool next(int i, Unit& u) const {
        const long L = (long)i * G + c; if (L >= nwg) return false;
        int wgid = (int)L; { const int q = nwg / NXCD, r = nwg % NXCD, xcd = wgid % NXCD, off = wgid / NXCD; wgid = (xcd < r ? xcd * (q + 1) : r * (q + 1) + (xcd - r) * q) + off; }
        const int nig = WGM * nN, gid = wgid / nig, fm = gid * WGM, gsz = (nM - fm) < WGM ? (nM - fm) : WGM;
        u.pm = fm + ((wgid % nig) % gsz); u.pn = (wgid % nig) / gsz; return true;
    }
    __device__ __forceinline__ void a_ready(const Unit&) const {}
    __device__ __forceinline__ void done(const Unit&) const {}
};

__device__ __forceinline__ unsigned cvt_pk_bf16(float lo, float hi) { unsigned r; asm volatile("v_cvt_pk_bf16_f32 %0, %1, %2" : "=v"(r) : "v"(lo), "v"(hi)); return r; }
typedef unsigned u32x2 __attribute__((ext_vector_type(2)));
typedef float f32x2 __attribute__((ext_vector_type(2)));
constexpr float RMS_EPS = 1e-6f, LOG2E = 1.4426950408889634f;
constexpr int DM = 1024, DFF_ = 2816, NZ_ = 3584;
__device__ __forceinline__ float sum4(const f32x4 a) { return (a[0] + a[1]) + (a[2] + a[3]); }
__device__ __forceinline__ float dot4(const f32x4 a) { return (a[0] * a[0] + a[1] * a[1]) + (a[2] * a[2] + a[3] * a[3]); }
__device__ __forceinline__ float row_rstd(const float* ssq, int row) {
    const f32x4* p = (const f32x4*)(ssq + (size_t)row * 16);
    const float s = (sum4(p[0]) + sum4(p[1])) + (sum4(p[2]) + sum4(p[3]));
    return __builtin_amdgcn_rsqf(s * (1.0f / 1024.0f) + RMS_EPS);
}
__device__ __forceinline__ float xlane(float v, int lane, int mask) { return __builtin_bit_cast(float, __builtin_amdgcn_ds_bpermute((lane ^ mask) << 2, __builtin_bit_cast(int, v))); }
__device__ __forceinline__ float fq_sum(float s, int lane) { s += xlane(s, lane, 16); s += xlane(s, lane, 32); return s; }
__device__ __forceinline__ void rows_rstd8(const float* ssq, int row0, int fq, int lane, float (&r)[8]) {
    f32x4 p[8];
#pragma unroll
    for (int i = 0; i < 8; ++i) p[i] = *(const f32x4*)(ssq + (size_t)(row0 + (i >> 2) * HALF + (i & 3) * 16) * 16 + 4 * fq);
#pragma unroll
    for (int i = 0; i < 8; ++i) { const float s = fq_sum(sum4(p[i]), lane); r[i] = __builtin_amdgcn_rsqf(s * (1.0f / 1024.0f) + RMS_EPS); }
}
__device__ __forceinline__ void build_rstd_tab(PG8_LAS float* tab, const float* ssq, int pm, int tid) {
    const int row = tid >> 1, hf = tid & 1; const f32x4* p = (const f32x4*)(ssq + (size_t)(pm * BM + row) * 16 + 8 * hf);
    float s = sum4(p[0]) + sum4(p[1]);
    s += __builtin_bit_cast(float, __builtin_amdgcn_update_dpp(0, __builtin_bit_cast(int, s), 0xB1, 0xF, 0xF, false));
    if (hf == 0) tab[row] = __builtin_amdgcn_rsqf(s * (1.0f / 1024.0f) + RMS_EPS);
}
__device__ __forceinline__ float sigmoid_f(float x) { return __builtin_amdgcn_rcpf(1.0f + __builtin_amdgcn_exp2f(-LOG2E * x)); }

struct EpiSwiGLU {
    static constexpr bool PERM = true, AFTER_DRAIN = false;
    bf16_t* O; const PG8_LAS float* tab;
    __device__ __forceinline__ void operator()(const f32x4 (&acc)[2][2][4][2], const Unit& u, int wr, int wc, int fr, int fq) const {
        const int row0 = u.pm * BM + wr * 64 + fr, col0 = u.pn * 128 + wc * 32 + 8 * fq;
        float rr[8]; int ro = wr * 64 + fr; asm volatile("" : "+v"(ro));
#pragma unroll
        for (int i = 0; i < 8; ++i) rr[i] = tab[ro + (i >> 2) * HALF + (i & 3) * 16];
#pragma unroll
        for (int ai = 0; ai < 2; ++ai)
#pragma unroll
            for (int m = 0; m < 4; ++m) { const int row = row0 + ai * HALF + m * 16; const float r = rr[ai * 4 + m], c = -LOG2E * r, r2 = r * r;
                f32x2 t[4], p[4];
#pragma unroll
                for (int n = 0; n < 2; ++n) { const f32x4 gv = acc[ai][0][m][n], uv = acc[ai][1][m][n];
                    const f32x2 g0 = __builtin_shufflevector(gv, gv, 0, 1), g1 = __builtin_shufflevector(gv, gv, 2, 3), u0 = __builtin_shufflevector(uv, uv, 0, 1), u1 = __builtin_shufflevector(uv, uv, 2, 3);
                    t[2 * n] = g0 * c; t[2 * n + 1] = g1 * c; p[2 * n] = g0 * u0; p[2 * n + 1] = g1 * u1; }
#pragma unroll
                for (int q = 0; q < 4; ++q) { t[q][0] = __builtin_amdgcn_exp2f(t[q][0]); t[q][1] = __builtin_amdgcn_exp2f(t[q][1]); }
#pragma unroll
                for (int q = 0; q < 4; ++q) t[q] = t[q] + 1.0f;
#pragma unroll
                for (int q = 0; q < 4; ++q) { t[q][0] = __builtin_amdgcn_rcpf(t[q][0]); t[q][1] = __builtin_amdgcn_rcpf(t[q][1]); }
#pragma unroll
                for (int q = 0; q < 4; ++q) p[q] = p[q] * (t[q] * r2);
                u32x4 w; w.x = cvt_pk_bf16(p[0][0], p[0][1]); w.y = cvt_pk_bf16(p[1][0], p[1][1]); w.z = cvt_pk_bf16(p[2][0], p[2][1]); w.w = cvt_pk_bf16(p[3][0], p[3][1]);
                *(u32x4*)(O + (size_t)row * DFF_ + col0) = w; }
    }
};
struct EpiRes {
    static constexpr bool PERM = true, AFTER_DRAIN = false;
    const bf16_t* base; bf16_t* hb; float* ssq_out; float alpha;
    __device__ __forceinline__ void operator()(const f32x4 (&acc)[2][2][4][2], const Unit& u, int wr, int wc, int fr, int fq) const {
        const int row0 = u.pm * BM + wr * 64 + fr, col0 = u.pn * BM + wc * 32 + 8 * fq;
        u32x4 bw[2][4][2];
#pragma unroll
        for (int ai = 0; ai < 2; ++ai)
#pragma unroll
            for (int m = 0; m < 4; ++m)
#pragma unroll
                for (int bj = 0; bj < 2; ++bj) bw[ai][m][bj] = *(const u32x4*)(base + (size_t)(row0 + ai * HALF + m * 16) * DM + col0 + bj * HALF);
#pragma unroll
        for (int ai = 0; ai < 2; ++ai)
#pragma unroll
            for (int m = 0; m < 4; ++m) { const int row = row0 + ai * HALF + m * 16; float s = 0.f;
#pragma unroll
                for (int bj = 0; bj < 2; ++bj) { const size_t off = (size_t)row * DM + col0 + bj * HALF; const u32x4 b4 = bw[ai][m][bj];
                    f32x4 v0 = acc[ai][bj][m][0] * alpha, v1 = acc[ai][bj][m][1] * alpha;
                    v0[0] += __uint_as_float(b4.x << 16); v0[1] += __uint_as_float(b4.x & 0xffff0000u); v0[2] += __uint_as_float(b4.y << 16); v0[3] += __uint_as_float(b4.y & 0xffff0000u);
                    v1[0] += __uint_as_float(b4.z << 16); v1[1] += __uint_as_float(b4.z & 0xffff0000u); v1[2] += __uint_as_float(b4.w << 16); v1[3] += __uint_as_float(b4.w & 0xffff0000u);
                    s += dot4(v0) + dot4(v1); u32x4 w; w.x = cvt_pk_bf16(v0[0], v0[1]); w.y = cvt_pk_bf16(v0[2], v0[3]); w.z = cvt_pk_bf16(v1[0], v1[1]); w.w = cvt_pk_bf16(v1[2], v1[3]); *(u32x4*)(hb + off) = w; }
                s = fq_sum(s, fq * 16 + fr);
                if (fq == 0) ssq_out[(size_t)row * 16 + u.pn * 4 + wc] = s; }
    }
};
struct EpiZ {
    static constexpr bool PERM = true, AFTER_DRAIN = false;
    bf16_t* Z; const PG8_LAS float* tab; float* ssqq; float* ssqkv;
    __device__ __forceinline__ void operator()(const f32x4 (&acc)[2][2][4][2], const Unit& u, int wr, int wc, int fr, int fq) const {
        const int row0 = u.pm * BM + wr * 64 + fr, col0 = u.pn * BM + wc * 32 + 8 * fq;
        float rr[8]; int ro = wr * 64 + fr; asm volatile("" : "+v"(ro));
#pragma unroll
        for (int i = 0; i < 8; ++i) rr[i] = tab[ro + (i >> 2) * HALF + (i & 3) * 16];
#pragma unroll
        for (int ai = 0; ai < 2; ++ai)
#pragma unroll
            for (int m = 0; m < 4; ++m) { const int row = row0 + ai * HALF + m * 16; const float r = rr[ai * 4 + m]; float s0 = 0.f, s1 = 0.f;
#pragma unroll
                for (int bj = 0; bj < 2; ++bj) { const f32x4 v0 = acc[ai][bj][m][0] * r, v1 = acc[ai][bj][m][1] * r;
                    if (bj == 0) s0 = dot4(v0) + dot4(v1); else s1 = dot4(v0) + dot4(v1);
                    u32x4 w; w.x = cvt_pk_bf16(v0[0], v0[1]); w.y = cvt_pk_bf16(v0[2], v0[3]); w.z = cvt_pk_bf16(v1[0], v1[1]); w.w = cvt_pk_bf16(v1[2], v1[3]);
                    *(u32x4*)(Z + (size_t)row * NZ_ + col0 + bj * HALF) = w; }
                if (u.pn < 2) { float s = (u.pn == 0) ? s0 + s1 : s0; s = fq_sum(s, fq * 16 + fr);
                    if (fq == 0) { if (u.pn == 0) ssqq[(size_t)row * 4 + wc] = s; else ssqkv[(size_t)row * 4 + wc] = s; } } }
    }
};
struct EpiMla {
    static constexpr bool PERM = true, AFTER_DRAIN = false;
    bf16_t* O; const float* ssqq; const float* ssqkv; const float* cs; const float* sn;
    __device__ __forceinline__ void operator()(const f32x4 (&acc)[2][2][4][2], const Unit& u, int wr, int wc, int fr, int fq) const {
        const int row0 = u.pm * BM + wr * 64 + fr, col0 = u.pn * BM + wc * 32 + 8 * fq;
        const float QSCALE = 0.10206207261596575f * LOG2E;
        float pq[8], pkv[8];
#pragma unroll
        for (int i = 0; i < 8; ++i) { const size_t row = (size_t)(row0 + (i >> 2) * HALF + (i & 3) * 16); pq[i] = ssqq[row * 4 + fq]; pkv[i] = ssqkv[row * 4 + fq]; }
        const int G0 = 8 * u.pn + wc, G1 = G0 + 4;
        const bool rope0 = (G0 == 2 || G0 == 5 || G0 == 8 || G0 == 11 || G0 == 28), rope1 = (G1 == 2 || G1 == 5 || G1 == 8 || G1 == 11 || G1 == 28);
#pragma unroll
        for (int i = 0; i < 8; ++i) { const float a = fq_sum(pq[i], fq * 16 + fr), b = fq_sum(pkv[i], fq * 16 + fr);
            pq[i] = __builtin_amdgcn_rsqf(a * (1.0f / 256.0f) + RMS_EPS) * QSCALE; pkv[i] = __builtin_amdgcn_rsqf(b * (1.0f / 128.0f) + RMS_EPS); }
#pragma unroll
        for (int ai = 0; ai < 2; ++ai) {
            f32x4 c4[4], s4[4];
            if (rope0 || rope1) {
#pragma unroll
                for (int m = 0; m < 4; ++m) { const size_t row = (size_t)(row0 + ai * HALF + m * 16); c4[m] = *(const f32x4*)(cs + row * 16 + 4 * fq); s4[m] = *(const f32x4*)(sn + row * 16 + 4 * fq); }
            } else {
#pragma unroll
                for (int m = 0; m < 4; ++m) { c4[m] = (f32x4){1.f, 1.f, 1.f, 1.f}; s4[m] = (f32x4){0.f, 0.f, 0.f, 0.f}; }
            }
#pragma unroll
            for (int m = 0; m < 4; ++m) { const int row = row0 + ai * HALF + m * 16; const float rq = pq[ai * 4 + m], rkv = pkv[ai * 4 + m];
#pragma unroll
                for (int bj = 0; bj < 2; ++bj) { const int G = 8 * u.pn + 4 * bj + wc; const float sc = G < 12 ? rq : (G < 28 ? rkv : 1.0f);
                    f32x4 x1 = acc[ai][bj][m][0] * sc, x2 = acc[ai][bj][m][1] * sc;
                    if (bj == 0 ? rope0 : rope1) { const f32x4 y1 = x1 * c4[m] - x2 * s4[m], y2 = x1 * s4[m] + x2 * c4[m]; x1 = y1; x2 = y2; }
                    u32x4 w; w.x = cvt_pk_bf16(x1[0], x1[1]); w.y = cvt_pk_bf16(x1[2], x1[3]); w.z = cvt_pk_bf16(x2[0], x2[1]); w.w = cvt_pk_bf16(x2[2], x2[3]);
                    *(u32x4*)(O + (size_t)row * DM + col0 + bj * HALF) = w; } }
        }
    }
};
struct EpiPlain {
    static constexpr bool PERM = true, AFTER_DRAIN = false;
    bf16_t* O; int ldc;
    __device__ __forceinline__ void operator()(const f32x4 (&acc)[2][2][4][2], const Unit& u, int wr, int wc, int fr, int fq) const {
        const int row0 = u.pm * BM + wr * 64 + fr, col0 = u.pn * BM + wc * 32 + 8 * fq;
#pragma unroll
        for (int ai = 0; ai < 2; ++ai)
#pragma unroll
            for (int m = 0; m < 4; ++m) { bf16_t* rowp = O + (size_t)(row0 + ai * HALF + m * 16) * ldc + col0;
#pragma unroll
                for (int bj = 0; bj < 2; ++bj) { const f32x4 v0 = acc[ai][bj][m][0], v1 = acc[ai][bj][m][1];
                    u32x4 w; w.x = cvt_pk_bf16(v0[0], v0[1]); w.y = cvt_pk_bf16(v0[2], v0[3]); w.z = cvt_pk_bf16(v1[0], v1[1]); w.w = cvt_pk_bf16(v1[2], v1[3]);
                    *(u32x4*)(rowp + bj * HALF) = w; } }
    }
};
struct EpiPle {
    static constexpr bool PERM = true, AFTER_DRAIN = false;
    const bf16_t* h; const bf16_t* pp; bf16_t* hb; const PG8_LAS float* tab; float* ssq_out;
    __device__ __forceinline__ void operator()(const f32x4 (&acc)[2][2][4][2], const Unit& u, int wr, int wc, int fr, int fq) const {
        const int row0 = u.pm * BM + wr * 64 + fr, col0 = u.pn * BM + wc * 32 + 8 * fq;
        int ro = wr * 64 + fr; asm volatile("" : "+v"(ro));
        u32x4 hw4[4][2], pw4[4][2];
#pragma unroll
        for (int i = 0; i < 3; ++i)
#pragma unroll
            for (int bj = 0; bj < 2; ++bj) { const size_t off = (size_t)(row0 + (i >> 2) * HALF + (i & 3) * 16) * DM + col0 + bj * HALF; hw4[i][bj] = *(const u32x4*)(h + off); pw4[i][bj] = *(const u32x4*)(pp + off); }
#pragma unroll
        for (int i = 0; i < 8; ++i) { const int ai = i >> 2, m = i & 3, row = row0 + ai * HALF + m * 16; const float r = tab[ro + ai * HALF + m * 16]; float s = 0.f;
            if (i + 3 < 8) {
#pragma unroll
                for (int bj = 0; bj < 2; ++bj) { const size_t off = (size_t)(row0 + ((i + 3) >> 2) * HALF + ((i + 3) & 3) * 16) * DM + col0 + bj * HALF; hw4[(i + 3) % 4][bj] = *(const u32x4*)(h + off); pw4[(i + 3) % 4][bj] = *(const u32x4*)(pp + off); }
            }
#pragma unroll
            for (int bj = 0; bj < 2; ++bj) { const size_t off = (size_t)row * DM + col0 + bj * HALF; const u32x4 hw = hw4[i % 4][bj], pw = pw4[i % 4][bj];
                const unsigned hu[4] = {hw.x, hw.y, hw.z, hw.w}, pu[4] = {pw.x, pw.y, pw.z, pw.w}; unsigned wo[4];
#pragma unroll
                for (int q = 0; q < 4; ++q) { const float a0 = acc[ai][bj][m][q >> 1][2 * (q & 1)] * r, a1 = acc[ai][bj][m][q >> 1][2 * (q & 1) + 1] * r;
                    const float v0 = __uint_as_float(hu[q] << 16) + __uint_as_float(pu[q] << 16) * sigmoid_f(a0), v1 = __uint_as_float(hu[q] & 0xffff0000u) + __uint_as_float(pu[q] & 0xffff0000u) * sigmoid_f(a1);
                    s += v0 * v0 + v1 * v1; wo[q] = cvt_pk_bf16(v0, v1); }
                u32x4 w; w.x = wo[0]; w.y = wo[1]; w.z = wo[2]; w.w = wo[3]; *(u32x4*)(hb + off) = w; }
            s = fq_sum(s, fq * 16 + fr);
            if (fq == 0) ssq_out[(size_t)row * 16 + u.pn * 4 + wc] = s; }
    }
};

template <class Epi, class Sched, bool ALIGN_EPI = false, bool SP2 = false>
__device__ __forceinline__ void gemm_phase(PG8_LAS unsigned char* lds, const Gemm g, const Sched& S, const Epi& E) {
    int tid_o = threadIdx.x; asm volatile("" : "+v"(tid_o));
    const int tid = tid_o, wid = __builtin_amdgcn_readfirstlane(tid >> 6), lane = tid & 63, wr = wid >> 2, wc = wid & 3, fr = lane & 15, fq = lane >> 4;
    const int K = g.K, nt = K / BK;
    unsigned voffA[2], voffB[2];
#pragma unroll
    for (int i = 0; i < 2; ++i) { int R, C; stage_rc(tid * 16 + i * 8192, R, C); const int Rb = Epi::PERM ? ((R & ~31) + perm32(R & 31)) : R;
        voffA[i] = (unsigned)(R * g.lda + C) * 2u; voffB[i] = (unsigned)(Rb * K + C) * 2u; }
    const size_t kstep = (size_t)(BK * 2);
    const size_t hstep = (size_t)HALF * K * 2;
    const size_t tstep = 2 * hstep; const size_t hstepA = (size_t)HALF * g.lda * 2, tstepA = 2 * hstepA;
    const unsigned ldsw = (unsigned)wid * 1024u;
    const int aoff = lds_byte(wr * 64 + fr, fq * 8), boff = lds_byte(wc * 32 + fr, fq * 8);
#define PG8_SA(b, h) (((b) * 2 + (h)) * HTB)
#define PG8_SB(b, h) ((4 + (b) * 2 + (h)) * HTB)
#define PG8_STAGE(bufoff, gbase, voff) do { _Pragma("unroll") for (int _i = 0; _i < 2; ++_i) \
        __builtin_amdgcn_global_load_lds((const unsigned*)((const char*)(gbase) + (voff)[_i]), (PG8_LAS unsigned*)(lds + (bufoff) + ldsw + _i * 8192), 16, 0, 0); } while (0)
#define PG8_LDA(dst, b, h) do { _Pragma("unroll") for (int m = 0; m < 4; ++m) _Pragma("unroll") for (int k = 0; k < 2; ++k) dst[m][k] = *(const PG8_LAS bf16x8*)(lds + PG8_SA(b, h) + aoff + m * 2048 + k * 1024); } while (0)
#define PG8_LDB(dst, b, h) do { _Pragma("unroll") for (int n = 0; n < 2; ++n) _Pragma("unroll") for (int k = 0; k < 2; ++k) dst[n][k] = *(const PG8_LAS bf16x8*)(lds + PG8_SB(b, h) + boff + n * 2048 + k * 1024); } while (0)
#define PG8_MMA(ai, bj, At, Bt) do { __builtin_amdgcn_s_setprio(1); _Pragma("unroll") for (int m = 0; m < 4; ++m) _Pragma("unroll") for (int n = 0; n < 2; ++n) _Pragma("unroll") for (int k = 0; k < 2; ++k) \
        acc[ai][bj][m][n] = __builtin_amdgcn_mfma_f32_16x16x32_bf16(Bt[n][k], At[m][k], acc[ai][bj][m][n], 0, 0, 0); __builtin_amdgcn_s_setprio(0); } while (0)
#define PG8_WAIT_V(n) asm volatile("s_waitcnt vmcnt(" #n ")" ::: "memory")
#define PG8_WAIT_L(n) asm volatile("s_waitcnt lgkmcnt(" #n ")" ::: "memory")
#define PG8_BAR __builtin_amdgcn_s_barrier()
#define PG8_SCHED __builtin_amdgcn_sched_barrier(0)
    Unit cur, nxt; int ui = 0;
    if (!S.next(0, cur)) return;
    f32x4 acc[2][2][4][2];
#pragma unroll
    for (int a = 0; a < 2; ++a)
#pragma unroll
        for (int b = 0; b < 2; ++b)
#pragma unroll
            for (int m = 0; m < 4; ++m)
#pragma unroll
                for (int n = 0; n < 2; ++n) acc[a][b][m][n] = (f32x4){0.f, 0.f, 0.f, 0.f};
    bf16x8 At[4][2], B0[2][2], B1[2][2];
    const char* cA = (const char*)g.A + (size_t)cur.pm * tstepA; const char* cB = (const char*)g.Bt + (size_t)cur.pn * tstep;
    S.a_ready(cur);
    if constexpr (SP2) {
        PG8_STAGE(PG8_SB(0, 0), cB, voffB); PG8_STAGE(PG8_SB(0, 1), cB + hstep, voffB); PG8_STAGE(PG8_SA(0, 0), cA, voffA); PG8_STAGE(PG8_SA(0, 1), cA + hstepA, voffA);
        if (wr == 1) PG8_BAR;
        PG8_WAIT_V(2); PG8_BAR;
        PG8_STAGE(PG8_SB(1, 0), cB + kstep, voffB); PG8_STAGE(PG8_SA(1, 0), cA + kstep, voffA); PG8_STAGE(PG8_SB(1, 1), cB + hstep + kstep, voffB);
        PG8_WAIT_V(6); PG8_BAR;
    } else {
        PG8_STAGE(PG8_SB(0, 0), cB, voffB); PG8_STAGE(PG8_SA(0, 0), cA, voffA); PG8_STAGE(PG8_SB(0, 1), cB + hstep, voffB); PG8_STAGE(PG8_SA(0, 1), cA + hstepA, voffA);
        if (wr == 1) PG8_BAR;
        PG8_WAIT_V(4); PG8_BAR;
        PG8_STAGE(PG8_SB(1, 0), cB + kstep, voffB); PG8_STAGE(PG8_SA(1, 0), cA + kstep, voffA); PG8_STAGE(PG8_SB(1, 1), cB + hstep + kstep, voffB);
        PG8_WAIT_V(6); PG8_BAR;
    }
    for (;;) {
        const bool has_next = S.next(ui + 1, nxt);
        const char* nA = has_next ? (const char*)g.A + (size_t)nxt.pm * tstepA : cA; const char* nB = has_next ? (const char*)g.Bt + (size_t)nxt.pn * tstep : cB;
        for (int t = 0; t < nt; t += 2) {
            const bool last = (t == nt - 2);
            const char* a1 = cA + (size_t)(t + 1) * kstep;
            const char* a2 = last ? nA : cA + (size_t)(t + 2) * kstep; const char* b2 = last ? nB : cB + (size_t)(t + 2) * kstep;
            const char* a3 = a2 + kstep; const char* b3 = b2 + kstep;
            if (last && has_next) S.a_ready(nxt);
            if constexpr (SP2) {
            PG8_LDB(B0, 0, 0); PG8_LDB(B1, 0, 1); PG8_SCHED; PG8_LDA(At, 0, 0); PG8_STAGE(PG8_SA(1, 1), a1 + hstepA, voffA);
            PG8_WAIT_V(8); PG8_WAIT_L(0); PG8_BAR; PG8_MMA(0, 0, At, B0); PG8_MMA(0, 1, At, B1); PG8_BAR; PG8_SCHED;
            PG8_LDA(At, 0, 1); PG8_STAGE(PG8_SB(0, 0), b2, voffB); PG8_STAGE(PG8_SB(0, 1), b2 + hstep, voffB); PG8_STAGE(PG8_SA(0, 0), a2, voffA);
            PG8_WAIT_V(8); PG8_WAIT_L(0); PG8_BAR; PG8_MMA(1, 0, At, B0); PG8_MMA(1, 1, At, B1); PG8_BAR; PG8_SCHED;
            PG8_LDB(B0, 1, 0); PG8_LDB(B1, 1, 1); PG8_SCHED; PG8_LDA(At, 1, 0); PG8_STAGE(PG8_SA(0, 1), a2 + hstepA, voffA);
            PG8_WAIT_V(8); PG8_WAIT_L(0); PG8_BAR; PG8_MMA(0, 0, At, B0); PG8_MMA(0, 1, At, B1); PG8_BAR; PG8_SCHED;
            PG8_LDA(At, 1, 1); PG8_STAGE(PG8_SB(1, 0), b3, voffB); PG8_STAGE(PG8_SB(1, 1), b3 + hstep, voffB); PG8_STAGE(PG8_SA(1, 0), a3, voffA);
            PG8_WAIT_V(8); PG8_WAIT_L(0); PG8_BAR; PG8_MMA(1, 0, At, B0); PG8_MMA(1, 1, At, B1); PG8_BAR; PG8_SCHED;
            } else {
            PG8_LDB(B0, 0, 0); PG8_SCHED; PG8_LDA(At, 0, 0); PG8_STAGE(PG8_SA(1, 1), a1 + hstepA, voffA);
            PG8_WAIT_L(8); PG8_BAR; PG8_WAIT_L(0); PG8_MMA(0, 0, At, B0); PG8_BAR; PG8_SCHED;
            PG8_LDB(B1, 0, 1); PG8_STAGE(PG8_SB(0, 0), b2, voffB);
            PG8_BAR; PG8_WAIT_L(0); PG8_MMA(0, 1, At, B1); PG8_BAR;
            PG8_LDA(At, 0, 1); PG8_STAGE(PG8_SA(0, 0), a2, voffA);
            PG8_BAR; PG8_WAIT_L(0); PG8_MMA(1, 0, At, B0); PG8_BAR; PG8_SCHED;
            PG8_STAGE(PG8_SB(0, 1), b2 + hstep, voffB);
            PG8_WAIT_V(6); PG8_BAR; PG8_MMA(1, 1, At, B1); PG8_BAR;
            PG8_LDB(B0, 1, 0); PG8_SCHED; PG8_LDA(At, 1, 0); PG8_STAGE(PG8_SA(0, 1), a2 + hstepA, voffA);
            PG8_WAIT_L(8); PG8_BAR; PG8_WAIT_L(0); PG8_MMA(0, 0, At, B0); PG8_BAR; PG8_SCHED;
            PG8_LDB(B1, 1, 1); PG8_STAGE(PG8_SB(1, 0), b3, voffB);
            PG8_BAR; PG8_WAIT_L(0); PG8_MMA(0, 1, At, B1); PG8_BAR;
            PG8_LDA(At, 1, 1); PG8_STAGE(PG8_SA(1, 0), a3, voffA);
            PG8_BAR; PG8_WAIT_L(0); PG8_MMA(1, 0, At, B0); PG8_BAR; PG8_SCHED;
            PG8_STAGE(PG8_SB(1, 1), b3 + hstep, voffB);
            PG8_WAIT_V(6); PG8_BAR; PG8_MMA(1, 1, At, B1); PG8_BAR;
            }
        }
        if constexpr (ALIGN_EPI) { if (wr == 0) PG8_BAR; }
        if constexpr (!Epi::AFTER_DRAIN) { E(acc, cur, wr, wc, fr, fq); S.done(cur); }
        if (!has_next) break;
#pragma unroll
        for (int a = 0; a < 2; ++a)
#pragma unroll
            for (int b = 0; b < 2; ++b)
#pragma unroll
                for (int m = 0; m < 4; ++m)
#pragma unroll
                    for (int n = 0; n < 2; ++n) acc[a][b][m][n] = (f32x4){0.f, 0.f, 0.f, 0.f};
        cur = nxt; cA = nA; cB = nB; ++ui;
        if constexpr (ALIGN_EPI) { if (wr == 1) PG8_BAR; }
    }
    PG8_WAIT_V(0);
    if constexpr (!ALIGN_EPI) { if (wr == 0) PG8_BAR; }
    PG8_BAR;
    if constexpr (Epi::AFTER_DRAIN) { E.fused(acc, cur, wr, wc, fr, fq, lds, wid, lane); S.done(cur); }
#undef PG8_SA
#undef PG8_SB
#undef PG8_STAGE
#undef PG8_LDA
#undef PG8_LDB
#undef PG8_MMA
#undef PG8_WAIT_V
#undef PG8_WAIT_L
#undef PG8_BAR
#undef PG8_SCHED
}
}

constexpr int NWAVES = 8;
constexpr int M = 16384, SEQ = 4096, NBATCH = 4, DEPTH = 4, D = 1024, DFF = 2816, NGU = 2 * DFF, NZ = 3584, NZSRC = 3488, PLED = 256;
constexpr int ZC_U = 512, ZC_V = 768, ZC_HQ = 1024, ZC_HF = 1536, ZC_HI = 2048, ZC_HG = 2304, ZC_RQ = 2560, ZC_RK = 2816, ZC_RV = 3072, ZC_RG = 3328;
constexpr int QC_Q = 0, QC_KN = 384, QC_V = 640, QC_KR = 896;
constexpr size_t MiB = 1u << 20;
constexpr size_t WS_CTL = 0, CTL_ZERO_BYTES = 1 * MiB;
constexpr size_t WS_WGU = 1 * MiB;
constexpr size_t WS_WD = WS_WGU + 88 * MiB;
constexpr size_t WS_WIN = WS_WD + 44 * MiB;
constexpr size_t WS_WMLA = WS_WIN + 28 * MiB;
constexpr size_t WS_WOUT = WS_WMLA + 4 * MiB;
constexpr size_t WS_WPG = WS_WOUT + 8 * MiB;
constexpr size_t WS_WPP = WS_WPG + 8 * MiB;
constexpr size_t WS_WSG = WS_WPP + 2 * MiB;
constexpr size_t WS_B0 = WS_WSG + 1 * MiB;
constexpr size_t WS_B1 = WS_B0 + 32 * MiB;
constexpr size_t WS_ZH = WS_B1 + 32 * MiB;
constexpr size_t WS_QKV = WS_ZH + 112 * MiB;
constexpr size_t WS_PBF = WS_QKV + 32 * MiB;
constexpr size_t WS_HST = WS_PBF + 8 * MiB;
constexpr size_t WS_HDC = WS_HST + 32 * MiB;
constexpr size_t WS_HLB = WS_HDC + 768 * 1024;
constexpr size_t WS_RST = WS_HDC + 1 * MiB;
constexpr size_t WS_ROPE = WS_RST + 8 * MiB;
constexpr size_t WS_SSQ = WS_ROPE + 6 * MiB;
constexpr size_t WS_SSQ2 = WS_SSQ + 2 * MiB;
constexpr size_t WS_END = WS_SSQ2 + 1 * MiB;
constexpr int CW_TMO = 0, CW_BAR = 4096, CW_GRP = 65536;
constexpr int MAX_LAUNCHES = 16;
constexpr int RING_OFF = 0, RING_BYTES = 131072, LDSCTL_OFF = RING_BYTES, MISC_OFF = 147456 - 256, TAB_OFF = MISC_OFF - 1024, LDS_BYTES = 147456;

#define GAS __attribute__((address_space(1)))
#define LAS __attribute__((address_space(3)))
typedef unsigned short bf16;
typedef unsigned v4u __attribute__((ext_vector_type(4)));
typedef unsigned v2u __attribute__((ext_vector_type(2)));
typedef float f32x4 __attribute__((ext_vector_type(4)));
typedef short bf16x8 __attribute__((ext_vector_type(8)));
typedef GAS unsigned gu32;
#define RLX_AGENT __ATOMIC_RELAXED, __HIP_MEMORY_SCOPE_AGENT
#define LDS_WAIT() asm volatile("s_waitcnt lgkmcnt(0)" ::: "memory")
#define VM_WAIT() asm volatile("s_waitcnt vmcnt(0)" ::: "memory")
__device__ __forceinline__ unsigned f2bf(float f) { unsigned u = __builtin_bit_cast(unsigned, f); return (u + 0x7fffu + ((u >> 16) & 1u)) >> 16; }
__device__ __forceinline__ unsigned pk2(float lo, float hi) { return f2bf(lo) | (f2bf(hi) << 16); }
__device__ __forceinline__ float bf2f(bf16 v) { return __uint_as_float((unsigned)v << 16); }
__device__ __forceinline__ float wave_sum(float v) {
#pragma unroll
    for (int o = 1; o < 64; o <<= 1) v += __shfl_xor(v, o);
    return v;
}
__device__ __forceinline__ float wave_max(float v) {
#pragma unroll
    for (int o = 1; o < 64; o <<= 1) v = fmaxf(v, __shfl_xor(v, o));
    return v;
}
__device__ const double ROPE_INVT[48] = {
1.59154943091895346e-01, 8.94994016088910133e-02, 5.03292121044870353e-02, 2.83021958306233987e-02, 1.59154943091895339e-02, 8.94994016088910237e-03, 5.03292121044870370e-03, 2.83021958306233987e-03, 1.59154943091895356e-03, 8.94994016088910237e-04, 5.03292121044870326e-04, 2.83021958306233954e-04, 1.59154943091895351e-04, 8.94994016088910182e-05, 5.03292121044870354e-05, 2.83021958306233961e-05,
1.59154943091895346e-01, 1.19349370211248862e-01, 8.94994016088910133e-02, 6.71150830052272551e-02, 5.03292121044870353e-02, 3.77415847174197711e-02, 2.83021958306233987e-02, 2.12236527647776604e-02, 1.59154943091895339e-02, 1.19349370211248862e-02, 8.94994016088910237e-03, 6.71150830052272534e-03, 5.03292121044870370e-03, 3.77415847174197719e-03, 2.83021958306233987e-03, 2.12236527647776622e-03, 1.59154943091895356e-03, 1.19349370211248849e-03, 8.94994016088910237e-04, 6.71150830052272599e-04, 5.03292121044870326e-04, 3.77415847174197741e-04, 2.83021958306233954e-04, 2.12236527647776605e-04, 1.59154943091895351e-04, 1.19349370211248862e-04, 8.94994016088910182e-05, 6.71150830052272545e-05, 5.03292121044870354e-05, 3.77415847174197768e-05, 2.83021958306233961e-05, 2.12236527647776592e-05 };

#define XB_TMO      128
#define XB_XCNT(j)  (256  + 64 * (j))
#define XB_XSUB(j)  (1280 + 64 * (j))
#define XB_XGEN(j)  (2304 + 64 * (j))
#define XB_TOP      3328
#define XB_TOPGEN   3392
#define XCD_BAR_WORDS 3456
#define XB_SPIN_CAP (1u << 18)

__device__ __forceinline__ unsigned xb_ld(unsigned* p)              { return __hip_atomic_load(p, __ATOMIC_RELAXED, __HIP_MEMORY_SCOPE_AGENT); }
__device__ __forceinline__ unsigned xb_add(unsigned* p, unsigned v) { return __hip_atomic_fetch_add(p, v, __ATOMIC_RELAXED, __HIP_MEMORY_SCOPE_AGENT); }
__device__ __forceinline__ unsigned xb_xcc_id() { return (unsigned)__builtin_amdgcn_s_getreg((3 << 11) | 20) & 0xFu; }
#define XB_SPIN(cond, bar) do { unsigned _sp = 0; while (cond) { __builtin_amdgcn_s_sleep(1); \
    if ((++_sp & 255u) == 0u) { if (xb_ld(&(bar)[XB_TMO])) break; if (_sp > XB_SPIN_CAP) { atomicAdd(&(bar)[XB_TMO], 1u); break; } } } } while (0)

struct XcdBarrier {
    unsigned* bar; unsigned x;
    volatile LAS unsigned* st;
};

__device__ __forceinline__ XcdBarrier xcd_barrier_post(unsigned* bar, volatile LAS unsigned* st) {
    XcdBarrier b; b.bar = bar; b.x = xb_xcc_id(); b.st = st;
    if (threadIdx.x == 0) (void)xb_add(&bar[XB_XCNT(b.x)], 1u);
    return b;
}
__device__ __forceinline__ void xcd_barrier_complete(unsigned* bar, unsigned x, unsigned& nloc, unsigned& nx) {
    const unsigned G = gridDim.x * gridDim.y * gridDim.z;
    unsigned sum, cnt, mine, sp = 0u;
    for (;;) {
        sum = 0u; cnt = 0u; mine = 0u;
#pragma unroll
        for (unsigned j = 0; j < 16; ++j) { const unsigned c = xb_ld(&bar[XB_XCNT(j)]); sum += c; cnt += (c > 0u) ? 1u : 0u; mine = (j == x) ? c : mine; }
        if (sum == G) break;
        __builtin_amdgcn_s_sleep(1);
        if ((++sp & 255u) == 0u) { if (xb_ld(&bar[XB_TMO])) break; if (sp > XB_SPIN_CAP) { atomicAdd(&bar[XB_TMO], 1u); break; } }
    }
    nloc = mine > 0u ? mine : 1u; nx = cnt > 0u ? cnt : 1u;
}

__device__ __forceinline__ void xcd_barrier(const XcdBarrier& b) {
    asm volatile("s_waitcnt vmcnt(0)" ::: "memory");
    __syncthreads();
    if (threadIdx.x == 0) {
        unsigned* bar = b.bar;
        __builtin_amdgcn_s_waitcnt(0);
        unsigned nloc = b.st[0], nx = b.st[1];
        if (nloc == 0u) { xcd_barrier_complete(bar, b.x, nloc, nx); b.st[0] = nloc; b.st[1] = nx; }
        const unsigned old = xb_add(&bar[XB_XSUB(b.x)], 1u);
        const unsigned gen = old / nloc;
        if (old + 1u == (gen + 1u) * nloc) {
            __builtin_amdgcn_fence(__ATOMIC_RELEASE, "agent");
            asm volatile("s_waitcnt vmcnt(0)" ::: "memory");
            const unsigned og = xb_add(&bar[XB_TOP], 1u);
            const unsigned tg = og / nx;
            if (og + 1u == (tg + 1u) * nx) xb_add(&bar[XB_TOPGEN], 1u);
            else XB_SPIN(xb_ld(&bar[XB_TOPGEN]) == tg, bar);
            __builtin_amdgcn_fence(__ATOMIC_ACQUIRE, "agent");
            xb_add(&bar[XB_XGEN(b.x)], 1u);
            asm volatile("s_waitcnt vmcnt(0)" ::: "memory");
        } else {
            XB_SPIN(xb_ld(&bar[XB_XGEN(b.x)]) == gen, bar);
            __builtin_amdgcn_fence(__ATOMIC_ACQUIRE, "agent");
            asm volatile("s_waitcnt vmcnt(0)" ::: "memory");
        }
    }
    __syncthreads();
}

__device__ __forceinline__ void group_sync(unsigned* cnt, unsigned* xmask, unsigned members, volatile LAS unsigned* seq  , unsigned* bar) {
    asm volatile("s_waitcnt vmcnt(0)" ::: "memory");
    __syncthreads();
    if (threadIdx.x == 0) {
        __builtin_amdgcn_s_waitcnt(0);
        unsigned same = seq[1];
        if (same == 0u) { const unsigned mk = xb_ld(xmask); same = (mk & (mk - 1u)) == 0u ? 1u : 2u; seq[1] = same; }
        if (same != 1u) { __builtin_amdgcn_fence(__ATOMIC_RELEASE, "agent"); asm volatile("s_waitcnt vmcnt(0)" ::: "memory"); }
        const unsigned target = seq[0] + members; seq[0] = target;
        (void)xb_add(cnt, 1u);
        XB_SPIN(xb_ld(cnt) < target, bar);
        __builtin_amdgcn_fence(__ATOMIC_ACQUIRE, "agent");
        asm volatile("s_waitcnt vmcnt(0)" ::: "memory");
    }
    __syncthreads();
}

__device__ __forceinline__ void xcd_barrier_arrive(const XcdBarrier& b, volatile LAS unsigned* gen1) {
    asm volatile("s_waitcnt vmcnt(0)" ::: "memory");
    __syncthreads();
    if (threadIdx.x == 0) {
        unsigned* bar = b.bar;
        __builtin_amdgcn_s_waitcnt(0);
        unsigned nloc = b.st[0], nx = b.st[1];
        if (nloc == 0u) { xcd_barrier_complete(bar, b.x, nloc, nx); b.st[0] = nloc; b.st[1] = nx; }
        const unsigned old = xb_add(&bar[XB_XSUB(b.x)], 1u);
        const unsigned gen = old / nloc;
        gen1[0] = gen;
        if (old + 1u == (gen + 1u) * nloc) {
            __builtin_amdgcn_fence(__ATOMIC_RELEASE, "agent");
            asm volatile("s_waitcnt vmcnt(0)" ::: "memory");
            const unsigned og = xb_add(&bar[XB_TOP], 1u);
            const unsigned tg = og / nx;
            if (og + 1u == (tg + 1u) * nx) xb_add(&bar[XB_TOPGEN], 1u);
            xb_add(&bar[XB_XGEN(b.x)], 1u);
        }
    }
    __syncthreads();
}
__device__ __forceinline__ void xcd_barrier_wait(const XcdBarrier& b, volatile LAS unsigned* gen1) {
    if (threadIdx.x == 0) {
        unsigned* bar = b.bar;
        const unsigned gen = gen1[0];
        XB_SPIN(xb_ld(&bar[XB_TOPGEN]) == gen, bar);
        __builtin_amdgcn_fence(__ATOMIC_ACQUIRE, "agent");
        asm volatile("s_waitcnt vmcnt(0)" ::: "memory");
    }
    __syncthreads();
}

enum { IN_X = 0, IN_P, IN_POS, IN_F1N, IN_F1G, IN_F1U, IN_F1D, IN_MIXN, IN_WIN, IN_QN, IN_WUQ, IN_KVN, IN_WUKV, IN_SGLN, IN_SGW, IN_SGB, IN_HGLB, IN_HGN, IN_RETN, IN_WOUT,
       IN_F2N, IN_F2G, IN_F2U, IN_F2D, IN_PLEN, IN_PLEP, IN_PLEG, IN_FINN, N_IN };
struct Args { const float* in[N_IN]; float* out; unsigned char* ws; int ph_lo, ph_hi, li, pad; };
constexpr int N_PHASES = 42;

struct ConvItem { const float* W; const float* gain; bf16* WT; int N, ldk, k0, n0, kind; };
__device__ __forceinline__ int conv_drow(int kind, int n) { return kind == 0 ? n : (kind == 3 ? (n < 416 ? n : n + 96) : ((n >> 7) * 256 + (n & 127) + (kind == 2 ? 128 : 0))); }
constexpr int IT_FF = 16 * 44, IT_DN = 44 * 16, IT_WIN = 16 * 55, IT_SQ = 16 * 16, IT_PP = 4 * 16, IT_LAYER = 4 * IT_FF + 2 * IT_DN + IT_WIN + 2 * IT_SQ + IT_PP;
__device__ __forceinline__ ConvItem conv_decode(const Args& a, unsigned char* ws, int it) {
    ConvItem c; const int l = it / IT_LAYER; int r = it - l * IT_LAYER;
    { constexpr int E_ = IT_LAYER - 2 * IT_FF - IT_DN;
      r = r < 2 * IT_FF ? r : r < 2 * IT_FF + IT_DN ? r + 2 * IT_FF : r < E_ ? r + 2 * IT_FF + IT_DN : r < E_ + 2 * IT_FF ? r - E_ + 2 * IT_FF : r - E_ + 2 * IT_FF + IT_DN; }
    if (r < 4 * IT_FF) { const int f = r / IT_FF; r -= f * IT_FF; const int second = f >> 1, up = f & 1; const int kb = r / 44, nb = r - 44 * kb;
        c.W = (second ? (up ? a.in[IN_F2U] : a.in[IN_F2G]) : (up ? a.in[IN_F1U] : a.in[IN_F1G])) + (size_t)l * D * DFF; c.gain = (second ? a.in[IN_F2N] : a.in[IN_F1N]) + l * D;
        c.WT = (bf16*)(ws + WS_WGU) + (size_t)(2 * l + second) * NGU * D; c.N = DFF; c.ldk = D; c.k0 = 64 * kb; c.n0 = 64 * nb; c.kind = 1 + up; return c; }
    r -= 4 * IT_FF;
    if (r < 2 * IT_DN) { const int second = r / IT_DN; r -= second * IT_DN; const int kb = r / 16, nb = r - 16 * kb;
        c.W = (second ? a.in[IN_F2D] : a.in[IN_F1D]) + (size_t)l * DFF * D; c.gain = nullptr; c.WT = (bf16*)(ws + WS_WD) + (size_t)(2 * l + second) * D * DFF; c.N = D; c.ldk = DFF; c.k0 = 64 * kb; c.n0 = 64 * nb; c.kind = 0; return c; }
    r -= 2 * IT_DN;
    if (r < IT_WIN) { const int kb = r / 55, nb = r - 55 * kb;
        c.W = a.in[IN_WIN] + (size_t)l * D * NZSRC; c.gain = a.in[IN_MIXN] + l * D; c.WT = (bf16*)(ws + WS_WIN) + (size_t)l * NZ * D; c.N = NZSRC; c.ldk = D; c.k0 = 64 * kb; c.n0 = 64 * nb; c.kind = 3; return c; }
    r -= IT_WIN;
    if (r < IT_SQ) { const int kb = r / 16, nb = r - 16 * kb; c.W = a.in[IN_WOUT] + (size_t)l * D * D; c.gain = nullptr; c.WT = (bf16*)(ws + WS_WOUT) + (size_t)l * D * D; c.N = D; c.ldk = D; c.k0 = 64 * kb; c.n0 = 64 * nb; c.kind = 0; return c; }
    r -= IT_SQ;
    if (r < IT_SQ) { const int kb = r / 16, nb = r - 16 * kb; c.W = a.in[IN_PLEG] + (size_t)l * D * D; c.gain = a.in[IN_PLEN] + l * D; c.WT = (bf16*)(ws + WS_WPG) + (size_t)l * D * D; c.N = D; c.ldk = D; c.k0 = 64 * kb; c.n0 = 64 * nb; c.kind = 0; return c; }
    r -= IT_SQ;
    { const int kb = r / 16, nb = r - 16 * kb; c.W = a.in[IN_PLEP] + (size_t)l * PLED * D; c.gain = nullptr; c.WT = (bf16*)(ws + WS_WPP) + (size_t)l * D * PLED; c.N = D; c.ldk = PLED; c.k0 = 64 * kb; c.n0 = 64 * nb; c.kind = 0; return c; }
}
__device__ __forceinline__ void conv_load(const ConvItem& c, int lane, float (&v)[64]) {
    const int n = c.n0 + lane; const bool ok = n < c.N; const float* p = c.W + (size_t)c.k0 * c.N + (ok ? n : c.n0);
#pragma unroll
    for (int i = 0; i < 64; ++i) v[i] = p[(size_t)i * c.N];
}
__device__ __forceinline__ void conv_store(const ConvItem& c, int lane, const float (&v)[64], LAS float* scr) {
#pragma unroll
    for (int i = 0; i < 64; ++i) scr[i * 65 + lane] = v[i];
    LDS_WAIT(); asm volatile("" ::: "memory");
    const int k8 = (lane & 7) * 8; f32x4 g0 = {1.f, 1.f, 1.f, 1.f}, g1 = {1.f, 1.f, 1.f, 1.f};
    if (c.gain) { g0 = *(const f32x4*)(c.gain + c.k0 + k8); g1 = *(const f32x4*)(c.gain + c.k0 + k8 + 4); }
#pragma unroll
    for (int j = 0; j < 8; ++j) { const int nl = (lane >> 3) + 8 * j, n = c.n0 + nl; const LAS float* s = scr + k8 * 65 + nl;
        v4u o; o.x = pk2(s[0 * 65] * g0[0], s[1 * 65] * g0[1]); o.y = pk2(s[2 * 65] * g0[2], s[3 * 65] * g0[3]); o.z = pk2(s[4 * 65] * g1[0], s[5 * 65] * g1[1]); o.w = pk2(s[6 * 65] * g1[2], s[7 * 65] * g1[3]);
        if (n < c.N) *(v4u*)(c.WT + (size_t)conv_drow(c.kind, n) * c.ldk + c.k0 + k8) = o; }
    LDS_WAIT(); asm volatile("" ::: "memory");
}

__device__ __forceinline__ void prologue_misc(const Args& a, int gt, int NGT) {
    unsigned char* ws = a.ws;
    bf16* Win = (bf16*)(ws + WS_WIN); bf16* Wmla = (bf16*)(ws + WS_WMLA); bf16* Wsg = (bf16*)(ws + WS_WSG);
    { unsigned z_ = 0u; asm volatile("" : "+v"(z_));
      for (int i = gt; i < DEPTH * 96 * (D / 8); i += NGT) { const int l = i / (96 * 128), r = i - l * 96 * 128; const int row = 416 + r / 128, c8 = r & 127;
        *(v4u*)(Win + ((size_t)l * NZ + row) * D + 8 * c8) = (v4u){z_, z_, z_, z_}; } }
    for (int i = gt; i < DEPTH * 1024 * 64; i += NGT) { const int l = i >> 16, r = i & 65535, n = ((r >> 12) << 6) + (r & 63), k8 = ((r >> 6) & 63) * 8;
        const float* wuq = a.in[IN_WUQ] + (size_t)l * 256 * 384; const float* wukv = a.in[IN_WUKV] + (size_t)l * 128 * 512;
        const float* qg = a.in[IN_QN] + l * 256; const float* kvg = a.in[IN_KVN] + l * 128;
        const int G_ = n >> 5, p_ = n & 31; const bool rg_ = (G_ == 2 || G_ == 5 || G_ == 8 || G_ == 11 || G_ == 28);
        const int ns = rg_ ? (n & ~31) + 16 * ((p_ >> 2) & 1) + 4 * (p_ >> 3) + (p_ & 3) : n;
        float v[8];
#pragma unroll
        for (int j = 0; j < 8; ++j) { const int k = k8 + j; float x = 0.f;
            if (n < 384) { if (k < 256) x = wuq[(size_t)k * 384 + ns] * qg[k]; }
            else if (n < 896) { if (k >= 256 && k < 384) { const int nn = (n - 384) & 255, hh = nn >> 6, jj = (nn & 63) + (n >= 640 ? 64 : 0); x = wukv[(size_t)(k - 256) * 512 + hh * 128 + jj] * kvg[k - 256]; } }
            else if (n < 928) { if (k == 384 + (ns - 896)) x = 1.0f; }
            v[j] = x; }
        v4u o; o.x = pk2(v[0], v[1]); o.y = pk2(v[2], v[3]); o.z = pk2(v[4], v[5]); o.w = pk2(v[6], v[7]);
        *(v4u*)(Wmla + ((size_t)l * 1024 + n) * 512 + k8) = o; }
    for (int i = gt; i < DEPTH * 4 * 128 * 128 / 2; i += NGT) { const int e = 2 * i, s = e & 127, t = (e >> 7) & 127; const float* w = a.in[IN_SGW];
        const float x0 = s <= t ? w[e] : 0.f, x1 = (s + 1) <= t ? w[e + 1] : 0.f; ((unsigned*)Wsg)[i] = pk2(x0, x1); }
    { const float* lblog = a.in[IN_HGLB]; float* hlb = (float*)(ws + WS_HLB);
      for (int i = gt; i < DEPTH * 512; i += NGT) { const int l = i >> 9, ch = i & 511;
          const float x0 = lblog[ch], x1 = lblog[512 + ch], x2 = lblog[1024 + ch], x3 = lblog[1536 + ch]; const float mx_ = fmaxf(fmaxf(x0, x1), fmaxf(x2, x3));
          const float e0 = __expf(x0 - mx_), e1 = __expf(x1 - mx_), e2 = __expf(x2 - mx_), e3 = __expf(x3 - mx_);
          hlb[i] = ((l >= 1 ? e1 : 0.f) + (l >= 2 ? e2 : 0.f) + (l >= 3 ? e3 : 0.f)) / (e0 + e1 + e2 + e3); } }
    { const int* pos = (const int*)a.in[IN_POS]; float* mcs = (float*)(ws + WS_ROPE); float* msn = mcs + (size_t)M * 16; float* rcs = msn + (size_t)M * 16; float* rsn = rcs + (size_t)M * 32;
      for (int i = gt; i < M * 48; i += NGT) { const int m = i / 48, f = i - 48 * m; const double turns = (double)pos[m] * ROPE_INVT[f]; const float fr = (float)(turns - __builtin_rint(turns));
          const float c = __builtin_amdgcn_cosf(fr), s = __builtin_amdgcn_sinf(fr);
          if (f < 16) { mcs[(size_t)m * 16 + f] = c; msn[(size_t)m * 16 + f] = s; } else { rcs[(size_t)m * 32 + f - 16] = c; rsn[(size_t)m * 32 + f - 16] = s; } } }
}

__device__ __forceinline__ void conv_items(const Args& a, unsigned char* ws, LAS float* scr, int lane, int it0, int it_end, int stride) {
    int it = it0; float va[64], vb[64];
    if (it < it_end) { ConvItem ca = conv_decode(a, ws, it); conv_load(ca, lane, va);
        for (;;) { const int itb = it + stride; const bool hb = itb < it_end; ConvItem cb = ca; if (hb) { cb = conv_decode(a, ws, itb); conv_load(cb, lane, vb); }
            conv_store(ca, lane, va, scr); if (!hb) break;
            const int ita = itb + stride; const bool ha = ita < it_end; if (ha) { ca = conv_decode(a, ws, ita); conv_load(ca, lane, va); }
            conv_store(cb, lane, vb, scr); if (!ha) break; it = ita; } }
}

__device__ __forceinline__ void conv_items_simple(const Args& a, unsigned char* ws, LAS float* scr, int lane, int it0, int it_end, int stride) {
#pragma unroll 1
    for (int it = it0; it < it_end; it += stride) { float va[64]; const ConvItem ca = conv_decode(a, ws, it); conv_load(ca, lane, va); conv_store(ca, lane, va, scr); }
}

__device__ __forceinline__ void prologue(const Args& a, LAS unsigned char* lds, int tid, int lane, int wave, int vcu, int G) {
    unsigned char* ws = a.ws;
    bf16* Win = (bf16*)(ws + WS_WIN); bf16* Wmla = (bf16*)(ws + WS_WMLA); bf16* Wsg = (bf16*)(ws + WS_WSG);
    LAS float* scr = (LAS float*)(lds + RING_OFF + wave * 16640);
    const int gw = vcu * NWAVES + wave, NGW = G * NWAVES;
    const int gt = (vcu * NWAVES + wave) * 64 + lane, NGT = NGW * 64;
    conv_items(a, ws, scr, lane, gw, (G == 256 ? 1 : DEPTH) * IT_LAYER, NGW);
    { const float* x = a.in[IN_X]; bf16* B0 = (bf16*)(ws + WS_B0); float* ssq = (float*)(ws + WS_SSQ);
      for (int m0 = gw; m0 < M; m0 += 4 * NGW) { f32x4 v[4][4];
#pragma unroll
          for (int r = 0; r < 4; ++r) { const int mr = m0 + r * NGW, m = mr < M ? mr : m0; const f32x4* xr = (const f32x4*)(x + (size_t)m * D) + lane;
#pragma unroll
              for (int q = 0; q < 4; ++q) v[r][q] = xr[64 * q]; }
#pragma unroll
          for (int r = 0; r < 4; ++r) { const int m = m0 + r * NGW; if (m < M) { unsigned long long* o8 = (unsigned long long*)(B0 + (size_t)m * D) + lane; float t[4];
#pragma unroll
              for (int q = 0; q < 4; ++q) { t[q] = wave_sum(pg8::dot4(v[r][q])); o8[64 * q] = (unsigned long long)pk2(v[r][q][0], v[r][q][1]) | ((unsigned long long)pk2(v[r][q][2], v[r][q][3]) << 32); }
              if (lane < 16) { float val = 0.f; if (lane == 0) val = t[0]; if (lane == 4) val = t[1]; if (lane == 8) val = t[2]; if (lane == 12) val = t[3]; ssq[(size_t)m * 16 + lane] = val; } } } } }
    prologue_misc(a, gt, NGT);
}

namespace mx {
typedef const LAS bf16* lcp;
#define MFMA16(a, b, c) __builtin_amdgcn_mfma_f32_16x16x32_bf16((a), (b), (c), 0, 0, 0)
__device__ __forceinline__ bf16x8 frag(lcp base, int row, int stride, int k) { return *(const LAS bf16x8*)(base + row * stride + k); }
__device__ __forceinline__ bf16x8 frag2(lcp base, int row, int stride, int k) {
    typedef short s16x4 __attribute__((ext_vector_type(4)));
    const s16x4 lo = *(const LAS s16x4*)(base + row * stride + k), hi = *(const LAS s16x4*)(base + row * stride + k + 16);
    return (bf16x8){lo[0], lo[1], lo[2], lo[3], hi[0], hi[1], hi[2], hi[3]};
}
typedef __bf16 bf16x8c_ __attribute__((ext_vector_type(8)));
typedef float f32x8c_ __attribute__((ext_vector_type(8)));
__device__ __forceinline__ bf16x8 pack_pair(const f32x4 a, const f32x4 b) {
    const f32x8c_ v = {a[0], a[1], a[2], a[3], b[0], b[1], b[2], b[3]}; return __builtin_bit_cast(bf16x8, __builtin_convertvector(v, bf16x8c_));
}
__device__ __forceinline__ float lo16(unsigned w) { return __uint_as_float(w << 16); }
__device__ __forceinline__ float hi16(unsigned w) { return __uint_as_float(w & 0xffff0000u); }
__device__ __forceinline__ void unpack8(const v4u w, float (&x)[8]) { x[0] = lo16(w.x); x[1] = hi16(w.x); x[2] = lo16(w.y); x[3] = hi16(w.y); x[4] = lo16(w.z); x[5] = hi16(w.z); x[6] = lo16(w.w); x[7] = hi16(w.w); }
__device__ __forceinline__ v4u pack8(const float (&x)[8]) { v4u w; w.x = pg8::cvt_pk_bf16(x[0], x[1]); w.y = pg8::cvt_pk_bf16(x[2], x[3]); w.z = pg8::cvt_pk_bf16(x[4], x[5]); w.w = pg8::cvt_pk_bf16(x[6], x[7]); return w; }
__device__ __forceinline__ float silu_fast(float x) { return x * __builtin_amdgcn_rcpf(1.0f + __builtin_amdgcn_exp2f(-1.4426950408889634f * x)); }
#define WG_SYNC_L() do { asm volatile("s_waitcnt lgkmcnt(0)" ::: "memory"); __builtin_amdgcn_s_barrier(); asm volatile("" ::: "memory"); } while (0)
#define WG_SYNC() do { asm volatile("s_waitcnt vmcnt(0) lgkmcnt(0)" ::: "memory"); __builtin_amdgcn_s_barrier(); asm volatile("" ::: "memory"); } while (0)

constexpr int RET_C = 128;
__device__ __forceinline__ float ret_lg2(int h) { return __builtin_amdgcn_logf(1.0f - __builtin_amdgcn_exp2f(-(5.0f + (float)h))); }
__device__ __forceinline__ void ret_rope8(const bf16* zrow, const float* cs, const float* sn, int grp, float sc, float (&o1)[8], float (&o2)[8]) {
    float x1[8], x2[8]; unpack8(*(const v4u*)(zrow + 8 * grp), x1); unpack8(*(const v4u*)(zrow + 32 + 8 * grp), x2);
    const f32x4 c0 = *(const f32x4*)(cs + 8 * grp), c1 = *(const f32x4*)(cs + 8 * grp + 4), s0 = *(const f32x4*)(sn + 8 * grp), s1 = *(const f32x4*)(sn + 8 * grp + 4);
#pragma unroll
    for (int j = 0; j < 8; ++j) { const float c = j < 4 ? c0[j & 3] : c1[j & 3], s = j < 4 ? s0[j & 3] : s1[j & 3]; o1[j] = (x1[j] * c - x2[j] * s) * sc; o2[j] = (x1[j] * s + x2[j] * c) * sc; }
}
__device__ __forceinline__ void ret_pass1(int job, const bf16* Z, const float* rcs, const float* rsn, float* RST, LAS unsigned char* lds, int tid) {
    asm volatile("" : "+s"(job));
    const int lane = tid & 63, w = __builtin_amdgcn_readfirstlane(tid >> 6), r15 = lane & 15, g = lane >> 4;
    const int h = job & 3, n = (job >> 2) & 31, b = job >> 7; const size_t m0 = (size_t)b * SEQ + (size_t)n * RET_C; const float lg2 = ret_lg2(h);
    LAS bf16* kT = (LAS bf16*)lds; LAS bf16* vT = kT + 64 * 136;
    { const int row = tid & 127, grp = tid >> 7; const size_t m = m0 + row; float o1[8], o2[8];
      ret_rope8(Z + m * NZ + ZC_RK + 64 * h, rcs + m * 32, rsn + m * 32, grp, __builtin_amdgcn_exp2f(-(float)(row + 1) * lg2 - 3.0f), o1, o2);
#pragma unroll
      for (int j = 0; j < 8; ++j) { kT[(8 * grp + j) * 136 + row] = (bf16)f2bf(o1[j]); kT[(32 + 8 * grp + j) * 136 + row] = (bf16)f2bf(o2[j]); }
      const v4u v0 = *(const v4u*)(Z + m * NZ + ZC_RV + 64 * h + 16 * grp), v1 = *(const v4u*)(Z + m * NZ + ZC_RV + 64 * h + 16 * grp + 8);
      const unsigned vw[8] = {v0.x, v0.y, v0.z, v0.w, v1.x, v1.y, v1.z, v1.w};
#pragma unroll
      for (int j = 0; j < 8; ++j) { vT[(16 * grp + 2 * j) * 136 + row] = (bf16)(vw[j] & 0xffffu); vT[(16 * grp + 2 * j + 1) * 136 + row] = (bf16)(vw[j] >> 16); } }
    WG_SYNC();
    const int et = w & 3, dt0 = (w >> 2) * 2; f32x4 acc0 = {0.f, 0.f, 0.f, 0.f}, acc1 = {0.f, 0.f, 0.f, 0.f};
#pragma unroll
    for (int kk = 0; kk < 4; ++kk) { const bf16x8 a = frag(vT, 16 * et + r15, 136, 32 * kk + 8 * g);
        acc0 = MFMA16(a, frag(kT, 16 * dt0 + r15, 136, 32 * kk + 8 * g), acc0); acc1 = MFMA16(a, frag(kT, 16 * dt0 + 16 + r15, 136, 32 * kk + 8 * g), acc1); }
    const float gc = __builtin_amdgcn_exp2f((float)RET_C * lg2); float* dst = RST + ((size_t)((b * 4 + h) * 32 + n) * 64 + 16 * et + 4 * g) * 64 + 16 * dt0 + r15;
#pragma unroll
    for (int j = 0; j < 4; ++j) { dst[j * 64] = acc0[j] * gc; dst[j * 64 + 16] = acc1[j] * gc; }
    WG_SYNC();
}
__device__ __forceinline__ void ret_scan(float* RST, int gt) {
    if (gt >= 16 * 4096) return;
    const int bh = gt >> 12, idx = gt & 4095, h = bh & 3; const float gc = __builtin_amdgcn_exp2f((float)RET_C * ret_lg2(h)); float* p = RST + (size_t)bh * 32 * 4096 + idx; float run = 0.f;
    float t[32];
#pragma unroll
    for (int i = 0; i < 32; ++i) t[i] = p[(size_t)i * 4096];
#pragma unroll
    for (int i = 0; i < 32; ++i) { p[(size_t)i * 4096] = run; run = gc * run + t[i]; }
}
__device__ __forceinline__ void ret_pass3(int job, const bf16* Z, const float* rcs, const float* rsn, const float* RST, const float* normg, bf16* Y, LAS unsigned char* lds, int tid) {
    asm volatile("" : "+s"(job));
    const int lane = tid & 63, w = __builtin_amdgcn_readfirstlane(tid >> 6), r15 = lane & 15, g = lane >> 4;
    const int h = job & 3, n = (job >> 2) & 31, b = job >> 7; const size_t m0 = (size_t)b * SEQ + (size_t)n * RET_C; const float lg2 = ret_lg2(h);
    LAS bf16* qs = (LAS bf16*)lds; LAS bf16* ks = qs + 128 * 72; LAS bf16* vT = ks + 128 * 72; LAS bf16* sT = vT + 64 * 136;
    { const int row = tid & 127, grp = tid >> 7; const size_t m = m0 + row; float o1[8], o2[8];
      ret_rope8(Z + m * NZ + ZC_RQ + 64 * h, rcs + m * 32, rsn + m * 32, grp, __builtin_amdgcn_exp2f((float)(row + 1) * lg2), o1, o2);
      *(LAS v4u*)(qs + row * 72 + 8 * grp) = pack8(o1); *(LAS v4u*)(qs + row * 72 + 32 + 8 * grp) = pack8(o2);
      ret_rope8(Z + m * NZ + ZC_RK + 64 * h, rcs + m * 32, rsn + m * 32, grp, __builtin_amdgcn_exp2f(-(float)(row + 1) * lg2 - 3.0f), o1, o2);
      *(LAS v4u*)(ks + row * 72 + 8 * grp) = pack8(o1); *(LAS v4u*)(ks + row * 72 + 32 + 8 * grp) = pack8(o2);
      const v4u v0 = *(const v4u*)(Z + m * NZ + ZC_RV + 64 * h + 16 * grp), v1 = *(const v4u*)(Z + m * NZ + ZC_RV + 64 * h + 16 * grp + 8);
      const unsigned vw[8] = {v0.x, v0.y, v0.z, v0.w, v1.x, v1.y, v1.z, v1.w};
#pragma unroll
      for (int j = 0; j < 8; ++j) { vT[(16 * grp + 2 * j) * 136 + row] = (bf16)(vw[j] & 0xffffu); vT[(16 * grp + 2 * j + 1) * 136 + row] = (bf16)(vw[j] >> 16); }
      const int e = tid >> 3, d8 = (tid & 7) * 8; const float* sp = RST + ((size_t)((b * 4 + h) * 32 + n) * 64 + e) * 64 + d8; const f32x4 a0 = *(const f32x4*)sp, a1 = *(const f32x4*)(sp + 4);
      const float sv[8] = {a0[0], a0[1], a0[2], a0[3], a1[0], a1[1], a1[2], a1[3]}; *(LAS v4u*)(sT + e * 72 + d8) = pack8(sv); }
    const size_t mrow = m0 + 16 * w + r15; v2u gwp[4]; f32x4 ngp[4];
#pragma unroll
    for (int et = 0; et < 4; ++et) { gwp[et] = *(const v2u*)(Z + mrow * NZ + ZC_RG + 64 * h + 16 * et + 4 * g); ngp[et] = *(const f32x4*)(normg + 64 * h + 16 * et + 4 * g); }
    WG_SYNC();
    bf16x8 qf[2]; qf[0] = frag(qs, 16 * w + r15, 72, 8 * g); qf[1] = frag(qs, 16 * w + r15, 72, 32 + 8 * g);
    f32x4 Dt[8];
#pragma unroll
    for (int sb = 0; sb < 8; ++sb) { f32x4 acc = {0.f, 0.f, 0.f, 0.f};
        if (sb <= w) { acc = MFMA16(frag(ks, 16 * sb + r15, 72, 8 * g), qf[0], acc); acc = MFMA16(frag(ks, 16 * sb + r15, 72, 32 + 8 * g), qf[1], acc);
            if (sb == w) {
#pragma unroll
                for (int j = 0; j < 4; ++j) if (4 * g + j > r15) acc[j] = 0.f; } }
        Dt[sb] = acc; }
    f32x4 O[4];
#pragma unroll
    for (int et = 0; et < 4; ++et) O[et] = (f32x4){0.f, 0.f, 0.f, 0.f};
#pragma unroll
    for (int k2 = 0; k2 < 4; ++k2) if (2 * k2 <= w) { const bf16x8 pb = pack_pair(Dt[2 * k2], Dt[2 * k2 + 1]);
#pragma unroll
        for (int et = 0; et < 4; ++et) O[et] = MFMA16(frag2(vT, 16 * et + r15, 136, 32 * k2 + 4 * g), pb, O[et]); }
#pragma unroll
    for (int kk = 0; kk < 2; ++kk)
#pragma unroll
        for (int et = 0; et < 4; ++et) O[et] = MFMA16(frag(sT, 16 * et + r15, 72, 32 * kk + 8 * g), qf[kk], O[et]);
    float s1 = 0.f;
#pragma unroll
    for (int et = 0; et < 4; ++et) s1 += pg8::sum4(O[et]);
    s1 = pg8::fq_sum(s1, lane); const float mean = s1 * (1.0f / 64.0f); float s2 = 0.f;
#pragma unroll
    for (int et = 0; et < 4; ++et) { O[et] = O[et] - mean; s2 += pg8::dot4(O[et]); }
    s2 = pg8::fq_sum(s2, lane); const float rstd = __builtin_amdgcn_rsqf(s2 * (1.0f / 64.0f) + 1e-6f);
    const size_t m = m0 + 16 * w + r15;
#pragma unroll
    for (int et = 0; et < 4; ++et) { const int e = 16 * et + 4 * g; const v2u gw = gwp[et]; const f32x4 ng = ngp[et];
        v2u o; o.x = pg8::cvt_pk_bf16(O[et][0] * rstd * ng[0] * silu_fast(lo16(gw.x)), O[et][1] * rstd * ng[1] * silu_fast(hi16(gw.x)));
        o.y = pg8::cvt_pk_bf16(O[et][2] * rstd * ng[2] * silu_fast(lo16(gw.y)), O[et][3] * rstd * ng[3] * silu_fast(hi16(gw.y)));
        *(v2u*)(Y + m * 1024 + 768 + 64 * h + e) = o; }
    WG_SYNC();
}

__device__ __forceinline__ float hg_lb(const float* lblog, int l, int ch) {
    const float x0 = lblog[ch], x1 = lblog[512 + ch], x2 = lblog[1024 + ch], x3 = lblog[1536 + ch]; const float mx_ = fmaxf(fmaxf(x0, x1), fmaxf(x2, x3));
    const float e0 = __expf(x0 - mx_), e1 = __expf(x1 - mx_), e2 = __expf(x2 - mx_), e3 = __expf(x3 - mx_);
    return ((l >= 1 ? e1 : 0.f) + (l >= 2 ? e2 : 0.f) + (l >= 3 ? e3 : 0.f)) / (e0 + e1 + e2 + e3);
}
__device__ __forceinline__ void hg_lb8(const float* lblog, int l, int ch, float (&lb)[8]) {
    f32x4 x[4][2];
#pragma unroll
    for (int r = 0; r < 4; ++r) { x[r][0] = *(const f32x4*)(lblog + 512 * r + ch); x[r][1] = *(const f32x4*)(lblog + 512 * r + ch + 4); }
#pragma unroll
    for (int j = 0; j < 8; ++j) { const float x0 = x[0][j >> 2][j & 3], x1 = x[1][j >> 2][j & 3], x2 = x[2][j >> 2][j & 3], x3 = x[3][j >> 2][j & 3]; const float mx_ = fmaxf(fmaxf(x0, x1), fmaxf(x2, x3));
        const float e0 = __expf(x0 - mx_), e1 = __expf(x1 - mx_), e2 = __expf(x2 - mx_), e3 = __expf(x3 - mx_);
        lb[j] = ((l >= 1 ? e1 : 0.f) + (l >= 2 ? e2 : 0.f) + (l >= 3 ? e3 : 0.f)) / (e0 + e1 + e2 + e3); }
}
__device__ __forceinline__ void hg_lb8t(const float* hlb, int ch, float (&lb)[8]) {
    const f32x4 a0 = *(const f32x4*)(hlb + ch), a1 = *(const f32x4*)(hlb + ch + 4);
    lb[0] = a0[0]; lb[1] = a0[1]; lb[2] = a0[2]; lb[3] = a0[3]; lb[4] = a1[0]; lb[5] = a1[1]; lb[6] = a1[2]; lb[7] = a1[3];
}
__device__ __forceinline__ void hg_gates8(const v4u (&fw)[4], const float (&lb)[8], LAS float* T, int kc, int tq, float (&bc)[4][8], float (&kk)[4][8], float (&bmid)[8], float (&blast)[8]) {
    float run[8];
#pragma unroll
    for (int j = 0; j < 8; ++j) run[j] = 0.f;
#pragma unroll
    for (int i = 0; i < 4; ++i) { float f[8]; unpack8(fw[i], f);
#pragma unroll
        for (int j = 0; j < 8; ++j) { const float fg = lb[j] + (1.0f - lb[j]) * __builtin_amdgcn_rcpf(1.0f + __builtin_amdgcn_exp2f(-1.4426950408889634f * f[j]));
            kk[i][j] = 1.0f - fg; run[j] += __builtin_amdgcn_logf(fg); bc[i][j] = run[j]; } }
    *(LAS f32x4*)(T + tq * 128 + 8 * kc) = (f32x4){run[0], run[1], run[2], run[3]}; *(LAS f32x4*)(T + tq * 128 + 8 * kc + 4) = (f32x4){run[4], run[5], run[6], run[7]};
    WG_SYNC_L();
    float off[8];
#pragma unroll
    for (int j = 0; j < 8; ++j) { off[j] = 0.f; bmid[j] = 0.f; blast[j] = 0.f; }
#pragma unroll
    for (int t2 = 0; t2 < 16; ++t2) { const f32x4 a0 = *(const LAS f32x4*)(T + t2 * 128 + 8 * kc), a1 = *(const LAS f32x4*)(T + t2 * 128 + 8 * kc + 4);
#pragma unroll
        for (int j = 0; j < 8; ++j) { const float v = j < 4 ? a0[j & 3] : a1[j & 3]; if (t2 < tq) off[j] += v; if (t2 < 8) bmid[j] += v; blast[j] += v; } }
#pragma unroll
    for (int i = 0; i < 4; ++i)
#pragma unroll
        for (int j = 0; j < 8; ++j) bc[i][j] += off[j];
}
__device__ __forceinline__ void hg_store_vT(const v4u v0, const v4u v1, int u, LAS bf16* vT) {
    const int row = u & 63, grp = u >> 6; const unsigned vw[8] = {v0.x, v0.y, v0.z, v0.w, v1.x, v1.y, v1.z, v1.w};
#pragma unroll
    for (int j = 0; j < 8; ++j) { vT[(16 * grp + 2 * j) * 72 + row] = (bf16)(vw[j] & 0xffffu); vT[(16 * grp + 2 * j + 1) * 72 + row] = (bf16)(vw[j] >> 16); }
}
__device__ __forceinline__ void hg_pass1(int pair, const bf16* Z, const float* hlb, bf16* HST, float* HDC, LAS unsigned char* lds, int tid) {
    asm volatile("" : "+s"(pair));
    const int lane = tid & 63, w = __builtin_amdgcn_readfirstlane(tid >> 6), r15 = lane & 15, g = lane >> 4, half = w >> 2, wq = w & 3, u = tid & 255, kc = u & 15, tq = u >> 4;
    const int job = 2 * pair + half, h = job & 3, c = (job >> 2) & 63, b = job >> 8; const size_t m0 = (size_t)b * SEQ + (size_t)c * 64;
    LAS float* T = (LAS float*)lds + half * 2048; LAS bf16* koT = (LAS bf16*)(lds + 16384) + half * (128 * 72 + 64 * 72); LAS bf16* vT = koT + 128 * 72;
    v4u fw[4];
#pragma unroll
    for (int i = 0; i < 4; ++i) fw[i] = *(const v4u*)(Z + (m0 + 4 * tq + i) * NZ + ZC_HF + 128 * h + 8 * kc);
    const bf16* vp = Z + (m0 + (u & 63)) * NZ + ZC_HI + 64 * h + 16 * (u >> 6); const v4u v0 = *(const v4u*)vp, v1 = *(const v4u*)(vp + 8);
    float lb[8]; hg_lb8t(hlb, 128 * h + 8 * kc, lb);
    float bc[4][8], kk[4][8], bmid[8], blast[8]; hg_gates8(fw, lb, T, kc, tq, bc, kk, bmid, blast);
#pragma unroll
    for (int j = 0; j < 8; ++j) { v2u o; o.x = pg8::cvt_pk_bf16(kk[0][j] * __builtin_amdgcn_exp2f(blast[j] - bc[0][j]), kk[1][j] * __builtin_amdgcn_exp2f(blast[j] - bc[1][j])); o.y = pg8::cvt_pk_bf16(kk[2][j] * __builtin_amdgcn_exp2f(blast[j] - bc[2][j]), kk[3][j] * __builtin_amdgcn_exp2f(blast[j] - bc[3][j]));
        *(LAS v2u*)(koT + (8 * kc + j) * 72 + 4 * tq) = o; }
    if (tq == 0) { float* dp = HDC + (size_t)((b * 4 + h) * 64 + c) * 128 + 8 * kc; *(f32x4*)dp = (f32x4){__builtin_amdgcn_exp2f(blast[0]), __builtin_amdgcn_exp2f(blast[1]), __builtin_amdgcn_exp2f(blast[2]), __builtin_amdgcn_exp2f(blast[3])}; *(f32x4*)(dp + 4) = (f32x4){__builtin_amdgcn_exp2f(blast[4]), __builtin_amdgcn_exp2f(blast[5]), __builtin_amdgcn_exp2f(blast[6]), __builtin_amdgcn_exp2f(blast[7])}; }
    hg_store_vT(v0, v1, u, vT);
    WG_SYNC_L();
    f32x4 acc[4][2];
#pragma unroll
    for (int et = 0; et < 4; ++et) { acc[et][0] = (f32x4){0.f, 0.f, 0.f, 0.f}; acc[et][1] = (f32x4){0.f, 0.f, 0.f, 0.f}; }
#pragma unroll
    for (int k2 = 0; k2 < 2; ++k2) { const bf16x8 b0 = frag(koT, 32 * wq + r15, 72, 32 * k2 + 8 * g), b1 = frag(koT, 32 * wq + 16 + r15, 72, 32 * k2 + 8 * g);
#pragma unroll
        for (int et = 0; et < 4; ++et) { const bf16x8 a = frag(vT, 16 * et + r15, 72, 32 * k2 + 8 * g); acc[et][0] = MFMA16(a, b0, acc[et][0]); acc[et][1] = MFMA16(a, b1, acc[et][1]); } }
    bf16* dst = HST + (size_t)((b * 4 + h) * 64 + c) * 8192 + 32 * wq + r15;
#pragma unroll
    for (int et = 0; et < 4; ++et)
#pragma unroll
        for (int j = 0; j < 4; ++j) { dst[(16 * et + 4 * g + j) * 128] = (bf16)f2bf(acc[et][0][j]); dst[(16 * et + 4 * g + j) * 128 + 16] = (bf16)f2bf(acc[et][1][j]); }
    WG_SYNC_L();
}
__device__ __forceinline__ void hg_scan(bf16* HST, const float* HDC, int gt) {
    const int bh = gt >> 12, idx = (gt & 4095) * 2, k = idx & 127; unsigned* p = (unsigned*)(HST + (size_t)bh * 64 * 8192 + idx); const float* dp = HDC + (size_t)bh * 64 * 128 + k; float r0 = 0.f, r1 = 0.f;
#pragma unroll 1
    for (int c0 = 0; c0 < 64; c0 += 16) { unsigned t[16]; float d0[16], d1[16];
#pragma unroll
        for (int i = 0; i < 16; ++i) { t[i] = p[(size_t)(c0 + i) * 4096]; const float2 dd = *(const float2*)(dp + (c0 + i) * 128); d0[i] = dd.x; d1[i] = dd.y; }
#pragma unroll
        for (int i = 0; i < 16; ++i) { p[(size_t)(c0 + i) * 4096] = pg8::cvt_pk_bf16(r0, r1); r0 = d0[i] * r0 + lo16(t[i]); r1 = d1[i] * r1 + hi16(t[i]); } }
}
__device__ __forceinline__ void hg_pass3(int pair, const bf16* Z, const float* hlb, const bf16* HST, const float* normg, bf16* Y, LAS unsigned char* lds, int tid) {
    asm volatile("" : "+s"(pair));
    const int lane = tid & 63, w = __builtin_amdgcn_readfirstlane(tid >> 6), r15 = lane & 15, g = lane >> 4, half = w >> 2, tb = w & 3, u = tid & 255, kc = u & 15, tq = u >> 4;
    const int job = 2 * pair + half, h = job & 3, c = (job >> 2) & 63, b = job >> 8; const size_t m0 = (size_t)b * SEQ + (size_t)c * 64;
    LAS bf16* qs = (LAS bf16*)lds + half * (3 * 64 * 136 + 64 * 72); LAS bf16* ks = qs + 64 * 136; LAS bf16* sT = ks + 64 * 136; LAS bf16* vT = sT + 64 * 136;
    LAS float* T = (LAS float*)qs;
    v4u fw[4], qw[4];
#pragma unroll
    for (int i = 0; i < 4; ++i) { const bf16* zr = Z + (m0 + 4 * tq + i) * NZ + 128 * h + 8 * kc; fw[i] = *(const v4u*)(zr + ZC_HF); qw[i] = *(const v4u*)(zr + ZC_HQ); }
    const bf16* vp = Z + (m0 + (u & 63)) * NZ + ZC_HI + 64 * h + 16 * (u >> 6); const v4u v0 = *(const v4u*)vp, v1 = *(const v4u*)(vp + 8);
    v4u st[4];
#pragma unroll
    for (int i = 0; i < 4; ++i) st[i] = *(const v4u*)(HST + (size_t)((b * 4 + h) * 64 + c) * 8192 + ((u >> 4) + 16 * i) * 128 + 8 * kc);
    const size_t mrow = m0 + 16 * tb + r15; v2u gw[4]; f32x4 ng[4];
#pragma unroll
    for (int et = 0; et < 4; ++et) { gw[et] = *(const v2u*)(Z + mrow * NZ + ZC_HG + 64 * h + 16 * et + 4 * g); ng[et] = *(const f32x4*)(normg + 64 * h + 16 * et + 4 * g); }
    float lb[8]; hg_lb8t(hlb, 128 * h + 8 * kc, lb);
    { float bc[4][8], kk[4][8], bmid[8], blast[8]; hg_gates8(fw, lb, T, kc, tq, bc, kk, bmid, blast);
      WG_SYNC_L();
#pragma unroll
      for (int i = 0; i < 4; ++i) { float q[8], xq[8], xk[8]; unpack8(qw[i], q);
#pragma unroll
          for (int j = 0; j < 8; ++j) { xq[j] = q[j] * __builtin_amdgcn_exp2f(bc[i][j] - bmid[j]); xk[j] = kk[i][j] * __builtin_amdgcn_exp2f(bmid[j] - bc[i][j]); }
          *(LAS v4u*)(qs + (4 * tq + i) * 136 + 8 * kc) = pack8(xq); *(LAS v4u*)(ks + (4 * tq + i) * 136 + 8 * kc) = pack8(xk); }
      float em[8];
#pragma unroll
      for (int j = 0; j < 8; ++j) em[j] = __builtin_amdgcn_exp2f(bmid[j]);
#pragma unroll
      for (int i = 0; i < 4; ++i) { float sv[8]; unpack8(st[i], sv);
#pragma unroll
          for (int j = 0; j < 8; ++j) sv[j] *= em[j];
          *(LAS v4u*)(sT + ((u >> 4) + 16 * i) * 136 + 8 * kc) = pack8(sv); } }
    hg_store_vT(v0, v1, u, vT);
    WG_SYNC_L();
    bf16x8 qf[4];
#pragma unroll
    for (int kq = 0; kq < 4; ++kq) qf[kq] = frag(qs, 16 * tb + r15, 136, 32 * kq + 8 * g);
    f32x4 Dt[4];
#pragma unroll
    for (int sb = 0; sb < 4; ++sb) { f32x4 acc = {0.f, 0.f, 0.f, 0.f};
        if (sb <= tb) {
#pragma unroll
            for (int kq = 0; kq < 4; ++kq) acc = MFMA16(frag(ks, 16 * sb + r15, 136, 32 * kq + 8 * g), qf[kq], acc);
            if (sb == tb) {
#pragma unroll
                for (int j = 0; j < 4; ++j) if (4 * g + j > r15) acc[j] = 0.f; } }
        Dt[sb] = acc; }
    f32x4 O[4];
#pragma unroll
    for (int et = 0; et < 4; ++et) O[et] = (f32x4){0.f, 0.f, 0.f, 0.f};
#pragma unroll
    for (int k2 = 0; k2 < 2; ++k2) if (2 * k2 <= tb) { const bf16x8 pb = pack_pair(Dt[2 * k2], Dt[2 * k2 + 1]);
#pragma unroll
        for (int et = 0; et < 4; ++et) O[et] = MFMA16(frag2(vT, 16 * et + r15, 72, 32 * k2 + 4 * g), pb, O[et]); }
#pragma unroll
    for (int kq = 0; kq < 4; ++kq)
#pragma unroll
        for (int et = 0; et < 4; ++et) O[et] = MFMA16(frag(sT, 16 * et + r15, 136, 32 * kq + 8 * g), qf[kq], O[et]);
    float s2 = 0.f;
#pragma unroll
    for (int et = 0; et < 4; ++et) s2 += pg8::dot4(O[et]);
    s2 = pg8::fq_sum(s2, lane); const float rstd = __builtin_amdgcn_rsqf(s2 * (1.0f / 64.0f) + 1e-6f);
#pragma unroll
    for (int et = 0; et < 4; ++et) { const int e = 16 * et + 4 * g;
        v2u o; o.x = pg8::cvt_pk_bf16(O[et][0] * rstd * ng[et][0] * silu_fast(lo16(gw[et].x)), O[et][1] * rstd * ng[et][1] * silu_fast(hi16(gw[et].x)));
        o.y = pg8::cvt_pk_bf16(O[et][2] * rstd * ng[et][2] * silu_fast(lo16(gw[et].y)), O[et][3] * rstd * ng[et][3] * silu_fast(hi16(gw[et].y)));
        *(v2u*)(Y + mrow * 1024 + 512 + 64 * h + e) = o; }
    WG_SYNC_L();
}
__device__ __forceinline__ float gelu_as(float v) {
    const float t = __builtin_amdgcn_rcpf(fabsf(v) * 0.2316418882f + 1.0f);
    float q = t * 0.5307027145f + (-0.7265760135f); q = q * t + 0.7107068705f; q = q * t + (-0.142248368f); q = q * t + 0.127414796f; q = q * t;
    const float m = v * (q * __builtin_amdgcn_exp2f(v * v * -0.72134752044f));
    return v < 0.f ? m : v - m;
}
__device__ __forceinline__ float row16_sum(float v) {
    v += __builtin_bit_cast(float, __builtin_amdgcn_update_dpp(0, __builtin_bit_cast(int, v), 0xB1, 0xF, 0xF, false));
    v += __builtin_bit_cast(float, __builtin_amdgcn_update_dpp(0, __builtin_bit_cast(int, v), 0x4E, 0xF, 0xF, false));
    v += __builtin_bit_cast(float, __builtin_amdgcn_update_dpp(0, __builtin_bit_cast(int, v), 0x141, 0xF, 0xF, false));
    v += __builtin_bit_cast(float, __builtin_amdgcn_update_dpp(0, __builtin_bit_cast(int, v), 0x140, 0xF, 0xF, false));
    return v;
}
__device__ __forceinline__ void sg_job(int job, const bf16* Z, const float* lng, const bf16* Wsg  , const float* bs  , bf16* Y, LAS unsigned char* lds, int tid) {
    asm volatile("" : "+s"(job));
    const int lane = tid & 63, w = __builtin_amdgcn_readfirstlane(tid >> 6), r15 = lane & 15, g = lane >> 4;
    const int hh = job & 1; const size_t m0 = (size_t)(job >> 1) * 128;
    LAS bf16* vT = (LAS bf16*)lds;
    const int hl = w >> 2, tq = w & 3, h = 2 * hh + hl; const bf16* Wh = Wsg + (size_t)h * 128 * 128;
    v4u zv[4][2];
#pragma unroll
    for (int p = 0; p < 4; ++p) { const bf16* zr = Z + (m0 + 16 * w + 4 * g + p) * NZ + ZC_V + 16 * r15; zv[p][0] = *(const v4u*)zr; zv[p][1] = *(const v4u*)(zr + 8); }
    f32x4 gl[4];
#pragma unroll
    for (int c4 = 0; c4 < 4; ++c4) gl[c4] = *(const f32x4*)(lng + 16 * r15 + 4 * c4);
    bf16x8 wf[2][4]; v2u uw[2][4]; float bias[2];
#pragma unroll
    for (int i = 0; i < 2; ++i) { const int t = 16 * (2 * tq + i) + r15; bias[i] = bs[h * 128 + t];
#pragma unroll
        for (int kk = 0; kk < 4; ++kk) wf[i][kk] = *(const bf16x8*)(Wh + (size_t)t * 128 + 32 * kk + 8 * g);
#pragma unroll
        for (int dt = 0; dt < 4; ++dt) uw[i][dt] = *(const v2u*)(Z + (m0 + t) * NZ + ZC_U + 128 * hh + 64 * hl + 16 * dt + 4 * g); }
    float i256 = 1.0f / 256.0f; asm volatile("" : "+s"(i256));
    { unsigned ys[16][2];
      float yv[2][16];
#pragma unroll
      for (int p = 0; p < 4; ++p) { float x[16]; unpack8(zv[p][0], *(float(*)[8])&x[0]); unpack8(zv[p][1], *(float(*)[8])&x[8]); float s1 = 0.f, s2 = 0.f;
#pragma unroll
          for (int c = 0; c < 16; ++c) { x[c] = gelu_as(x[c]); s1 += x[c]; s2 += x[c] * x[c]; }
          s1 = row16_sum(s1); s2 = row16_sum(s2); const float mean = s1 * i256, rstd = __builtin_amdgcn_rsqf(fmaxf(s2 * i256 - mean * mean, 0.f) + 1e-6f);
#pragma unroll
          for (int c = 0; c < 16; ++c) yv[p & 1][c] = (x[c] - mean) * rstd * gl[c >> 2][c & 3];
          if (p & 1) {
#pragma unroll
              for (int c = 0; c < 16; ++c) ys[c][p >> 1] = pg8::cvt_pk_bf16(yv[0][c], yv[1][c]); } }
      if ((r15 >> 3) == hh) { const int cq = r15 & 7;
#pragma unroll
          for (int c = 0; c < 16; ++c) { v2u o; o.x = ys[c][0]; o.y = ys[c][1]; *(LAS v2u*)(vT + (16 * cq + c) * 136 + ((16 * w + 4 * g) ^ (8 * cq))) = o; } } }
    WG_SYNC_L();
    f32x4 acc[2][4];
#pragma unroll
    for (int i = 0; i < 2; ++i)
#pragma unroll
        for (int dt = 0; dt < 4; ++dt) acc[i][dt] = (f32x4){0.f, 0.f, 0.f, 0.f};
#pragma unroll
    for (int i = 0; i < 2; ++i) { const int tb = 2 * tq + i;
#pragma unroll
        for (int kk = 0; kk < 4; ++kk) if (2 * kk <= tb) {
#pragma unroll
            for (int dt = 0; dt < 4; ++dt) acc[i][dt] = MFMA16(frag(vT, 64 * hl + 16 * dt + r15, 136, (32 * kk + 8 * g) ^ (8 * ((4 * hl + dt) & 7))), wf[i][kk], acc[i][dt]); } }
#pragma unroll
    for (int i = 0; i < 2; ++i) { const int t = 16 * (2 * tq + i) + r15; const size_t m = m0 + t;
#pragma unroll
        for (int dt = 0; dt < 4; ++dt) { const int d = 128 * hh + 64 * hl + 16 * dt + 4 * g; const v2u u2 = uw[i][dt];
            v2u o; o.x = pg8::cvt_pk_bf16(gelu_as(lo16(u2.x)) * (acc[i][dt][0] + bias[i]), gelu_as(hi16(u2.x)) * (acc[i][dt][1] + bias[i]));
            o.y = pg8::cvt_pk_bf16(gelu_as(lo16(u2.y)) * (acc[i][dt][2] + bias[i]), gelu_as(hi16(u2.y)) * (acc[i][dt][3] + bias[i]));
            *(v2u*)(Y + m * 1024 + 256 + d) = o; } }
    WG_SYNC_L();
}

__device__ __forceinline__ void mla_qblock(int b, int h, int qb, const bf16* QKV, bf16* Y, LAS unsigned char* lds, int tid) {
    const int lane = tid & 63, w = __builtin_amdgcn_readfirstlane(tid >> 6), r15 = lane & 15, g = lane >> 4;
    LAS bf16* Kb = (LAS bf16*)lds; LAS bf16* Vt = Kb + 2 * 64 * 104;
    const size_t mb = (size_t)b * SEQ; const int t_row = 128 * qb + 16 * w + r15;
    const int ntile = 2 * (qb + 1);
    bf16x8 qf[3];
#pragma unroll
    for (int kk = 0; kk < 3; ++kk) qf[kk] = *(const bf16x8*)(QKV + (mb + t_row) * 1024 + QC_Q + 96 * h + 32 * kk + 8 * g);
    const int srow = tid >> 3, spc = tid & 7, rrow = (tid >> 2) & 63, rpc = tid & 3;
    v4u ldk, ldr, ldv;
#define MLA_LOAD(kt) do { const bf16* kp = QKV + (mb + 64 * (kt) + srow) * 1024; ldk = *(const v4u*)(kp + QC_KN + 64 * h + 8 * spc); ldv = *(const v4u*)(QKV + (mb + 64 * (kt) + lane) * 1024 + QC_V + 64 * h + 8 * w); \
        if (tid < 256) ldr = *(const v4u*)(QKV + (mb + 64 * (kt) + rrow) * 1024 + QC_KR + 8 * rpc); } while (0)
#define MLA_STORE(buf) do { LAS bf16* kd = Kb + (buf) * 64 * 104; LAS bf16* vd = Vt + (buf) * 64 * 72; *(LAS v4u*)(kd + srow * 104 + 8 * spc) = ldk; if (tid < 256) *(LAS v4u*)(kd + rrow * 104 + 64 + 8 * rpc) = ldr; \
        const unsigned vw_[4] = {ldv.x, ldv.y, ldv.z, ldv.w}; _Pragma("unroll") for (int j_ = 0; j_ < 4; ++j_) { vd[(8 * w + 2 * j_) * 72 + lane] = (bf16)(vw_[j_] & 0xffffu); vd[(8 * w + 2 * j_ + 1) * 72 + lane] = (bf16)(vw_[j_] >> 16); } } while (0)
    MLA_LOAD(0); MLA_STORE(0); WG_SYNC();
    float m_run = -INFINITY, l_run = 0.f; f32x4 O[4];
#pragma unroll
    for (int et = 0; et < 4; ++et) O[et] = (f32x4){0.f, 0.f, 0.f, 0.f};
    const int t_lo = 128 * qb + 16 * w;
    for (int kt = 0; kt < ntile; ++kt) {
        if (kt + 1 < ntile) MLA_LOAD(kt + 1);
        if (64 * kt <= t_lo + 15) {
            lcp kb = Kb + (kt & 1) * 64 * 104; lcp vb = Vt + (kt & 1) * 64 * 72;
            f32x4 S[4];
#pragma unroll
            for (int sb = 0; sb < 4; ++sb) { f32x4 acc = {0.f, 0.f, 0.f, 0.f};
#pragma unroll
                for (int kk = 0; kk < 3; ++kk) acc = MFMA16(frag(kb, 16 * sb + r15, 104, 32 * kk + 8 * g), qf[kk], acc);
                S[sb] = acc; }
            if (64 * kt + 63 > t_lo) {
#pragma unroll
                for (int sb = 0; sb < 4; ++sb)
#pragma unroll
                    for (int j = 0; j < 4; ++j) if (64 * kt + 16 * sb + 4 * g + j > t_row) S[sb][j] = -INFINITY; }
            float mx_ = fmaxf(fmaxf(fmaxf(S[0][0], S[0][1]), fmaxf(S[0][2], S[0][3])), fmaxf(fmaxf(S[1][0], S[1][1]), fmaxf(S[1][2], S[1][3])));
            mx_ = fmaxf(mx_, fmaxf(fmaxf(fmaxf(S[2][0], S[2][1]), fmaxf(S[2][2], S[2][3])), fmaxf(fmaxf(S[3][0], S[3][1]), fmaxf(S[3][2], S[3][3]))));
            mx_ = fmaxf(mx_, __shfl_xor(mx_, 16)); mx_ = fmaxf(mx_, __shfl_xor(mx_, 32));
            const float m_new = fmaxf(m_run, mx_), corr = __builtin_amdgcn_exp2f(m_run - m_new); m_run = m_new; float ps = 0.f;
#pragma unroll
            for (int sb = 0; sb < 4; ++sb)
#pragma unroll
                for (int j = 0; j < 4; ++j) { const float p = __builtin_amdgcn_exp2f(S[sb][j] - m_new); S[sb][j] = p; ps += p; }
            l_run = l_run * corr + ps;
#pragma unroll
            for (int et = 0; et < 4; ++et) O[et] = O[et] * corr;
#pragma unroll
            for (int k2 = 0; k2 < 2; ++k2) { const bf16x8 pb = pack_pair(S[2 * k2], S[2 * k2 + 1]);
#pragma unroll
                for (int et = 0; et < 4; ++et) O[et] = MFMA16(frag2(vb, 16 * et + r15, 72, 32 * k2 + 4 * g), pb, O[et]); }
        }
        if (kt + 1 < ntile) MLA_STORE((kt + 1) & 1);
        WG_SYNC();
    }
#undef MLA_LOAD
#undef MLA_STORE
    l_run += __shfl_xor(l_run, 16); l_run += __shfl_xor(l_run, 32); const float inv = 1.0f / l_run;
#pragma unroll
    for (int et = 0; et < 4; ++et) { v2u o; o.x = pg8::cvt_pk_bf16(O[et][0] * inv, O[et][1] * inv); o.y = pg8::cvt_pk_bf16(O[et][2] * inv, O[et][3] * inv);
        *(v2u*)(Y + (mb + t_row) * 1024 + 64 * h + 16 * et + 4 * g) = o; }
}
typedef float f32x16 __attribute__((ext_vector_type(16)));
typedef short v4i16_t __attribute__((ext_vector_type(4)));
#define MFMA32(a, b, c) __builtin_amdgcn_mfma_f32_32x32x16_bf16((a), (b), (c), 0, 0, 0)
__device__ __forceinline__ bf16x8 vtr2(const LAS unsigned char* p0, const LAS unsigned char* p1) {
    typedef short s16x4_ __attribute__((ext_vector_type(4))); s16x4_ lo, hi; const unsigned a0 = (unsigned)(uintptr_t)p0, a1 = (unsigned)(uintptr_t)p1;
    asm volatile("ds_read_b64_tr_b16 %0, %2\n\tds_read_b64_tr_b16 %1, %3\n\ts_waitcnt lgkmcnt(0)" : "=&v"(lo), "=&v"(hi) : "v"(a0), "v"(a1) : "memory");
    return (bf16x8){lo[0], lo[1], lo[2], lo[3], hi[0], hi[1], hi[2], hi[3]};
}
__device__ __forceinline__ bf16x8 pack8f(float a0, float a1, float a2, float a3, float a4, float a5, float a6, float a7) {
    v4u w; w.x = pg8::cvt_pk_bf16(a0, a1); w.y = pg8::cvt_pk_bf16(a2, a3); w.z = pg8::cvt_pk_bf16(a4, a5); w.w = pg8::cvt_pk_bf16(a6, a7); return __builtin_bit_cast(bf16x8, w);
}
constexpr float MLA_THR = 8.0f;
constexpr int MLA_NS = 7, MLA_VSLOT = 8192, MLA_KSLOT = 12288, MLA_KBASE = MLA_NS * MLA_VSLOT, MLA_COMB = 0;
__device__ __forceinline__ void mla_qblock2(int b, int h, int qb, const bf16* QKV, bf16* Y, LAS unsigned char* lds, int tid) {
    const int lane = tid & 63, w = __builtin_amdgcn_readfirstlane(tid >> 6), r31 = lane & 31, hh = lane >> 5, rg = w & 3, kh = w >> 2;
    const size_t mb = (size_t)b * SEQ; const int t_lo = 128 * qb + 32 * rg, t_row = t_lo + r31, ntile = 2 * (qb + 1);
    bf16x8 qf[6];
#pragma unroll
    for (int kk = 0; kk < 6; ++kk) qf[kk] = *(const bf16x8*)(QKV + (mb + t_row) * 1024 + QC_Q + 96 * h + 16 * kk + 8 * hh);
    int soff[3];
#pragma unroll
    for (int j = 0; j < 3; ++j) { const int c = w + 8 * j, P = 64 * c + lane;
        if (c < 12) { const int row = P / 12, pos = P - 12 * row; int pc = pos - ((row >> 2) & 3); pc = pc < 0 ? pc + 12 : pc; soff[j] = row * 1024 + (pc < 8 ? QC_KN + 64 * h + 8 * pc : QC_KR + 8 * (pc - 8)); }
        else { const int P2 = P - 768, row = P2 >> 3, pp = P2 & 7, piece = pp ^ (4 * ((row >> 1) & 1)); soff[j] = row * 1024 + QC_V + 64 * h + 8 * piece; } }
    const bool has3 = w < 4; const bf16* tile0 = QKV + mb * 1024; const unsigned lds0 = (unsigned)(uintptr_t)lds;
    int koff[6];
    { const int row = 32 * kh + r31, a = (row >> 2) & 3;
#pragma unroll
      for (int kk = 0; kk < 6; ++kk) { int pos = 2 * kk + hh + a; pos = pos >= 12 ? pos - 12 : pos; koff[kk] = row * 192 + 16 * pos; } }
    int voff[2];
    { const int q = (lane & 15) >> 2, p = lane & 3, gb = (lane >> 4) & 1, x = q >> 1;
#pragma unroll
      for (int et = 0; et < 2; ++et) voff[et] = (32 * kh + 4 * hh + q) * 128 + 8 * ((8 * (et ^ x)) + 4 * gb + p); }
#define MLA_GLDS(src, dst) do { unsigned keep_; asm volatile("s_mov_b32 %0, m0\n\ts_mov_b32 m0, %2\n\ts_nop 0\n\tglobal_load_lds_dwordx4 %1, off\n\ts_mov_b32 m0, %0" : "=&s"(keep_) : "v"(src), "s"(dst) : "memory"); } while (0)
#define MLA_DMA(kt) do { const bf16* tb_ = tile0 + (size_t)(kt) * 65536; const unsigned kb_ = lds0 + MLA_KBASE + ((kt) % MLA_NS) * MLA_KSLOT, vb_ = lds0 + ((kt) % MLA_NS) * MLA_VSLOT; \
        const unsigned d0_ = (unsigned)__builtin_amdgcn_readfirstlane((int)(kb_ + 1024 * w)), d1_ = (unsigned)__builtin_amdgcn_readfirstlane((int)(w < 4 ? kb_ + 1024 * (w + 8) : vb_ + 1024 * (w - 4))), d2_ = (unsigned)__builtin_amdgcn_readfirstlane((int)(vb_ + 1024 * (w + 4))); \
        MLA_GLDS(tb_ + soff[0], d0_); MLA_GLDS(tb_ + soff[1], d1_); if (has3) MLA_GLDS(tb_ + soff[2], d2_); } while (0)
    asm volatile("s_waitcnt vmcnt(0)" ::: "memory");
#pragma unroll
    for (int kk = 0; kk < 6; ++kk) asm volatile("" : "+v"(qf[kk]));
#pragma unroll
    for (int i = 0; i < MLA_NS - 1; ++i) if (i < ntile) MLA_DMA(i);
    float m_run = 0.f; f32x16 O0, O1, Lacc, negm;
#pragma unroll
    for (int i = 0; i < 16; ++i) { O0[i] = 0.f; O1[i] = 0.f; Lacc[i] = 0.f; negm[i] = 0.f; }
    const bf16x8 ones8 = (bf16x8){0x3F80, 0x3F80, 0x3F80, 0x3F80, 0x3F80, 0x3F80, 0x3F80, 0x3F80};
    for (int kt = 0; kt < ntile; ++kt) {
        { const int ahead = (ntile - 1 - kt) < (MLA_NS - 2) ? (ntile - 1 - kt) : (MLA_NS - 2);
          if (has3) { switch (ahead) { case 0: asm volatile("s_waitcnt vmcnt(0)" ::: "memory"); break; case 1: asm volatile("s_waitcnt vmcnt(3)" ::: "memory"); break; case 2: asm volatile("s_waitcnt vmcnt(6)" ::: "memory"); break;
                                       case 3: asm volatile("s_waitcnt vmcnt(9)" ::: "memory"); break; default: asm volatile("s_waitcnt vmcnt(12)" ::: "memory"); break; } }
          else      { switch (ahead) { case 0: asm volatile("s_waitcnt vmcnt(0)" ::: "memory"); break; case 1: asm volatile("s_waitcnt vmcnt(2)" ::: "memory"); break; case 2: asm volatile("s_waitcnt vmcnt(4)" ::: "memory"); break;
                                       case 3: asm volatile("s_waitcnt vmcnt(6)" ::: "memory"); break; default: asm volatile("s_waitcnt vmcnt(8)" ::: "memory"); break; } } }
        asm volatile("" ::: "memory"); __builtin_amdgcn_s_barrier(); asm volatile("" ::: "memory");
        if (kt + MLA_NS - 1 < ntile) MLA_DMA(kt + MLA_NS - 1);
        const int k_lo = 64 * kt + 32 * kh;
        if (k_lo <= t_lo + 31) {
            const LAS unsigned char* sb = lds + MLA_KBASE + (kt % MLA_NS) * MLA_KSLOT; const LAS unsigned char* vb = lds + (kt % MLA_NS) * MLA_VSLOT;
            f32x16 S = negm;
            typedef short s16x4_ __attribute__((ext_vector_type(4)));
            s16x4_ va0, va1, va2, va3, vb0, vb1, vb2, vb3;
            { bf16x8 k0, k1, k2, k3, k4, k5; const unsigned kbase = (unsigned)(uintptr_t)sb;
              asm volatile("ds_read_b128 %0, %6\n\tds_read_b128 %1, %7\n\tds_read_b128 %2, %8\n\tds_read_b128 %3, %9\n\tds_read_b128 %4, %10\n\tds_read_b128 %5, %11\n\ts_waitcnt lgkmcnt(0)"
                           : "=&v"(k0), "=&v"(k1), "=&v"(k2), "=&v"(k3), "=&v"(k4), "=&v"(k5)
                           : "v"(kbase + koff[0]), "v"(kbase + koff[1]), "v"(kbase + koff[2]), "v"(kbase + koff[3]), "v"(kbase + koff[4]), "v"(kbase + koff[5]) : "memory");
              const unsigned vbase = (unsigned)(uintptr_t)vb, a0 = vbase + voff[0], a1 = vbase + voff[1];
              asm volatile("ds_read_b64_tr_b16 %0, %8\n\tds_read_b64_tr_b16 %1, %8 offset:1024\n\tds_read_b64_tr_b16 %2, %8 offset:2048\n\tds_read_b64_tr_b16 %3, %8 offset:3072\n\t"
                           "ds_read_b64_tr_b16 %4, %9\n\tds_read_b64_tr_b16 %5, %9 offset:1024\n\tds_read_b64_tr_b16 %6, %9 offset:2048\n\tds_read_b64_tr_b16 %7, %9 offset:3072"
                           : "=&v"(va0), "=&v"(va1), "=&v"(va2), "=&v"(va3), "=&v"(vb0), "=&v"(vb1), "=&v"(vb2), "=&v"(vb3) : "v"(a0), "v"(a1) : "memory");
              S = MFMA32(k0, qf[0], S); S = MFMA32(k1, qf[1], S); S = MFMA32(k2, qf[2], S); S = MFMA32(k3, qf[3], S); S = MFMA32(k4, qf[4], S); S = MFMA32(k5, qf[5], S); }
            if (k_lo + 31 > t_lo) {
#pragma unroll
                for (int i = 0; i < 16; ++i) if (k_lo + (i & 3) + 8 * (i >> 2) + 4 * hh > t_row) S[i] = -INFINITY; }
            float mx_ = fmaxf(fmaxf(fmaxf(S[0], S[1]), fmaxf(S[2], S[3])), fmaxf(fmaxf(S[4], S[5]), fmaxf(S[6], S[7])));
            mx_ = fmaxf(mx_, fmaxf(fmaxf(fmaxf(S[8], S[9]), fmaxf(S[10], S[11])), fmaxf(fmaxf(S[12], S[13]), fmaxf(S[14], S[15]))));
            mx_ = fmaxf(mx_, __shfl_xor(mx_, 32));
            if (__builtin_expect(__any(mx_ > MLA_THR), 0)) {
                const float d = fmaxf(mx_, 0.f), f = __builtin_amdgcn_exp2f(-d); m_run += d;
#pragma unroll
                for (int i = 0; i < 16; ++i) { S[i] -= d; O0[i] *= f; O1[i] *= f; Lacc[i] *= f; negm[i] = -m_run; } }
#pragma unroll
            for (int i = 0; i < 16; ++i) S[i] = __builtin_amdgcn_exp2f(S[i]);
            const bf16x8 P0 = pack8f(S[0], S[1], S[2], S[3], S[4], S[5], S[6], S[7]), P1 = pack8f(S[8], S[9], S[10], S[11], S[12], S[13], S[14], S[15]);
            asm volatile("s_waitcnt lgkmcnt(0)" : "+v"(va0), "+v"(va1), "+v"(va2), "+v"(va3), "+v"(vb0), "+v"(vb1), "+v"(vb2), "+v"(vb3) :: "memory");
#define V8(l_, h_) ((bf16x8){l_[0], l_[1], l_[2], l_[3], h_[0], h_[1], h_[2], h_[3]})
            O0 = MFMA32(V8(va0, va1), P0, O0); O0 = MFMA32(V8(va2, va3), P1, O0); O1 = MFMA32(V8(vb0, vb1), P0, O1); O1 = MFMA32(V8(vb2, vb3), P1, O1);
            Lacc = MFMA32(ones8, P0, Lacc); Lacc = MFMA32(ones8, P1, Lacc);
#undef V8
        }
    }
#undef MLA_DMA
#undef MLA_GLDS
    LAS float* cb = (LAS float*)(lds + MLA_COMB + rg * 8704);
    WG_SYNC_L();
    if (kh == 1) {
#pragma unroll
        for (int i = 0; i < 16; ++i) { cb[i * 64 + lane] = O0[i]; cb[(16 + i) * 64 + lane] = O1[i]; }
        cb[2048 + lane] = m_run; cb[2112 + lane] = Lacc[0]; }
    WG_SYNC();
    if (kh == 0) { const float m1 = cb[2048 + lane], l1 = cb[2112 + lane]; const float m = fmaxf(m_run, m1), f0 = __builtin_amdgcn_exp2f(m_run - m), f1 = __builtin_amdgcn_exp2f(m1 - m);
        const float l = f0 * Lacc[0] + f1 * l1; const float inv = 1.0f / l; bf16* yp = Y + (mb + t_row) * 1024 + 64 * h + 4 * hh;
#pragma unroll
        for (int i4 = 0; i4 < 4; ++i4) { float o[4], o2[4];
#pragma unroll
            for (int j = 0; j < 4; ++j) { o[j] = (f0 * O0[4 * i4 + j] + f1 * cb[(4 * i4 + j) * 64 + lane]) * inv; o2[j] = (f0 * O1[4 * i4 + j] + f1 * cb[(16 + 4 * i4 + j) * 64 + lane]) * inv; }
            v2u a; a.x = pg8::cvt_pk_bf16(o[0], o[1]); a.y = pg8::cvt_pk_bf16(o[2], o[3]); *(v2u*)(yp + 8 * i4) = a;
            v2u c2; c2.x = pg8::cvt_pk_bf16(o2[0], o2[1]); c2.y = pg8::cvt_pk_bf16(o2[2], o2[3]); *(v2u*)(yp + 32 + 8 * i4) = c2; } }
    WG_SYNC();
}
__device__ __forceinline__ float max3f(float a, float b, float c) { float r; asm("v_max3_f32 %0, %1, %2, %3" : "=v"(r) : "v"(a), "v"(b), "v"(c)); return r; }
typedef __bf16 bf16x8n_ __attribute__((ext_vector_type(8)));
typedef float f32x8_ __attribute__((ext_vector_type(8)));
__device__ __forceinline__ bf16x8 pack8v(float a0, float a1, float a2, float a3, float a4, float a5, float a6, float a7) {
    const f32x8_ v = {a0, a1, a2, a3, a4, a5, a6, a7}; return __builtin_bit_cast(bf16x8, __builtin_convertvector(v, bf16x8n_));
}
template <bool HAS_NEXT>
__device__ __forceinline__ void mla_step(const LAS unsigned char* kslot_next, const LAS unsigned char* vslot_cur, const int (&koff)[6], const int (&voff)[2], const bf16x8 (&qf)[6], const bf16x8 ones8,
                                         bool diag_next, int klo_next, int t_row, int hh, int a32  , f32x16& S, f32x16& negm, float& m_run, f32x16& O0, f32x16& O1, f32x16& Lacc) {
    typedef short s16x4_ __attribute__((ext_vector_type(4)));
    s16x4_ va0, va1, va2, va3, vb0, vb1, vb2, vb3; f32x16 Sn;
    { const unsigned vbase = (unsigned)(uintptr_t)vslot_cur, a0 = vbase + voff[0], a1 = vbase + voff[1];
      asm volatile("ds_read_b64_tr_b16 %0, %8\n\tds_read_b64_tr_b16 %1, %8 offset:1024\n\tds_read_b64_tr_b16 %2, %8 offset:2048\n\tds_read_b64_tr_b16 %3, %8 offset:3072\n\t"
                   "ds_read_b64_tr_b16 %4, %9\n\tds_read_b64_tr_b16 %5, %9 offset:1024\n\tds_read_b64_tr_b16 %6, %9 offset:2048\n\tds_read_b64_tr_b16 %7, %9 offset:3072"
                   : "=&v"(va0), "=&v"(va1), "=&v"(va2), "=&v"(va3), "=&v"(vb0), "=&v"(vb1), "=&v"(vb2), "=&v"(vb3) : "v"(a0), "v"(a1) : "memory"); }
    if constexpr (HAS_NEXT) {
        bf16x8 k0, k1, k2, k3, k4, k5; const unsigned kbase = (unsigned)(uintptr_t)kslot_next;
        asm volatile("ds_read_b128 %0, %14\n\tds_read_b128 %1, %15\n\tds_read_b128 %2, %16\n\tds_read_b128 %3, %17\n\tds_read_b128 %4, %18\n\tds_read_b128 %5, %19\n\ts_waitcnt lgkmcnt(0)"
                     : "=&v"(k0), "=&v"(k1), "=&v"(k2), "=&v"(k3), "=&v"(k4), "=&v"(k5), "+v"(va0), "+v"(va1), "+v"(va2), "+v"(va3), "+v"(vb0), "+v"(vb1), "+v"(vb2), "+v"(vb3)
                     : "v"(kbase + koff[0]), "v"(kbase + koff[1]), "v"(kbase + koff[2]), "v"(kbase + koff[3]), "v"(kbase + koff[4]), "v"(kbase + koff[5]) : "memory");
        if (diag_next) { f32x16 c_ = negm;
#pragma unroll
            for (int i = 0; i < 16; ++i) if (klo_next + (i & 3) + 8 * (i >> 2) + 4 * hh > t_row) c_[i] = -INFINITY;
            asm volatile("" ::: "memory"); Sn = MFMA32(k0, qf[0], c_); }
        else Sn = MFMA32(k0, qf[0], negm);
        Sn = MFMA32(k1, qf[1], Sn); Sn = MFMA32(k2, qf[2], Sn); Sn = MFMA32(k3, qf[3], Sn); Sn = MFMA32(k4, qf[4], Sn); Sn = MFMA32(k5, qf[5], Sn);
    } else {
        asm volatile("s_waitcnt lgkmcnt(0)" : "+v"(va0), "+v"(va1), "+v"(va2), "+v"(va3), "+v"(vb0), "+v"(vb1), "+v"(vb2), "+v"(vb3) :: "memory");
    }
    float mx_ = max3f(max3f(S[0], S[1], S[2]), max3f(S[3], S[4], S[5]), max3f(S[6], S[7], S[8]));
    mx_ = max3f(mx_, max3f(S[9], S[10], S[11]), max3f(S[12], S[13], max3f(S[14], S[15], S[15])));
    mx_ = max3f(mx_, __builtin_bit_cast(float, __builtin_amdgcn_ds_bpermute(a32, __builtin_bit_cast(int, mx_))), mx_);
    if (__builtin_expect(__any(mx_ > MLA_THR), 0)) {
        const float d = fmaxf(mx_, 0.f), f = __builtin_amdgcn_exp2f(-d); m_run += d;
#pragma unroll
        for (int i = 0; i < 16; ++i) { S[i] -= d; O0[i] *= f; O1[i] *= f; Lacc[i] *= f; negm[i] = -m_run; if (HAS_NEXT) Sn[i] -= d; } }
#pragma unroll
    for (int i = 0; i < 16; ++i) S[i] = __builtin_amdgcn_exp2f(S[i]);
    const bf16x8 P0 = pack8v(S[0], S[1], S[2], S[3], S[4], S[5], S[6], S[7]), P1 = pack8v(S[8], S[9], S[10], S[11], S[12], S[13], S[14], S[15]);
#define V8(l_, h_) ((bf16x8){l_[0], l_[1], l_[2], l_[3], h_[0], h_[1], h_[2], h_[3]})
    O0 = MFMA32(V8(va0, va1), P0, O0); O1 = MFMA32(V8(vb0, vb1), P0, O1); Lacc = MFMA32(ones8, P0, Lacc);
    O0 = MFMA32(V8(va2, va3), P1, O0); O1 = MFMA32(V8(vb2, vb3), P1, O1); Lacc = MFMA32(ones8, P1, Lacc);
#undef V8
    S = Sn;
}
__device__ __forceinline__ float xmax32(float v) { float a = v, b = v; asm volatile("s_nop 1\n\tv_permlane32_swap_b32 %0, %1\n\ts_nop 1" : "+v"(a), "+v"(b)); return max3f(a, b, a); }
typedef short s16x4m_ __attribute__((ext_vector_type(4)));
template <bool HAS_NEXT>
__device__ __forceinline__ void mla_step5(const LAS unsigned char* kslot2, const LAS unsigned char* vslot1, const int (&koff)[6], const int (&voff)[2], const bf16x8 (&qf)[6], const bf16x8 ones8, bool has_k2,
                                          bool diag_next, int klo_next, int t_row, int hh, f32x16& S, f32x16& negm, float& m_run, f32x16& O0, f32x16& O1, f32x16& Lacc, bf16x8 (&kr)[6], s16x4m_ (&vr)[8]) {
    f32x16 Sn;
    if constexpr (HAS_NEXT) {
        asm volatile("s_waitcnt lgkmcnt(8)" : "+v"(kr[0]), "+v"(kr[1]), "+v"(kr[2]), "+v"(kr[3]), "+v"(kr[4]), "+v"(kr[5]) :: "memory");
        if (diag_next) { f32x16 c_ = negm;
#pragma unroll
            for (int i = 0; i < 16; ++i) if (klo_next + (i & 3) + 8 * (i >> 2) + 4 * hh > t_row) c_[i] = -INFINITY;
            asm volatile("" ::: "memory"); Sn = MFMA32(kr[0], qf[0], c_); }
        else Sn = MFMA32(kr[0], qf[0], negm);
        Sn = MFMA32(kr[1], qf[1], Sn); Sn = MFMA32(kr[2], qf[2], Sn); Sn = MFMA32(kr[3], qf[3], Sn); Sn = MFMA32(kr[4], qf[4], Sn); Sn = MFMA32(kr[5], qf[5], Sn);
        if (has_k2) { const unsigned kbase = (unsigned)(uintptr_t)kslot2;
            asm volatile("ds_read_b128 %0, %6\n\tds_read_b128 %1, %7\n\tds_read_b128 %2, %8\n\tds_read_b128 %3, %9\n\tds_read_b128 %4, %10\n\tds_read_b128 %5, %11"
                         : "+v"(kr[0]), "+v"(kr[1]), "+v"(kr[2]), "+v"(kr[3]), "+v"(kr[4]), "+v"(kr[5])
                         : "v"(kbase + koff[0]), "v"(kbase + koff[1]), "v"(kbase + koff[2]), "v"(kbase + koff[3]), "v"(kbase + koff[4]), "v"(kbase + koff[5]) : "memory"); }
    }
    float mx_ = max3f(max3f(S[0], S[1], S[2]), max3f(S[3], S[4], S[5]), max3f(S[6], S[7], S[8]));
    mx_ = max3f(mx_, max3f(S[9], S[10], S[11]), max3f(S[12], S[13], max3f(S[14], S[15], S[15])));
    mx_ = xmax32(mx_);
    if (__builtin_expect(__any(mx_ > MLA_THR), 0)) {
        const float d = fmaxf(mx_, 0.f), f = __builtin_amdgcn_exp2f(-d); m_run += d;
#pragma unroll
        for (int i = 0; i < 16; ++i) { S[i] -= d; O0[i] *= f; O1[i] *= f; Lacc[i] *= f; negm[i] = -m_run; if (HAS_NEXT) Sn[i] -= d; } }
#pragma unroll
    for (int i = 0; i < 16; ++i) S[i] = __builtin_amdgcn_exp2f(S[i]);
    const bf16x8 P0 = pack8v(S[0], S[1], S[2], S[3], S[4], S[5], S[6], S[7]), P1 = pack8v(S[8], S[9], S[10], S[11], S[12], S[13], S[14], S[15]);
    if (HAS_NEXT && has_k2) asm volatile("s_waitcnt lgkmcnt(6)" : "+v"(vr[0]), "+v"(vr[1]), "+v"(vr[2]), "+v"(vr[3]), "+v"(vr[4]), "+v"(vr[5]), "+v"(vr[6]), "+v"(vr[7]) :: "memory");
    else asm volatile("s_waitcnt lgkmcnt(0)" : "+v"(vr[0]), "+v"(vr[1]), "+v"(vr[2]), "+v"(vr[3]), "+v"(vr[4]), "+v"(vr[5]), "+v"(vr[6]), "+v"(vr[7]) :: "memory");
#define V8(l_, h_) ((bf16x8){l_[0], l_[1], l_[2], l_[3], h_[0], h_[1], h_[2], h_[3]})
    O0 = MFMA32(V8(vr[0], vr[1]), P0, O0); O1 = MFMA32(V8(vr[4], vr[5]), P0, O1); Lacc = MFMA32(ones8, P0, Lacc);
    O0 = MFMA32(V8(vr[2], vr[3]), P1, O0); O1 = MFMA32(V8(vr[6], vr[7]), P1, O1); Lacc = MFMA32(ones8, P1, Lacc);
#undef V8
    if constexpr (HAS_NEXT) {
        const unsigned vbase = (unsigned)(uintptr_t)vslot1, a0 = vbase + voff[0], a1 = vbase + voff[1];
        asm volatile("ds_read_b64_tr_b16 %0, %8\n\tds_read_b64_tr_b16 %1, %8 offset:1024\n\tds_read_b64_tr_b16 %2, %8 offset:2048\n\tds_read_b64_tr_b16 %3, %8 offset:3072\n\t"
                     "ds_read_b64_tr_b16 %4, %9\n\tds_read_b64_tr_b16 %5, %9 offset:1024\n\tds_read_b64_tr_b16 %6, %9 offset:2048\n\tds_read_b64_tr_b16 %7, %9 offset:3072"
                     : "+v"(vr[0]), "+v"(vr[1]), "+v"(vr[2]), "+v"(vr[3]), "+v"(vr[4]), "+v"(vr[5]), "+v"(vr[6]), "+v"(vr[7]) : "v"(a0), "v"(a1) : "memory");
        S = Sn; }
}
__device__ __forceinline__ void mla_qblock3(int b, int h, int qb, const bf16* QKV, bf16* Y, LAS unsigned char* lds, int tid) {
    asm volatile("" : "+s"(b), "+s"(h), "+s"(qb));
    const int lane = tid & 63, w = __builtin_amdgcn_readfirstlane(tid >> 6), r31 = lane & 31, hh = lane >> 5, rg = w & 3, kh = w >> 2;
    const size_t mb = (size_t)b * SEQ; const int t_lo = 128 * qb + 32 * rg, t_row = t_lo + r31, ntile = 2 * (qb + 1);
    const int a32 = (lane ^ 32) << 2;
    bf16x8 qf[6];
#pragma unroll
    for (int kk = 0; kk < 6; ++kk) qf[kk] = *(const bf16x8*)(QKV + (mb + t_row) * 1024 + QC_Q + 96 * h + 16 * kk + 8 * hh);
    int soff[3];
#pragma unroll
    for (int j = 0; j < 3; ++j) { const int c = w + 8 * j, P = 64 * c + lane;
        if (c < 12) { const int row = P / 12, pos = P - 12 * row; int pc = pos - ((row >> 2) & 3); pc = pc < 0 ? pc + 12 : pc; soff[j] = row * 1024 + (pc < 8 ? QC_KN + 64 * h + 8 * pc : QC_KR + 8 * (pc - 8)); }
        else { const int P2 = P - 768, row = P2 >> 3, pp = P2 & 7, piece = pp ^ (4 * ((row >> 1) & 1)); soff[j] = row * 1024 + QC_V + 64 * h + 8 * piece; } }
    const bool has3 = w < 4; const bf16* tile0 = QKV + mb * 1024; const unsigned lds0 = (unsigned)(uintptr_t)lds;
    int koff[6];
    { const int row = 32 * kh + r31, a = (row >> 2) & 3;
#pragma unroll
      for (int kk = 0; kk < 6; ++kk) { int pos = 2 * kk + hh + a; pos = pos >= 12 ? pos - 12 : pos; koff[kk] = row * 192 + 16 * pos; } }
    int voff[2];
    { const int q = (lane & 15) >> 2, p = lane & 3, gb = (lane >> 4) & 1, x = q >> 1;
#pragma unroll
      for (int et = 0; et < 2; ++et) voff[et] = (32 * kh + 4 * hh + q) * 128 + 8 * ((8 * (et ^ x)) + 4 * gb + p); }
#define MLA_GLDS(src, dst) do { unsigned keep_; asm volatile("s_mov_b32 %0, m0\n\ts_mov_b32 m0, %2\n\ts_nop 0\n\tglobal_load_lds_dwordx4 %1, off\n\ts_mov_b32 m0, %0" : "=&s"(keep_) : "v"(src), "s"(dst) : "memory"); } while (0)
#define MLA_DMA(kt) do { const bf16* tb_ = tile0 + (size_t)(kt) * 65536; const unsigned kb_ = lds0 + MLA_KBASE + ((kt) % MLA_NS) * MLA_KSLOT, vb_ = lds0 + ((kt) % MLA_NS) * MLA_VSLOT; \
        const unsigned d0_ = (unsigned)__builtin_amdgcn_readfirstlane((int)(kb_ + 1024 * w)), d1_ = (unsigned)__builtin_amdgcn_readfirstlane((int)(w < 4 ? kb_ + 1024 * (w + 8) : vb_ + 1024 * (w - 4))), d2_ = (unsigned)__builtin_amdgcn_readfirstlane((int)(vb_ + 1024 * (w + 4))); \
        MLA_GLDS(tb_ + soff[0], d0_); MLA_GLDS(tb_ + soff[1], d1_); if (has3) MLA_GLDS(tb_ + soff[2], d2_); } while (0)
#define MLA_WAIT(n) do { const int n_ = (n); \
        if (has3) { switch (n_) { case 0: asm volatile("s_waitcnt vmcnt(0)" ::: "memory"); break; case 1: asm volatile("s_waitcnt vmcnt(3)" ::: "memory"); break; case 2: asm volatile("s_waitcnt vmcnt(6)" ::: "memory"); break; \
                                  case 3: asm volatile("s_waitcnt vmcnt(9)" ::: "memory"); break; default: asm volatile("s_waitcnt vmcnt(12)" ::: "memory"); break; } } \
        else      { switch (n_) { case 0: asm volatile("s_waitcnt vmcnt(0)" ::: "memory"); break; case 1: asm volatile("s_waitcnt vmcnt(2)" ::: "memory"); break; case 2: asm volatile("s_waitcnt vmcnt(4)" ::: "memory"); break; \
                                  case 3: asm volatile("s_waitcnt vmcnt(6)" ::: "memory"); break; default: asm volatile("s_waitcnt vmcnt(8)" ::: "memory"); break; } } \
        asm volatile("" ::: "memory"); __builtin_amdgcn_s_barrier(); asm volatile("" ::: "memory"); } while (0)
    asm volatile("s_waitcnt vmcnt(0)" ::: "memory");
#pragma unroll
    for (int kk = 0; kk < 6; ++kk) asm volatile("" : "+v"(qf[kk]));
#pragma unroll
    for (int i = 0; i < MLA_NS - 1; ++i) if (i < ntile) MLA_DMA(i);
    float m_run = 0.f; f32x16 O0, O1, Lacc, negm, S;
#pragma unroll
    for (int i = 0; i < 16; ++i) { O0[i] = 0.f; O1[i] = 0.f; Lacc[i] = 0.f; negm[i] = 0.f; }
    unsigned one2_ = 0x3f803f80u; asm volatile("" : "+v"(one2_));
    const bf16x8 ones8 = __builtin_bit_cast(bf16x8, (v4u){one2_, one2_, one2_, one2_});
    { const int behind = (ntile - 1) < (MLA_NS - 2) ? (ntile - 1) : (MLA_NS - 2); MLA_WAIT(behind);
      S = negm; const int k_lo = 32 * kh;
      if (k_lo + 31 > t_lo) {
#pragma unroll
          for (int i = 0; i < 16; ++i) if (k_lo + (i & 3) + 8 * (i >> 2) + 4 * hh > t_row) S[i] = -INFINITY; }
      bf16x8 k0, k1, k2, k3, k4, k5; const unsigned kbase = lds0 + MLA_KBASE;
      asm volatile("ds_read_b128 %0, %6\n\tds_read_b128 %1, %7\n\tds_read_b128 %2, %8\n\tds_read_b128 %3, %9\n\tds_read_b128 %4, %10\n\tds_read_b128 %5, %11\n\ts_waitcnt lgkmcnt(0)"
                   : "=&v"(k0), "=&v"(k1), "=&v"(k2), "=&v"(k3), "=&v"(k4), "=&v"(k5)
                   : "v"(kbase + koff[0]), "v"(kbase + koff[1]), "v"(kbase + koff[2]), "v"(kbase + koff[3]), "v"(kbase + koff[4]), "v"(kbase + koff[5]) : "memory");
      S = MFMA32(k0, qf[0], S); S = MFMA32(k1, qf[1], S); S = MFMA32(k2, qf[2], S); S = MFMA32(k3, qf[3], S); S = MFMA32(k4, qf[4], S); S = MFMA32(k5, qf[5], S); }
    for (int kt = 0; kt + 1 < ntile; ++kt) {
        { const int rem = ntile - 2 - kt, behind = rem < (MLA_NS - 3) ? rem : (MLA_NS - 3); MLA_WAIT(behind); }
        if (kt + MLA_NS - 1 < ntile) MLA_DMA(kt + MLA_NS - 1);
        const int klo_n = 64 * (kt + 1) + 32 * kh;
        mla_step<true>(lds + MLA_KBASE + ((kt + 1) % MLA_NS) * MLA_KSLOT, lds + (kt % MLA_NS) * MLA_VSLOT, koff, voff, qf, ones8, klo_n + 31 > t_lo, klo_n, t_row, hh, a32, S, negm, m_run, O0, O1, Lacc);
    }
    mla_step<false>(lds, lds + ((ntile - 1) % MLA_NS) * MLA_VSLOT, koff, voff, qf, ones8, false, 0, t_row, hh, a32, S, negm, m_run, O0, O1, Lacc);
#undef MLA_WAIT
#undef MLA_DMA
#undef MLA_GLDS
    LAS float* cb = (LAS float*)(lds + MLA_COMB + rg * 8704);
    WG_SYNC_L();
    if (kh == 1) {
#pragma unroll
        for (int i = 0; i < 16; ++i) { cb[i * 64 + lane] = O0[i]; cb[(16 + i) * 64 + lane] = O1[i]; }
        cb[2048 + lane] = m_run; cb[2112 + lane] = Lacc[0]; }
    WG_SYNC();
    if (kh == 0) { const float m1 = cb[2048 + lane], l1 = cb[2112 + lane]; const float m = fmaxf(m_run, m1), f0 = __builtin_amdgcn_exp2f(m_run - m), f1 = __builtin_amdgcn_exp2f(m1 - m);
        const float l = f0 * Lacc[0] + f1 * l1; const float inv = 1.0f / l; bf16* yp = Y + (mb + t_row) * 1024 + 64 * h + 4 * hh;
#pragma unroll
        for (int i4 = 0; i4 < 4; ++i4) { float o[4], o2[4];
#pragma unroll
            for (int j = 0; j < 4; ++j) { o[j] = (f0 * O0[4 * i4 + j] + f1 * cb[(4 * i4 + j) * 64 + lane]) * inv; o2[j] = (f0 * O1[4 * i4 + j] + f1 * cb[(16 + 4 * i4 + j) * 64 + lane]) * inv; }
            v2u a; a.x = pg8::cvt_pk_bf16(o[0], o[1]); a.y = pg8::cvt_pk_bf16(o[2], o[3]); *(v2u*)(yp + 8 * i4) = a;
            v2u c2; c2.x = pg8::cvt_pk_bf16(o2[0], o2[1]); c2.y = pg8::cvt_pk_bf16(o2[2], o2[3]); *(v2u*)(yp + 32 + 8 * i4) = c2; } }
    WG_SYNC();
}
__device__ __forceinline__ void mla_qblock5(int b, int h, int qb, const bf16* QKV, bf16* Y, LAS unsigned char* lds, int tid) {
    asm volatile("" : "+s"(b), "+s"(h), "+s"(qb));
    const int lane = tid & 63, w = __builtin_amdgcn_readfirstlane(tid >> 6), r31 = lane & 31, hh = lane >> 5, rg = w & 3, kh = w >> 2;
    const size_t mb = (size_t)b * SEQ; const int t_lo = 128 * qb + 32 * rg, t_row = t_lo + r31, ntile = 2 * (qb + 1);
    const int a32 = (lane ^ 32) << 2;
    bf16x8 qf[6];
#pragma unroll
    for (int kk = 0; kk < 6; ++kk) qf[kk] = *(const bf16x8*)(QKV + (mb + t_row) * 1024 + QC_Q + 96 * h + 16 * kk + 8 * hh);
    int soff[3];
#pragma unroll
    for (int j = 0; j < 3; ++j) { const int c = w + 8 * j, P = 64 * c + lane;
        if (c < 12) { const int row = P / 12, pos = P - 12 * row; int pc = pos - ((row >> 2) & 3); pc = pc < 0 ? pc + 12 : pc; soff[j] = row * 1024 + (pc < 8 ? QC_KN + 64 * h + 8 * pc : QC_KR + 8 * (pc - 8)); }
        else { const int P2 = P - 768, row = P2 >> 3, pp = P2 & 7, piece = pp ^ (4 * ((row >> 1) & 1)); soff[j] = row * 1024 + QC_V + 64 * h + 8 * piece; } }
    const bool has3 = w < 4; const bf16* tile0 = QKV + mb * 1024; const unsigned lds0 = (unsigned)(uintptr_t)lds;
    int koff[6];
    { const int row = 32 * kh + r31, a = (row >> 2) & 3;
#pragma unroll
      for (int kk = 0; kk < 6; ++kk) { int pos = 2 * kk + hh + a; pos = pos >= 12 ? pos - 12 : pos; koff[kk] = row * 192 + 16 * pos; } }
    int voff[2];
    { const int q = (lane & 15) >> 2, p = lane & 3, gb = (lane >> 4) & 1, x = q >> 1;
#pragma unroll
      for (int et = 0; et < 2; ++et) voff[et] = (32 * kh + 4 * hh + q) * 128 + 8 * ((8 * (et ^ x)) + 4 * gb + p); }
#define MLA_GLDS(src, dst) do { unsigned keep_; asm volatile("s_mov_b32 %0, m0\n\ts_mov_b32 m0, %2\n\ts_nop 0\n\tglobal_load_lds_dwordx4 %1, off\n\ts_mov_b32 m0, %0" : "=&s"(keep_) : "v"(src), "s"(dst) : "memory"); } while (0)
#define MLA_DMA(kt) do { const bf16* tb_ = tile0 + (size_t)(kt) * 65536; const unsigned kb_ = lds0 + MLA_KBASE + ((kt) % MLA_NS) * MLA_KSLOT, vb_ = lds0 + ((kt) % MLA_NS) * MLA_VSLOT; \
        const unsigned d0_ = (unsigned)__builtin_amdgcn_readfirstlane((int)(kb_ + 1024 * w)), d1_ = (unsigned)__builtin_amdgcn_readfirstlane((int)(w < 4 ? kb_ + 1024 * (w + 8) : vb_ + 1024 * (w - 4))), d2_ = (unsigned)__builtin_amdgcn_readfirstlane((int)(vb_ + 1024 * (w + 4))); \
        MLA_GLDS(tb_ + soff[0], d0_); MLA_GLDS(tb_ + soff[1], d1_); if (has3) MLA_GLDS(tb_ + soff[2], d2_); } while (0)
#define MLA_WAIT(n) do { const int n_ = (n); \
        if (has3) { switch (n_) { case 0: asm volatile("s_waitcnt vmcnt(0)" ::: "memory"); break; case 1: asm volatile("s_waitcnt vmcnt(3)" ::: "memory"); break; case 2: asm volatile("s_waitcnt vmcnt(6)" ::: "memory"); break; \
                                  case 3: asm volatile("s_waitcnt vmcnt(9)" ::: "memory"); break; default: asm volatile("s_waitcnt vmcnt(12)" ::: "memory"); break; } } \
        else      { switch (n_) { case 0: asm volatile("s_waitcnt vmcnt(0)" ::: "memory"); break; case 1: asm volatile("s_waitcnt vmcnt(2)" ::: "memory"); break; case 2: asm volatile("s_waitcnt vmcnt(4)" ::: "memory"); break; \
                                  case 3: asm volatile("s_waitcnt vmcnt(6)" ::: "memory"); break; default: asm volatile("s_waitcnt vmcnt(8)" ::: "memory"); break; } } \
        asm volatile("" ::: "memory"); __builtin_amdgcn_s_barrier(); asm volatile("" ::: "memory"); } while (0)
    asm volatile("s_waitcnt vmcnt(0)" ::: "memory");
#pragma unroll
    for (int kk = 0; kk < 6; ++kk) asm volatile("" : "+v"(qf[kk]));
#pragma unroll
    for (int i = 0; i < MLA_NS - 1; ++i) if (i < ntile) MLA_DMA(i);
    float m_run = 0.f; f32x16 O0, O1, Lacc, negm, S;
#pragma unroll
    for (int i = 0; i < 16; ++i) { O0[i] = 0.f; O1[i] = 0.f; Lacc[i] = 0.f; negm[i] = 0.f; }
    unsigned one2_ = 0x3f803f80u; asm volatile("" : "+v"(one2_));
    const bf16x8 ones8 = __builtin_bit_cast(bf16x8, (v4u){one2_, one2_, one2_, one2_});
    bf16x8 kr[6]; s16x4m_ vr[8];
    { const int behind = (ntile - 2) < (MLA_NS - 3) ? (ntile - 2) : (MLA_NS - 3); MLA_WAIT(behind);
      S = negm; const int k_lo = 32 * kh;
      if (k_lo + 31 > t_lo) {
#pragma unroll
          for (int i = 0; i < 16; ++i) if (k_lo + (i & 3) + 8 * (i >> 2) + 4 * hh > t_row) S[i] = -INFINITY; }
      bf16x8 k0, k1, k2, k3, k4, k5; const unsigned kbase = lds0 + MLA_KBASE;
      asm volatile("ds_read_b128 %0, %6\n\tds_read_b128 %1, %7\n\tds_read_b128 %2, %8\n\tds_read_b128 %3, %9\n\tds_read_b128 %4, %10\n\tds_read_b128 %5, %11\n\ts_waitcnt lgkmcnt(0)"
                   : "=&v"(k0), "=&v"(k1), "=&v"(k2), "=&v"(k3), "=&v"(k4), "=&v"(k5)
                   : "v"(kbase + koff[0]), "v"(kbase + koff[1]), "v"(kbase + koff[2]), "v"(kbase + koff[3]), "v"(kbase + koff[4]), "v"(kbase + koff[5]) : "memory");
      S = MFMA32(k0, qf[0], S); S = MFMA32(k1, qf[1], S); S = MFMA32(k2, qf[2], S); S = MFMA32(k3, qf[3], S); S = MFMA32(k4, qf[4], S); S = MFMA32(k5, qf[5], S);
      { const unsigned kb1 = lds0 + MLA_KBASE + (1 % MLA_NS) * MLA_KSLOT;
        asm volatile("ds_read_b128 %0, %6\n\tds_read_b128 %1, %7\n\tds_read_b128 %2, %8\n\tds_read_b128 %3, %9\n\tds_read_b128 %4, %10\n\tds_read_b128 %5, %11"
                     : "=&v"(kr[0]), "=&v"(kr[1]), "=&v"(kr[2]), "=&v"(kr[3]), "=&v"(kr[4]), "=&v"(kr[5])
                     : "v"(kb1 + koff[0]), "v"(kb1 + koff[1]), "v"(kb1 + koff[2]), "v"(kb1 + koff[3]), "v"(kb1 + koff[4]), "v"(kb1 + koff[5]) : "memory");
        const unsigned a0 = lds0 + voff[0], a1 = lds0 + voff[1];
        asm volatile("ds_read_b64_tr_b16 %0, %8\n\tds_read_b64_tr_b16 %1, %8 offset:1024\n\tds_read_b64_tr_b16 %2, %8 offset:2048\n\tds_read_b64_tr_b16 %3, %8 offset:3072\n\t"
                     "ds_read_b64_tr_b16 %4, %9\n\tds_read_b64_tr_b16 %5, %9 offset:1024\n\tds_read_b64_tr_b16 %6, %9 offset:2048\n\tds_read_b64_tr_b16 %7, %9 offset:3072"
                     : "=&v"(vr[0]), "=&v"(vr[1]), "=&v"(vr[2]), "=&v"(vr[3]), "=&v"(vr[4]), "=&v"(vr[5]), "=&v"(vr[6]), "=&v"(vr[7]) : "v"(a0), "v"(a1) : "memory"); } }
    for (int kt = 0; kt + 1 < ntile; ++kt) {
        { const int rem = ntile - 3 - kt, behind = rem < 0 ? 0 : (rem < (MLA_NS - 4) ? rem : (MLA_NS - 4)); MLA_WAIT(behind); }
        if (kt + MLA_NS - 1 < ntile) MLA_DMA(kt + MLA_NS - 1);
        const int klo_n = 64 * (kt + 1) + 32 * kh;
        mla_step5<true>(lds + MLA_KBASE + ((kt + 2) % MLA_NS) * MLA_KSLOT, lds + ((kt + 1) % MLA_NS) * MLA_VSLOT, koff, voff, qf, ones8, kt + 2 < ntile, klo_n + 31 > t_lo, klo_n, t_row, hh, S, negm, m_run, O0, O1, Lacc, kr, vr);
    }
    mla_step5<false>(lds, lds, koff, voff, qf, ones8, false, false, 0, t_row, hh, S, negm, m_run, O0, O1, Lacc, kr, vr);
#undef MLA_WAIT
#undef MLA_DMA
#undef MLA_GLDS
    LAS float* cb = (LAS float*)(lds + MLA_COMB + rg * 8704);
    WG_SYNC_L();
    if (kh == 1) {
#pragma unroll
        for (int i = 0; i < 16; ++i) { cb[i * 64 + lane] = O0[i]; cb[(16 + i) * 64 + lane] = O1[i]; }
        cb[2048 + lane] = m_run; cb[2112 + lane] = Lacc[0]; }
    WG_SYNC();
    if (kh == 0) { const float m1 = cb[2048 + lane], l1 = cb[2112 + lane]; const float m = fmaxf(m_run, m1), f0 = __builtin_amdgcn_exp2f(m_run - m), f1 = __builtin_amdgcn_exp2f(m1 - m);
        const float l = f0 * Lacc[0] + f1 * l1; const float inv = 1.0f / l; bf16* yp = Y + (mb + t_row) * 1024 + 64 * h + 4 * hh;
#pragma unroll
        for (int i4 = 0; i4 < 4; ++i4) { float o[4], o2[4];
#pragma unroll
            for (int j = 0; j < 4; ++j) { o[j] = (f0 * O0[4 * i4 + j] + f1 * cb[(4 * i4 + j) * 64 + lane]) * inv; o2[j] = (f0 * O1[4 * i4 + j] + f1 * cb[(16 + 4 * i4 + j) * 64 + lane]) * inv; }
            v2u a; a.x = pg8::cvt_pk_bf16(o[0], o[1]); a.y = pg8::cvt_pk_bf16(o[2], o[3]); *(v2u*)(yp + 8 * i4) = a;
            v2u c2; c2.x = pg8::cvt_pk_bf16(o2[0], o2[1]); c2.y = pg8::cvt_pk_bf16(o2[2], o2[3]); *(v2u*)(yp + 32 + 8 * i4) = c2; } }
    WG_SYNC();
}
}

#define V_WGU ((bf16*)(ws + WS_WGU))
#define V_WD ((bf16*)(ws + WS_WD))
#define V_WIN ((bf16*)(ws + WS_WIN))
#define V_WMLA ((bf16*)(ws + WS_WMLA))
#define V_WOUT ((bf16*)(ws + WS_WOUT))
#define V_WPG ((bf16*)(ws + WS_WPG))
#define V_WPP ((bf16*)(ws + WS_WPP))
#define V_B0 ((bf16*)(ws + WS_B0))
#define V_B1 ((bf16*)(ws + WS_B1))
#define V_ZH ((bf16*)(ws + WS_ZH))
#define V_QKV ((bf16*)(ws + WS_QKV))
#define V_PBF ((bf16*)(ws + WS_PBF))
#define V_SSQ0 ((float*)(ws + WS_SSQ))
#define V_SSQ1 ((float*)(ws + WS_SSQ) + (size_t)M * 16)
#define V_SSQQ ((float*)(ws + WS_SSQ2))
#define V_SSQKV ((float*)(ws + WS_SSQ2) + (size_t)M * 4)
#define V_MCS ((float*)(ws + WS_ROPE))
#define V_MSN ((float*)(ws + WS_ROPE) + (size_t)M * 16)
#define V_RCS ((float*)(ws + WS_ROPE) + (size_t)M * 32)
#define V_RSN ((float*)(ws + WS_ROPE) + (size_t)M * 64)
#define V_HST ((bf16*)(ws + WS_HST))
#define V_HDC ((float*)(ws + WS_HDC))
#define V_RST ((float*)(ws + WS_RST))
#ifndef MIX_RET
#define MIX_RET 1
#endif
#ifndef MIX_HG
#define MIX_HG 1
#endif
#ifndef MIX_SG
#define MIX_SG 1
#endif
#ifndef MIX_MLA
#define MIX_MLA 1
#endif
template <bool G256>
__global__ void __launch_bounds__(NWAVES * 64, 2) mk_fwd(Args a) {
    extern __shared__ __attribute__((aligned(16))) unsigned char lds_raw[];
    LAS unsigned char* lds = (LAS unsigned char*)lds_raw;
    volatile LAS unsigned* MISC = (volatile LAS unsigned*)(lds + MISC_OFF);
    const int tid = threadIdx.x;
    const int G = G256 ? 256 : (int)gridDim.x; const int bx = blockIdx.x; const int vcu = (G % 8 == 0) ? (bx % 8) * (G / 8) + bx / 8 : bx;
    unsigned char* ws = a.ws;
    gu32* ctl = (gu32*)(ws + WS_CTL);
    for (int u = tid; u < (LDS_BYTES - LDSCTL_OFF) / 4; u += NWAVES * 64) ((LAS unsigned*)(lds + LDSCTL_OFF))[u] = 0u;
    __syncthreads();
    XcdBarrier bar = xcd_barrier_post((unsigned*)(ctl + CW_BAR) + a.li * XCD_BAR_WORDS, MISC + 8);
    if (tid == 0) (void)__hip_atomic_fetch_or((unsigned*)(ctl + CW_GRP) + a.li * 4096 + (bx & 63) * 64 + 32, 1u << bar.x, __ATOMIC_RELAXED, __HIP_MEMORY_SCOPE_AGENT);
    const int lo = a.ph_lo, hi = a.ph_hi;
#define IN(k) (lo <= (k) && (k) < hi)
#define SEAM(k) do { if (IN(k) && IN((k) + 1)) xcd_barrier(bar); } while (0)
#define GSEAM(k) do { if (IN(k) && IN((k) + 1)) { if (G == 256) { unsigned go_ = (unsigned)a.li * 4096u + (blockIdx.x & 63u) * 64u; asm volatile("" : "+s"(go_)); unsigned* gc_ = (unsigned*)(a.ws + WS_CTL) + CW_GRP + go_; group_sync(gc_, gc_ + 32, 4u, MISC + 12, bar.bar); } else xcd_barrier(bar); } } while (0)
    float* out = a.out;
#ifdef PROBE_CLASS
#ifndef PROBE_MULT
#define PROBE_MULT 4
#endif
    unsigned long long pr_acc = 0, pr_t0 = 0;
#define PH_BEGIN(c) do { if ((c) == PROBE_CLASS) pr_t0 = wall_clock64(); } while (0)
#define PH_END(c) do { if ((c) == PROBE_CLASS) pr_acc += wall_clock64() - pr_t0; } while (0)
#else
#define PH_BEGIN(c) do { } while (0)
#define PH_END(c) do { } while (0)
#endif

    PH_BEGIN(0);
    if (IN(0)) { const int t0_ = threadIdx.x; prologue(a, lds, t0_, t0_ & 63, __builtin_amdgcn_readfirstlane(t0_ >> 6), vcu, G); }
    SEAM(0);
    PH_END(0);

    for (int hl = 0; hl < 2 * DEPTH; ++hl) {
        const int l = hl >> 1, second = hl & 1, pb = 1 + 10 * l + 7 * second;
        int tid_o = tid; asm volatile("" : "+v"(tid_o));
        PH_BEGIN(1); if (IN(pb)) {
            pg8::Gemm g{(second == 0 && l > 0) ? V_B1 : V_B0, V_WGU + (size_t)(2 * l + second) * NGU * D, M, NGU, D, D}; pg8::StaticOrder S; S.init(M, NGU, G, bx);
            pg8::EpiSwiGLU E{V_ZH, (const LAS float*)(lds + TAB_OFF)};
            if (G == 256 && bx >= 128 && l + 1 < DEPTH) { const int t0 = (l + 1) * IT_LAYER + (second ? 2 : 0) * (IT_LAYER / 3), t1 = second ? (l + 2) * IT_LAYER : t0 + IT_LAYER / 3;
                conv_items_simple(a, ws, (LAS float*)(lds + RING_OFF + (tid_o >> 6) * 16640), tid_o & 63, t0 + (bx - 128) * NWAVES + (tid_o >> 6), t1, 128 * NWAVES); asm volatile("s_waitcnt vmcnt(0) lgkmcnt(0)" ::: "memory"); __syncthreads(); }
            { int bxo = blockIdx.x; asm volatile("" : "+s"(bxo)); pg8::build_rstd_tab((LAS float*)(lds + TAB_OFF), V_SSQ0, 8 * (bxo & 7) + ((bxo >> 3) & 7), tid_o); asm volatile("s_waitcnt lgkmcnt(0)" ::: "memory"); __syncthreads(); }
            pg8::gemm_phase<pg8::EpiSwiGLU, pg8::StaticOrder, true, true>(lds + RING_OFF, g, S, E);
        }
        GSEAM(pb); PH_END(1);
        PH_BEGIN(2); if (IN(pb + 1)) {
            pg8::Gemm g{V_ZH, V_WD + (size_t)(2 * l + second) * D * DFF, M, D, DFF, DFF}; pg8::StaticOrder S; S.init(M, D, G, bx);
            pg8::EpiRes E{(second == 0 && l > 0) ? V_B1 : V_B0, V_B0, V_SSQ1, 0.5f};
            pg8::gemm_phase<pg8::EpiRes, pg8::StaticOrder, false, true>(lds + RING_OFF, g, S, E);
        }
        GSEAM(pb + 1); PH_END(2);
        if (!second) {
            PH_BEGIN(3); if (IN(pb + 2)) {
                pg8::Gemm g{V_B0, V_WIN + (size_t)l * NZ * D, M, NZ, D, D}; pg8::StaticOrder S; S.init(M, NZ, G, bx);
                pg8::EpiZ E{V_ZH, (const LAS float*)(lds + TAB_OFF), V_SSQQ, V_SSQKV};
                if (G == 256 && bx >= 128 && l + 1 < DEPTH) { const int t0 = (l + 1) * IT_LAYER + (IT_LAYER / 3), t1 = t0 + IT_LAYER / 3;
                    conv_items_simple(a, ws, (LAS float*)(lds + RING_OFF + (tid_o >> 6) * 16640), tid_o & 63, t0 + (bx - 128) * NWAVES + (tid_o >> 6), t1, 128 * NWAVES); asm volatile("s_waitcnt vmcnt(0) lgkmcnt(0)" ::: "memory"); __syncthreads(); }
                { int bxo = blockIdx.x; asm volatile("" : "+s"(bxo)); pg8::build_rstd_tab((LAS float*)(lds + TAB_OFF), V_SSQ1, 8 * (bxo & 7) + ((bxo >> 3) & 7), tid_o); asm volatile("s_waitcnt lgkmcnt(0)" ::: "memory"); __syncthreads(); }
                pg8::gemm_phase<pg8::EpiZ, pg8::StaticOrder, true, true>(lds + RING_OFF, g, S, E);
                const f32x4* ps = (const f32x4*)(a.in[IN_P] + (size_t)l * M * PLED); v2u* pd = (v2u*)V_PBF;
                if (bx >= 128) {
                    for (int i0 = (bx - 128) * (NWAVES * 64) + tid_o; i0 < M * PLED / 4; i0 += 4 * 128 * NWAVES * 64) { f32x4 v[4];
#pragma unroll
                        for (int q = 0; q < 4; ++q) { const int i = i0 + q * 128 * NWAVES * 64; v[q] = ps[i < M * PLED / 4 ? i : i0]; }
#pragma unroll
                        for (int q = 0; q < 4; ++q) { const int i = i0 + q * 128 * NWAVES * 64; if (i < M * PLED / 4) { v2u o; o.x = pk2(v[q][0], v[q][1]); o.y = pk2(v[q][2], v[q][3]); pd[i] = o; } } } }
            }
            GSEAM(pb + 2); PH_END(3);
            const bool split = IN(pb + 3) && IN(pb + 4) && IN(pb + 5);
            PH_BEGIN(4); if (IN(pb + 3)) {
                pg8::Gemm g{V_ZH, V_WMLA + (size_t)l * 1024 * 512, M, 1024, 512, NZ}; pg8::StaticOrder S; S.init(M, 1024, G, bx);
                pg8::EpiMla E{V_QKV, V_SSQQ, V_SSQKV, V_MCS, V_MSN};
                int bxo = blockIdx.x; asm volatile("" : "+s"(bxo));
                const int mpm = 8 * (bxo & 7) + ((bxo >> 3) & 7), mpn = bxo >> 6;
                PH_BEGIN(40); pg8::gemm_phase<pg8::EpiMla, pg8::StaticOrder, false, true>(lds + RING_OFF, g, S, E); PH_END(40);
#if MIX_RET
                PH_BEGIN(41); for (int j0 = bx; j0 < 512; j0 += G) { const int j = (G == 256) ? (mpm >> 4) * 128 + (2 * (mpm & 15) + (j0 >> 8)) * 4 + mpn : j0; mx::ret_pass1(j, V_ZH, V_RCS, V_RSN, V_RST, lds + RING_OFF, tid_o); } PH_END(41);
#endif
#if MIX_HG
                PH_BEGIN(42); for (int p0 = bx; p0 < 512; p0 += G) { const int pr = (G == 256) ? (mpm >> 4) * 128 + (4 * (mpm & 15) + mpn) * 2 + (p0 >> 8) : p0; mx::hg_pass1(pr, V_ZH, (const float*)(ws + WS_HLB) + l * 512, V_HST, V_HDC, lds + RING_OFF, tid_o); } PH_END(42);
#endif
                if (split) xcd_barrier_arrive(bar, MISC + 14);
#if MIX_SG
                PH_BEGIN(43); for (int j0 = bx; j0 < 256; j0 += G) { const int j = (G == 256) ? 4 * mpm + mpn : j0; mx::sg_job(j, V_ZH, a.in[IN_SGLN] + l * 256, (const bf16*)(ws + WS_WSG) + (size_t)l * 4 * 128 * 128, a.in[IN_SGB] + l * 512, V_B1, lds + RING_OFF, tid_o); } PH_END(43);
#endif
            }
            if (split) xcd_barrier_wait(bar, MISC + 14); else SEAM(pb + 3); PH_END(4);
            PH_BEGIN(5); if (IN(pb + 4)) {
#if MIX_HG
                for (int gt = bx * (NWAVES * 64) + tid_o; gt < 16 * 4096; gt += G * NWAVES * 64) mx::hg_scan(V_HST, V_HDC, gt);
#endif
#if MIX_RET
                for (int gt = ((bx + G / 2) % G) * (NWAVES * 64) + tid_o; gt < 16 * 4096; gt += G * NWAVES * 64) mx::ret_scan(V_RST, gt);
#endif
            }
            if (split) xcd_barrier_arrive(bar, MISC + 14); else SEAM(pb + 4); PH_END(5);
            PH_BEGIN(6); if (IN(pb + 5)) {
#if MIX_MLA
                PH_BEGIN(60); for (int j0 = bx; j0 < 256; j0 += G) { const int j = (G == 256) ? ((j0 & 7) * 32 + (j0 >> 3)) : j0, bh = j >> 4, sq = j & 15;
                    mx::mla_qblock5(bh >> 2, bh & 3, 31 - sq, V_QKV, V_B1, lds + RING_OFF, tid_o); mx::mla_qblock5(bh >> 2, bh & 3, sq, V_QKV, V_B1, lds + RING_OFF, tid_o); } PH_END(60);
#endif
                if (split) xcd_barrier_wait(bar, MISC + 14);
#if MIX_RET
                PH_BEGIN(61); for (int j = bx; j < 512; j += G) mx::ret_pass3(j, V_ZH, V_RCS, V_RSN, V_RST, a.in[IN_RETN] + l * 256, V_B1, lds + RING_OFF, tid_o); PH_END(61);
#endif
#if MIX_HG
                PH_BEGIN(62); for (int pr = bx; pr < 512; pr += G) mx::hg_pass3(pr, V_ZH, (const float*)(ws + WS_HLB) + l * 512, V_HST, a.in[IN_HGN] + l * 256, V_B1, lds + RING_OFF, tid_o); PH_END(62);
#endif
            }
            const bool split3 = IN(pb + 5) && IN(pb + 6);
            if (split3) xcd_barrier_arrive(bar, MISC + 14); else SEAM(pb + 5); PH_END(6);
            PH_BEGIN(7); if (IN(pb + 6)) {
                { pg8::Gemm g{V_PBF, V_WPP + (size_t)l * D * PLED, M, D, PLED, PLED}; pg8::StaticOrder S; S.init(M, D, G, bx);
                  pg8::EpiPlain E{(bf16*)out, D};
                  pg8::gemm_phase<pg8::EpiPlain, pg8::StaticOrder, false, true>(lds + RING_OFF, g, S, E); }
                if (split3) xcd_barrier_wait(bar, MISC + 14);
                { pg8::Gemm g{V_B1, V_WOUT + (size_t)l * D * D, M, D, D, D}; pg8::StaticOrder S; S.init(M, D, G, bx);
                  pg8::EpiRes E{V_B0, V_B0, V_SSQ0, 1.0f};
                  pg8::gemm_phase<pg8::EpiRes, pg8::StaticOrder, false, true>(lds + RING_OFF, g, S, E); }
            }
            GSEAM(pb + 6); PH_END(7);
        } else {
            PH_BEGIN(8); if (IN(pb + 2)) {
                pg8::Gemm g{V_B0, V_WPG + (size_t)l * D * D, M, D, D, D}; pg8::StaticOrder S; S.init(M, D, G, bx);
                pg8::EpiPle E{V_B0, (const bf16*)out, V_B1, (const LAS float*)(lds + TAB_OFF), V_SSQ0};
                { int bxo = blockIdx.x; asm volatile("" : "+s"(bxo)); pg8::build_rstd_tab((LAS float*)(lds + TAB_OFF), V_SSQ1, 8 * (bxo & 7) + ((bxo >> 3) & 7), tid_o); asm volatile("s_waitcnt lgkmcnt(0)" ::: "memory"); __syncthreads(); }
                pg8::gemm_phase<pg8::EpiPle, pg8::StaticOrder, false, true>(lds + RING_OFF, g, S, E);
            }
            if (l + 1 < DEPTH) GSEAM(pb + 2); else SEAM(pb + 2); PH_END(8);
        }
    }
    PH_BEGIN(9);
    if (IN(41)) {
        const float* gfin = a.in[IN_FINN];
        const int tf_ = threadIdx.x, lane = tf_ & 63, wave = __builtin_amdgcn_readfirstlane(tf_ >> 6);
        const f32x4 gf[4] = {*(const f32x4*)(gfin + 8 * lane), *(const f32x4*)(gfin + 8 * lane + 4), *(const f32x4*)(gfin + 512 + 8 * lane), *(const f32x4*)(gfin + 512 + 8 * lane + 4)};
        const int pl = (G == 256), mfirst = pl ? (8 * (bx & 7) + ((bx >> 3) & 7)) * 256 + (bx >> 6) * 64 + wave * 8 : vcu * NWAVES + wave, mstep = pl ? 1 : G * NWAVES, mend = pl ? mfirst + 8 : M;
        for (int m0 = mfirst; m0 < mend; m0 += 4 * mstep) { v4u hw[4][2]; f32x4 sp[4];
#pragma unroll
            for (int r = 0; r < 4; ++r) { const int mr = m0 + r * mstep, m = mr < mend ? mr : m0; const bf16* hr = V_B1 + (size_t)m * D; hw[r][0] = *(const v4u*)(hr + 8 * lane); hw[r][1] = *(const v4u*)(hr + 512 + 8 * lane); sp[r] = *(const f32x4*)(V_SSQ0 + (size_t)m * 16 + 4 * (lane & 3)); }
#pragma unroll
            for (int r = 0; r < 4; ++r) { const int m = m0 + r * mstep; if (m < mend) { float s = pg8::sum4(sp[r]); s += __shfl_xor(s, 1); s += __shfl_xor(s, 2); const float rs = __builtin_amdgcn_rsqf(s * (1.0f / 1024.0f) + pg8::RMS_EPS); float* orow = out + (size_t)m * D;
#pragma unroll
                for (int j = 0; j < 2; ++j) { const v4u w = hw[r][j]; const f32x4 g0 = gf[2 * j], g1 = gf[2 * j + 1];
                    f32x4 o0, o1; o0[0] = __uint_as_float(w.x << 16) * rs * g0[0]; o0[1] = __uint_as_float(w.x & 0xffff0000u) * rs * g0[1]; o0[2] = __uint_as_float(w.y << 16) * rs * g0[2]; o0[3] = __uint_as_float(w.y & 0xffff0000u) * rs * g0[3];
                    o1[0] = __uint_as_float(w.z << 16) * rs * g1[0]; o1[1] = __uint_as_float(w.z & 0xffff0000u) * rs * g1[1]; o1[2] = __uint_as_float(w.w << 16) * rs * g1[2]; o1[3] = __uint_as_float(w.w & 0xffff0000u) * rs * g1[3];
                    *(f32x4*)(orow + 512 * j + 8 * lane) = o0; *(f32x4*)(orow + 512 * j + 8 * lane + 4) = o1; } } } }
    }
    PH_END(9);
#ifdef MLA_DBG_V
    if (bx == 0 && tid == 0) { const unsigned mv = __hip_atomic_load(&mx::g_dbg_mism, __ATOMIC_RELAXED, __HIP_MEMORY_SCOPE_AGENT); unsigned code = 0;
        for (int q_ = 0; q_ < 4; ++q_) code |= (((mv >> (8 * q_)) & 0xffu) ? 1u : 0u) << q_;
        const unsigned any8 = (mv | (mv >> 8) | (mv >> 16) | (mv >> 24)) & 0xffu;
        const unsigned long long t_end = wall_clock64(); while (wall_clock64() - t_end < (unsigned long long)(code * 256u + any8) * 1000ull) __builtin_amdgcn_s_sleep(8); }
#endif
#ifdef PROBE_CLASS
    if (bx == 0 && tid == 0) { const unsigned long long t_end = wall_clock64(); while (wall_clock64() - t_end < (unsigned long long)PROBE_MULT * pr_acc) __builtin_amdgcn_s_sleep(8); }
#endif
#undef IN
#undef SEAM
#undef GSEAM
}

#ifndef MK_MODE
#define MK_MODE 0
#endif
#if MK_MODE != 0
__device__ __forceinline__ float gelu_exact(float x) { return 0.5f * x * (1.0f + erff(x * 0.70710678118654752f)); }
__device__ __forceinline__ float silu_f(float x) { return x / (1.0f + __expf(-x)); }
__global__ void __launch_bounds__(256) nv_mla(const bf16* QKV, bf16* Y) {
    const int lane = threadIdx.x & 63, gw = blockIdx.x * 4 + (threadIdx.x >> 6); const int t = gw & (SEQ - 1), bh = gw >> 12, b = bh >> 2, h = bh & 3;
    const size_t m = (size_t)b * SEQ + t;
    float q[96];
#pragma unroll
    for (int d = 0; d < 96; ++d) q[d] = bf2f(QKV[m * 1024 + QC_Q + 96 * h + d]);
    float mi = -INFINITY, li = 0.f, acc[64];
#pragma unroll
    for (int e = 0; e < 64; ++e) acc[e] = 0.f;
    for (int s = lane; s <= t; s += 64) { const bf16* kr = QKV + ((size_t)b * SEQ + s) * 1024; float dot = 0.f;
#pragma unroll
        for (int d = 0; d < 64; ++d) dot += q[d] * bf2f(kr[QC_KN + 64 * h + d]);
#pragma unroll
        for (int d = 0; d < 32; ++d) dot += q[64 + d] * bf2f(kr[QC_KR + d]);
        const float mn = fmaxf(mi, dot), corr = exp2f(mi - mn), p = exp2f(dot - mn); li = li * corr + p; mi = mn;
#pragma unroll
        for (int e = 0; e < 64; ++e) acc[e] = acc[e] * corr + p * bf2f(kr[QC_V + 64 * h + e]); }
    const float mg = wave_max(mi), w = (mi == -INFINITY) ? 0.f : exp2f(mi - mg); const float L = wave_sum(li * w); float res = 0.f;
#pragma unroll
    for (int e = 0; e < 64; ++e) { const float v = wave_sum(acc[e] * w); if (lane == e) res = v; }
    Y[m * 1024 + 64 * h + lane] = (bf16)f2bf(res / L);
}
__global__ void __launch_bounds__(256) nv_ret_prep(const bf16* Z, const float* rcs, const float* rsn, float* QR, float* KR) {
    const int i = blockIdx.x * 256 + threadIdx.x; if (i >= M * 128) return; const int m = i >> 7, r = i & 127, h = r >> 5, j = r & 31;
    const float c = rcs[(size_t)m * 32 + j], s = rsn[(size_t)m * 32 + j];
    { const float x1 = bf2f(Z[(size_t)m * NZ + ZC_RQ + 64 * h + j]), x2 = bf2f(Z[(size_t)m * NZ + ZC_RQ + 64 * h + 32 + j]); QR[(size_t)m * 256 + 64 * h + j] = x1 * c - x2 * s; QR[(size_t)m * 256 + 64 * h + 32 + j] = x1 * s + x2 * c; }
    { const float x1 = bf2f(Z[(size_t)m * NZ + ZC_RK + 64 * h + j]), x2 = bf2f(Z[(size_t)m * NZ + ZC_RK + 64 * h + 32 + j]); KR[(size_t)m * 256 + 64 * h + j] = 0.125f * (x1 * c - x2 * s); KR[(size_t)m * 256 + 64 * h + 32 + j] = 0.125f * (x1 * s + x2 * c); }
}
__global__ void __launch_bounds__(256) nv_ret(const bf16* Z, const float* QR, const float* KR, const float* normg, bf16* Y) {
    const int lane = threadIdx.x & 63, gw = blockIdx.x * 4 + (threadIdx.x >> 6); const int t = gw & (SEQ - 1), bh = gw >> 12, b = bh >> 2, h = bh & 3;
    const size_t m = (size_t)b * SEQ + t; const float lg2 = log2f(1.0f - exp2f(-(5.0f + (float)h)));
    float q[64], acc[64];
#pragma unroll
    for (int d = 0; d < 64; ++d) { q[d] = QR[m * 256 + 64 * h + d]; acc[d] = 0.f; }
    for (int s = lane; s <= t; s += 64) { const size_t ms = (size_t)b * SEQ + s; float dot = 0.f;
#pragma unroll
        for (int d = 0; d < 64; ++d) dot += q[d] * KR[ms * 256 + 64 * h + d];
        const float p = dot * exp2f((float)(t - s) * lg2);
#pragma unroll
        for (int e = 0; e < 64; ++e) acc[e] += p * bf2f(Z[ms * NZ + ZC_RV + 64 * h + e]); }
    float o = 0.f;
#pragma unroll
    for (int e = 0; e < 64; ++e) { const float v = wave_sum(acc[e]); if (lane == e) o = v; }
    const float mean = wave_sum(o) * (1.0f / 64.0f), oc = o - mean, var = wave_sum(oc * oc) * (1.0f / 64.0f);
    const float gate = silu_f(bf2f(Z[m * NZ + ZC_RG + 64 * h + lane]));
    Y[m * 1024 + 768 + 64 * h + lane] = (bf16)f2bf(oc * rsqrtf(var + 1e-6f) * normg[64 * h + lane] * gate);
}
__global__ void __launch_bounds__(64) nv_hgrn(const bf16* Z, const float* lblog, int l, const float* normg, bf16* Y) {
    __shared__ float sq[128], sf[128], sk[128];
    const int lane = threadIdx.x, bh = blockIdx.x, b = bh >> 2, h = bh & 3;
    float lb[2];
#pragma unroll
    for (int c = 0; c < 2; ++c) { const int ch = 128 * h + lane + 64 * c; const float x0 = lblog[ch], x1 = lblog[512 + ch], x2 = lblog[1024 + ch], x3 = lblog[1536 + ch];
        const float mx = fmaxf(fmaxf(x0, x1), fmaxf(x2, x3)); const float e0 = __expf(x0 - mx), e1 = __expf(x1 - mx), e2 = __expf(x2 - mx), e3 = __expf(x3 - mx); const float inv = 1.0f / (e0 + e1 + e2 + e3);
        lb[c] = (l >= 1 ? e1 : 0.f) * inv + (l >= 2 ? e2 : 0.f) * inv + (l >= 3 ? e3 : 0.f) * inv; }
    float S[128];
#pragma unroll
    for (int k = 0; k < 128; ++k) S[k] = 0.f;
    const float ng = normg[64 * h + lane];
    for (int t = 0; t < SEQ; ++t) { const size_t m = (size_t)b * SEQ + t; const bf16* zr = Z + m * NZ;
        __syncthreads();
#pragma unroll
        for (int c = 0; c < 2; ++c) { const int k = lane + 64 * c; const float f = bf2f(zr[ZC_HF + 128 * h + k]); const float fg = lb[c] + (1.0f - lb[c]) / (1.0f + __expf(-f));
            sq[k] = bf2f(zr[ZC_HQ + 128 * h + k]); sf[k] = fg; sk[k] = 1.0f - fg; }
        __syncthreads();
        const float v = bf2f(zr[ZC_HI + 64 * h + lane]); float o = 0.f;
#pragma unroll
        for (int k = 0; k < 128; ++k) { S[k] = sf[k] * S[k] + sk[k] * v; o += sq[k] * S[k]; }
        const float ms = wave_sum(o * o) * (1.0f / 64.0f); const float gate = silu_f(bf2f(zr[ZC_HG + 64 * h + lane]));
        Y[m * 1024 + 512 + 64 * h + lane] = (bf16)f2bf(o * rsqrtf(ms + 1e-6f) * ng * gate); }
}
__global__ void __launch_bounds__(256) nv_sg_prep(const bf16* Z, const float* lng, bf16* V) {
    const int lane = threadIdx.x & 63, m = blockIdx.x * 4 + (threadIdx.x >> 6); float x[4]; float s = 0.f;
#pragma unroll
    for (int j = 0; j < 4; ++j) { x[j] = gelu_exact(bf2f(Z[(size_t)m * NZ + ZC_V + lane + 64 * j])); s += x[j]; }
    const float mean = wave_sum(s) * (1.0f / 256.0f); float q = 0.f;
#pragma unroll
    for (int j = 0; j < 4; ++j) { x[j] -= mean; q += x[j] * x[j]; }
    const float rstd = rsqrtf(wave_sum(q) * (1.0f / 256.0f) + 1e-6f);
#pragma unroll
    for (int j = 0; j < 4; ++j) V[(size_t)m * 256 + lane + 64 * j] = (bf16)f2bf(x[j] * rstd * lng[lane + 64 * j]);
}
__global__ void __launch_bounds__(256) nv_sg(const bf16* Z, const bf16* V, const float* w, const float* bs, bf16* Y) {
    const int d = threadIdx.x, m = blockIdx.x, t = m & 127, h = d >> 6; const size_t m0 = (size_t)(m - t);
    float acc = bs[h * 128 + t]; const float* wr = w + ((size_t)h * 128 + t) * 128;
    for (int s = 0; s <= t; ++s) acc += wr[s] * bf2f(V[(m0 + s) * 256 + d]);
    Y[(size_t)m * 1024 + 256 + d] = (bf16)f2bf(gelu_exact(bf2f(Z[(size_t)m * NZ + ZC_U + d])) * acc);
}
#endif

extern "C" void kernel_launch(void* const* d_in, const int* in_sizes, int n_in, void* d_out, int out_size, void* d_ws, size_t ws_size, hipStream_t stream) {
    static int grid = 0; static void (*kfn)(Args) = nullptr;
    if (grid == 0) {
        if (n_in != N_IN || in_sizes[0] != M * D || out_size != M * D || ws_size < WS_END) { fprintf(stderr, "kernel_launch: unexpected shapes (n_in %d, in0 %d, out %d, ws %zu < %zu?)\n", n_in, n_in > 0 ? in_sizes[0] : -1, out_size, ws_size, (size_t)WS_END); grid = -1; return; }
        int dev = 0, cus = 0, per_cu = 0;
        if (hipGetDevice(&dev) != hipSuccess || hipDeviceGetAttribute(&cus, hipDeviceAttributeMultiprocessorCount, dev) != hipSuccess) { grid = -1; return; }
        if (cus != 256) { fprintf(stderr, "kernel_launch: this build is specialised for a 256-CU device (found %d)\n", cus); grid = -1; return; }
        kfn = mk_fwd<true>;
        if (hipFuncSetAttribute((const void*)kfn, hipFuncAttributeMaxDynamicSharedMemorySize, LDS_BYTES) != hipSuccess) { fprintf(stderr, "kernel_launch: hipFuncSetAttribute failed\n"); grid = -1; return; }
        if (hipOccupancyMaxActiveBlocksPerMultiprocessor(&per_cu, (const void*)kfn, NWAVES * 64, LDS_BYTES) != hipSuccess || per_cu < 1) { fprintf(stderr, "kernel_launch: occupancy query says %d\n", per_cu); }
        (void)hipGetLastError();
        grid = cus;
    }
    if (grid < 0) return;
    if (hipMemsetAsync((char*)d_ws + WS_CTL, 0, CTL_ZERO_BYTES, stream) != hipSuccess) return;
    Args a{};
    for (int i = 0; i < N_IN; ++i) a.in[i] = (const float*)d_in[i];
    a.out = (float*)d_out; a.ws = (unsigned char*)d_ws;
    auto launch = [&](int lo, int hi, int li) { a.ph_lo = lo; a.ph_hi = hi; a.li = li; hipLaunchKernelGGL(kfn, dim3(grid), dim3(NWAVES * 64), LDS_BYTES, stream, a); };
#if MK_MODE == 0
    launch(0, N_PHASES, 0);
#else
    unsigned char* ws = (unsigned char*)d_ws;
    const bf16* Z = (const bf16*)(ws + WS_ZH); const bf16* QKV = (const bf16*)(ws + WS_QKV); bf16* Y = (bf16*)(ws + WS_B1);
    float* QR = (float*)(ws + WS_HST); float* KR = QR + (size_t)M * 256; bf16* V = (bf16*)(ws + WS_RST);
    const float* rcs = (const float*)(ws + WS_ROPE) + (size_t)M * 32; const float* rsn = rcs + (size_t)M * 32;
    int li = 0, lo = 0;
    for (int l = 0; l < DEPTH; ++l) {
        launch(lo, 1 + 10 * l + 3, li++);
#if !MIX_RET
        hipLaunchKernelGGL(nv_ret_prep, dim3(M * 128 / 256), dim3(256), 0, stream, Z, rcs, rsn, QR, KR);
        hipLaunchKernelGGL(nv_ret, dim3(M), dim3(256), 0, stream, Z, (const float*)QR, (const float*)KR, (const float*)d_in[IN_RETN] + l * 256, Y);
#endif
#if !MIX_HG
        hipLaunchKernelGGL(nv_hgrn, dim3(16), dim3(64), 0, stream, Z, (const float*)d_in[IN_HGLB], l, (const float*)d_in[IN_HGN] + l * 256, Y);
#endif
#if !MIX_SG
        hipLaunchKernelGGL(nv_sg_prep, dim3(M / 4), dim3(256), 0, stream, Z, (const float*)d_in[IN_SGLN] + l * 256, V);
        hipLaunchKernelGGL(nv_sg, dim3(M), dim3(256), 0, stream, Z, (const bf16*)V, (const float*)d_in[IN_SGW] + (size_t)l * 4 * 128 * 128, (const float*)d_in[IN_SGB] + l * 512, Y);
#endif
        launch(1 + 10 * l + 3, 1 + 10 * l + 6, li++);
#if !MIX_MLA
        hipLaunchKernelGGL(nv_mla, dim3(M), dim3(256), 0, stream, QKV, Y);
#endif
        lo = 1 + 10 * l + 6;
    }
    launch(lo, N_PHASES, li++);
#endif
}
```

```cpp
#include <hip/hip_runtime.h>
#include <cstdio>
#include <cstdint>
#include <cmath>
namespace pg8 {
#define PG8_LAS __attribute__((address_space(3)))
typedef unsigned short bf16_t;
typedef short bf16x8 __attribute__((ext_vector_type(8)));
typedef float f32x4 __attribute__((ext_vector_type(4)));
typedef unsigned u32x4 __attribute__((ext_vector_type(4)));
constexpr int BM = 256, BK = 64, HALF = 128, HTB = HALF * BK * 2  , STAGE_BYTES = 8 * HTB, NXCD = 8, WGM = 8;

__host__ __device__ __forceinline__ int lds_byte(int r, int c) { const int st = (r >> 4) * 2 + (c >> 5), rr = r & 15, cc = c & 31, ob = rr * 64 + cc * 2; return st * 1024 + (ob ^ (((ob >> 9) & 1) << 5)); }
__host__ __device__ __forceinline__ void stage_rc(int b, int& R, int& C) { const int st = b / 1024, sb = b % 1024, swz = sb ^ (((sb >> 9) & 1) << 5); R = (st >> 1) * 16 + swz / 64; C = (st & 1) * 32 + (swz % 64) / 2; }
__host__ __device__ __forceinline__ int perm32(int rho) { const int n = rho >> 4, i = rho & 15; return 8 * (i >> 2) + 4 * n + (i & 3); }

struct Unit { int pm, pn; };
struct Gemm { const bf16_t* A; const bf16_t* Bt; int M, N, K, lda; };

struct StaticOrder {
    int nM, nN, nwg, G, c;
    __host__ __device__ void init(int M, int N, int G_, int c_) { nM = M / BM; nN = N / BM; nwg = nM * nN; G = G_; c = c_; }
    __host__ __device__ bool next(int i, Unit& u) const {
        const long L = (long)i * G + c; if (L >= nwg) return false;
        int wgid = (int)L; { const int q = nwg / NXCD, r = nwg % NXCD, xcd = wgid % NXCD, off = wgid / NXCD; wgid = (xcd < r ? xcd * (q + 1) : r * (q + 1) + (xcd - r) * q) + off; }
        const int nig = WGM * nN, gid = wgid / nig, fm = gid * WGM, gsz = (nM - fm) < WGM ? (nM - fm) : WGM;
        u.pm = fm + ((wgid % nig) % gsz); u.pn = (wgid % nig) / gsz; return true;
    }
    __device__ __forceinline__ void a_ready(const Unit&) const {}
    __device__ __forceinline__ void done(const Unit&) const {}
};

__device__ __forceinline__ unsigned cvt_pk_bf16(float lo, float hi) { unsigned r; asm volatile("v_cvt_pk_bf16_f32 %0, %1, %2" : "=v"(r) : "v"(lo), "v"(hi)); return r; }
typedef unsigned u32x2 __attribute__((ext_vector_type(2)));
typedef float f32x2 __attribute__((ext_vector_type(2)));
constexpr float RMS_EPS = 1e-6f, LOG2E = 1.4426950408889634f;
constexpr int DM = 1024, DFF_ = 2816, NZ_ = 3584;
__device__ __forceinline__ float sum4(const f32x4 a) { return (a[0] + a[1]) + (a[2] + a[3]); }
__device__ __forceinline__ float dot4(const f32x4 a) { return (a[0] * a[0] + a[1] * a[1]) + (a[2] * a[2] + a[3] * a[3]); }
__device__ __forceinline__ float row_rstd(const float* ssq, int row) {
    const f32x4* p = (const f32x4*)(ssq + (size_t)row * 16);
    const float s = (sum4(p[0]) + sum4(p[1])) + (sum4(p[2]) + sum4(p[3]));
    return __builtin_amdgcn_rsqf(s * (1.0f / 1024.0f) + RMS_EPS);
}
__device__ __forceinline__ float xlane(float v, int lane, int mask) { return __builtin_bit_cast(float, __builtin_amdgcn_ds_bpermute((lane ^ mask) << 2, __builtin_bit_cast(int, v))); }
__device__ __forceinline__ float fq_sum(float s, int lane) { s += xlane(s, lane, 16); s += xlane(s, lane, 32); return s; }
__device__ __forceinline__ void rows_rstd8(const float* ssq, int row0, int fq, int lane, float (&r)[8]) {
    f32x4 p[8];
#pragma unroll
    for (int i = 0; i < 8; ++i) p[i] = *(const f32x4*)(ssq + (size_t)(row0 + (i >> 2) * HALF + (i & 3) * 16) * 16 + 4 * fq);
#pragma unroll
    for (int i = 0; i < 8; ++i) { const float s = fq_sum(sum4(p[i]), lane); r[i] = __builtin_amdgcn_rsqf(s * (1.0f / 1024.0f) + RMS_EPS); }
}
__device__ __forceinline__ void build_rstd_tab(PG8_LAS float* tab, const float* ssq, int pm, int tid) {
    const int row = tid >> 1, hf = tid & 1; const f32x4* p = (const f32x4*)(ssq + (size_t)(pm * BM + row) * 16 + 8 * hf);
    float s = sum4(p[0]) + sum4(p[1]);
    s += __builtin_bit_cast(float, __builtin_amdgcn_update_dpp(0, __builtin_bit_cast(int, s), 0xB1, 0xF, 0xF, false));
    if (hf == 0) tab[row] = __builtin_amdgcn_rsqf(s * (1.0f / 1024.0f) + RMS_EPS);
}
__device__ __forceinline__ float sigmoid_f(float x) { return __builtin_amdgcn_rcpf(1.0f + __builtin_amdgcn_exp2f(-LOG2E * x)); }

struct EpiSwiGLU {
    static constexpr bool PERM = true, AFTER_DRAIN = false;
    bf16_t* O; const PG8_LAS float* tab;
    __device__ __forceinline__ void operator()(const f32x4 (&acc)[2][2][4][2], const Unit& u, int wr, int wc, int fr, int fq) const {
        const int row0 = u.pm * BM + wr * 64 + fr, col0 = u.pn * 128 + wc * 32 + 8 * fq;
        float rr[8]; int ro = wr * 64 + fr; asm volatile("" : "+v"(ro));
#pragma unroll
        for (int i = 0; i < 8; ++i) rr[i] = tab[ro + (i >> 2) * HALF + (i & 3) * 16];
#pragma unroll
        for (int ai = 0; ai < 2; ++ai)
#pragma unroll
            for (int m = 0; m < 4; ++m) { const int row = row0 + ai * HALF + m * 16; const float r = rr[ai * 4 + m], c = -LOG2E * r, r2 = r * r;
                f32x2 t[4], p[4];
#pragma unroll
                for (int n = 0; n < 2; ++n) { const f32x4 gv = acc[ai][0][m][n], uv = acc[ai][1][m][n];
                    const f32x2 g0 = __builtin_shufflevector(gv, gv, 0, 1), g1 = __builtin_shufflevector(gv, gv, 2, 3), u0 = __builtin_shufflevector(uv, uv, 0, 1), u1 = __builtin_shufflevector(uv, uv, 2, 3);
                    t[2 * n] = g0 * c; t[2 * n + 1] = g1 * c; p[2 * n] = g0 * u0; p[2 * n + 1] = g1 * u1; }
#pragma unroll
                for (int q = 0; q < 4; ++q) { t[q][0] = __builtin_amdgcn_exp2f(t[q][0]); t[q][1] = __builtin_amdgcn_exp2f(t[q][1]); }
#pragma unroll
                for (int q = 0; q < 4; ++q) t[q] = t[q] + 1.0f;
#pragma unroll
                for (int q = 0; q < 4; ++q) { t[q][0] = __builtin_amdgcn_rcpf(t[q][0]); t[q][1] = __builtin_amdgcn_rcpf(t[q][1]); }
#pragma unroll
                for (int q = 0; q < 4; ++q) p[q] = p[q] * (t[q] * r2);
                u32x4 w; w.x = cvt_pk_bf16(p[0][0], p[0][1]); w.y = cvt_pk_bf16(p[1][0], p[1][1]); w.z = cvt_pk_bf16(p[2][0], p[2][1]); w.w = cvt_pk_bf16(p[3][0], p[3][1]);
                *(u32x4*)(O + (size_t)row * DFF_ + col0) = w; }
    }
};
struct EpiRes {
    static constexpr bool PERM = true, AFTER_DRAIN = false;
    const bf16_t* base; bf16_t* hb; float* ssq_out; float alpha;
    __device__ __forceinline__ void operator()(const f32x4 (&acc)[2][2][4][2], const Unit& u, int wr, int wc, int fr, int fq) const {
        const int row0 = u.pm * BM + wr * 64 + fr, col0 = u.pn * BM + wc * 32 + 8 * fq;
        u32x4 bw[2][4][2];
#pragma unroll
        for (int ai = 0; ai < 2; ++ai)
#pragma unroll
            for (int m = 0; m < 4; ++m)
#pragma unroll
                for (int bj = 0; bj < 2; ++bj) bw[ai][m][bj] = *(const u32x4*)(base + (size_t)(row0 + ai * HALF + m * 16) * DM + col0 + bj * HALF);
#pragma unroll
        for (int ai = 0; ai < 2; ++ai)
#pragma unroll
            for (int m = 0; m < 4; ++m) { const int row = row0 + ai * HALF + m * 16; float s = 0.f;
#pragma unroll
                for (int bj = 0; bj < 2; ++bj) { const size_t off = (size_t)row * DM + col0 + bj * HALF; const u32x4 b4 = bw[ai][m][bj];
                    f32x4 v0 = acc[ai][bj][m][0] * alpha, v1 = acc[ai][bj][m][1] * alpha;
                    v0[0] += __uint_as_float(b4.x << 16); v0[1] += __uint_as_float(b4.x & 0xffff0000u); v0[2] += __uint_as_float(b4.y << 16); v0[3] += __uint_as_float(b4.y & 0xffff0000u);
                    v1[0] += __uint_as_float(b4.z << 16); v1[1] += __uint_as_float(b4.z & 0xffff0000u); v1[2] += __uint_as_float(b4.w << 16); v1[3] += __uint_as_float(b4.w & 0xffff0000u);
                    s += dot4(v0) + dot4(v1); u32x4 w; w.x = cvt_pk_bf16(v0[0], v0[1]); w.y = cvt_pk_bf16(v0[2], v0[3]); w.z = cvt_pk_bf16(v1[0], v1[1]); w.w = cvt_pk_bf16(v1[2], v1[3]); *(u32x4*)(hb + off) = w; }
                s = fq_sum(s, fq * 16 + fr);
                if (fq == 0) ssq_out[(size_t)row * 16 + u.pn * 4 + wc] = s; }
    }
};
struct EpiZ {
    static constexpr bool PERM = true, AFTER_DRAIN = false;
    bf16_t* Z; const PG8_LAS float* tab; float* ssqq; float* ssqkv;
    __device__ __forceinline__ void operator()(const f32x4 (&acc)[2][2][4][2], const Unit& u, int wr, int wc, int fr, int fq) const {
        const int row0 = u.pm * BM + wr * 64 + fr, col0 = u.pn * BM + wc * 32 + 8 * fq;
        float rr[8]; int ro = wr * 64 + fr; asm volatile("" : "+v"(ro));
#pragma unroll
        for (int i = 0; i < 8; ++i) rr[i] = tab[ro + (i >> 2) * HALF + (i & 3) * 16];
#pragma unroll
        for (int ai = 0; ai < 2; ++ai)
#pragma unroll
            for (int m = 0; m < 4; ++m) { const int row = row0 + ai * HALF + m * 16; const float r = rr[ai * 4 + m]; float s0 = 0.f, s1 = 0.f;
#pragma unroll
                for (int bj = 0; bj < 2; ++bj) { const f32x4 v0 = acc[ai][bj][m][0] * r, v1 = acc[ai][bj][m][1] * r;
                    if (bj == 0) s0 = dot4(v0) + dot4(v1); else s1 = dot4(v0) + dot4(v1);
                    u32x4 w; w.x = cvt_pk_bf16(v0[0], v0[1]); w.y = cvt_pk_bf16(v0[2], v0[3]); w.z = cvt_pk_bf16(v1[0], v1[1]); w.w = cvt_pk_bf16(v1[2], v1[3]);
                    *(u32x4*)(Z + (size_t)row * NZ_ + col0 + bj * HALF) = w; }
                if (u.pn < 2) { float s = (u.pn == 0) ? s0 + s1 : s0; s = fq_sum(s, fq * 16 + fr);
                    if (fq == 0) { if (u.pn == 0) ssqq[(size_t)row * 4 + wc] = s; else ssqkv[(size_t)row * 4 + wc] = s; } } }
    }
};
struct EpiMla {
    static constexpr bool PERM = true, AFTER_DRAIN = false;
    bf16_t* O; const float* ssqq; const float* ssqkv; const float* cs; const float* sn;
    __device__ __forceinline__ void operator()(const f32x4 (&acc)[2][2][4][2], const Unit& u, int wr, int wc, int fr, int fq) const {
        const int row0 = u.pm * BM + wr * 64 + fr, col0 = u.pn * BM + wc * 32 + 8 * fq;
        const float QSCALE = 0.10206207261596575f * LOG2E;
        float pq[8], pkv[8];
#pragma unroll
        for (int i = 0; i < 8; ++i) { const size_t row = (size_t)(row0 + (i >> 2) * HALF + (i & 3) * 16); pq[i] = ssqq[row * 4 + fq]; pkv[i] = ssqkv[row * 4 + fq]; }
        const int G0 = 8 * u.pn + wc, G1 = G0 + 4;
        const bool rope0 = (G0 == 2 || G0 == 5 || G0 == 8 || G0 == 11 || G0 == 28), rope1 = (G1 == 2 || G1 == 5 || G1 == 8 || G1 == 11 || G1 == 28);
#pragma unroll
        for (int i = 0; i < 8; ++i) { const float a = fq_sum(pq[i], fq * 16 + fr), b = fq_sum(pkv[i], fq * 16 + fr);
            pq[i] = __builtin_amdgcn_rsqf(a * (1.0f / 256.0f) + RMS_EPS) * QSCALE; pkv[i] = __builtin_amdgcn_rsqf(b * (1.0f / 128.0f) + RMS_EPS); }
#pragma unroll
        for (int ai = 0; ai < 2; ++ai) {
            f32x4 c4[4], s4[4];
            if (rope0 || rope1) {
#pragma unroll
                for (int m = 0; m < 4; ++m) { const size_t row = (size_t)(row0 + ai * HALF + m * 16); c4[m] = *(const f32x4*)(cs + row * 16 + 4 * fq); s4[m] = *(const f32x4*)(sn + row * 16 + 4 * fq); }
            } else {
#pragma unroll
                for (int m = 0; m < 4; ++m) { c4[m] = (f32x4){1.f, 1.f, 1.f, 1.f}; s4[m] = (f32x4){0.f, 0.f, 0.f, 0.f}; }
            }
#pragma unroll
            for (int m = 0; m < 4; ++m) { const int row = row0 + ai * HALF + m * 16; const float rq = pq[ai * 4 + m], rkv = pkv[ai * 4 + m];
#pragma unroll
                for (int bj = 0; bj < 2; ++bj) { const int G = 8 * u.pn + 4 * bj + wc; const float sc = G < 12 ? rq : (G < 28 ? rkv : 1.0f);
                    f32x4 x1 = acc[ai][bj][m][0] * sc, x2 = acc[ai][bj][m][1] * sc;
                    if (bj == 0 ? rope0 : rope1) { const f32x4 y1 = x1 * c4[m] - x2 * s4[m], y2 = x1 * s4[m] + x2 * c4[m]; x1 = y1; x2 = y2; }
                    u32x4 w; w.x = cvt_pk_bf16(x1[0], x1[1]); w.y = cvt_pk_bf16(x1[2], x1[3]); w.z = cvt_pk_bf16(x2[0], x2[1]); w.w = cvt_pk_bf16(x2[2], x2[3]);
                    *(u32x4*)(O + (size_t)row * DM + col0 + bj * HALF) = w; } }
        }
    }
};
struct EpiPlain {
    static constexpr bool PERM = true, AFTER_DRAIN = false;
    bf16_t* O; int ldc;
    __device__ __forceinline__ void operator()(const f32x4 (&acc)[2][2][4][2], const Unit& u, int wr, int wc, int fr, int fq) const {
        const int row0 = u.pm * BM + wr * 64 + fr, col0 = u.pn * BM + wc * 32 + 8 * fq;
#pragma unroll
        for (int ai = 0; ai < 2; ++ai)
#pragma unroll
            for (int m = 0; m < 4; ++m) { bf16_t* rowp = O + (size_t)(row0 + ai * HALF + m * 16) * ldc + col0;
#pragma unroll
                for (int bj = 0; bj < 2; ++bj) { const f32x4 v0 = acc[ai][bj][m][0], v1 = acc[ai][bj][m][1];
                    u32x4 w; w.x = cvt_pk_bf16(v0[0], v0[1]); w.y = cvt_pk_bf16(v0[2], v0[3]); w.z = cvt_pk_bf16(v1[0], v1[1]); w.w = cvt_pk_bf16(v1[2], v1[3]);
                    *(u32x4*)(rowp + bj * HALF) = w; } }
    }
};
struct EpiPle {
    static constexpr bool PERM = true, AFTER_DRAIN = false;
    const bf16_t* h; const bf16_t* pp; bf16_t* hb; const PG8_LAS float* tab; float* ssq_out;
    __device__ __forceinline__ void operator()(const f32x4 (&acc)[2][2][4][2], const Unit& u, int wr, int wc, int fr, int fq) const {
        const int row0 = u.pm * BM + wr * 64 + fr, col0 = u.pn * BM + wc * 32 + 8 * fq;
        int ro = wr * 64 + fr; asm volatile("" : "+v"(ro));
        u32x4 hw4[4][2], pw4[4][2];
#pragma unroll
        for (int i = 0; i < 3; ++i)
#pragma unroll
            for (int bj = 0; bj < 2; ++bj) { const size_t off = (size_t)(row0 + (i >> 2) * HALF + (i & 3) * 16) * DM + col0 + bj * HALF; hw4[i][bj] = *(const u32x4*)(h + off); pw4[i][bj] = *(const u32x4*)(pp + off); }
#pragma unroll
        for (int i = 0; i < 8; ++i) { const int ai = i >> 2, m = i & 3, row = row0 + ai * HALF + m * 16; const float r = tab[ro + ai * HALF + m * 16]; float s = 0.f;
            if (i + 3 < 8) {
#pragma unroll
                for (int bj = 0; bj < 2; ++bj) { const size_t off = (size_t)(row0 + ((i + 3) >> 2) * HALF + ((i + 3) & 3) * 16) * DM + col0 + bj * HALF; hw4[(i + 3) % 4][bj] = *(const u32x4*)(h + off); pw4[(i + 3) % 4][bj] = *(const u32x4*)(pp + off); }
            }
#pragma unroll
            for (int bj = 0; bj < 2; ++bj) { const size_t off = (size_t)row * DM + col0 + bj * HALF; const u32x4 hw = hw4[i % 4][bj], pw = pw4[i % 4][bj];
                const unsigned hu[4] = {hw.x, hw.y, hw.z, hw.w}, pu[4] = {pw.x, pw.y, pw.z, pw.w}; unsigned wo[4];
#pragma unroll
                for (int q = 0; q < 4; ++q) { const float a0 = acc[ai][bj][m][q >> 1][2 * (q & 1)] * r, a1 = acc[ai][bj][m][q >> 1][2 * (q & 1) + 1] * r;
                    const float v0 = __uint_as_float(hu[q] << 16) + __uint_as_float(pu[q] << 16) * sigmoid_f(a0), v1 = __uint_as_float(hu[q] & 0xffff0000u) + __uint_as_float(pu[q] & 0xffff0000u) * sigmoid_f(a1);
                    s += v0 * v0 + v1 * v1; wo[q] = cvt_pk_bf16(v0, v1); }
                u32x4 w; w.x = wo[0]; w.y = wo[1]; w.z = wo[2]; w.w = wo[3]; *(u32x4*)(hb + off) = w; }
            s = fq_sum(s, fq * 16 + fr);
            if (fq == 0) ssq_out[(size_t)row * 16 + u.pn * 4 + wc] = s; }
    }
};

template <class Epi, class Sched, bool ALIGN_EPI = false, bool SP2 = false>
__device__ __forceinline__ void gemm_phase(PG8_LAS unsigned char* lds, const Gemm g, const Sched& S, const Epi& E) {
    int tid_o = threadIdx.x; asm volatile("" : "+v"(tid_o));
    const int tid = tid_o, wid = __builtin_amdgcn_readfirstlane(tid >> 6), lane = tid & 63, wr = wid >> 2, wc = wid & 3, fr = lane & 15, fq = lane >> 4;
    const int K = g.K, nt = K / BK;
    unsigned voffA[2], voffB[2];
#pragma unroll
    for (int i = 0; i < 2; ++i) { int R, C; stage_rc(tid * 16 + i * 8192, R, C); const int Rb = Epi::PERM ? ((R & ~31) + perm32(R & 31)) : R;
        voffA[i] = (unsigned)(R * g.lda + C) * 2u; voffB[i] = (unsigned)(Rb * K + C) * 2u; }
    const size_t kstep = (size_t)(BK * 2);
    const size_t hstep = (size_t)HALF * K * 2;
    const size_t tstep = 2 * hstep; const size_t hstepA = (size_t)HALF * g.lda * 2, tstepA = 2 * hstepA;
    const unsigned ldsw = (unsigned)wid * 1024u;
    const int aoff = lds_byte(wr * 64 + fr, fq * 8), boff = lds_byte(wc * 32 + fr, fq * 8);
#define PG8_SA(b, h) (((b) * 2 + (h)) * HTB)
#define PG8_SB(b, h) ((4 + (b) * 2 + (h)) * HTB)
#define PG8_STAGE(bufoff, gbase, voff) do { _Pragma("unroll") for (int _i = 0; _i < 2; ++_i) \
        __builtin_amdgcn_global_load_lds((const unsigned*)((const char*)(gbase) + (voff)[_i]), (PG8_LAS unsigned*)(lds + (bufoff) + ldsw + _i * 8192), 16, 0, 0); } while (0)
#define PG8_LDA(dst, b, h) do { _Pragma("unroll") for (int m = 0; m < 4; ++m) _Pragma("unroll") for (int k = 0; k < 2; ++k) dst[m][k] = *(const PG8_LAS bf16x8*)(lds + PG8_SA(b, h) + aoff + m * 2048 + k * 1024); } while (0)
#define PG8_LDB(dst, b, h) do { _Pragma("unroll") for (int n = 0; n < 2; ++n) _Pragma("unroll") for (int k = 0; k < 2; ++k) dst[n][k] = *(const PG8_LAS bf16x8*)(lds + PG8_SB(b, h) + boff + n * 2048 + k * 1024); } while (0)
#define PG8_MMA(ai, bj, At, Bt) do { __builtin_amdgcn_s_setprio(1); _Pragma("unroll") for (int m = 0; m < 4; ++m) _Pragma("unroll") for (int n = 0; n < 2; ++n) _Pragma("unroll") for (int k = 0; k < 2; ++k) \
        acc[ai][bj][m][n] = __builtin_amdgcn_mfma_f32_16x16x32_bf16(Bt[n][k], At[m][k], acc[ai][bj][m][n], 0, 0, 0); __builtin_amdgcn_s_setprio(0); } while (0)
#define PG8_WAIT_V(n) asm volatile("s_waitcnt vmcnt(" #n ")" ::: "memory")
#define PG8_WAIT_L(n) asm volatile("s_waitcnt lgkmcnt(" #n ")" ::: "memory")
#define PG8_BAR __builtin_amdgcn_s_barrier()
#define PG8_SCHED __builtin_amdgcn_sched_barrier(0)
    Unit cur, nxt; int ui = 0;
    if (!S.next(0, cur)) return;
    f32x4 acc[2][2][4][2];
#pragma unroll
    for (int a = 0; a < 2; ++a)
#pragma unroll
        for (int b = 0; b < 2; ++b)
#pragma unroll
            for (int m = 0; m < 4; ++m)
#pragma unroll
                for (int n = 0; n < 2; ++n) acc[a][b][m][n] = (f32x4){0.f, 0.f, 0.f, 0.f};
    bf16x8 At[4][2], B0[2][2], B1[2][2];
    const char* cA = (const char*)g.A + (size_t)cur.pm * tstepA; const char* cB = (const char*)g.Bt + (size_t)cur.pn * tstep;
    S.a_ready(cur);
    if constexpr (SP2) {
        PG8_STAGE(PG8_SB(0, 0), cB, voffB); PG8_STAGE(PG8_SB(0, 1), cB + hstep, voffB); PG8_STAGE(PG8_SA(0, 0), cA, voffA); PG8_STAGE(PG8_SA(0, 1), cA + hstepA, voffA);
        if (wr == 1) PG8_BAR;
        PG8_WAIT_V(2); PG8_BAR;
        PG8_STAGE(PG8_SB(1, 0), cB + kstep, voffB); PG8_STAGE(PG8_SA(1, 0), cA + kstep, voffA); PG8_STAGE(PG8_SB(1, 1), cB + hstep + kstep, voffB);
        PG8_WAIT_V(6); PG8_BAR;
    } else {
        PG8_STAGE(PG8_SB(0, 0), cB, voffB); PG8_STAGE(PG8_SA(0, 0), cA, voffA); PG8_STAGE(PG8_SB(0, 1), cB + hstep, voffB); PG8_STAGE(PG8_SA(0, 1), cA + hstepA, voffA);
        if (wr == 1) PG8_BAR;
        PG8_WAIT_V(4); PG8_BAR;
        PG8_STAGE(PG8_SB(1, 0), cB + kstep, voffB); PG8_STAGE(PG8_SA(1, 0), cA + kstep, voffA); PG8_STAGE(PG8_SB(1, 1), cB + hstep + kstep, voffB);
        PG8_WAIT_V(6); PG8_BAR;
    }
    for (;;) {
        const bool has_next = S.next(ui + 1, nxt);
        const char* nA = has_next ? (const char*)g.A + (size_t)nxt.pm * tstepA : cA; const char* nB = has_next ? (const char*)g.Bt + (size_t)nxt.pn * tstep : cB;
        for (int t = 0; t < nt; t += 2) {
            const bool last = (t == nt - 2);
            const char* a1 = cA + (size_t)(t + 1) * kstep;
            const char* a2 = last ? nA : cA + (size_t)(t + 2) * kstep; const char* b2 = last ? nB : cB + (size_t)(t + 2) * kstep;
            const char* a3 = a2 + kstep; const char* b3 = b2 + kstep;
            if (last && has_next) S.a_ready(nxt);
            if constexpr (SP2) {
            PG8_LDB(B0, 0, 0); PG8_LDB(B1, 0, 1); PG8_SCHED; PG8_LDA(At, 0, 0); PG8_STAGE(PG8_SA(1, 1), a1 + hstepA, voffA);
            PG8_WAIT_V(8); PG8_WAIT_L(0); PG8_BAR; PG8_MMA(0, 0, At, B0); PG8_MMA(0, 1, At, B1); PG8_BAR; PG8_SCHED;
            PG8_LDA(At, 0, 1); PG8_STAGE(PG8_SB(0, 0), b2, voffB); PG8_STAGE(PG8_SB(0, 1), b2 + hstep, voffB); PG8_STAGE(PG8_SA(0, 0), a2, voffA);
            PG8_WAIT_V(8); PG8_WAIT_L(0); PG8_BAR; PG8_MMA(1, 0, At, B0); PG8_MMA(1, 1, At, B1); PG8_BAR; PG8_SCHED;
            PG8_LDB(B0, 1, 0); PG8_LDB(B1, 1, 1); PG8_SCHED; PG8_LDA(At, 1, 0); PG8_STAGE(PG8_SA(0, 1), a2 + hstepA, voffA);
            PG8_WAIT_V(8); PG8_WAIT_L(0); PG8_BAR; PG8_MMA(0, 0, At, B0); PG8_MMA(0, 1, At, B1); PG8_BAR; PG8_SCHED;
            PG8_LDA(At, 1, 1); PG8_STAGE(PG8_SB(1, 0), b3, voffB); PG8_STAGE(PG8_SB(1, 1), b3 + hstep, voffB); PG8_STAGE(PG8_SA(1, 0), a3, voffA);
            PG8_WAIT_V(8); PG8_WAIT_L(0); PG8_BAR; PG8_MMA(1, 0, At, B0); PG8_MMA(1, 1, At, B1); PG8_BAR; PG8_SCHED;
            } else {
            PG8_LDB(B0, 0, 0); PG8_SCHED; PG8_LDA(At, 0, 0); PG8_STAGE(PG8_SA(1, 1), a1 + hstepA, voffA);
            PG8_WAIT_L(8); PG8_BAR; PG8_WAIT_L(0); PG8_MMA(0, 0, At, B0); PG8_BAR; PG8_SCHED;
            PG8_LDB(B1, 0, 1); PG8_STAGE(PG8_SB(0, 0), b2, voffB);
            PG8_BAR; PG8_WAIT_L(0); PG8_MMA(0, 1, At, B1); PG8_BAR;
            PG8_LDA(At, 0, 1); PG8_STAGE(PG8_SA(0, 0), a2, voffA);
            PG8_BAR; PG8_WAIT_L(0); PG8_MMA(1, 0, At, B0); PG8_BAR; PG8_SCHED;
            PG8_STAGE(PG8_SB(0, 1), b2 + hstep, voffB);
            PG8_WAIT_V(6); PG8_BAR; PG8_MMA(1, 1, At, B1); PG8_BAR;
            PG8_LDB(B0, 1, 0); PG8_SCHED; PG8_LDA(At, 1, 0); PG8_STAGE(PG8_SA(0, 1), a2 + hstepA, voffA);
            PG8_WAIT_L(8); PG8_BAR; PG8_WAIT_L(0); PG8_MMA(0, 0, At, B0); PG8_BAR; PG8_SCHED;
            PG8_LDB(B1, 1, 1); PG8_STAGE(PG8_SB(1, 0), b3, voffB);
            PG8_BAR; PG8_WAIT_L(0); PG8_MMA(0, 1, At, B1); PG8_BAR;
            PG8_LDA(At, 1, 1); PG8_STAGE(PG8_SA(1, 0), a3, voffA);
            PG8_BAR; PG8_WAIT_L(0); PG8_MMA(1, 0, At, B0); PG8_BAR; PG8_SCHED;
            PG8_STAGE(PG8_SB(1, 1), b3 + hstep, voffB);
            PG8_WAIT_V(6); PG8_BAR; PG8_MMA(1, 1, At, B1); PG8_BAR;
            }
        }
        if constexpr (ALIGN_EPI) { if (wr == 0) PG8_BAR; }
        if constexpr (!Epi::AFTER_DRAIN) { E(acc, cur, wr, wc, fr, fq); S.done(cur); }
        if (!has_next) break;
#pragma unroll
        for (int a = 0; a < 2; ++a)
#pragma unroll
            for (int b = 0; b < 2; ++b)
#pragma unroll
                for (int m = 0; m < 4; ++m)
#pragma unroll
                    for (int n = 0; n < 2; ++n) acc[a][b][m][n] = (f32x4){0.f, 0.f, 0.f, 0.f};
        cur = nxt; cA = nA; cB = nB; ++ui;
        if constexpr (ALIGN_EPI) { if (wr == 1) PG8_BAR; }
    }
    PG8_WAIT_V(0);
    if constexpr (!ALIGN_EPI) { if (wr == 0) PG8_BAR; }
    PG8_BAR;
    if constexpr (Epi::AFTER_DRAIN) { E.fused(acc, cur, wr, wc, fr, fq, lds, wid, lane); S.done(cur); }
#undef PG8_SA
#undef PG8_SB
#undef PG8_STAGE
#undef PG8_LDA
#undef PG8_LDB
#undef PG8_MMA
#undef PG8_WAIT_V
#undef PG8_WAIT_L
#undef PG8_BAR
#undef PG8_SCHED
}
}

constexpr int NWAVES = 8;
constexpr int M = 16384, SEQ = 4096, NBATCH = 4, DEPTH = 4, D = 1024, DFF = 2816, NGU = 2 * DFF, NZ = 3584, NZSRC = 3488, PLED = 256;
constexpr int ZC_U = 512, ZC_V = 768, ZC_HQ = 1024, ZC_HF = 1536, ZC_HI = 2048, ZC_HG = 2304, ZC_RQ = 2560, ZC_RK = 2816, ZC_RV = 3072, ZC_RG = 3328;
constexpr int QC_Q = 0, QC_KN = 384, QC_V = 640, QC_KR = 896;
constexpr size_t MiB = 1u << 20;
constexpr size_t WS_CTL = 0, CTL_ZERO_BYTES = 1 * MiB;
constexpr size_t WS_WGU = 1 * MiB;
constexpr size_t WS_WD = WS_WGU + 88 * MiB;
constexpr size_t WS_WIN = WS_WD + 44 * MiB;
constexpr size_t WS_WMLA = WS_WIN + 28 * MiB;
constexpr size_t WS_WOUT = WS_WMLA + 4 * MiB;
constexpr size_t WS_WPG = WS_WOUT + 8 * MiB;
constexpr size_t WS_WPP = WS_WPG + 8 * MiB;
constexpr size_t WS_WSG = WS_WPP + 2 * MiB;
constexpr size_t WS_B0 = WS_WSG + 1 * MiB;
constexpr size_t WS_B1 = WS_B0 + 32 * MiB;
constexpr size_t WS_ZH = WS_B1 + 32 * MiB;
constexpr size_t WS_QKV = WS_ZH + 112 * MiB;
constexpr size_t WS_PBF = WS_QKV + 32 * MiB;
constexpr size_t WS_HST = WS_PBF + 8 * MiB;
constexpr size_t WS_HDC = WS_HST + 32 * MiB;
constexpr size_t WS_HLB = WS_HDC + 768 * 1024;
constexpr size_t WS_RST = WS_HDC + 1 * MiB;
constexpr size_t WS_ROPE = WS_RST + 8 * MiB;
constexpr size_t WS_SSQ = WS_ROPE + 6 * MiB;
constexpr size_t WS_SSQ2 = WS_SSQ + 2 * MiB;
constexpr size_t WS_END = WS_SSQ2 + 1 * MiB;
constexpr int CW_TMO = 0, CW_BAR = 4096, CW_GRP = 65536;
constexpr int MAX_LAUNCHES = 16;
constexpr int RING_OFF = 0, RING_BYTES = 131072, LDSCTL_OFF = RING_BYTES, MISC_OFF = 147456 - 256, TAB_OFF = MISC_OFF - 1024, LDS_BYTES = 147456;

#define GAS __attribute__((address_space(1)))
#define LAS __attribute__((address_space(3)))
typedef unsigned short bf16;
typedef unsigned v4u __attribute__((ext_vector_type(4)));
typedef unsigned v2u __attribute__((ext_vector_type(2)));
typedef float f32x4 __attribute__((ext_vector_type(4)));
typedef short bf16x8 __attribute__((ext_vector_type(8)));
typedef GAS unsigned gu32;
#define RLX_AGENT __ATOMIC_RELAXED, __HIP_MEMORY_SCOPE_AGENT
#define LDS_WAIT() asm volatile("s_waitcnt lgkmcnt(0)" ::: "memory")
#define VM_WAIT() asm volatile("s_waitcnt vmcnt(0)" ::: "memory")
__device__ __forceinline__ unsigned f2bf(float f) { unsigned u = __builtin_bit_cast(unsigned, f); return (u + 0x7fffu + ((u >> 16) & 1u)) >> 16; }
__device__ __forceinline__ unsigned pk2(float lo, float hi) { return f2bf(lo) | (f2bf(hi) << 16); }
__device__ __forceinline__ float bf2f(bf16 v) { return __uint_as_float((unsigned)v << 16); }
__device__ __forceinline__ float wave_sum(float v) {
#pragma unroll
    for (int o = 1; o < 64; o <<= 1) v += __shfl_xor(v, o);
    return v;
}
__device__ __forceinline__ float wave_max(float v) {
#pragma unroll
    for (int o = 1; o < 64; o <<= 1) v = fmaxf(v, __shfl_xor(v, o));
    return v;
}
__device__ const double ROPE_INVT[48] = {
1.59154943091895346e-01, 8.94994016088910133e-02, 5.03292121044870353e-02, 2.83021958306233987e-02, 1.59154943091895339e-02, 8.94994016088910237e-03, 5.03292121044870370e-03, 2.83021958306233987e-03, 1.59154943091895356e-03, 8.94994016088910237e-04, 5.03292121044870326e-04, 2.83021958306233954e-04, 1.59154943091895351e-04, 8.94994016088910182e-05, 5.03292121044870354e-05, 2.83021958306233961e-05,
1.59154943091895346e-01, 1.19349370211248862e-01, 8.94994016088910133e-02, 6.71150830052272551e-02, 5.03292121044870353e-02, 3.77415847174197711e-02, 2.83021958306233987e-02, 2.12236527647776604e-02, 1.59154943091895339e-02, 1.19349370211248862e-02, 8.94994016088910237e-03, 6.71150830052272534e-03, 5.03292121044870370e-03, 3.77415847174197719e-03, 2.83021958306233987e-03, 2.12236527647776622e-03, 1.59154943091895356e-03, 1.19349370211248849e-03, 8.94994016088910237e-04, 6.71150830052272599e-04, 5.03292121044870326e-04, 3.77415847174197741e-04, 2.83021958306233954e-04, 2.12236527647776605e-04, 1.59154943091895351e-04, 1.19349370211248862e-04, 8.94994016088910182e-05, 6.71150830052272545e-05, 5.03292121044870354e-05, 3.77415847174197768e-05, 2.83021958306233961e-05, 2.12236527647776592e-05 };

#define XB_TMO      128
#define XB_XCNT(j)  (256  + 64 * (j))
#define XB_XSUB(j)  (1280 + 64 * (j))
#define XB_XGEN(j)  (2304 + 64 * (j))
#define XB_TOP      3328
#define XB_TOPGEN   3392
#define XCD_BAR_WORDS 3456
#define XB_SPIN_CAP (1u << 18)

__device__ __forceinline__ unsigned xb_ld(unsigned* p)              { return __hip_atomic_load(p, __ATOMIC_RELAXED, __HIP_MEMORY_SCOPE_AGENT); }
__device__ __forceinline__ unsigned xb_add(unsigned* p, unsigned v) { return __hip_atomic_fetch_add(p, v, __ATOMIC_RELAXED, __HIP_MEMORY_SCOPE_AGENT); }
__device__ __forceinline__ unsigned xb_xcc_id() { return (unsigned)__builtin_amdgcn_s_getreg((3 << 11) | 20) & 0xFu; }
#define XB_SPIN(cond, bar) do { unsigned _sp = 0; while (cond) { __builtin_amdgcn_s_sleep(1); \
    if ((++_sp & 255u) == 0u) { if (xb_ld(&(bar)[XB_TMO])) break; if (_sp > XB_SPIN_CAP) { atomicAdd(&(bar)[XB_TMO], 1u); break; } } } } while (0)

struct XcdBarrier {
    unsigned* bar; unsigned x;
    volatile LAS unsigned* st;
};

__device__ __forceinline__ XcdBarrier xcd_barrier_post(unsigned* bar, volatile LAS unsigned* st) {
    XcdBarrier b; b.bar = bar; b.x = xb_xcc_id(); b.st = st;
    if (threadIdx.x == 0) (void)xb_add(&bar[XB_XCNT(b.x)], 1u);
    return b;
}
__device__ __forceinline__ void xcd_barrier_complete(unsigned* bar, unsigned x, unsigned& nloc, unsigned& nx) {
    const unsigned G = gridDim.x * gridDim.y * gridDim.z;
    unsigned sum, cnt, mine, sp = 0u;
    for (;;) {
        sum = 0u; cnt = 0u; mine = 0u;
#pragma unroll
        for (unsigned j = 0; j < 16; ++j) { const unsigned c = xb_ld(&bar[XB_XCNT(j)]); sum += c; cnt += (c > 0u) ? 1u : 0u; mine = (j == x) ? c : mine; }
        if (sum == G) break;
        __builtin_amdgcn_s_sleep(1);
        if ((++sp & 255u) == 0u) { if (xb_ld(&bar[XB_TMO])) break; if (sp > XB_SPIN_CAP) { atomicAdd(&bar[XB_TMO], 1u); break; } }
    }
    nloc = mine > 0u ? mine : 1u; nx = cnt > 0u ? cnt : 1u;
}

__device__ __forceinline__ void xcd_barrier(const XcdBarrier& b) {
    asm volatile("s_waitcnt vmcnt(0)" ::: "memory");
    __syncthreads();
    if (threadIdx.x == 0) {
        unsigned* bar = b.bar;
        __builtin_amdgcn_s_waitcnt(0);
        unsigned nloc = b.st[0], nx = b.st[1];
        if (nloc == 0u) { xcd_barrier_complete(bar, b.x, nloc, nx); b.st[0] = nloc; b.st[1] = nx; }
        const unsigned old = xb_add(&bar[XB_XSUB(b.x)], 1u);
        const unsigned gen = old / nloc;
        if (old + 1u == (gen + 1u) * nloc) {
            __builtin_amdgcn_fence(__ATOMIC_RELEASE, "agent");
            asm volatile("s_waitcnt vmcnt(0)" ::: "memory");
            const unsigned og = xb_add(&bar[XB_TOP], 1u);
            const unsigned tg = og / nx;
            if (og + 1u == (tg + 1u) * nx) xb_add(&bar[XB_TOPGEN], 1u);
            else XB_SPIN(xb_ld(&bar[XB_TOPGEN]) == tg, bar);
            __builtin_amdgcn_fence(__ATOMIC_ACQUIRE, "agent");
            xb_add(&bar[XB_XGEN(b.x)], 1u);
            asm volatile("s_waitcnt vmcnt(0)" ::: "memory");
        } else {
            XB_SPIN(xb_ld(&bar[XB_XGEN(b.x)]) == gen, bar);
            __builtin_amdgcn_fence(__ATOMIC_ACQUIRE, "agent");
            asm volatile("s_waitcnt vmcnt(0)" ::: "memory");
        }
    }
    __syncthreads();
}

__device__ __forceinline__ void group_sync(unsigned* cnt, unsigned* xmask, unsigned members, volatile LAS unsigned* seq  , unsigned* bar) {
    asm volatile("s_waitcnt vmcnt(0)" ::: "memory");
    __syncthreads();
    if (threadIdx.x == 0) {
        __builtin_amdgcn_s_waitcnt(0);
        unsigned same = seq[1];
        if (same == 0u) { const unsigned mk = xb_ld(xmask); same = (mk & (mk - 1u)) == 0u ? 1u : 2u; seq[1] = same; }
        if (same != 1u) { __builtin_amdgcn_fence(__ATOMIC_RELEASE, "agent"); asm volatile("s_waitcnt vmcnt(0)" ::: "memory"); }
        const unsigned target = seq[0] + members; seq[0] = target;
        (void)xb_add(cnt, 1u);
        XB_SPIN(xb_ld(cnt) < target, bar);
        __builtin_amdgcn_fence(__ATOMIC_ACQUIRE, "agent");
        asm volatile("s_waitcnt vmcnt(0)" ::: "memory");
    }
    __syncthreads();
}

__device__ __forceinline__ void xcd_barrier_arrive(const XcdBarrier& b, volatile LAS unsigned* gen1) {
    asm volatile("s_waitcnt vmcnt(0)" ::: "memory");
    __syncthreads();
    if (threadIdx.x == 0) {
        unsigned* bar = b.bar;
        __builtin_amdgcn_s_waitcnt(0);
        unsigned nloc = b.st[0], nx = b.st[1];
        if (nloc == 0u) { xcd_barrier_complete(bar, b.x, nloc, nx); b.st[0] = nloc; b.st[1] = nx; }
        const unsigned old = xb_add(&bar[XB_XSUB(b.x)], 1u);
        const unsigned gen = old / nloc;
        gen1[0] = gen;
        if (old + 1u == (gen + 1u) * nloc) {
            __builtin_amdgcn_fence(__ATOMIC_RELEASE, "agent");
            asm volatile("s_waitcnt vmcnt(0)" ::: "memory");
            const unsigned og = xb_add(&bar[XB_TOP], 1u);
            const unsigned tg = og / nx;
            if (og + 1u == (tg + 1u) * nx) xb_add(&bar[XB_TOPGEN], 1u);
            xb_add(&bar[XB_XGEN(b.x)], 1u);
        }
    }
    __syncthreads();
}
__device__ __forceinline__ void xcd_barrier_wait(const XcdBarrier& b, volatile LAS unsigned* gen1) {
    if (threadIdx.x == 0) {
        unsigned* bar = b.bar;
        const unsigned gen = gen1[0];
        XB_SPIN(xb_ld(&bar[XB_TOPGEN]) == gen, bar);
        __builtin_amdgcn_fence(__ATOMIC_ACQUIRE, "agent");
        asm volatile("s_waitcnt vmcnt(0)" ::: "memory");
    }
    __syncthreads();
}

enum { IN_X = 0, IN_P, IN_POS, IN_F1N, IN_F1G, IN_F1U, IN_F1D, IN_MIXN, IN_WIN, IN_QN, IN_WUQ, IN_KVN, IN_WUKV, IN_SGLN, IN_SGW, IN_SGB, IN_HGLB, IN_HGN, IN_RETN, IN_WOUT,
       IN_F2N, IN_F2G, IN_F2U, IN_F2D, IN_PLEN, IN_PLEP, IN_PLEG, IN_FINN, N_IN };
struct Args { const float* in[N_IN]; float* out; unsigned char* ws; int ph_lo, ph_hi, li, pad; };
constexpr int N_PHASES = 42;

struct ConvItem { const float* W; const float* gain; bf16* WT; int N, ldk, k0, n0, kind; };
__device__ __forceinline__ int conv_drow(int kind, int n) { return kind == 0 ? n : (kind == 3 ? (n < 416 ? n : n + 96) : ((n >> 7) * 256 + (n & 127) + (kind == 2 ? 128 : 0))); }
constexpr int IT_FF = 16 * 44, IT_DN = 44 * 16, IT_WIN = 16 * 55, IT_SQ = 16 * 16, IT_PP = 4 * 16, IT_LAYER = 4 * IT_FF + 2 * IT_DN + IT_WIN + 2 * IT_SQ + IT_PP;
__device__ __forceinline__ ConvItem conv_decode(const Args& a, unsigned char* ws, int it) {
    ConvItem c; const int l = it / IT_LAYER; int r = it - l * IT_LAYER;
    { constexpr int E_ = IT_LAYER - 2 * IT_FF - IT_DN;
      r = r < 2 * IT_FF ? r : r < 2 * IT_FF + IT_DN ? r + 2 * IT_FF : r < E_ ? r + 2 * IT_FF + IT_DN : r < E_ + 2 * IT_FF ? r - E_ + 2 * IT_FF : r - E_ + 2 * IT_FF + IT_DN; }
    if (r < 4 * IT_FF) { const int f = r / IT_FF; r -= f * IT_FF; const int second = f >> 1, up = f & 1; const int kb = r / 44, nb = r - 44 * kb;
        c.W = (second ? (up ? a.in[IN_F2U] : a.in[IN_F2G]) : (up ? a.in[IN_F1U] : a.in[IN_F1G])) + (size_t)l * D * DFF; c.gain = (second ? a.in[IN_F2N] : a.in[IN_F1N]) + l * D;
        c.WT = (bf16*)(ws + WS_WGU) + (size_t)(2 * l + second) * NGU * D; c.N = DFF; c.ldk = D; c.k0 = 64 * kb; c.n0 = 64 * nb; c.kind = 1 + up; return c; }
    r -= 4 * IT_FF;
    if (r < 2 * IT_DN) { const int second = r / IT_DN; r -= second * IT_DN; const int kb = r / 16, nb = r - 16 * kb;
        c.W = (second ? a.in[IN_F2D] : a.in[IN_F1D]) + (size_t)l * DFF * D; c.gain = nullptr; c.WT = (bf16*)(ws + WS_WD) + (size_t)(2 * l + second) * D * DFF; c.N = D; c.ldk = DFF; c.k0 = 64 * kb; c.n0 = 64 * nb; c.kind = 0; return c; }
    r -= 2 * IT_DN;
    if (r < IT_WIN) { const int kb = r / 55, nb = r - 55 * kb;
        c.W = a.in[IN_WIN] + (size_t)l * D * NZSRC; c.gain = a.in[IN_MIXN] + l * D; c.WT = (bf16*)(ws + WS_WIN) + (size_t)l * NZ * D; c.N = NZSRC; c.ldk = D; c.k0 = 64 * kb; c.n0 = 64 * nb; c.kind = 3; return c; }
    r -= IT_WIN;
    if (r < IT_SQ) { const int kb = r / 16, nb = r - 16 * kb; c.W = a.in[IN_WOUT] + (size_t)l * D * D; c.gain = nullptr; c.WT = (bf16*)(ws + WS_WOUT) + (size_t)l * D * D; c.N = D; c.ldk = D; c.k0 = 64 * kb; c.n0 = 64 * nb; c.kind = 0; return c; }
    r -= IT_SQ;
    if (r < IT_SQ) { const int kb = r / 16, nb = r - 16 * kb; c.W = a.in[IN_PLEG] + (size_t)l * D * D; c.gain = a.in[IN_PLEN] + l * D; c.WT = (bf16*)(ws + WS_WPG) + (size_t)l * D * D; c.N = D; c.ldk = D; c.k0 = 64 * kb; c.n0 = 64 * nb; c.kind = 0; return c; }
    r -= IT_SQ;
    { const int kb = r / 16, nb = r - 16 * kb; c.W = a.in[IN_PLEP] + (size_t)l * PLED * D; c.gain = nullptr; c.WT = (bf16*)(ws + WS_WPP) + (size_t)l * D * PLED; c.N = D; c.ldk = PLED; c.k0 = 64 * kb; c.n0 = 64 * nb; c.kind = 0; return c; }
}
__device__ __forceinline__ void conv_load(const ConvItem& c, int lane, float (&v)[64]) {
    const int r4 = lane >> 4, c4 = lane & 15; const bool ok = c.n0 + 4 * c4 < c.N; const float* p = c.W + (size_t)(c.k0 + r4) * c.N + c.n0 + (ok ? 4 * c4 : 0);
#pragma unroll
    for (int i = 0; i < 16; ++i) { const f32x4 t = *(const f32x4*)(p + (size_t)(4 * i) * c.N); v[4 * i] = t[0]; v[4 * i + 1] = t[1]; v[4 * i + 2] = t[2]; v[4 * i + 3] = t[3]; }
}
__device__ __forceinline__ void conv_store(const ConvItem& c, int lane, const float (&v)[64], LAS float* scr) {
    { const int r4 = lane >> 4, c4 = lane & 15;
#pragma unroll
      for (int i = 0; i < 16; ++i)
#pragma unroll
          for (int j = 0; j < 4; ++j) scr[(4 * i + r4) * 65 + 4 * c4 + j] = v[4 * i + j]; }
    LDS_WAIT(); asm volatile("" ::: "memory");
    const int k8 = (lane & 7) * 8; f32x4 g0 = {1.f, 1.f, 1.f, 1.f}, g1 = {1.f, 1.f, 1.f, 1.f};
    if (c.gain) { g0 = *(const f32x4*)(c.gain + c.k0 + k8); g1 = *(const f32x4*)(c.gain + c.k0 + k8 + 4); }
#pragma unroll
    for (int j = 0; j < 8; ++j) { const int nl = (lane >> 3) + 8 * j, n = c.n0 + nl; const LAS float* s = scr + k8 * 65 + nl;
        v4u o; o.x = pk2(s[0 * 65] * g0[0], s[1 * 65] * g0[1]); o.y = pk2(s[2 * 65] * g0[2], s[3 * 65] * g0[3]); o.z = pk2(s[4 * 65] * g1[0], s[5 * 65] * g1[1]); o.w = pk2(s[6 * 65] * g1[2], s[7 * 65] * g1[3]);
        if (n < c.N) *(v4u*)(c.WT + (size_t)conv_drow(c.kind, n) * c.ldk + c.k0 + k8) = o; }
    LDS_WAIT(); asm volatile("" ::: "memory");
}

__device__ __forceinline__ void prologue_misc(const Args& a, int gt, int NGT) {
    unsigned char* ws = a.ws;
    bf16* Win = (bf16*)(ws + WS_WIN); bf16* Wmla = (bf16*)(ws + WS_WMLA); bf16* Wsg = (bf16*)(ws + WS_WSG);
    { unsigned z_ = 0u; asm volatile("" : "+v"(z_));
      for (int i = gt; i < DEPTH * 96 * (D / 8); i += NGT) { const int l = i / (96 * 128), r = i - l * 96 * 128; const int row = 416 + r / 128, c8 = r & 127;
        *(v4u*)(Win + ((size_t)l * NZ + row) * D + 8 * c8) = (v4u){z_, z_, z_, z_}; } }
    for (int i = gt; i < DEPTH * 1024 * 64; i += NGT) { const int l = i >> 16, r = i & 65535, n = ((r >> 12) << 6) + (r & 63), k8 = ((r >> 6) & 63) * 8;
        const float* wuq = a.in[IN_WUQ] + (size_t)l * 256 * 384; const float* wukv = a.in[IN_WUKV] + (size_t)l * 128 * 512;
        const float* qg = a.in[IN_QN] + l * 256; const float* kvg = a.in[IN_KVN] + l * 128;
        const int G_ = n >> 5, p_ = n & 31; const bool rg_ = (G_ == 2 || G_ == 5 || G_ == 8 || G_ == 11 || G_ == 28);
        const int ns = rg_ ? (n & ~31) + 16 * ((p_ >> 2) & 1) + 4 * (p_ >> 3) + (p_ & 3) : n;
        float v[8];
#pragma unroll
        for (int j = 0; j < 8; ++j) { const int k = k8 + j; float x = 0.f;
            if (n < 384) { if (k < 256) x = wuq[(size_t)k * 384 + ns] * qg[k]; }
            else if (n < 896) { if (k >= 256 && k < 384) { const int nn = (n - 384) & 255, hh = nn >> 6, jj = (nn & 63) + (n >= 640 ? 64 : 0); x = wukv[(size_t)(k - 256) * 512 + hh * 128 + jj] * kvg[k - 256]; } }
            else if (n < 928) { if (k == 384 + (ns - 896)) x = 1.0f; }
            v[j] = x; }
        v4u o; o.x = pk2(v[0], v[1]); o.y = pk2(v[2], v[3]); o.z = pk2(v[4], v[5]); o.w = pk2(v[6], v[7]);
        *(v4u*)(Wmla + ((size_t)l * 1024 + n) * 512 + k8) = o; }
    for (int i = gt; i < DEPTH * 4 * 128 * 128 / 2; i += NGT) { const int e = 2 * i, s = e & 127, t = (e >> 7) & 127; const float* w = a.in[IN_SGW];
        const float x0 = s <= t ? w[e] : 0.f, x1 = (s + 1) <= t ? w[e + 1] : 0.f; ((unsigned*)Wsg)[i] = pk2(x0, x1); }
    { const float* lblog = a.in[IN_HGLB]; float* hlb = (float*)(ws + WS_HLB);
      for (int i = gt; i < DEPTH * 512; i += NGT) { const int l = i >> 9, ch = i & 511;
          const float x0 = lblog[ch], x1 = lblog[512 + ch], x2 = lblog[1024 + ch], x3 = lblog[1536 + ch]; const float mx_ = fmaxf(fmaxf(x0, x1), fmaxf(x2, x3));
          const float e0 = __expf(x0 - mx_), e1 = __expf(x1 - mx_), e2 = __expf(x2 - mx_), e3 = __expf(x3 - mx_);
          hlb[i] = ((l >= 1 ? e1 : 0.f) + (l >= 2 ? e2 : 0.f) + (l >= 3 ? e3 : 0.f)) / (e0 + e1 + e2 + e3); } }
    { const int* pos = (const int*)a.in[IN_POS]; float* mcs = (float*)(ws + WS_ROPE); float* msn = mcs + (size_t)M * 16; float* rcs = msn + (size_t)M * 16; float* rsn = rcs + (size_t)M * 32;
      for (int i = gt; i < M * 48; i += NGT) { const int m = i / 48, f = i - 48 * m; const double turns = (double)pos[m] * ROPE_INVT[f]; const float fr = (float)(turns - __builtin_rint(turns));
          const float c = __builtin_amdgcn_cosf(fr), s = __builtin_amdgcn_sinf(fr);
          if (f < 16) { mcs[(size_t)m * 16 + f] = c; msn[(size_t)m * 16 + f] = s; } else { rcs[(size_t)m * 32 + f - 16] = c; rsn[(size_t)m * 32 + f - 16] = s; } } }
}

__device__ __forceinline__ void conv_items(const Args& a, unsigned char* ws, LAS float* scr, int lane, int it0, int it_end, int stride) {
    int it = it0; float va[64], vb[64];
    if (it < it_end) { ConvItem ca = conv_decode(a, ws, it); conv_load(ca, lane, va);
        for (;;) { const int itb = it + stride; const bool hb = itb < it_end; ConvItem cb = ca; if (hb) { cb = conv_decode(a, ws, itb); conv_load(cb, lane, vb); }
            conv_store(ca, lane, va, scr); if (!hb) break;
            const int ita = itb + stride; const bool ha = ita < it_end; if (ha) { ca = conv_decode(a, ws, ita); conv_load(ca, lane, va); }
            conv_store(cb, lane, vb, scr); if (!ha) break; it = ita; } }
}

__device__ __forceinline__ void conv_items_simple(const Args& a, unsigned char* ws, LAS float* scr, int lane, int it0, int it_end, int stride) {
#pragma unroll 1
    for (int it = it0; it < it_end; it += stride) { float va[64]; const ConvItem ca = conv_decode(a, ws, it); conv_load(ca, lane, va); conv_store(ca, lane, va, scr); }
}

__device__ __forceinline__ void prologue(const Args& a, LAS unsigned char* lds, int tid, int lane, int wave, int vcu, int G) {
    unsigned char* ws = a.ws;
    bf16* Win = (bf16*)(ws + WS_WIN); bf16* Wmla = (bf16*)(ws + WS_WMLA); bf16* Wsg = (bf16*)(ws + WS_WSG);
    LAS float* scr = (LAS float*)(lds + RING_OFF + wave * 16640);
    const int gw = vcu * NWAVES + wave, NGW = G * NWAVES;
    const int gt = (vcu * NWAVES + wave) * 64 + lane, NGT = NGW * 64;
    conv_items(a, ws, scr, lane, gw, (G == 256 ? 1 : DEPTH) * IT_LAYER, NGW);
    { const float* x = a.in[IN_X]; bf16* B0 = (bf16*)(ws + WS_B0); float* ssq = (float*)(ws + WS_SSQ);
      for (int m0 = gw; m0 < M; m0 += 4 * NGW) { f32x4 v[4][4];
#pragma unroll
          for (int r = 0; r < 4; ++r) { const int mr = m0 + r * NGW, m = mr < M ? mr : m0; const f32x4* xr = (const f32x4*)(x + (size_t)m * D) + lane;
#pragma unroll
              for (int q = 0; q < 4; ++q) v[r][q] = xr[64 * q]; }
#pragma unroll
          for (int r = 0; r < 4; ++r) { const int m = m0 + r * NGW; if (m < M) { unsigned long long* o8 = (unsigned long long*)(B0 + (size_t)m * D) + lane; float t[4];
#pragma unroll
              for (int q = 0; q < 4; ++q) { t[q] = wave_sum(pg8::dot4(v[r][q])); o8[64 * q] = (unsigned long long)pk2(v[r][q][0], v[r][q][1]) | ((unsigned long long)pk2(v[r][q][2], v[r][q][3]) << 32); }
              if (lane < 16) { float val = 0.f; if (lane == 0) val = t[0]; if (lane == 4) val = t[1]; if (lane == 8) val = t[2]; if (lane == 12) val = t[3]; ssq[(size_t)m * 16 + lane] = val; } } } } }
    prologue_misc(a, gt, NGT);
}

namespace mx {
typedef const LAS bf16* lcp;
#define MFMA16(a, b, c) __builtin_amdgcn_mfma_f32_16x16x32_bf16((a), (b), (c), 0, 0, 0)
__device__ __forceinline__ bf16x8 frag(lcp base, int row, int stride, int k) { return *(const LAS bf16x8*)(base + row * stride + k); }
__device__ __forceinline__ bf16x8 frag2(lcp base, int row, int stride, int k) {
    typedef short s16x4 __attribute__((ext_vector_type(4)));
    const s16x4 lo = *(const LAS s16x4*)(base + row * stride + k), hi = *(const LAS s16x4*)(base + row * stride + k + 16);
    return (bf16x8){lo[0], lo[1], lo[2], lo[3], hi[0], hi[1], hi[2], hi[3]};
}
typedef __bf16 bf16x8c_ __attribute__((ext_vector_type(8)));
typedef float f32x8c_ __attribute__((ext_vector_type(8)));
__device__ __forceinline__ bf16x8 pack_pair(const f32x4 a, const f32x4 b) {
    const f32x8c_ v = {a[0], a[1], a[2], a[3], b[0], b[1], b[2], b[3]}; return __builtin_bit_cast(bf16x8, __builtin_convertvector(v, bf16x8c_));
}
__device__ __forceinline__ float lo16(unsigned w) { return __uint_as_float(w << 16); }
__device__ __forceinline__ float hi16(unsigned w) { return __uint_as_float(w & 0xffff0000u); }
__device__ __forceinline__ void unpack8(const v4u w, float (&x)[8]) { x[0] = lo16(w.x); x[1] = hi16(w.x); x[2] = lo16(w.y); x[3] = hi16(w.y); x[4] = lo16(w.z); x[5] = hi16(w.z); x[6] = lo16(w.w); x[7] = hi16(w.w); }
__device__ __forceinline__ v4u pack8(const float (&x)[8]) { v4u w; w.x = pg8::cvt_pk_bf16(x[0], x[1]); w.y = pg8::cvt_pk_bf16(x[2], x[3]); w.z = pg8::cvt_pk_bf16(x[4], x[5]); w.w = pg8::cvt_pk_bf16(x[6], x[7]); return w; }
__device__ __forceinline__ float silu_fast(float x) { return x * __builtin_amdgcn_rcpf(1.0f + __builtin_amdgcn_exp2f(-1.4426950408889634f * x)); }
#define WG_SYNC_L() do { asm volatile("s_waitcnt lgkmcnt(0)" ::: "memory"); __builtin_amdgcn_s_barrier(); asm volatile("" ::: "memory"); } while (0)
#define WG_SYNC() do { asm volatile("s_waitcnt vmcnt(0) lgkmcnt(0)" ::: "memory"); __builtin_amdgcn_s_barrier(); asm volatile("" ::: "memory"); } while (0)

constexpr int RET_C = 128;
__device__ __forceinline__ float ret_lg2(int h) { return __builtin_amdgcn_logf(1.0f - __builtin_amdgcn_exp2f(-(5.0f + (float)h))); }
__device__ __forceinline__ void ret_rope8(const bf16* zrow, const float* cs, const float* sn, int grp, float sc, float (&o1)[8], float (&o2)[8]) {
    float x1[8], x2[8]; unpack8(*(const v4u*)(zrow + 8 * grp), x1); unpack8(*(const v4u*)(zrow + 32 + 8 * grp), x2);
    const f32x4 c0 = *(const f32x4*)(cs + 8 * grp), c1 = *(const f32x4*)(cs + 8 * grp + 4), s0 = *(const f32x4*)(sn + 8 * grp), s1 = *(const f32x4*)(sn + 8 * grp + 4);
#pragma unroll
    for (int j = 0; j < 8; ++j) { const float c = j < 4 ? c0[j & 3] : c1[j & 3], s = j < 4 ? s0[j & 3] : s1[j & 3]; o1[j] = (x1[j] * c - x2[j] * s) * sc; o2[j] = (x1[j] * s + x2[j] * c) * sc; }
}
__device__ __forceinline__ void ret_pass1(int job, const bf16* Z, const float* rcs, const float* rsn, float* RST, LAS unsigned char* lds, int tid) {
    asm volatile("" : "+s"(job));
    const int lane = tid & 63, w = __builtin_amdgcn_readfirstlane(tid >> 6), r15 = lane & 15, g = lane >> 4;
    const int h = job & 3, n = (job >> 2) & 31, b = job >> 7; const size_t m0 = (size_t)b * SEQ + (size_t)n * RET_C; const float lg2 = ret_lg2(h);
    LAS bf16* kT = (LAS bf16*)lds; LAS bf16* vT = kT + 64 * 136;
    { const int row = tid & 127, grp = tid >> 7; const size_t m = m0 + row; float o1[8], o2[8];
      ret_rope8(Z + m * NZ + ZC_RK + 64 * h, rcs + m * 32, rsn + m * 32, grp, __builtin_amdgcn_exp2f(-(float)(row + 1) * lg2 - 3.0f), o1, o2);
#pragma unroll
      for (int j = 0; j < 8; ++j) { kT[(8 * grp + j) * 136 + row] = (bf16)f2bf(o1[j]); kT[(32 + 8 * grp + j) * 136 + row] = (bf16)f2bf(o2[j]); }
      const v4u v0 = *(const v4u*)(Z + m * NZ + ZC_RV + 64 * h + 16 * grp), v1 = *(const v4u*)(Z + m * NZ + ZC_RV + 64 * h + 16 * grp + 8);
      const unsigned vw[8] = {v0.x, v0.y, v0.z, v0.w, v1.x, v1.y, v1.z, v1.w};
#pragma unroll
      for (int j = 0; j < 8; ++j) { vT[(16 * grp + 2 * j) * 136 + row] = (bf16)(vw[j] & 0xffffu); vT[(16 * grp + 2 * j + 1) * 136 + row] = (bf16)(vw[j] >> 16); } }
    WG_SYNC();
    const int et = w & 3, dt0 = (w >> 2) * 2; f32x4 acc0 = {0.f, 0.f, 0.f, 0.f}, acc1 = {0.f, 0.f, 0.f, 0.f};
#pragma unroll
    for (int kk = 0; kk < 4; ++kk) { const bf16x8 a = frag(vT, 16 * et + r15, 136, 32 * kk + 8 * g);
        acc0 = MFMA16(a, frag(kT, 16 * dt0 + r15, 136, 32 * kk + 8 * g), acc0); acc1 = MFMA16(a, frag(kT, 16 * dt0 + 16 + r15, 136, 32 * kk + 8 * g), acc1); }
    const float gc = __builtin_amdgcn_exp2f((float)RET_C * lg2); float* dst = RST + ((size_t)((b * 4 + h) * 32 + n) * 64 + 16 * et + 4 * g) * 64 + 16 * dt0 + r15;
#pragma unroll
    for (int j = 0; j < 4; ++j) { dst[j * 64] = acc0[j] * gc; dst[j * 64 + 16] = acc1[j] * gc; }
    WG_SYNC();
}
__device__ __forceinline__ void ret_scan(float* RST, int gt) {
    if (gt >= 16 * 4096) return;
    const int bh = gt >> 12, idx = gt & 4095, h = bh & 3; const float gc = __builtin_amdgcn_exp2f((float)RET_C * ret_lg2(h)); float* p = RST + (size_t)bh * 32 * 4096 + idx; float run = 0.f;
    float t[32];
#pragma unroll
    for (int i = 0; i < 32; ++i) t[i] = p[(size_t)i * 4096];
#pragma unroll
    for (int i = 0; i < 32; ++i) { p[(size_t)i * 4096] = run; run = gc * run + t[i]; }
}
__device__ __forceinline__ void ret_pass3(int job, const bf16* Z, const float* rcs, const float* rsn, const float* RST, const float* normg, bf16* Y, LAS unsigned char* lds, int tid) {
    asm volatile("" : "+s"(job));
    const int lane = tid & 63, w = __builtin_amdgcn_readfirstlane(tid >> 6), r15 = lane & 15, g = lane >> 4;
    const int h = job & 3, n = (job >> 2) & 31, b = job >> 7; const size_t m0 = (size_t)b * SEQ + (size_t)n * RET_C; const float lg2 = ret_lg2(h);
    LAS bf16* qs = (LAS bf16*)lds; LAS bf16* ks = qs + 128 * 72; LAS bf16* vT = ks + 128 * 72; LAS bf16* sT = vT + 64 * 136;
    { const int row = tid & 127, grp = tid >> 7; const size_t m = m0 + row; float o1[8], o2[8];
      ret_rope8(Z + m * NZ + ZC_RQ + 64 * h, rcs + m * 32, rsn + m * 32, grp, __builtin_amdgcn_exp2f((float)(row + 1) * lg2), o1, o2);
      *(LAS v4u*)(qs + row * 72 + 8 * grp) = pack8(o1); *(LAS v4u*)(qs + row * 72 + 32 + 8 * grp) = pack8(o2);
      ret_rope8(Z + m * NZ + ZC_RK + 64 * h, rcs + m * 32, rsn + m * 32, grp, __builtin_amdgcn_exp2f(-(float)(row + 1) * lg2 - 3.0f), o1, o2);
      *(LAS v4u*)(ks + row * 72 + 8 * grp) = pack8(o1); *(LAS v4u*)(ks + row * 72 + 32 + 8 * grp) = pack8(o2);
      const v4u v0 = *(const v4u*)(Z + m * NZ + ZC_RV + 64 * h + 16 * grp), v1 = *(const v4u*)(Z + m * NZ + ZC_RV + 64 * h + 16 * grp + 8);
      const unsigned vw[8] = {v0.x, v0.y, v0.z, v0.w, v1.x, v1.y, v1.z, v1.w};
#pragma unroll
      for (int j = 0; j < 8; ++j) { vT[(16 * grp + 2 * j) * 136 + row] = (bf16)(vw[j] & 0xffffu); vT[(16 * grp + 2 * j + 1) * 136 + row] = (bf16)(vw[j] >> 16); }
      const int e = tid >> 3, d8 = (tid & 7) * 8; const float* sp = RST + ((size_t)((b * 4 + h) * 32 + n) * 64 + e) * 64 + d8; const f32x4 a0 = *(const f32x4*)sp, a1 = *(const f32x4*)(sp + 4);
      const float sv[8] = {a0[0], a0[1], a0[2], a0[3], a1[0], a1[1], a1[2], a1[3]}; *(LAS v4u*)(sT + e * 72 + d8) = pack8(sv); }
    const size_t mrow = m0 + 16 * w + r15; v2u gwp[4]; f32x4 ngp[4];
#pragma unroll
    for (int et = 0; et < 4; ++et) { gwp[et] = *(const v2u*)(Z + mrow * NZ + ZC_RG + 64 * h + 16 * et + 4 * g); ngp[et] = *(const f32x4*)(normg + 64 * h + 16 * et + 4 * g); }
    WG_SYNC();
    bf16x8 qf[2]; qf[0] = frag(qs, 16 * w + r15, 72, 8 * g); qf[1] = frag(qs, 16 * w + r15, 72, 32 + 8 * g);
    f32x4 Dt[8];
#pragma unroll
    for (int sb = 0; sb < 8; ++sb) { f32x4 acc = {0.f, 0.f, 0.f, 0.f};
        if (sb <= w) { acc = MFMA16(frag(ks, 16 * sb + r15, 72, 8 * g), qf[0], acc); acc = MFMA16(frag(ks, 16 * sb + r15, 72, 32 + 8 * g), qf[1], acc);
            if (sb == w) {
#pragma unroll
                for (int j = 0; j < 4; ++j) if (4 * g + j > r15) acc[j] = 0.f; } }
        Dt[sb] = acc; }
    f32x4 O[4];
#pragma unroll
    for (int et = 0; et < 4; ++et) O[et] = (f32x4){0.f, 0.f, 0.f, 0.f};
#pragma unroll
    for (int k2 = 0; k2 < 4; ++k2) if (2 * k2 <= w) { const bf16x8 pb = pack_pair(Dt[2 * k2], Dt[2 * k2 + 1]);
#pragma unroll
        for (int et = 0; et < 4; ++et) O[et] = MFMA16(frag2(vT, 16 * et + r15, 136, 32 * k2 + 4 * g), pb, O[et]); }
#pragma unroll
    for (int kk = 0; kk < 2; ++kk)
#pragma unroll
        for (int et = 0; et < 4; ++et) O[et] = MFMA16(frag(sT, 16 * et + r15, 72, 32 * kk + 8 * g), qf[kk], O[et]);
    float s1 = 0.f;
#pragma unroll
    for (int et = 0; et < 4; ++et) s1 += pg8::sum4(O[et]);
    s1 = pg8::fq_sum(s1, lane); const float mean = s1 * (1.0f / 64.0f); float s2 = 0.f;
#pragma unroll
    for (int et = 0; et < 4; ++et) { O[et] = O[et] - mean; s2 += pg8::dot4(O[et]); }
    s2 = pg8::fq_sum(s2, lane); const float rstd = __builtin_amdgcn_rsqf(s2 * (1.0f / 64.0f) + 1e-6f);
    const size_t m = m0 + 16 * w + r15;
#pragma unroll
    for (int et = 0; et < 4; ++et) { const int e = 16 * et + 4 * g; const v2u gw = gwp[et]; const f32x4 ng = ngp[et];
        v2u o; o.x = pg8::cvt_pk_bf16(O[et][0] * rstd * ng[0] * silu_fast(lo16(gw.x)), O[et][1] * rstd * ng[1] * silu_fast(hi16(gw.x)));
        o.y = pg8::cvt_pk_bf16(O[et][2] * rstd * ng[2] * silu_fast(lo16(gw.y)), O[et][3] * rstd * ng[3] * silu_fast(hi16(gw.y)));
        *(v2u*)(Y + m * 1024 + 768 + 64 * h + e) = o; }
    WG_SYNC();
}

__device__ __forceinline__ float hg_lb(const float* lblog, int l, int ch) {
    const float x0 = lblog[ch], x1 = lblog[512 + ch], x2 = lblog[1024 + ch], x3 = lblog[1536 + ch]; const float mx_ = fmaxf(fmaxf(x0, x1), fmaxf(x2, x3));
    const float e0 = __expf(x0 - mx_), e1 = __expf(x1 - mx_), e2 = __expf(x2 - mx_), e3 = __expf(x3 - mx_);
    return ((l >= 1 ? e1 : 0.f) + (l >= 2 ? e2 : 0.f) + (l >= 3 ? e3 : 0.f)) / (e0 + e1 + e2 + e3);
}
__device__ __forceinline__ void hg_lb8(const float* lblog, int l, int ch, float (&lb)[8]) {
    f32x4 x[4][2];
#pragma unroll
    for (int r = 0; r < 4; ++r) { x[r][0] = *(const f32x4*)(lblog + 512 * r + ch); x[r][1] = *(const f32x4*)(lblog + 512 * r + ch + 4); }
#pragma unroll
    for (int j = 0; j < 8; ++j) { const float x0 = x[0][j >> 2][j & 3], x1 = x[1][j >> 2][j & 3], x2 = x[2][j >> 2][j & 3], x3 = x[3][j >> 2][j & 3]; const float mx_ = fmaxf(fmaxf(x0, x1), fmaxf(x2, x3));
        const float e0 = __expf(x0 - mx_), e1 = __expf(x1 - mx_), e2 = __expf(x2 - mx_), e3 = __expf(x3 - mx_);
        lb[j] = ((l >= 1 ? e1 : 0.f) + (l >= 2 ? e2 : 0.f) + (l >= 3 ? e3 : 0.f)) / (e0 + e1 + e2 + e3); }
}
__device__ __forceinline__ void hg_lb8t(const float* hlb, int ch, float (&lb)[8]) {
    const f32x4 a0 = *(const f32x4*)(hlb + ch), a1 = *(const f32x4*)(hlb + ch + 4);
    lb[0] = a0[0]; lb[1] = a0[1]; lb[2] = a0[2]; lb[3] = a0[3]; lb[4] = a1[0]; lb[5] = a1[1]; lb[6] = a1[2]; lb[7] = a1[3];
}
__device__ __forceinline__ void hg_gates8(const v4u (&fw)[4], const float (&lb)[8], LAS float* T, int kc, int tq, float (&bc)[4][8], float (&kk)[4][8], float (&bmid)[8], float (&blast)[8]) {
    float run[8];
#pragma unroll
    for (int j = 0; j < 8; ++j) run[j] = 0.f;
#pragma unroll
    for (int i = 0; i < 4; ++i) { float f[8]; unpack8(fw[i], f);
#pragma unroll
        for (int j = 0; j < 8; ++j) { const float fg = lb[j] + (1.0f - lb[j]) * __builtin_amdgcn_rcpf(1.0f + __builtin_amdgcn_exp2f(-1.4426950408889634f * f[j]));
            kk[i][j] = 1.0f - fg; run[j] += __builtin_amdgcn_logf(fg); bc[i][j] = run[j]; } }
    *(LAS f32x4*)(T + tq * 128 + 8 * kc) = (f32x4){run[0], run[1], run[2], run[3]}; *(LAS f32x4*)(T + tq * 128 + 8 * kc + 4) = (f32x4){run[4], run[5], run[6], run[7]};
    WG_SYNC_L();
    float off[8];
#pragma unroll
    for (int j = 0; j < 8; ++j) { off[j] = 0.f; bmid[j] = 0.f; blast[j] = 0.f; }
#pragma unroll
    for (int t2 = 0; t2 < 16; ++t2) { const f32x4 a0 = *(const LAS f32x4*)(T + t2 * 128 + 8 * kc), a1 = *(const LAS f32x4*)(T + t2 * 128 + 8 * kc + 4);
#pragma unroll
        for (int j = 0; j < 8; ++j) { const float v = j < 4 ? a0[j & 3] : a1[j & 3]; if (t2 < tq) off[j] += v; if (t2 < 8) bmid[j] += v; blast[j] += v; } }
#pragma unroll
    for (int i = 0; i < 4; ++i)
#pragma unroll
        for (int j = 0; j < 8; ++j) bc[i][j] += off[j];
}
__device__ __forceinline__ void hg_store_vT(const v4u v0, const v4u v1, int u, LAS bf16* vT) {
    const int row = u & 63, grp = u >> 6; const unsigned vw[8] = {v0.x, v0.y, v0.z, v0.w, v1.x, v1.y, v1.z, v1.w};
#pragma unroll
    for (int j = 0; j < 8; ++j) { vT[(16 * grp + 2 * j) * 72 + row] = (bf16)(vw[j] & 0xffffu); vT[(16 * grp + 2 * j + 1) * 72 + row] = (bf16)(vw[j] >> 16); }
}
__device__ __forceinline__ void hg_pass1(int pair, const bf16* Z, const float* hlb, bf16* HST, float* HDC, LAS unsigned char* lds, int tid) {
    asm volatile("" : "+s"(pair));
    const int lane = tid & 63, w = __builtin_amdgcn_readfirstlane(tid >> 6), r15 = lane & 15, g = lane >> 4, half = w >> 2, wq = w & 3, u = tid & 255, kc = u & 15, tq = u >> 4;
    const int job = 2 * pair + half, h = job & 3, c = (job >> 2) & 63, b = job >> 8; const size_t m0 = (size_t)b * SEQ + (size_t)c * 64;
    LAS float* T = (LAS float*)lds + half * 2048; LAS bf16* koT = (LAS bf16*)(lds + 16384) + half * (128 * 72 + 64 * 72); LAS bf16* vT = koT + 128 * 72;
    v4u fw[4];
#pragma unroll
    for (int i = 0; i < 4; ++i) fw[i] = *(const v4u*)(Z + (m0 + 4 * tq + i) * NZ + ZC_HF + 128 * h + 8 * kc);
    const bf16* vp = Z + (m0 + (u & 63)) * NZ + ZC_HI + 64 * h + 16 * (u >> 6); const v4u v0 = *(const v4u*)vp, v1 = *(const v4u*)(vp + 8);
    float lb[8]; hg_lb8t(hlb, 128 * h + 8 * kc, lb);
    float bc[4][8], kk[4][8], bmid[8], blast[8]; hg_gates8(fw, lb, T, kc, tq, bc, kk, bmid, blast);
#pragma unroll
    for (int j = 0; j < 8; ++j) { v2u o; o.x = pg8::cvt_pk_bf16(kk[0][j] * __builtin_amdgcn_exp2f(blast[j] - bc[0][j]), kk[1][j] * __builtin_amdgcn_exp2f(blast[j] - bc[1][j])); o.y = pg8::cvt_pk_bf16(kk[2][j] * __builtin_amdgcn_exp2f(blast[j] - bc[2][j]), kk[3][j] * __builtin_amdgcn_exp2f(blast[j] - bc[3][j]));
        *(LAS v2u*)(koT + (8 * kc + j) * 72 + 4 * tq) = o; }
    if (tq == 0) { float* dp = HDC + (size_t)((b * 4 + h) * 64 + c) * 128 + 8 * kc; *(f32x4*)dp = (f32x4){__builtin_amdgcn_exp2f(blast[0]), __builtin_amdgcn_exp2f(blast[1]), __builtin_amdgcn_exp2f(blast[2]), __builtin_amdgcn_exp2f(blast[3])}; *(f32x4*)(dp + 4) = (f32x4){__builtin_amdgcn_exp2f(blast[4]), __builtin_amdgcn_exp2f(blast[5]), __builtin_amdgcn_exp2f(blast[6]), __builtin_amdgcn_exp2f(blast[7])}; }
    hg_store_vT(v0, v1, u, vT);
    WG_SYNC_L();
    f32x4 acc[4][2];
#pragma unroll
    for (int et = 0; et < 4; ++et) { acc[et][0] = (f32x4){0.f, 0.f, 0.f, 0.f}; acc[et][1] = (f32x4){0.f, 0.f, 0.f, 0.f}; }
#pragma unroll
    for (int k2 = 0; k2 < 2; ++k2) { const bf16x8 b0 = frag(koT, 32 * wq + r15, 72, 32 * k2 + 8 * g), b1 = frag(koT, 32 * wq + 16 + r15, 72, 32 * k2 + 8 * g);
#pragma unroll
        for (int et = 0; et < 4; ++et) { const bf16x8 a = frag(vT, 16 * et + r15, 72, 32 * k2 + 8 * g); acc[et][0] = MFMA16(a, b0, acc[et][0]); acc[et][1] = MFMA16(a, b1, acc[et][1]); } }
    bf16* dst = HST + (size_t)((b * 4 + h) * 64 + c) * 8192 + 32 * wq + r15;
#pragma unroll
    for (int et = 0; et < 4; ++et)
#pragma unroll
        for (int j = 0; j < 4; ++j) { dst[(16 * et + 4 * g + j) * 128] = (bf16)f2bf(acc[et][0][j]); dst[(16 * et + 4 * g + j) * 128 + 16] = (bf16)f2bf(acc[et][1][j]); }
    WG_SYNC_L();
}
__device__ __forceinline__ void hg_scan(bf16* HST, const float* HDC, int gt) {
    const int bh = gt >> 12, idx = (gt & 4095) * 2, k = idx & 127; unsigned* p = (unsigned*)(HST + (size_t)bh * 64 * 8192 + idx); const float* dp = HDC + (size_t)bh * 64 * 128 + k; float r0 = 0.f, r1 = 0.f;
#pragma unroll 1
    for (int c0 = 0; c0 < 64; c0 += 16) { unsigned t[16]; float d0[16], d1[16];
#pragma unroll
        for (int i = 0; i < 16; ++i) { t[i] = p[(size_t)(c0 + i) * 4096]; const float2 dd = *(const float2*)(dp + (c0 + i) * 128); d0[i] = dd.x; d1[i] = dd.y; }
#pragma unroll
        for (int i = 0; i < 16; ++i) { p[(size_t)(c0 + i) * 4096] = pg8::cvt_pk_bf16(r0, r1); r0 = d0[i] * r0 + lo16(t[i]); r1 = d1[i] * r1 + hi16(t[i]); } }
}
__device__ __forceinline__ void hg_pass3(int pair, const bf16* Z, const float* hlb, const bf16* HST, const float* normg, bf16* Y, LAS unsigned char* lds, int tid) {
    asm volatile("" : "+s"(pair));
    const int lane = tid & 63, w = __builtin_amdgcn_readfirstlane(tid >> 6), r15 = lane & 15, g = lane >> 4, half = w >> 2, tb = w & 3, u = tid & 255, kc = u & 15, tq = u >> 4;
    const int job = 2 * pair + half, h = job & 3, c = (job >> 2) & 63, b = job >> 8; const size_t m0 = (size_t)b * SEQ + (size_t)c * 64;
    LAS bf16* qs = (LAS bf16*)lds + half * (3 * 64 * 136 + 64 * 72); LAS bf16* ks = qs + 64 * 136; LAS bf16* sT = ks + 64 * 136; LAS bf16* vT = sT + 64 * 136;
    LAS float* T = (LAS float*)qs;
    v4u fw[4], qw[4];
#pragma unroll
    for (int i = 0; i < 4; ++i) { const bf16* zr = Z + (m0 + 4 * tq + i) * NZ + 128 * h + 8 * kc; fw[i] = *(const v4u*)(zr + ZC_HF); qw[i] = *(const v4u*)(zr + ZC_HQ); }
    const bf16* vp = Z + (m0 + (u & 63)) * NZ + ZC_HI + 64 * h + 16 * (u >> 6); const v4u v0 = *(const v4u*)vp, v1 = *(const v4u*)(vp + 8);
    v4u st[4];
#pragma unroll
    for (int i = 0; i < 4; ++i) st[i] = *(const v4u*)(HST + (size_t)((b * 4 + h) * 64 + c) * 8192 + ((u >> 4) + 16 * i) * 128 + 8 * kc);
    const size_t mrow = m0 + 16 * tb + r15; v2u gw[4]; f32x4 ng[4];
#pragma unroll
    for (int et = 0; et < 4; ++et) { gw[et] = *(const v2u*)(Z + mrow * NZ + ZC_HG + 64 * h + 16 * et + 4 * g); ng[et] = *(const f32x4*)(normg + 64 * h + 16 * et + 4 * g); }
    float lb[8]; hg_lb8t(hlb, 128 * h + 8 * kc, lb);
    { float bc[4][8], kk[4][8], bmid[8], blast[8]; hg_gates8(fw, lb, T, kc, tq, bc, kk, bmid, blast);
      WG_SYNC_L();
#pragma unroll
      for (int i = 0; i < 4; ++i) { float q[8], xq[8], xk[8]; unpack8(qw[i], q);
#pragma unroll
          for (int j = 0; j < 8; ++j) { xq[j] = q[j] * __builtin_amdgcn_exp2f(bc[i][j] - bmid[j]); xk[j] = kk[i][j] * __builtin_amdgcn_exp2f(bmid[j] - bc[i][j]); }
          *(LAS v4u*)(qs + (4 * tq + i) * 136 + 8 * kc) = pack8(xq); *(LAS v4u*)(ks + (4 * tq + i) * 136 + 8 * kc) = pack8(xk); }
      float em[8];
#pragma unroll
      for (int j = 0; j < 8; ++j) em[j] = __builtin_amdgcn_exp2f(bmid[j]);
#pragma unroll
      for (int i = 0; i < 4; ++i) { float sv[8]; unpack8(st[i], sv);
#pragma unroll
          for (int j = 0; j < 8; ++j) sv[j] *= em[j];
          *(LAS v4u*)(sT + ((u >> 4) + 16 * i) * 136 + 8 * kc) = pack8(sv); } }
    hg_store_vT(v0, v1, u, vT);
    WG_SYNC_L();
    bf16x8 qf[4];
#pragma unroll
    for (int kq = 0; kq < 4; ++kq) qf[kq] = frag(qs, 16 * tb + r15, 136, 32 * kq + 8 * g);
    f32x4 Dt[4];
#pragma unroll
    for (int sb = 0; sb < 4; ++sb) { f32x4 acc = {0.f, 0.f, 0.f, 0.f};
        if (sb <= tb) {
#pragma unroll
            for (int kq = 0; kq < 4; ++kq) acc = MFMA16(frag(ks, 16 * sb + r15, 136, 32 * kq + 8 * g), qf[kq], acc);
            if (sb == tb) {
#pragma unroll
                for (int j = 0; j < 4; ++j) if (4 * g + j > r15) acc[j] = 0.f; } }
        Dt[sb] = acc; }
    f32x4 O[4];
#pragma unroll
    for (int et = 0; et < 4; ++et) O[et] = (f32x4){0.f, 0.f, 0.f, 0.f};
#pragma unroll
    for (int k2 = 0; k2 < 2; ++k2) if (2 * k2 <= tb) { const bf16x8 pb = pack_pair(Dt[2 * k2], Dt[2 * k2 + 1]);
#pragma unroll
        for (int et = 0; et < 4; ++et) O[et] = MFMA16(frag2(vT, 16 * et + r15, 72, 32 * k2 + 4 * g), pb, O[et]); }
#pragma unroll
    for (int kq = 0; kq < 4; ++kq)
#pragma unroll
        for (int et = 0; et < 4; ++et) O[et] = MFMA16(frag(sT, 16 * et + r15, 136, 32 * kq + 8 * g), qf[kq], O[et]);
    float s2 = 0.f;
#pragma unroll
    for (int et = 0; et < 4; ++et) s2 += pg8::dot4(O[et]);
    s2 = pg8::fq_sum(s2, lane); const float rstd = __builtin_amdgcn_rsqf(s2 * (1.0f / 64.0f) + 1e-6f);
#pragma unroll
    for (int et = 0; et < 4; ++et) { const int e = 16 * et + 4 * g;
        v2u o; o.x = pg8::cvt_pk_bf16(O[et][0] * rstd * ng[et][0] * silu_fast(lo16(gw[et].x)), O[et][1] * rstd * ng[et][1] * silu_fast(hi16(gw[et].x)));
        o.y = pg8::cvt_pk_bf16(O[et][2] * rstd * ng[et][2] * silu_fast(lo16(gw[et].y)), O[et][3] * rstd * ng[et][3] * silu_fast(hi16(gw[et].y)));
        *(v2u*)(Y + mrow * 1024 + 512 + 64 * h + e) = o; }
    WG_SYNC_L();
}
__device__ __forceinline__ float gelu_as(float v) {
    const float t = __builtin_amdgcn_rcpf(fabsf(v) * 0.2316418882f + 1.0f);
    float q = t * 0.5307027145f + (-0.7265760135f); q = q * t + 0.7107068705f; q = q * t + (-0.142248368f); q = q * t + 0.127414796f; q = q * t;
    const float m = v * (q * __builtin_amdgcn_exp2f(v * v * -0.72134752044f));
    return v < 0.f ? m : v - m;
}
__device__ __forceinline__ float row16_sum(float v) {
    v += __builtin_bit_cast(float, __builtin_amdgcn_update_dpp(0, __builtin_bit_cast(int, v), 0xB1, 0xF, 0xF, false));
    v += __builtin_bit_cast(float, __builtin_amdgcn_update_dpp(0, __builtin_bit_cast(int, v), 0x4E, 0xF, 0xF, false));
    v += __builtin_bit_cast(float, __builtin_amdgcn_update_dpp(0, __builtin_bit_cast(int, v), 0x141, 0xF, 0xF, false));
    v += __builtin_bit_cast(float, __builtin_amdgcn_update_dpp(0, __builtin_bit_cast(int, v), 0x140, 0xF, 0xF, false));
    return v;
}
__device__ __forceinline__ void sg_job(int job, const bf16* Z, const float* lng, const bf16* Wsg  , const float* bs  , bf16* Y, LAS unsigned char* lds, int tid) {
    asm volatile("" : "+s"(job));
    const int lane = tid & 63, w = __builtin_amdgcn_readfirstlane(tid >> 6), r15 = lane & 15, g = lane >> 4;
    const int hh = job & 1; const size_t m0 = (size_t)(job >> 1) * 128;
    LAS bf16* vT = (LAS bf16*)lds;
    const int hl = w >> 2, tq = w & 3, h = 2 * hh + hl; const bf16* Wh = Wsg + (size_t)h * 128 * 128;
    v4u zv[4][2];
#pragma unroll
    for (int p = 0; p < 4; ++p) { const bf16* zr = Z + (m0 + 16 * w + 4 * g + p) * NZ + ZC_V + 16 * r15; zv[p][0] = *(const v4u*)zr; zv[p][1] = *(const v4u*)(zr + 8); }
    f32x4 gl[4];
#pragma unroll
    for (int c4 = 0; c4 < 4; ++c4) gl[c4] = *(const f32x4*)(lng + 16 * r15 + 4 * c4);
    bf16x8 wf[2][4]; v2u uw[2][4]; float bias[2];
#pragma unroll
    for (int i = 0; i < 2; ++i) { const int t = 16 * (2 * tq + i) + r15; bias[i] = bs[h * 128 + t];
#pragma unroll
        for (int kk = 0; kk < 4; ++kk) wf[i][kk] = *(const bf16x8*)(Wh + (size_t)t * 128 + 32 * kk + 8 * g);
#pragma unroll
        for (int dt = 0; dt < 4; ++dt) uw[i][dt] = *(const v2u*)(Z + (m0 + t) * NZ + ZC_U + 128 * hh + 64 * hl + 16 * dt + 4 * g); }
    float i256 = 1.0f / 256.0f; asm volatile("" : "+s"(i256));
    { unsigned ys[16][2];
      float yv[2][16];
#pragma unroll
      for (int p = 0; p < 4; ++p) { float x[16]; unpack8(zv[p][0], *(float(*)[8])&x[0]); unpack8(zv[p][1], *(float(*)[8])&x[8]); float s1 = 0.f, s2 = 0.f;
#pragma unroll
          for (int c = 0; c < 16; ++c) { x[c] = gelu_as(x[c]); s1 += x[c]; s2 += x[c] * x[c]; }
          s1 = row16_sum(s1); s2 = row16_sum(s2); const float mean = s1 * i256, rstd = __builtin_amdgcn_rsqf(fmaxf(s2 * i256 - mean * mean, 0.f) + 1e-6f);
#pragma unroll
          for (int c = 0; c < 16; ++c) yv[p & 1][c] = (x[c] - mean) * rstd * gl[c >> 2][c & 3];
          if (p & 1) {
#pragma unroll
              for (int c = 0; c < 16; ++c) ys[c][p >> 1] = pg8::cvt_pk_bf16(yv[0][c], yv[1][c]); } }
      if ((r15 >> 3) == hh) { const int cq = r15 & 7;
#pragma unroll
          for (int c = 0; c < 16; ++c) { v2u o; o.x = ys[c][0]; o.y = ys[c][1]; *(LAS v2u*)(vT + (16 * cq + c) * 136 + ((16 * w + 4 * g) ^ (8 * cq))) = o; } } }
    WG_SYNC_L();
    f32x4 acc[2][4];
#pragma unroll
    for (int i = 0; i < 2; ++i)
#pragma unroll
        for (int dt = 0; dt < 4; ++dt) acc[i][dt] = (f32x4){0.f, 0.f, 0.f, 0.f};
#pragma unroll
    for (int i = 0; i < 2; ++i) { const int tb = 2 * tq + i;
#pragma unroll
        for (int kk = 0; kk < 4; ++kk) if (2 * kk <= tb) {
#pragma unroll
            for (int dt = 0; dt < 4; ++dt) acc[i][dt] = MFMA16(frag(vT, 64 * hl + 16 * dt + r15, 136, (32 * kk + 8 * g) ^ (8 * ((4 * hl + dt) & 7))), wf[i][kk], acc[i][dt]); } }
#pragma unroll
    for (int i = 0; i < 2; ++i) { const int t = 16 * (2 * tq + i) + r15; const size_t m = m0 + t;
#pragma unroll
        for (int dt = 0; dt < 4; ++dt) { const int d = 128 * hh + 64 * hl + 16 * dt + 4 * g; const v2u u2 = uw[i][dt];
            v2u o; o.x = pg8::cvt_pk_bf16(gelu_as(lo16(u2.x)) * (acc[i][dt][0] + bias[i]), gelu_as(hi16(u2.x)) * (acc[i][dt][1] + bias[i]));
            o.y = pg8::cvt_pk_bf16(gelu_as(lo16(u2.y)) * (acc[i][dt][2] + bias[i]), gelu_as(hi16(u2.y)) * (acc[i][dt][3] + bias[i]));
            *(v2u*)(Y + m * 1024 + 256 + d) = o; } }
    WG_SYNC_L();
}

__device__ __forceinline__ void mla_qblock(int b, int h, int qb, const bf16* QKV, bf16* Y, LAS unsigned char* lds, int tid) {
    const int lane = tid & 63, w = __builtin_amdgcn_readfirstlane(tid >> 6), r15 = lane & 15, g = lane >> 4;
    LAS bf16* Kb = (LAS bf16*)lds; LAS bf16* Vt = Kb + 2 * 64 * 104;
    const size_t mb = (size_t)b * SEQ; const int t_row = 128 * qb + 16 * w + r15;
    const int ntile = 2 * (qb + 1);
    bf16x8 qf[3];
#pragma unroll
    for (int kk = 0; kk < 3; ++kk) qf[kk] = *(const bf16x8*)(QKV + (mb + t_row) * 1024 + QC_Q + 96 * h + 32 * kk + 8 * g);
    const int srow = tid >> 3, spc = tid & 7, rrow = (tid >> 2) & 63, rpc = tid & 3;
    v4u ldk, ldr, ldv;
#define MLA_LOAD(kt) do { const bf16* kp = QKV + (mb + 64 * (kt) + srow) * 1024; ldk = *(const v4u*)(kp + QC_KN + 64 * h + 8 * spc); ldv = *(const v4u*)(QKV + (mb + 64 * (kt) + lane) * 1024 + QC_V + 64 * h + 8 * w); \
        if (tid < 256) ldr = *(const v4u*)(QKV + (mb + 64 * (kt) + rrow) * 1024 + QC_KR + 8 * rpc); } while (0)
#define MLA_STORE(buf) do { LAS bf16* kd = Kb + (buf) * 64 * 104; LAS bf16* vd = Vt + (buf) * 64 * 72; *(LAS v4u*)(kd + srow * 104 + 8 * spc) = ldk; if (tid < 256) *(LAS v4u*)(kd + rrow * 104 + 64 + 8 * rpc) = ldr; \
        const unsigned vw_[4] = {ldv.x, ldv.y, ldv.z, ldv.w}; _Pragma("unroll") for (int j_ = 0; j_ < 4; ++j_) { vd[(8 * w + 2 * j_) * 72 + lane] = (bf16)(vw_[j_] & 0xffffu); vd[(8 * w + 2 * j_ + 1) * 72 + lane] = (bf16)(vw_[j_] >> 16); } } while (0)
    MLA_LOAD(0); MLA_STORE(0); WG_SYNC();
    float m_run = -INFINITY, l_run = 0.f; f32x4 O[4];
#pragma unroll
    for (int et = 0; et < 4; ++et) O[et] = (f32x4){0.f, 0.f, 0.f, 0.f};
    const int t_lo = 128 * qb + 16 * w;
    for (int kt = 0; kt < ntile; ++kt) {
        if (kt + 1 < ntile) MLA_LOAD(kt + 1);
        if (64 * kt <= t_lo + 15) {
            lcp kb = Kb + (kt & 1) * 64 * 104; lcp vb = Vt + (kt & 1) * 64 * 72;
            f32x4 S[4];
#pragma unroll
            for (int sb = 0; sb < 4; ++sb) { f32x4 acc = {0.f, 0.f, 0.f, 0.f};
#pragma unroll
                for (int kk = 0; kk < 3; ++kk) acc = MFMA16(frag(kb, 16 * sb + r15, 104, 32 * kk + 8 * g), qf[kk], acc);
                S[sb] = acc; }
            if (64 * kt + 63 > t_lo) {
#pragma unroll
                for (int sb = 0; sb < 4; ++sb)
#pragma unroll
                    for (int j = 0; j < 4; ++j) if (64 * kt + 16 * sb + 4 * g + j > t_row) S[sb][j] = -INFINITY; }
            float mx_ = fmaxf(fmaxf(fmaxf(S[0][0], S[0][1]), fmaxf(S[0][2], S[0][3])), fmaxf(fmaxf(S[1][0], S[1][1]), fmaxf(S[1][2], S[1][3])));
            mx_ = fmaxf(mx_, fmaxf(fmaxf(fmaxf(S[2][0], S[2][1]), fmaxf(S[2][2], S[2][3])), fmaxf(fmaxf(S[3][0], S[3][1]), fmaxf(S[3][2], S[3][3]))));
            mx_ = fmaxf(mx_, __shfl_xor(mx_, 16)); mx_ = fmaxf(mx_, __shfl_xor(mx_, 32));
            const float m_new = fmaxf(m_run, mx_), corr = __builtin_amdgcn_exp2f(m_run - m_new); m_run = m_new; float ps = 0.f;
#pragma unroll
            for (int sb = 0; sb < 4; ++sb)
#pragma unroll
                for (int j = 0; j < 4; ++j) { const float p = __builtin_amdgcn_exp2f(S[sb][j] - m_new); S[sb][j] = p; ps += p; }
            l_run = l_run * corr + ps;
#pragma unroll
            for (int et = 0; et < 4; ++et) O[et] = O[et] * corr;
#pragma unroll
            for (int k2 = 0; k2 < 2; ++k2) { const bf16x8 pb = pack_pair(S[2 * k2], S[2 * k2 + 1]);
#pragma unroll
                for (int et = 0; et < 4; ++et) O[et] = MFMA16(frag2(vb, 16 * et + r15, 72, 32 * k2 + 4 * g), pb, O[et]); }
        }
        if (kt + 1 < ntile) MLA_STORE((kt + 1) & 1);
        WG_SYNC();
    }
#undef MLA_LOAD
#undef MLA_STORE
    l_run += __shfl_xor(l_run, 16); l_run += __shfl_xor(l_run, 32); const float inv = 1.0f / l_run;
#pragma unroll
    for (int et = 0; et < 4; ++et) { v2u o; o.x = pg8::cvt_pk_bf16(O[et][0] * inv, O[et][1] * inv); o.y = pg8::cvt_pk_bf16(O[et][2] * inv, O[et][3] * inv);
        *(v2u*)(Y + (mb + t_row) * 1024 + 64 * h + 16 * et + 4 * g) = o; }
}
typedef float f32x16 __attribute__((ext_vector_type(16)));
typedef short v4i16_t __attribute__((ext_vector_type(4)));
#define MFMA32(a, b, c) __builtin_amdgcn_mfma_f32_32x32x16_bf16((a), (b), (c), 0, 0, 0)
__device__ __forceinline__ bf16x8 vtr2(const LAS unsigned char* p0, const LAS unsigned char* p1) {
    typedef short s16x4_ __attribute__((ext_vector_type(4))); s16x4_ lo, hi; const unsigned a0 = (unsigned)(uintptr_t)p0, a1 = (unsigned)(uintptr_t)p1;
    asm volatile("ds_read_b64_tr_b16 %0, %2\n\tds_read_b64_tr_b16 %1, %3\n\ts_waitcnt lgkmcnt(0)" : "=&v"(lo), "=&v"(hi) : "v"(a0), "v"(a1) : "memory");
    return (bf16x8){lo[0], lo[1], lo[2], lo[3], hi[0], hi[1], hi[2], hi[3]};
}
__device__ __forceinline__ bf16x8 pack8f(float a0, float a1, float a2, float a3, float a4, float a5, float a6, float a7) {
    v4u w; w.x = pg8::cvt_pk_bf16(a0, a1); w.y = pg8::cvt_pk_bf16(a2, a3); w.z = pg8::cvt_pk_bf16(a4, a5); w.w = pg8::cvt_pk_bf16(a6, a7); return __builtin_bit_cast(bf16x8, w);
}
constexpr float MLA_THR = 8.0f;
constexpr int MLA_NS = 6, MLA_VSLOT = 8192, MLA_KSLOT = 12288, MLA_KBASE = MLA_NS * MLA_VSLOT, MLA_COMB = 0;
__device__ __forceinline__ void mla_qblock2(int b, int h, int qb, const bf16* QKV, bf16* Y, LAS unsigned char* lds, int tid) {
    const int lane = tid & 63, w = __builtin_amdgcn_readfirstlane(tid >> 6), r31 = lane & 31, hh = lane >> 5, rg = w & 3, kh = w >> 2;
    const size_t mb = (size_t)b * SEQ; const int t_lo = 128 * qb + 32 * rg, t_row = t_lo + r31, ntile = 2 * (qb + 1);
    bf16x8 qf[6];
#pragma unroll
    for (int kk = 0; kk < 6; ++kk) qf[kk] = *(const bf16x8*)(QKV + (mb + t_row) * 1024 + QC_Q + 96 * h + 16 * kk + 8 * hh);
    int soff[3];
#pragma unroll
    for (int j = 0; j < 3; ++j) { const int c = w + 8 * j, P = 64 * c + lane;
        if (c < 12) { const int row = P / 12, pos = P - 12 * row; int pc = pos - ((row >> 2) & 3); pc = pc < 0 ? pc + 12 : pc; soff[j] = row * 1024 + (pc < 8 ? QC_KN + 64 * h + 8 * pc : QC_KR + 8 * (pc - 8)); }
        else { const int P2 = P - 768, row = P2 >> 3, pp = P2 & 7, piece = pp ^ (4 * ((row >> 1) & 1)); soff[j] = row * 1024 + QC_V + 64 * h + 8 * piece; } }
    const bool has3 = w < 4; const bf16* tile0 = QKV + mb * 1024; const unsigned lds0 = (unsigned)(uintptr_t)lds;
    int koff[6];
    { const int row = 32 * kh + r31, a = (row >> 2) & 3;
#pragma unroll
      for (int kk = 0; kk < 6; ++kk) { int pos = 2 * kk + hh + a; pos = pos >= 12 ? pos - 12 : pos; koff[kk] = row * 192 + 16 * pos; } }
    int voff[2];
    { const int q = (lane & 15) >> 2, p = lane & 3, gb = (lane >> 4) & 1, x = q >> 1;
#pragma unroll
      for (int et = 0; et < 2; ++et) voff[et] = (32 * kh + 4 * hh + q) * 128 + 8 * ((8 * (et ^ x)) + 4 * gb + p); }
#define MLA_GLDS(src, dst) do { unsigned keep_; asm volatile("s_mov_b32 %0, m0\n\ts_mov_b32 m0, %2\n\ts_nop 0\n\tglobal_load_lds_dwordx4 %1, off\n\ts_mov_b32 m0, %0" : "=&s"(keep_) : "v"(src), "s"(dst) : "memory"); } while (0)
#define MLA_DMA(kt) do { const bf16* tb_ = tile0 + (size_t)(kt) * 65536; const unsigned kb_ = lds0 + MLA_KBASE + ((kt) % MLA_NS) * MLA_KSLOT, vb_ = lds0 + ((kt) % MLA_NS) * MLA_VSLOT; \
        const unsigned d0_ = (unsigned)__builtin_amdgcn_readfirstlane((int)(kb_ + 1024 * w)), d1_ = (unsigned)__builtin_amdgcn_readfirstlane((int)(w < 4 ? kb_ + 1024 * (w + 8) : vb_ + 1024 * (w - 4))), d2_ = (unsigned)__builtin_amdgcn_readfirstlane((int)(vb_ + 1024 * (w + 4))); \
        MLA_GLDS(tb_ + soff[0], d0_); MLA_GLDS(tb_ + soff[1], d1_); if (has3) MLA_GLDS(tb_ + soff[2], d2_); } while (0)
    asm volatile("s_waitcnt vmcnt(0)" ::: "memory");
#pragma unroll
    for (int kk = 0; kk < 6; ++kk) asm volatile("" : "+v"(qf[kk]));
#pragma unroll
    for (int i = 0; i < MLA_NS - 1; ++i) if (i < ntile) MLA_DMA(i);
    float m_run = 0.f; f32x16 O0, O1, Lacc, negm;
#pragma unroll
    for (int i = 0; i < 16; ++i) { O0[i] = 0.f; O1[i] = 0.f; Lacc[i] = 0.f; negm[i] = 0.f; }
    const bf16x8 ones8 = (bf16x8){0x3F80, 0x3F80, 0x3F80, 0x3F80, 0x3F80, 0x3F80, 0x3F80, 0x3F80};
    for (int kt = 0; kt < ntile; ++kt) {
        { const int ahead = (ntile - 1 - kt) < (MLA_NS - 2) ? (ntile - 1 - kt) : (MLA_NS - 2);
          if (has3) { switch (ahead) { case 0: asm volatile("s_waitcnt vmcnt(0)" ::: "memory"); break; case 1: asm volatile("s_waitcnt vmcnt(3)" ::: "memory"); break; case 2: asm volatile("s_waitcnt vmcnt(6)" ::: "memory"); break;
                                       case 3: asm volatile("s_waitcnt vmcnt(9)" ::: "memory"); break; default: asm volatile("s_waitcnt vmcnt(12)" ::: "memory"); break; } }
          else      { switch (ahead) { case 0: asm volatile("s_waitcnt vmcnt(0)" ::: "memory"); break; case 1: asm volatile("s_waitcnt vmcnt(2)" ::: "memory"); break; case 2: asm volatile("s_waitcnt vmcnt(4)" ::: "memory"); break;
                                       case 3: asm volatile("s_waitcnt vmcnt(6)" ::: "memory"); break; default: asm volatile("s_waitcnt vmcnt(8)" ::: "memory"); break; } } }
        asm volatile("" ::: "memory"); __builtin_amdgcn_s_barrier(); asm volatile("" ::: "memory");
        if (kt + MLA_NS - 1 < ntile) MLA_DMA(kt + MLA_NS - 1);
        const int k_lo = 64 * kt + 32 * kh;
        if (k_lo <= t_lo + 31) {
            const LAS unsigned char* sb = lds + MLA_KBASE + (kt % MLA_NS) * MLA_KSLOT; const LAS unsigned char* vb = lds + (kt % MLA_NS) * MLA_VSLOT;
            f32x16 S = negm;
            typedef short s16x4_ __attribute__((ext_vector_type(4)));
            s16x4_ va0, va1, va2, va3, vb0, vb1, vb2, vb3;
            { bf16x8 k0, k1, k2, k3, k4, k5; const unsigned kbase = (unsigned)(uintptr_t)sb;
              asm volatile("ds_read_b128 %0, %6\n\tds_read_b128 %1, %7\n\tds_read_b128 %2, %8\n\tds_read_b128 %3, %9\n\tds_read_b128 %4, %10\n\tds_read_b128 %5, %11\n\ts_waitcnt lgkmcnt(0)"
                           : "=&v"(k0), "=&v"(k1), "=&v"(k2), "=&v"(k3), "=&v"(k4), "=&v"(k5)
                           : "v"(kbase + koff[0]), "v"(kbase + koff[1]), "v"(kbase + koff[2]), "v"(kbase + koff[3]), "v"(kbase + koff[4]), "v"(kbase + koff[5]) : "memory");
              const unsigned vbase = (unsigned)(uintptr_t)vb, a0 = vbase + voff[0], a1 = vbase + voff[1];
              asm volatile("ds_read_b64_tr_b16 %0, %8\n\tds_read_b64_tr_b16 %1, %8 offset:1024\n\tds_read_b64_tr_b16 %2, %8 offset:2048\n\tds_read_b64_tr_b16 %3, %8 offset:3072\n\t"
                           "ds_read_b64_tr_b16 %4, %9\n\tds_read_b64_tr_b16 %5, %9 offset:1024\n\tds_read_b64_tr_b16 %6, %9 offset:2048\n\tds_read_b64_tr_b16 %7, %9 offset:3072"
                           : "=&v"(va0), "=&v"(va1), "=&v"(va2), "=&v"(va3), "=&v"(vb0), "=&v"(vb1), "=&v"(vb2), "=&v"(vb3) : "v"(a0), "v"(a1) : "memory");
              S = MFMA32(k0, qf[0], S); S = MFMA32(k1, qf[1], S); S = MFMA32(k2, qf[2], S); S = MFMA32(k3, qf[3], S); S = MFMA32(k4, qf[4], S); S = MFMA32(k5, qf[5], S); }
            if (k_lo + 31 > t_lo) {
#pragma unroll
                for (int i = 0; i < 16; ++i) if (k_lo + (i & 3) + 8 * (i >> 2) + 4 * hh > t_row) S[i] = -INFINITY; }
            float mx_ = fmaxf(fmaxf(fmaxf(S[0], S[1]), fmaxf(S[2], S[3])), fmaxf(fmaxf(S[4], S[5]), fmaxf(S[6], S[7])));
            mx_ = fmaxf(mx_, fmaxf(fmaxf(fmaxf(S[8], S[9]), fmaxf(S[10], S[11])), fmaxf(fmaxf(S[12], S[13]), fmaxf(S[14], S[15]))));
            mx_ = fmaxf(mx_, __shfl_xor(mx_, 32));
            if (__builtin_expect(__any(mx_ > MLA_THR), 0)) {
                const float d = fmaxf(mx_, 0.f), f = __builtin_amdgcn_exp2f(-d); m_run += d;
#pragma unroll
                for (int i = 0; i < 16; ++i) { S[i] -= d; O0[i] *= f; O1[i] *= f; Lacc[i] *= f; negm[i] = -m_run; } }
#pragma unroll
            for (int i = 0; i < 16; ++i) S[i] = __builtin_amdgcn_exp2f(S[i]);
            const bf16x8 P0 = pack8f(S[0], S[1], S[2], S[3], S[4], S[5], S[6], S[7]), P1 = pack8f(S[8], S[9], S[10], S[11], S[12], S[13], S[14], S[15]);
            asm volatile("s_waitcnt lgkmcnt(0)" : "+v"(va0), "+v"(va1), "+v"(va2), "+v"(va3), "+v"(vb0), "+v"(vb1), "+v"(vb2), "+v"(vb3) :: "memory");
#define V8(l_, h_) ((bf16x8){l_[0], l_[1], l_[2], l_[3], h_[0], h_[1], h_[2], h_[3]})
            O0 = MFMA32(V8(va0, va1), P0, O0); O0 = MFMA32(V8(va2, va3), P1, O0); O1 = MFMA32(V8(vb0, vb1), P0, O1); O1 = MFMA32(V8(vb2, vb3), P1, O1);
            Lacc = MFMA32(ones8, P0, Lacc); Lacc = MFMA32(ones8, P1, Lacc);
#undef V8
        }
    }
#undef MLA_DMA
#undef MLA_GLDS
    LAS float* cb = (LAS float*)(lds + MLA_COMB + rg * 8704);
    WG_SYNC_L();
    if (kh == 1) {
#pragma unroll
        for (int i = 0; i < 16; ++i) { cb[i * 64 + lane] = O0[i]; cb[(16 + i) * 64 + lane] = O1[i]; }
        cb[2048 + lane] = m_run; cb[2112 + lane] = Lacc[0]; }
    WG_SYNC();
    if (kh == 0) { const float m1 = cb[2048 + lane], l1 = cb[2112 + lane]; const float m = fmaxf(m_run, m1), f0 = __builtin_amdgcn_exp2f(m_run - m), f1 = __builtin_amdgcn_exp2f(m1 - m);
        const float l = f0 * Lacc[0] + f1 * l1; const float inv = 1.0f / l; bf16* yp = Y + (mb + t_row) * 1024 + 64 * h + 4 * hh;
#pragma unroll
        for (int i4 = 0; i4 < 4; ++i4) { float o[4], o2[4];
#pragma unroll
            for (int j = 0; j < 4; ++j) { o[j] = (f0 * O0[4 * i4 + j] + f1 * cb[(4 * i4 + j) * 64 + lane]) * inv; o2[j] = (f0 * O1[4 * i4 + j] + f1 * cb[(16 + 4 * i4 + j) * 64 + lane]) * inv; }
            v2u a; a.x = pg8::cvt_pk_bf16(o[0], o[1]); a.y = pg8::cvt_pk_bf16(o[2], o[3]); *(v2u*)(yp + 8 * i4) = a;
            v2u c2; c2.x = pg8::cvt_pk_bf16(o2[0], o2[1]); c2.y = pg8::cvt_pk_bf16(o2[2], o2[3]); *(v2u*)(yp + 32 + 8 * i4) = c2; } }
    WG_SYNC();
}
__device__ __forceinline__ float max3f(float a, float b, float c) { float r; asm("v_max3_f32 %0, %1, %2, %3" : "=v"(r) : "v"(a), "v"(b), "v"(c)); return r; }
typedef __bf16 bf16x8n_ __attribute__((ext_vector_type(8)));
typedef float f32x8_ __attribute__((ext_vector_type(8)));
__device__ __forceinline__ bf16x8 pack8v(float a0, float a1, float a2, float a3, float a4, float a5, float a6, float a7) {
    const f32x8_ v = {a0, a1, a2, a3, a4, a5, a6, a7}; return __builtin_bit_cast(bf16x8, __builtin_convertvector(v, bf16x8n_));
}
template <bool HAS_NEXT>
__device__ __forceinline__ void mla_step(const LAS unsigned char* kslot_next, const LAS unsigned char* vslot_cur, const int (&koff)[6], const int (&voff)[2], const bf16x8 (&qf)[6], const bf16x8 ones8,
                                         bool diag_next, int klo_next, int t_row, int hh, int a32  , f32x16& S, f32x16& negm, float& m_run, f32x16& O0, f32x16& O1, f32x16& Lacc) {
    typedef short s16x4_ __attribute__((ext_vector_type(4)));
    s16x4_ va0, va1, va2, va3, vb0, vb1, vb2, vb3; f32x16 Sn;
    { const unsigned vbase = (unsigned)(uintptr_t)vslot_cur, a0 = vbase + voff[0], a1 = vbase + voff[1];
      asm volatile("ds_read_b64_tr_b16 %0, %8\n\tds_read_b64_tr_b16 %1, %8 offset:1024\n\tds_read_b64_tr_b16 %2, %8 offset:2048\n\tds_read_b64_tr_b16 %3, %8 offset:3072\n\t"
                   "ds_read_b64_tr_b16 %4, %9\n\tds_read_b64_tr_b16 %5, %9 offset:1024\n\tds_read_b64_tr_b16 %6, %9 offset:2048\n\tds_read_b64_tr_b16 %7, %9 offset:3072"
                   : "=&v"(va0), "=&v"(va1), "=&v"(va2), "=&v"(va3), "=&v"(vb0), "=&v"(vb1), "=&v"(vb2), "=&v"(vb3) : "v"(a0), "v"(a1) : "memory"); }
    if constexpr (HAS_NEXT) {
        bf16x8 k0, k1, k2, k3, k4, k5; const unsigned kbase = (unsigned)(uintptr_t)kslot_next;
        asm volatile("ds_read_b128 %0, %14\n\tds_read_b128 %1, %15\n\tds_read_b128 %2, %16\n\tds_read_b128 %3, %17\n\tds_read_b128 %4, %18\n\tds_read_b128 %5, %19\n\ts_waitcnt lgkmcnt(0)"
                     : "=&v"(k0), "=&v"(k1), "=&v"(k2), "=&v"(k3), "=&v"(k4), "=&v"(k5), "+v"(va0), "+v"(va1), "+v"(va2), "+v"(va3), "+v"(vb0), "+v"(vb1), "+v"(vb2), "+v"(vb3)
                     : "v"(kbase + koff[0]), "v"(kbase + koff[1]), "v"(kbase + koff[2]), "v"(kbase + koff[3]), "v"(kbase + koff[4]), "v"(kbase + koff[5]) : "memory");
        if (diag_next) { f32x16 c_ = negm;
#pragma unroll
            for (int i = 0; i < 16; ++i) if (klo_next + (i & 3) + 8 * (i >> 2) + 4 * hh > t_row) c_[i] = -INFINITY;
            asm volatile("" ::: "memory"); Sn = MFMA32(k0, qf[0], c_); }
        else Sn = MFMA32(k0, qf[0], negm);
        Sn = MFMA32(k1, qf[1], Sn); Sn = MFMA32(k2, qf[2], Sn); Sn = MFMA32(k3, qf[3], Sn); Sn = MFMA32(k4, qf[4], Sn); Sn = MFMA32(k5, qf[5], Sn);
    } else {
        asm volatile("s_waitcnt lgkmcnt(0)" : "+v"(va0), "+v"(va1), "+v"(va2), "+v"(va3), "+v"(vb0), "+v"(vb1), "+v"(vb2), "+v"(vb3) :: "memory");
    }
    float mx_ = max3f(max3f(S[0], S[1], S[2]), max3f(S[3], S[4], S[5]), max3f(S[6], S[7], S[8]));
    mx_ = max3f(mx_, max3f(S[9], S[10], S[11]), max3f(S[12], S[13], max3f(S[14], S[15], S[15])));
    mx_ = max3f(mx_, __builtin_bit_cast(float, __builtin_amdgcn_ds_bpermute(a32, __builtin_bit_cast(int, mx_))), mx_);
    if (__builtin_expect(__any(mx_ > MLA_THR), 0)) {
        const float d = fmaxf(mx_, 0.f), f = __builtin_amdgcn_exp2f(-d); m_run += d;
#pragma unroll
        for (int i = 0; i < 16; ++i) { S[i] -= d; O0[i] *= f; O1[i] *= f; Lacc[i] *= f; negm[i] = -m_run; if (HAS_NEXT) Sn[i] -= d; } }
#pragma unroll
    for (int i = 0; i < 16; ++i) S[i] = __builtin_amdgcn_exp2f(S[i]);
    const bf16x8 P0 = pack8v(S[0], S[1], S[2], S[3], S[4], S[5], S[6], S[7]), P1 = pack8v(S[8], S[9], S[10], S[11], S[12], S[13], S[14], S[15]);
#define V8(l_, h_) ((bf16x8){l_[0], l_[1], l_[2], l_[3], h_[0], h_[1], h_[2], h_[3]})
    O0 = MFMA32(V8(va0, va1), P0, O0); O1 = MFMA32(V8(vb0, vb1), P0, O1); Lacc = MFMA32(ones8, P0, Lacc);
    O0 = MFMA32(V8(va2, va3), P1, O0); O1 = MFMA32(V8(vb2, vb3), P1, O1); Lacc = MFMA32(ones8, P1, Lacc);
#undef V8
    S = Sn;
}
__device__ __forceinline__ float xmax32(float v) { float a = v, b = v; asm volatile("s_nop 1\n\tv_permlane32_swap_b32 %0, %1\n\ts_nop 1" : "+v"(a), "+v"(b)); return max3f(a, b, a); }
typedef short s16x4m_ __attribute__((ext_vector_type(4)));
template <bool HAS_NEXT>
__device__ __forceinline__ void mla_step5(const LAS unsigned char* kslot2, const LAS unsigned char* vslot1, const int (&koff)[6], const int (&voff)[2], const bf16x8 (&qf)[6], const bf16x8 ones8, bool has_k2,
                                          bool diag_next, int klo_next, int t_row, int hh, f32x16& S, f32x16& negm, float& m_run, f32x16& O0, f32x16& O1, f32x16& Lacc, bf16x8 (&kr)[6], s16x4m_ (&vr)[8]) {
    f32x16 Sn;
    if constexpr (HAS_NEXT) {
        asm volatile("s_waitcnt lgkmcnt(8)" : "+v"(kr[0]), "+v"(kr[1]), "+v"(kr[2]), "+v"(kr[3]), "+v"(kr[4]), "+v"(kr[5]) :: "memory");
        if (diag_next) { f32x16 c_ = negm;
#pragma unroll
            for (int i = 0; i < 16; ++i) if (klo_next + (i & 3) + 8 * (i >> 2) + 4 * hh > t_row) c_[i] = -INFINITY;
            asm volatile("" ::: "memory"); Sn = MFMA32(kr[0], qf[0], c_); }
        else Sn = MFMA32(kr[0], qf[0], negm);
        Sn = MFMA32(kr[1], qf[1], Sn); Sn = MFMA32(kr[2], qf[2], Sn); Sn = MFMA32(kr[3], qf[3], Sn); Sn = MFMA32(kr[4], qf[4], Sn); Sn = MFMA32(kr[5], qf[5], Sn);
        if (has_k2) { const unsigned kbase = (unsigned)(uintptr_t)kslot2;
            asm volatile("ds_read_b128 %0, %6\n\tds_read_b128 %1, %7\n\tds_read_b128 %2, %8\n\tds_read_b128 %3, %9\n\tds_read_b128 %4, %10\n\tds_read_b128 %5, %11"
                         : "+v"(kr[0]), "+v"(kr[1]), "+v"(kr[2]), "+v"(kr[3]), "+v"(kr[4]), "+v"(kr[5])
                         : "v"(kbase + koff[0]), "v"(kbase + koff[1]), "v"(kbase + koff[2]), "v"(kbase + koff[3]), "v"(kbase + koff[4]), "v"(kbase + koff[5]) : "memory"); }
    }
    float mx_ = max3f(max3f(S[0], S[1], S[2]), max3f(S[3], S[4], S[5]), max3f(S[6], S[7], S[8]));
    mx_ = max3f(mx_, max3f(S[9], S[10], S[11]), max3f(S[12], S[13], max3f(S[14], S[15], S[15])));
    mx_ = xmax32(mx_);
    if (__builtin_expect(__any(mx_ > MLA_THR), 0)) {
        const float d = fmaxf(mx_, 0.f), f = __builtin_amdgcn_exp2f(-d); m_run += d;
#pragma unroll
        for (int i = 0; i < 16; ++i) { S[i] -= d; O0[i] *= f; O1[i] *= f; Lacc[i] *= f; negm[i] = -m_run; if (HAS_NEXT) Sn[i] -= d; } }
#pragma unroll
    for (int i = 0; i < 16; ++i) S[i] = __builtin_amdgcn_exp2f(S[i]);
    const bf16x8 P0 = pack8v(S[0], S[1], S[2], S[3], S[4], S[5], S[6], S[7]), P1 = pack8v(S[8], S[9], S[10], S[11], S[12], S[13], S[14], S[15]);
    if (HAS_NEXT && has_k2) asm volatile("s_waitcnt lgkmcnt(6)" : "+v"(vr[0]), "+v"(vr[1]), "+v"(vr[2]), "+v"(vr[3]), "+v"(vr[4]), "+v"(vr[5]), "+v"(vr[6]), "+v"(vr[7]) :: "memory");
    else asm volatile("s_waitcnt lgkmcnt(0)" : "+v"(vr[0]), "+v"(vr[1]), "+v"(vr[2]), "+v"(vr[3]), "+v"(vr[4]), "+v"(vr[5]), "+v"(vr[6]), "+v"(vr[7]) :: "memory");
#define V8(l_, h_) ((bf16x8){l_[0], l_[1], l_[2], l_[3], h_[0], h_[1], h_[2], h_[3]})
    O0 = MFMA32(V8(vr[0], vr[1]), P0, O0); O1 = MFMA32(V8(vr[4], vr[5]), P0, O1); Lacc = MFMA32(ones8, P0, Lacc);
    O0 = MFMA32(V8(vr[2], vr[3]), P1, O0); O1 = MFMA32(V8(vr[6], vr[7]), P1, O1); Lacc = MFMA32(ones8, P1, Lacc);
#undef V8
    if constexpr (HAS_NEXT) {
        const unsigned vbase = (unsigned)(uintptr_t)vslot1, a0 = vbase + voff[0], a1 = vbase + voff[1];
        asm volatile("ds_read_b64_tr_b16 %0, %8\n\tds_read_b64_tr_b16 %1, %8 offset:1024\n\tds_read_b64_tr_b16 %2, %8 offset:2048\n\tds_read_b64_tr_b16 %3, %8 offset:3072\n\t"
                     "ds_read_b64_tr_b16 %4, %9\n\tds_read_b64_tr_b16 %5, %9 offset:1024\n\tds_read_b64_tr_b16 %6, %9 offset:2048\n\tds_read_b64_tr_b16 %7, %9 offset:3072"
                     : "+v"(vr[0]), "+v"(vr[1]), "+v"(vr[2]), "+v"(vr[3]), "+v"(vr[4]), "+v"(vr[5]), "+v"(vr[6]), "+v"(vr[7]) : "v"(a0), "v"(a1) : "memory");
        S = Sn; }
}
__device__ __forceinline__ void mla_qblock3(int b, int h, int qb, const bf16* QKV, bf16* Y, LAS unsigned char* lds, int tid) {
    asm volatile("" : "+s"(b), "+s"(h), "+s"(qb));
    const int lane = tid & 63, w = __builtin_amdgcn_readfirstlane(tid >> 6), r31 = lane & 31, hh = lane >> 5, rg = w & 3, kh = w >> 2;
    const size_t mb = (size_t)b * SEQ; const int t_lo = 128 * qb + 32 * rg, t_row = t_lo + r31, ntile = 2 * (qb + 1);
    const int a32 = (lane ^ 32) << 2;
    bf16x8 qf[6];
#pragma unroll
    for (int kk = 0; kk < 6; ++kk) qf[kk] = *(const bf16x8*)(QKV + (mb + t_row) * 1024 + QC_Q + 96 * h + 16 * kk + 8 * hh);
    int soff[3];
#pragma unroll
    for (int j = 0; j < 3; ++j) { const int c = w + 8 * j, P = 64 * c + lane;
        if (c < 12) { const int row = P / 12, pos = P - 12 * row; int pc = pos - ((row >> 2) & 3); pc = pc < 0 ? pc + 12 : pc; soff[j] = row * 1024 + (pc < 8 ? QC_KN + 64 * h + 8 * pc : QC_KR + 8 * (pc - 8)); }
        else { const int P2 = P - 768, row = P2 >> 3, pp = P2 & 7, piece = pp ^ (4 * ((row >> 1) & 1)); soff[j] = row * 1024 + QC_V + 64 * h + 8 * piece; } }
    const bool has3 = w < 4; const bf16* tile0 = QKV + mb * 1024; const unsigned lds0 = (unsigned)(uintptr_t)lds;
    int koff[6];
    { const int row = 32 * kh + r31, a = (row >> 2) & 3;
#pragma unroll
      for (int kk = 0; kk < 6; ++kk) { int pos = 2 * kk + hh + a; pos = pos >= 12 ? pos - 12 : pos; koff[kk] = row * 192 + 16 * pos; } }
    int voff[2];
    { const int q = (lane & 15) >> 2, p = lane & 3, gb = (lane >> 4) & 1, x = q >> 1;
#pragma unroll
      for (int et = 0; et < 2; ++et) voff[et] = (32 * kh + 4 * hh + q) * 128 + 8 * ((8 * (et ^ x)) + 4 * gb + p); }
#define MLA_GLDS(src, dst) do { unsigned keep_; asm volatile("s_mov_b32 %0, m0\n\ts_mov_b32 m0, %2\n\ts_nop 0\n\tglobal_load_lds_dwordx4 %1, off\n\ts_mov_b32 m0, %0" : "=&s"(keep_) : "v"(src), "s"(dst) : "memory"); } while (0)
#define MLA_DMA(kt) do { const bf16* tb_ = tile0 + (size_t)(kt) * 65536; const unsigned kb_ = lds0 + MLA_KBASE + ((kt) % MLA_NS) * MLA_KSLOT, vb_ = lds0 + ((kt) % MLA_NS) * MLA_VSLOT; \
        const unsigned d0_ = (unsigned)__builtin_amdgcn_readfirstlane((int)(kb_ + 1024 * w)), d1_ = (unsigned)__builtin_amdgcn_readfirstlane((int)(w < 4 ? kb_ + 1024 * (w + 8) : vb_ + 1024 * (w - 4))), d2_ = (unsigned)__builtin_amdgcn_readfirstlane((int)(vb_ + 1024 * (w + 4))); \
        MLA_GLDS(tb_ + soff[0], d0_); MLA_GLDS(tb_ + soff[1], d1_); if (has3) MLA_GLDS(tb_ + soff[2], d2_); } while (0)
#define MLA_WAIT(n) do { const int n_ = (n); \
        if (has3) { switch (n_) { case 0: asm volatile("s_waitcnt vmcnt(0)" ::: "memory"); break; case 1: asm volatile("s_waitcnt vmcnt(3)" ::: "memory"); break; case 2: asm volatile("s_waitcnt vmcnt(6)" ::: "memory"); break; \
                                  case 3: asm volatile("s_waitcnt vmcnt(9)" ::: "memory"); break; default: asm volatile("s_waitcnt vmcnt(12)" ::: "memory"); break; } } \
        else      { switch (n_) { case 0: asm volatile("s_waitcnt vmcnt(0)" ::: "memory"); break; case 1: asm volatile("s_waitcnt vmcnt(2)" ::: "memory"); break; case 2: asm volatile("s_waitcnt vmcnt(4)" ::: "memory"); break; \
                                  case 3: asm volatile("s_waitcnt vmcnt(6)" ::: "memory"); break; default: asm volatile("s_waitcnt vmcnt(8)" ::: "memory"); break; } } \
        asm volatile("" ::: "memory"); __builtin_amdgcn_s_barrier(); asm volatile("" ::: "memory"); } while (0)
    asm volatile("s_waitcnt vmcnt(0)" ::: "memory");
#pragma unroll
    for (int kk = 0; kk < 6; ++kk) asm volatile("" : "+v"(qf[kk]));
#pragma unroll
    for (int i = 0; i < MLA_NS - 1; ++i) if (i < ntile) MLA_DMA(i);
    float m_run = 0.f; f32x16 O0, O1, Lacc, negm, S;
#pragma unroll
    for (int i = 0; i < 16; ++i) { O0[i] = 0.f; O1[i] = 0.f; Lacc[i] = 0.f; negm[i] = 0.f; }
    unsigned one2_ = 0x3f803f80u; asm volatile("" : "+v"(one2_));
    const bf16x8 ones8 = __builtin_bit_cast(bf16x8, (v4u){one2_, one2_, one2_, one2_});
    { const int behind = (ntile - 1) < (MLA_NS - 2) ? (ntile - 1) : (MLA_NS - 2); MLA_WAIT(behind);
      S = negm; const int k_lo = 32 * kh;
      if (k_lo + 31 > t_lo) {
#pragma unroll
          for (int i = 0; i < 16; ++i) if (k_lo + (i & 3) + 8 * (i >> 2) + 4 * hh > t_row) S[i] = -INFINITY; }
      bf16x8 k0, k1, k2, k3, k4, k5; const unsigned kbase = lds0 + MLA_KBASE;
      asm volatile("ds_read_b128 %0, %6\n\tds_read_b128 %1, %7\n\tds_read_b128 %2, %8\n\tds_read_b128 %3, %9\n\tds_read_b128 %4, %10\n\tds_read_b128 %5, %11\n\ts_waitcnt lgkmcnt(0)"
                   : "=&v"(k0), "=&v"(k1), "=&v"(k2), "=&v"(k3), "=&v"(k4), "=&v"(k5)
                   : "v"(kbase + koff[0]), "v"(kbase + koff[1]), "v"(kbase + koff[2]), "v"(kbase + koff[3]), "v"(kbase + koff[4]), "v"(kbase + koff[5]) : "memory");
      S = MFMA32(k0, qf[0], S); S = MFMA32(k1, qf[1], S); S = MFMA32(k2, qf[2], S); S = MFMA32(k3, qf[3], S); S = MFMA32(k4, qf[4], S); S = MFMA32(k5, qf[5], S); }
    for (int kt = 0; kt + 1 < ntile; ++kt) {
        { const int rem = ntile - 2 - kt, behind = rem < (MLA_NS - 3) ? rem : (MLA_NS - 3); MLA_WAIT(behind); }
        if (kt + MLA_NS - 1 < ntile) MLA_DMA(kt + MLA_NS - 1);
        const int klo_n = 64 * (kt + 1) + 32 * kh;
        mla_step<true>(lds + MLA_KBASE + ((kt + 1) % MLA_NS) * MLA_KSLOT, lds + (kt % MLA_NS) * MLA_VSLOT, koff, voff, qf, ones8, klo_n + 31 > t_lo, klo_n, t_row, hh, a32, S, negm, m_run, O0, O1, Lacc);
    }
    mla_step<false>(lds, lds + ((ntile - 1) % MLA_NS) * MLA_VSLOT, koff, voff, qf, ones8, false, 0, t_row, hh, a32, S, negm, m_run, O0, O1, Lacc);
#undef MLA_WAIT
#undef MLA_DMA
#undef MLA_GLDS
    LAS float* cb = (LAS float*)(lds + MLA_COMB + rg * 8704);
    WG_SYNC_L();
    if (kh == 1) {
#pragma unroll
        for (int i = 0; i < 16; ++i) { cb[i * 64 + lane] = O0[i]; cb[(16 + i) * 64 + lane] = O1[i]; }
        cb[2048 + lane] = m_run; cb[2112 + lane] = Lacc[0]; }
    WG_SYNC();
    if (kh == 0) { const float m1 = cb[2048 + lane], l1 = cb[2112 + lane]; const float m = fmaxf(m_run, m1), f0 = __builtin_amdgcn_exp2f(m_run - m), f1 = __builtin_amdgcn_exp2f(m1 - m);
        const float l = f0 * Lacc[0] + f1 * l1; const float inv = 1.0f / l; bf16* yp = Y + (mb + t_row) * 1024 + 64 * h + 4 * hh;
#pragma unroll
        for (int i4 = 0; i4 < 4; ++i4) { float o[4], o2[4];
#pragma unroll
            for (int j = 0; j < 4; ++j) { o[j] = (f0 * O0[4 * i4 + j] + f1 * cb[(4 * i4 + j) * 64 + lane]) * inv; o2[j] = (f0 * O1[4 * i4 + j] + f1 * cb[(16 + 4 * i4 + j) * 64 + lane]) * inv; }
            v2u a; a.x = pg8::cvt_pk_bf16(o[0], o[1]); a.y = pg8::cvt_pk_bf16(o[2], o[3]); *(v2u*)(yp + 8 * i4) = a;
            v2u c2; c2.x = pg8::cvt_pk_bf16(o2[0], o2[1]); c2.y = pg8::cvt_pk_bf16(o2[2], o2[3]); *(v2u*)(yp + 32 + 8 * i4) = c2; } }
    WG_SYNC();
}
__device__ __forceinline__ void mla_qblock5(int b, int h, int qb, const bf16* QKV, bf16* Y, LAS unsigned char* lds, int tid) {
    asm volatile("" : "+s"(b), "+s"(h), "+s"(qb));
    const int lane = tid & 63, w = __builtin_amdgcn_readfirstlane(tid >> 6), r31 = lane & 31, hh = lane >> 5, rg = w & 3, kh = w >> 2;
    const size_t mb = (size_t)b * SEQ; const int t_lo = 128 * qb + 32 * rg, t_row = t_lo + r31, ntile = 2 * (qb + 1);
    const int a32 = (lane ^ 32) << 2;
    bf16x8 qf[6];
#pragma unroll
    for (int kk = 0; kk < 6; ++kk) qf[kk] = *(const bf16x8*)(QKV + (mb + t_row) * 1024 + QC_Q + 96 * h + 16 * kk + 8 * hh);
    int soff[3];
#pragma unroll
    for (int j = 0; j < 3; ++j) { const int c = w + 8 * j, P = 64 * c + lane;
        if (c < 12) { const int row = P / 12, pos = P - 12 * row; int pc = pos - ((row >> 2) & 3); pc = pc < 0 ? pc + 12 : pc; soff[j] = row * 1024 + (pc < 8 ? QC_KN + 64 * h + 8 * pc : QC_KR + 8 * (pc - 8)); }
        else { const int P2 = P - 768, row = P2 >> 3, pp = P2 & 7, piece = pp ^ (4 * ((row >> 1) & 1)); soff[j] = row * 1024 + QC_V + 64 * h + 8 * piece; } }
    const bool has3 = w < 4; const bf16* tile0 = QKV + mb * 1024; const unsigned lds0 = (unsigned)(uintptr_t)lds;
    int koff[6];
    { const int row = 32 * kh + r31, a = (row >> 2) & 3;
#pragma unroll
      for (int kk = 0; kk < 6; ++kk) { int pos = 2 * kk + hh + a; pos = pos >= 12 ? pos - 12 : pos; koff[kk] = row * 192 + 16 * pos; } }
    int voff[2];
    { const int q = (lane & 15) >> 2, p = lane & 3, gb = (lane >> 4) & 1, x = q >> 1;
#pragma unroll
      for (int et = 0; et < 2; ++et) voff[et] = (32 * kh + 4 * hh + q) * 128 + 8 * ((8 * (et ^ x)) + 4 * gb + p); }
#define MLA_GLDS(src, dst) do { unsigned keep_; asm volatile("s_mov_b32 %0, m0\n\ts_mov_b32 m0, %2\n\ts_nop 0\n\tglobal_load_lds_dwordx4 %1, off\n\ts_mov_b32 m0, %0" : "=&s"(keep_) : "v"(src), "s"(dst) : "memory"); } while (0)
#define MLA_DMA(kt) do { const bf16* tb_ = tile0 + (size_t)(kt) * 65536; const unsigned kb_ = lds0 + MLA_KBASE + ((kt) % MLA_NS) * MLA_KSLOT, vb_ = lds0 + ((kt) % MLA_NS) * MLA_VSLOT; \
        const unsigned d0_ = (unsigned)__builtin_amdgcn_readfirstlane((int)(kb_ + 1024 * w)), d1_ = (unsigned)__builtin_amdgcn_readfirstlane((int)(w < 4 ? kb_ + 1024 * (w + 8) : vb_ + 1024 * (w - 4))), d2_ = (unsigned)__builtin_amdgcn_readfirstlane((int)(vb_ + 1024 * (w + 4))); \
        MLA_GLDS(tb_ + soff[0], d0_); MLA_GLDS(tb_ + soff[1], d1_); if (has3) MLA_GLDS(tb_ + soff[2], d2_); } while (0)
#define MLA_WAIT(n) do { const int n_ = (n); \
        if (has3) { switch (n_) { case 0: asm volatile("s_waitcnt vmcnt(0)" ::: "memory"); break; case 1: asm volatile("s_waitcnt vmcnt(3)" ::: "memory"); break; case 2: asm volatile("s_waitcnt vmcnt(6)" ::: "memory"); break; \
                                  case 3: asm volatile("s_waitcnt vmcnt(9)" ::: "memory"); break; default: asm volatile("s_waitcnt vmcnt(12)" ::: "memory"); break; } } \
        else      { switch (n_) { case 0: asm volatile("s_waitcnt vmcnt(0)" ::: "memory"); break; case 1: asm volatile("s_waitcnt vmcnt(2)" ::: "memory"); break; case 2: asm volatile("s_waitcnt vmcnt(4)" ::: "memory"); break; \
                                  case 3: asm volatile("s_waitcnt vmcnt(6)" ::: "memory"); break; default: asm volatile("s_waitcnt vmcnt(8)" ::: "memory"); break; } } \
        asm volatile("" ::: "memory"); __builtin_amdgcn_s_barrier(); asm volatile("" ::: "memory"); } while (0)
    asm volatile("s_waitcnt vmcnt(0)" ::: "memory");
#pragma unroll
    for (int kk = 0; kk < 6; ++kk) asm volatile("" : "+v"(qf[kk]));
#pragma unroll
    for (int i = 0; i < MLA_NS - 1; ++i) if (i < ntile) MLA_DMA(i);
    float m_run = 0.f; f32x16 O0, O1, Lacc, negm, S;
#pragma unroll
    for (int i = 0; i < 16; ++i) { O0[i] = 0.f; O1[i] = 0.f; Lacc[i] = 0.f; negm[i] = 0.f; }
    unsigned one2_ = 0x3f803f80u; asm volatile("" : "+v"(one2_));
    const bf16x8 ones8 = __builtin_bit_cast(bf16x8, (v4u){one2_, one2_, one2_, one2_});
    bf16x8 kr[6]; s16x4m_ vr[8];
    { const int behind = (ntile - 2) < (MLA_NS - 3) ? (ntile - 2) : (MLA_NS - 3); MLA_WAIT(behind);
      S = negm; const int k_lo = 32 * kh;
      if (k_lo + 31 > t_lo) {
#pragma unroll
          for (int i = 0; i < 16; ++i) if (k_lo + (i & 3) + 8 * (i >> 2) + 4 * hh > t_row) S[i] = -INFINITY; }
      bf16x8 k0, k1, k2, k3, k4, k5; const unsigned kbase = lds0 + MLA_KBASE;
      asm volatile("ds_read_b128 %0, %6\n\tds_read_b128 %1, %7\n\tds_read_b128 %2, %8\n\tds_read_b128 %3, %9\n\tds_read_b128 %4, %10\n\tds_read_b128 %5, %11\n\ts_waitcnt lgkmcnt(0)"
                   : "=&v"(k0), "=&v"(k1), "=&v"(k2), "=&v"(k3), "=&v"(k4), "=&v"(k5)
                   : "v"(kbase + koff[0]), "v"(kbase + koff[1]), "v"(kbase + koff[2]), "v"(kbase + koff[3]), "v"(kbase + koff[4]), "v"(kbase + koff[5]) : "memory");
      S = MFMA32(k0, qf[0], S); S = MFMA32(k1, qf[1], S); S = MFMA32(k2, qf[2], S); S = MFMA32(k3, qf[3], S); S = MFMA32(k4, qf[4], S); S = MFMA32(k5, qf[5], S);
      { const unsigned kb1 = lds0 + MLA_KBASE + (1 % MLA_NS) * MLA_KSLOT;
        asm volatile("ds_read_b128 %0, %6\n\tds_read_b128 %1, %7\n\tds_read_b128 %2, %8\n\tds_read_b128 %3, %9\n\tds_read_b128 %4, %10\n\tds_read_b128 %5, %11"
                     : "=&v"(kr[0]), "=&v"(kr[1]), "=&v"(kr[2]), "=&v"(kr[3]), "=&v"(kr[4]), "=&v"(kr[5])
                     : "v"(kb1 + koff[0]), "v"(kb1 + koff[1]), "v"(kb1 + koff[2]), "v"(kb1 + koff[3]), "v"(kb1 + koff[4]), "v"(kb1 + koff[5]) : "memory");
        const unsigned a0 = lds0 + voff[0], a1 = lds0 + voff[1];
        asm volatile("ds_read_b64_tr_b16 %0, %8\n\tds_read_b64_tr_b16 %1, %8 offset:1024\n\tds_read_b64_tr_b16 %2, %8 offset:2048\n\tds_read_b64_tr_b16 %3, %8 offset:3072\n\t"
                     "ds_read_b64_tr_b16 %4, %9\n\tds_read_b64_tr_b16 %5, %9 offset:1024\n\tds_read_b64_tr_b16 %6, %9 offset:2048\n\tds_read_b64_tr_b16 %7, %9 offset:3072"
                     : "=&v"(vr[0]), "=&v"(vr[1]), "=&v"(vr[2]), "=&v"(vr[3]), "=&v"(vr[4]), "=&v"(vr[5]), "=&v"(vr[6]), "=&v"(vr[7]) : "v"(a0), "v"(a1) : "memory"); } }
    for (int kt = 0; kt + 1 < ntile; ++kt) {
        { const int rem = ntile - 3 - kt, behind = rem < 0 ? 0 : (rem < (MLA_NS - 4) ? rem : (MLA_NS - 4)); MLA_WAIT(behind); }
        if (kt + MLA_NS - 1 < ntile) MLA_DMA(kt + MLA_NS - 1);
        const int klo_n = 64 * (kt + 1) + 32 * kh;
        mla_step5<true>(lds + MLA_KBASE + ((kt + 2) % MLA_NS) * MLA_KSLOT, lds + ((kt + 1) % MLA_NS) * MLA_VSLOT, koff, voff, qf, ones8, kt + 2 < ntile, klo_n + 31 > t_lo, klo_n, t_row, hh, S, negm, m_run, O0, O1, Lacc, kr, vr);
    }
    mla_step5<false>(lds, lds, koff, voff, qf, ones8, false, false, 0, t_row, hh, S, negm, m_run, O0, O1, Lacc, kr, vr);
#undef MLA_WAIT
#undef MLA_DMA
#undef MLA_GLDS
    LAS float* cb = (LAS float*)(lds + MLA_COMB + rg * 8704);
    WG_SYNC_L();
    if (kh == 1) {
#pragma unroll
        for (int i = 0; i < 16; ++i) { cb[i * 64 + lane] = O0[i]; cb[(16 + i) * 64 + lane] = O1[i]; }
        cb[2048 + lane] = m_run; cb[2112 + lane] = Lacc[0]; }
    WG_SYNC();
    if (kh == 0) { const float m1 = cb[2048 + lane], l1 = cb[2112 + lane]; const float m = fmaxf(m_run, m1), f0 = __builtin_amdgcn_exp2f(m_run - m), f1 = __builtin_amdgcn_exp2f(m1 - m);
        const float l = f0 * Lacc[0] + f1 * l1; const float inv = 1.0f / l; bf16* yp = Y + (mb + t_row) * 1024 + 64 * h + 4 * hh;
#pragma unroll
        for (int i4 = 0; i4 < 4; ++i4) { float o[4], o2[4];
#pragma unroll
            for (int j = 0; j < 4; ++j) { o[j] = (f0 * O0[4 * i4 + j] + f1 * cb[(4 * i4 + j) * 64 + lane]) * inv; o2[j] = (f0 * O1[4 * i4 + j] + f1 * cb[(16 + 4 * i4 + j) * 64 + lane]) * inv; }
            v2u a; a.x = pg8::cvt_pk_bf16(o[0], o[1]); a.y = pg8::cvt_pk_bf16(o[2], o[3]); *(v2u*)(yp + 8 * i4) = a;
            v2u c2; c2.x = pg8::cvt_pk_bf16(o2[0], o2[1]); c2.y = pg8::cvt_pk_bf16(o2[2], o2[3]); *(v2u*)(yp + 32 + 8 * i4) = c2; } }
    WG_SYNC();
}
}

#define V_WGU ((bf16*)(ws + WS_WGU))
#define V_WD ((bf16*)(ws + WS_WD))
#define V_WIN ((bf16*)(ws + WS_WIN))
#define V_WMLA ((bf16*)(ws + WS_WMLA))
#define V_WOUT ((bf16*)(ws + WS_WOUT))
#define V_WPG ((bf16*)(ws + WS_WPG))
#define V_WPP ((bf16*)(ws + WS_WPP))
#define V_B0 ((bf16*)(ws + WS_B0))
#define V_B1 ((bf16*)(ws + WS_B1))
#define V_ZH ((bf16*)(ws + WS_ZH))
#define V_QKV ((bf16*)(ws + WS_QKV))
#define V_PBF ((bf16*)(ws + WS_PBF))
#define V_SSQ0 ((float*)(ws + WS_SSQ))
#define V_SSQ1 ((float*)(ws + WS_SSQ) + (size_t)M * 16)
#define V_SSQQ ((float*)(ws + WS_SSQ2))
#define V_SSQKV ((float*)(ws + WS_SSQ2) + (size_t)M * 4)
#define V_MCS ((float*)(ws + WS_ROPE))
#define V_MSN ((float*)(ws + WS_ROPE) + (size_t)M * 16)
#define V_RCS ((float*)(ws + WS_ROPE) + (size_t)M * 32)
#define V_RSN ((float*)(ws + WS_ROPE) + (size_t)M * 64)
#define V_HST ((bf16*)(ws + WS_HST))
#define V_HDC ((float*)(ws + WS_HDC))
#define V_RST ((float*)(ws + WS_RST))
#ifndef MIX_RET
#define MIX_RET 1
#endif
#ifndef MIX_HG
#define MIX_HG 1
#endif
#ifndef MIX_SG
#define MIX_SG 1
#endif
#ifndef MIX_MLA
#define MIX_MLA 1
#endif
template <bool G256>
__global__ void __launch_bounds__(NWAVES * 64, 2) mk_fwd(Args a) {
    extern __shared__ __attribute__((aligned(16))) unsigned char lds_raw[];
    LAS unsigned char* lds = (LAS unsigned char*)lds_raw;
    volatile LAS unsigned* MISC = (volatile LAS unsigned*)(lds + MISC_OFF);
    const int tid = threadIdx.x;
    const int G = G256 ? 256 : (int)gridDim.x; const int bx = blockIdx.x; const int vcu = (G % 8 == 0) ? (bx % 8) * (G / 8) + bx / 8 : bx;
    unsigned char* ws = a.ws;
    gu32* ctl = (gu32*)(ws + WS_CTL);
    for (int u = tid; u < (LDS_BYTES - LDSCTL_OFF) / 4; u += NWAVES * 64) ((LAS unsigned*)(lds + LDSCTL_OFF))[u] = 0u;
    __syncthreads();
    XcdBarrier bar = xcd_barrier_post((unsigned*)(ctl + CW_BAR) + a.li * XCD_BAR_WORDS, MISC + 8);
    if (tid == 0) (void)__hip_atomic_fetch_or((unsigned*)(ctl + CW_GRP) + a.li * 4096 + (bx & 63) * 64 + 32, 1u << bar.x, __ATOMIC_RELAXED, __HIP_MEMORY_SCOPE_AGENT);
    const int lo = a.ph_lo, hi = a.ph_hi;
#define IN(k) (lo <= (k) && (k) < hi)
#define SEAM(k) do { if (IN(k) && IN((k) + 1)) xcd_barrier(bar); } while (0)
#define GSEAM(k) do { if (IN(k) && IN((k) + 1)) { if (G == 256) { unsigned go_ = (unsigned)a.li * 4096u + (blockIdx.x & 63u) * 64u; asm volatile("" : "+s"(go_)); unsigned* gc_ = (unsigned*)(a.ws + WS_CTL) + CW_GRP + go_; group_sync(gc_, gc_ + 32, 4u, MISC + 12, bar.bar); } else xcd_barrier(bar); } } while (0)
    float* out = a.out;
#ifdef PROBE_CLASS
#ifndef PROBE_MULT
#define PROBE_MULT 4
#endif
    unsigned long long pr_acc = 0, pr_t0 = 0;
#define PH_BEGIN(c) do { if ((c) == PROBE_CLASS) pr_t0 = wall_clock64(); } while (0)
#define PH_END(c) do { if ((c) == PROBE_CLASS) pr_acc += wall_clock64() - pr_t0; } while (0)
#else
#define PH_BEGIN(c) do { } while (0)
#define PH_END(c) do { } while (0)
#endif

    PH_BEGIN(0);
    if (IN(0)) { const int t0_ = threadIdx.x; prologue(a, lds, t0_, t0_ & 63, __builtin_amdgcn_readfirstlane(t0_ >> 6), vcu, G); }
    SEAM(0);
    PH_END(0);

    for (int hl = 0; hl < 2 * DEPTH; ++hl) {
        const int l = hl >> 1, second = hl & 1, pb = 1 + 10 * l + 7 * second;
        int tid_o = tid; asm volatile("" : "+v"(tid_o));
        PH_BEGIN(1); if (IN(pb)) {
            pg8::Gemm g{(second == 0 && l > 0) ? V_B1 : V_B0, V_WGU + (size_t)(2 * l + second) * NGU * D, M, NGU, D, D}; pg8::StaticOrder S; S.init(M, NGU, G, bx);
            pg8::EpiSwiGLU E{V_ZH, (const LAS float*)(lds + TAB_OFF)};
            if (G == 256 && bx >= 128 && l + 1 < DEPTH) { const int t0 = (l + 1) * IT_LAYER + (second ? 2 : 0) * (IT_LAYER / 3), t1 = second ? (l + 2) * IT_LAYER : t0 + IT_LAYER / 3;
                conv_items_simple(a, ws, (LAS float*)(lds + RING_OFF + (tid_o >> 6) * 16640), tid_o & 63, t0 + (bx - 128) * NWAVES + (tid_o >> 6), t1, 128 * NWAVES); asm volatile("s_waitcnt vmcnt(0) lgkmcnt(0)" ::: "memory"); __syncthreads(); }
            { int bxo = blockIdx.x; asm volatile("" : "+s"(bxo)); pg8::build_rstd_tab((LAS float*)(lds + TAB_OFF), V_SSQ0, 8 * (bxo & 7) + ((bxo >> 3) & 7), tid_o); asm volatile("s_waitcnt lgkmcnt(0)" ::: "memory"); __syncthreads(); }
            pg8::gemm_phase<pg8::EpiSwiGLU, pg8::StaticOrder, true, true>(lds + RING_OFF, g, S, E);
        }
        GSEAM(pb); PH_END(1);
        PH_BEGIN(2); if (IN(pb + 1)) {
            pg8::Gemm g{V_ZH, V_WD + (size_t)(2 * l + second) * D * DFF, M, D, DFF, DFF}; pg8::StaticOrder S; S.init(M, D, G, bx);
            pg8::EpiRes E{(second == 0 && l > 0) ? V_B1 : V_B0, V_B0, V_SSQ1, 0.5f};
            pg8::gemm_phase<pg8::EpiRes, pg8::StaticOrder, false, true>(lds + RING_OFF, g, S, E);
        }
        GSEAM(pb + 1); PH_END(2);
        if (!second) {
            PH_BEGIN(3); if (IN(pb + 2)) {
                pg8::Gemm g{V_B0, V_WIN + (size_t)l * NZ * D, M, NZ, D, D}; pg8::StaticOrder S; S.init(M, NZ, G, bx);
                pg8::EpiZ E{V_ZH, (const LAS float*)(lds + TAB_OFF), V_SSQQ, V_SSQKV};
                if (G == 256 && bx >= 128 && l + 1 < DEPTH) { const int t0 = (l + 1) * IT_LAYER + (IT_LAYER / 3), t1 = t0 + IT_LAYER / 3;
                    conv_items_simple(a, ws, (LAS float*)(lds + RING_OFF + (tid_o >> 6) * 16640), tid_o & 63, t0 + (bx - 128) * NWAVES + (tid_o >> 6), t1, 128 * NWAVES); asm volatile("s_waitcnt vmcnt(0) lgkmcnt(0)" ::: "memory"); __syncthreads(); }
                { int bxo = blockIdx.x; asm volatile("" : "+s"(bxo)); pg8::build_rstd_tab((LAS float*)(lds + TAB_OFF), V_SSQ1, 8 * (bxo & 7) + ((bxo >> 3) & 7), tid_o); asm volatile("s_waitcnt lgkmcnt(0)" ::: "memory"); __syncthreads(); }
                pg8::gemm_phase<pg8::EpiZ, pg8::StaticOrder, true, true>(lds + RING_OFF, g, S, E);
                const f32x4* ps = (const f32x4*)(a.in[IN_P] + (size_t)l * M * PLED); v2u* pd = (v2u*)V_PBF;
                if (bx >= 128) {
                    for (int i0 = (bx - 128) * (NWAVES * 64) + tid_o; i0 < M * PLED / 4; i0 += 4 * 128 * NWAVES * 64) { f32x4 v[4];
#pragma unroll
                        for (int q = 0; q < 4; ++q) { const int i = i0 + q * 128 * NWAVES * 64; v[q] = ps[i < M * PLED / 4 ? i : i0]; }
#pragma unroll
                        for (int q = 0; q < 4; ++q) { const int i = i0 + q * 128 * NWAVES * 64; if (i < M * PLED / 4) { v2u o; o.x = pk2(v[q][0], v[q][1]); o.y = pk2(v[q][2], v[q][3]); pd[i] = o; } } } }
            }
            GSEAM(pb + 2); PH_END(3);
            const bool split = IN(pb + 3) && IN(pb + 4) && IN(pb + 5);
            PH_BEGIN(4); if (IN(pb + 3)) {
                pg8::Gemm g{V_ZH, V_WMLA + (size_t)l * 1024 * 512, M, 1024, 512, NZ}; pg8::StaticOrder S; S.init(M, 1024, G, bx);
                pg8::EpiMla E{V_QKV, V_SSQQ, V_SSQKV, V_MCS, V_MSN};
                int bxo = blockIdx.x; asm volatile("" : "+s"(bxo));
                const int mpm = 8 * (bxo & 7) + ((bxo >> 3) & 7), mpn = bxo >> 6;
                PH_BEGIN(40); pg8::gemm_phase<pg8::EpiMla, pg8::StaticOrder, false, true>(lds + RING_OFF, g, S, E); PH_END(40);
#if MIX_RET
                PH_BEGIN(41); for (int j0 = bx; j0 < 512; j0 += G) { const int j = (G == 256) ? (mpm >> 4) * 128 + (2 * (mpm & 15) + (j0 >> 8)) * 4 + mpn : j0; mx::ret_pass1(j, V_ZH, V_RCS, V_RSN, V_RST, lds + RING_OFF, tid_o); } PH_END(41);
#endif
#if MIX_HG
                PH_BEGIN(42); for (int p0 = bx; p0 < 512; p0 += G) { const int pr = (G == 256) ? (mpm >> 4) * 128 + (4 * (mpm & 15) + mpn) * 2 + (p0 >> 8) : p0; mx::hg_pass1(pr, V_ZH, (const float*)(ws + WS_HLB) + l * 512, V_HST, V_HDC, lds + RING_OFF, tid_o); } PH_END(42);
#endif
                if (split) xcd_barrier_arrive(bar, MISC + 14);
#if MIX_SG
                PH_BEGIN(43); for (int j0 = bx; j0 < 256; j0 += G) { const int j = (G == 256) ? 4 * mpm + mpn : j0; mx::sg_job(j, V_ZH, a.in[IN_SGLN] + l * 256, (const bf16*)(ws + WS_WSG) + (size_t)l * 4 * 128 * 128, a.in[IN_SGB] + l * 512, V_B1, lds + RING_OFF, tid_o); } PH_END(43);
#endif
            }
            if (split) xcd_barrier_wait(bar, MISC + 14); else SEAM(pb + 3); PH_END(4);
            PH_BEGIN(5); if (IN(pb + 4)) {
#if MIX_HG
                for (int gt = bx * (NWAVES * 64) + tid_o; gt < 16 * 4096; gt += G * NWAVES * 64) mx::hg_scan(V_HST, V_HDC, gt);
#endif
#if MIX_RET
                for (int gt = ((bx + G / 2) % G) * (NWAVES * 64) + tid_o; gt < 16 * 4096; gt += G * NWAVES * 64) mx::ret_scan(V_RST, gt);
#endif
            }
            if (split) xcd_barrier_arrive(bar, MISC + 14); else SEAM(pb + 4); PH_END(5);
            PH_BEGIN(6); if (IN(pb + 5)) {
#if MIX_MLA
                PH_BEGIN(60); for (int j0 = bx; j0 < 256; j0 += G) { const int j = (G == 256) ? ((j0 & 7) * 32 + (j0 >> 3)) : j0, bh = j >> 4, sq = j & 15;
                    mx::mla_qblock5(bh >> 2, bh & 3, 31 - sq, V_QKV, V_B1, lds + RING_OFF, tid_o); mx::mla_qblock5(bh >> 2, bh & 3, sq, V_QKV, V_B1, lds + RING_OFF, tid_o); } PH_END(60);
#endif
                if (split) xcd_barrier_wait(bar, MISC + 14);
#if MIX_RET
                PH_BEGIN(61); for (int j = bx; j < 512; j += G) mx::ret_pass3(j, V_ZH, V_RCS, V_RSN, V_RST, a.in[IN_RETN] + l * 256, V_B1, lds + RING_OFF, tid_o); PH_END(61);
#endif
#if MIX_HG
                PH_BEGIN(62); for (int pr = bx; pr < 512; pr += G) mx::hg_pass3(pr, V_ZH, (const float*)(ws + WS_HLB) + l * 512, V_HST, a.in[IN_HGN] + l * 256, V_B1, lds + RING_OFF, tid_o); PH_END(62);
#endif
            }
            const bool split3 = IN(pb + 5) && IN(pb + 6);
            if (split3) xcd_barrier_arrive(bar, MISC + 14); else SEAM(pb + 5); PH_END(6);
            PH_BEGIN(7); if (IN(pb + 6)) {
                { pg8::Gemm g{V_PBF, V_WPP + (size_t)l * D * PLED, M, D, PLED, PLED}; pg8::StaticOrder S; S.init(M, D, G, bx);
                  pg8::EpiPlain E{(bf16*)out, D};
                  pg8::gemm_phase<pg8::EpiPlain, pg8::StaticOrder, false, true>(lds + RING_OFF, g, S, E); }
                if (split3) xcd_barrier_wait(bar, MISC + 14);
                { pg8::Gemm g{V_B1, V_WOUT + (size_t)l * D * D, M, D, D, D}; pg8::StaticOrder S; S.init(M, D, G, bx);
                  pg8::EpiRes E{V_B0, V_B0, V_SSQ0, 1.0f};
                  pg8::gemm_phase<pg8::EpiRes, pg8::StaticOrder, false, true>(lds + RING_OFF, g, S, E); }
            }
            GSEAM(pb + 6); PH_END(7);
        } else {
            PH_BEGIN(8); if (IN(pb + 2)) {
                pg8::Gemm g{V_B0, V_WPG + (size_t)l * D * D, M, D, D, D}; pg8::StaticOrder S; S.init(M, D, G, bx);
                pg8::EpiPle E{V_B0, (const bf16*)out, V_B1, (const LAS float*)(lds + TAB_OFF), V_SSQ0};
                { int bxo = blockIdx.x; asm volatile("" : "+s"(bxo)); pg8::build_rstd_tab((LAS float*)(lds + TAB_OFF), V_SSQ1, 8 * (bxo & 7) + ((bxo >> 3) & 7), tid_o); asm volatile("s_waitcnt lgkmcnt(0)" ::: "memory"); __syncthreads(); }
                pg8::gemm_phase<pg8::EpiPle, pg8::StaticOrder, false, true>(lds + RING_OFF, g, S, E);
            }
            if (l + 1 < DEPTH) GSEAM(pb + 2); else SEAM(pb + 2); PH_END(8);
        }
    }
    PH_BEGIN(9);
    if (IN(41)) {
        const float* gfin = a.in[IN_FINN];
        const int tf_ = threadIdx.x, lane = tf_ & 63, wave = __builtin_amdgcn_readfirstlane(tf_ >> 6);
        const f32x4 gf[4] = {*(const f32x4*)(gfin + 8 * lane), *(const f32x4*)(gfin + 8 * lane + 4), *(const f32x4*)(gfin + 512 + 8 * lane), *(const f32x4*)(gfin + 512 + 8 * lane + 4)};
        const int pl = (G == 256), mfirst = pl ? (8 * (bx & 7) + ((bx >> 3) & 7)) * 256 + (bx >> 6) * 64 + wave * 8 : vcu * NWAVES + wave, mstep = pl ? 1 : G * NWAVES, mend = pl ? mfirst + 8 : M;
        for (int m0 = mfirst; m0 < mend; m0 += 4 * mstep) { v4u hw[4][2]; f32x4 sp[4];
#pragma unroll
            for (int r = 0; r < 4; ++r) { const int mr = m0 + r * mstep, m = mr < mend ? mr : m0; const bf16* hr = V_B1 + (size_t)m * D; hw[r][0] = *(const v4u*)(hr + 8 * lane); hw[r][1] = *(const v4u*)(hr + 512 + 8 * lane); sp[r] = *(const f32x4*)(V_SSQ0 + (size_t)m * 16 + 4 * (lane & 3)); }
#pragma unroll
            for (int r = 0; r < 4; ++r) { const int m = m0 + r * mstep; if (m < mend) { float s = pg8::sum4(sp[r]); s += __shfl_xor(s, 1); s += __shfl_xor(s, 2); const float rs = __builtin_amdgcn_rsqf(s * (1.0f / 1024.0f) + pg8::RMS_EPS); float* orow = out + (size_t)m * D;
#pragma unroll
                for (int j = 0; j < 2; ++j) { const v4u w = hw[r][j]; const f32x4 g0 = gf[2 * j], g1 = gf[2 * j + 1];
                    f32x4 o0, o1; o0[0] = __uint_as_float(w.x << 16) * rs * g0[0]; o0[1] = __uint_as_float(w.x & 0xffff0000u) * rs * g0[1]; o0[2] = __uint_as_float(w.y << 16) * rs * g0[2]; o0[3] = __uint_as_float(w.y & 0xffff0000u) * rs * g0[3];
                    o1[0] = __uint_as_float(w.z << 16) * rs * g1[0]; o1[1] = __uint_as_float(w.z & 0xffff0000u) * rs * g1[1]; o1[2] = __uint_as_float(w.w << 16) * rs * g1[2]; o1[3] = __uint_as_float(w.w & 0xffff0000u) * rs * g1[3];
                    *(f32x4*)(orow + 512 * j + 8 * lane) = o0; *(f32x4*)(orow + 512 * j + 8 * lane + 4) = o1; } } } }
    }
    PH_END(9);
#ifdef MLA_DBG_V
    if (bx == 0 && tid == 0) { const unsigned mv = __hip_atomic_load(&mx::g_dbg_mism, __ATOMIC_RELAXED, __HIP_MEMORY_SCOPE_AGENT); unsigned code = 0;
        for (int q_ = 0; q_ < 4; ++q_) code |= (((mv >> (8 * q_)) & 0xffu) ? 1u : 0u) << q_;
        const unsigned any8 = (mv | (mv >> 8) | (mv >> 16) | (mv >> 24)) & 0xffu;
        const unsigned long long t_end = wall_clock64(); while (wall_clock64() - t_end < (unsigned long long)(code * 256u + any8) * 1000ull) __builtin_amdgcn_s_sleep(8); }
#endif
#ifdef PROBE_CLASS
    if (bx == 0 && tid == 0) { const unsigned long long t_end = wall_clock64(); while (wall_clock64() - t_end < (unsigned long long)PROBE_MULT * pr_acc) __builtin_amdgcn_s_sleep(8); }
#endif
#undef IN
#undef SEAM
#undef GSEAM
}

#ifndef MK_MODE
#define MK_MODE 0
#endif
#if MK_MODE != 0
__device__ __forceinline__ float gelu_exact(float x) { return 0.5f * x * (1.0f + erff(x * 0.70710678118654752f)); }
__device__ __forceinline__ float silu_f(float x) { return x / (1.0f + __expf(-x)); }
__global__ void __launch_bounds__(256) nv_mla(const bf16* QKV, bf16* Y) {
    const int lane = threadIdx.x & 63, gw = blockIdx.x * 4 + (threadIdx.x >> 6); const int t = gw & (SEQ - 1), bh = gw >> 12, b = bh >> 2, h = bh & 3;
    const size_t m = (size_t)b * SEQ + t;
    float q[96];
#pragma unroll
    for (int d = 0; d < 96; ++d) q[d] = bf2f(QKV[m * 1024 + QC_Q + 96 * h + d]);
    float mi = -INFINITY, li = 0.f, acc[64];
#pragma unroll
    for (int e = 0; e < 64; ++e) acc[e] = 0.f;
    for (int s = lane; s <= t; s += 64) { const bf16* kr = QKV + ((size_t)b * SEQ + s) * 1024; float dot = 0.f;
#pragma unroll
        for (int d = 0; d < 64; ++d) dot += q[d] * bf2f(kr[QC_KN + 64 * h + d]);
#pragma unroll
        for (int d = 0; d < 32; ++d) dot += q[64 + d] * bf2f(kr[QC_KR + d]);
        const float mn = fmaxf(mi, dot), corr = exp2f(mi - mn), p = exp2f(dot - mn); li = li * corr + p; mi = mn;
#pragma unroll
        for (int e = 0; e < 64; ++e) acc[e] = acc[e] * corr + p * bf2f(kr[QC_V + 64 * h + e]); }
    const float mg = wave_max(mi), w = (mi == -INFINITY) ? 0.f : exp2f(mi - mg); const float L = wave_sum(li * w); float res = 0.f;
#pragma unroll
    for (int e = 0; e < 64; ++e) { const float v = wave_sum(acc[e] * w); if (lane == e) res = v; }
    Y[m * 1024 + 64 * h + lane] = (bf16)f2bf(res / L);
}
__global__ void __launch_bounds__(256) nv_ret_prep(const bf16* Z, const float* rcs, const float* rsn, float* QR, float* KR) {
    const int i = blockIdx.x * 256 + threadIdx.x; if (i >= M * 128) return; const int m = i >> 7, r = i & 127, h = r >> 5, j = r & 31;
    const float c = rcs[(size_t)m * 32 + j], s = rsn[(size_t)m * 32 + j];
    { const float x1 = bf2f(Z[(size_t)m * NZ + ZC_RQ + 64 * h + j]), x2 = bf2f(Z[(size_t)m * NZ + ZC_RQ + 64 * h + 32 + j]); QR[(size_t)m * 256 + 64 * h + j] = x1 * c - x2 * s; QR[(size_t)m * 256 + 64 * h + 32 + j] = x1 * s + x2 * c; }
    { const float x1 = bf2f(Z[(size_t)m * NZ + ZC_RK + 64 * h + j]), x2 = bf2f(Z[(size_t)m * NZ + ZC_RK + 64 * h + 32 + j]); KR[(size_t)m * 256 + 64 * h + j] = 0.125f * (x1 * c - x2 * s); KR[(size_t)m * 256 + 64 * h + 32 + j] = 0.125f * (x1 * s + x2 * c); }
}
__global__ void __launch_bounds__(256) nv_ret(const bf16* Z, const float* QR, const float* KR, const float* normg, bf16* Y) {
    const int lane = threadIdx.x & 63, gw = blockIdx.x * 4 + (threadIdx.x >> 6); const int t = gw & (SEQ - 1), bh = gw >> 12, b = bh >> 2, h = bh & 3;
    const size_t m = (size_t)b * SEQ + t; const float lg2 = log2f(1.0f - exp2f(-(5.0f + (float)h)));
    float q[64], acc[64];
#pragma unroll
    for (int d = 0; d < 64; ++d) { q[d] = QR[m * 256 + 64 * h + d]; acc[d] = 0.f; }
    for (int s = lane; s <= t; s += 64) { const size_t ms = (size_t)b * SEQ + s; float dot = 0.f;
#pragma unroll
        for (int d = 0; d < 64; ++d) dot += q[d] * KR[ms * 256 + 64 * h + d];
        const float p = dot * exp2f((float)(t - s) * lg2);
#pragma unroll
        for (int e = 0; e < 64; ++e) acc[e] += p * bf2f(Z[ms * NZ + ZC_RV + 64 * h + e]); }
    float o = 0.f;
#pragma unroll
    for (int e = 0; e < 64; ++e) { const float v = wave_sum(acc[e]); if (lane == e) o = v; }
    const float mean = wave_sum(o) * (1.0f / 64.0f), oc = o - mean, var = wave_sum(oc * oc) * (1.0f / 64.0f);
    const float gate = silu_f(bf2f(Z[m * NZ + ZC_RG + 64 * h + lane]));
    Y[m * 1024 + 768 + 64 * h + lane] = (bf16)f2bf(oc * rsqrtf(var + 1e-6f) * normg[64 * h + lane] * gate);
}
__global__ void __launch_bounds__(64) nv_hgrn(const bf16* Z, const float* lblog, int l, const float* normg, bf16* Y) {
    __shared__ float sq[128], sf[128], sk[128];
    const int lane = threadIdx.x, bh = blockIdx.x, b = bh >> 2, h = bh & 3;
    float lb[2];
#pragma unroll
    for (int c = 0; c < 2; ++c) { const int ch = 128 * h + lane + 64 * c; const float x0 = lblog[ch], x1 = lblog[512 + ch], x2 = lblog[1024 + ch], x3 = lblog[1536 + ch];
        const float mx = fmaxf(fmaxf(x0, x1), fmaxf(x2, x3)); const float e0 = __expf(x0 - mx), e1 = __expf(x1 - mx), e2 = __expf(x2 - mx), e3 = __expf(x3 - mx); const float inv = 1.0f / (e0 + e1 + e2 + e3);
        lb[c] = (l >= 1 ? e1 : 0.f) * inv + (l >= 2 ? e2 : 0.f) * inv + (l >= 3 ? e3 : 0.f) * inv; }
    float S[128];
#pragma unroll
    for (int k = 0; k < 128; ++k) S[k] = 0.f;
    const float ng = normg[64 * h + lane];
    for (int t = 0; t < SEQ; ++t) { const size_t m = (size_t)b * SEQ + t; const bf16* zr = Z + m * NZ;
        __syncthreads();
#pragma unroll
        for (int c = 0; c < 2; ++c) { const int k = lane + 64 * c; const float f = bf2f(zr[ZC_HF + 128 * h + k]); const float fg = lb[c] + (1.0f - lb[c]) / (1.0f + __expf(-f));
            sq[k] = bf2f(zr[ZC_HQ + 128 * h + k]); sf[k] = fg; sk[k] = 1.0f - fg; }
        __syncthreads();
        const float v = bf2f(zr[ZC_HI + 64 * h + lane]); float o = 0.f;
#pragma unroll
        for (int k = 0; k < 128; ++k) { S[k] = sf[k] * S[k] + sk[k] * v; o += sq[k] * S[k]; }
        const float ms = wave_sum(o * o) * (1.0f / 64.0f); const float gate = silu_f(bf2f(zr[ZC_HG + 64 * h + lane]));
        Y[m * 1024 + 512 + 64 * h + lane] = (bf16)f2bf(o * rsqrtf(ms + 1e-6f) * ng * gate); }
}
__global__ void __launch_bounds__(256) nv_sg_prep(const bf16* Z, const float* lng, bf16* V) {
    const int lane = threadIdx.x & 63, m = blockIdx.x * 4 + (threadIdx.x >> 6); float x[4]; float s = 0.f;
#pragma unroll
    for (int j = 0; j < 4; ++j) { x[j] = gelu_exact(bf2f(Z[(size_t)m * NZ + ZC_V + lane + 64 * j])); s += x[j]; }
    const float mean = wave_sum(s) * (1.0f / 256.0f); float q = 0.f;
#pragma unroll
    for (int j = 0; j < 4; ++j) { x[j] -= mean; q += x[j] * x[j]; }
    const float rstd = rsqrtf(wave_sum(q) * (1.0f / 256.0f) + 1e-6f);
#pragma unroll
    for (int j = 0; j < 4; ++j) V[(size_t)m * 256 + lane + 64 * j] = (bf16)f2bf(x[j] * rstd * lng[lane + 64 * j]);
}
__global__ void __launch_bounds__(256) nv_sg(const bf16* Z, const bf16* V, const float* w, const float* bs, bf16* Y) {
    const int d = threadIdx.x, m = blockIdx.x, t = m & 127, h = d >> 6; const size_t m0 = (size_t)(m - t);
    float acc = bs[h * 128 + t]; const float* wr = w + ((size_t)h * 128 + t) * 128;
    for (int s = 0; s <= t; ++s) acc += wr[s] * bf2f(V[(m0 + s) * 256 + d]);
    Y[(size_t)m * 1024 + 256 + d] = (bf16)f2bf(gelu_exact(bf2f(Z[(size_t)m * NZ + ZC_U + d])) * acc);
}
#endif

extern "C" void kernel_launch(void* const* d_in, const int* in_sizes, int n_in, void* d_out, int out_size, void* d_ws, size_t ws_size, hipStream_t stream) {
    static int grid = 0; static void (*kfn)(Args) = nullptr;
    if (grid == 0) {
        if (n_in != N_IN || in_sizes[0] != M * D || out_size != M * D || ws_size < WS_END) { fprintf(stderr, "kernel_launch: unexpected shapes (n_in %d, in0 %d, out %d, ws %zu < %zu?)\n", n_in, n_in > 0 ? in_sizes[0] : -1, out_size, ws_size, (size_t)WS_END); grid = -1; return; }
        int dev = 0, cus = 0, per_cu = 0;
        if (hipGetDevice(&dev) != hipSuccess || hipDeviceGetAttribute(&cus, hipDeviceAttributeMultiprocessorCount, dev) != hipSuccess) { grid = -1; return; }
        if (cus != 256) { fprintf(stderr, "kernel_launch: this build is specialised for a 256-CU device (found %d)\n", cus); grid = -1; return; }
        kfn = mk_fwd<true>;
        if (hipFuncSetAttribute((const void*)kfn, hipFuncAttributeMaxDynamicSharedMemorySize, LDS_BYTES) != hipSuccess) { fprintf(stderr, "kernel_launch: hipFuncSetAttribute failed\n"); grid = -1; return; }
        if (hipOccupancyMaxActiveBlocksPerMultiprocessor(&per_cu, (const void*)kfn, NWAVES * 64, LDS_BYTES) != hipSuccess || per_cu < 1) { fprintf(stderr, "kernel_launch: occupancy query says %d\n", per_cu); }
        (void)hipGetLastError();
        grid = cus;
    }
    if (grid < 0) return;
    if (hipMemsetAsync((char*)d_ws + WS_CTL, 0, CTL_ZERO_BYTES, stream) != hipSuccess) return;
    Args a{};
    for (int i = 0; i < N_IN; ++i) a.in[i] = (const float*)d_in[i];
    a.out = (float*)d_out; a.ws = (unsigned char*)d_ws;
    auto launch = [&](int lo, int hi, int li) { a.ph_lo = lo; a.ph_hi = hi; a.li = li; hipLaunchKernelGGL(kfn, dim3(grid), dim3(NWAVES * 64), LDS_BYTES, stream, a); };
#if MK_MODE == 0
    launch(0, N_PHASES, 0);
#else
    unsigned char* ws = (unsigned char*)d_ws;
    const bf16* Z = (const bf16*)(ws + WS_ZH); const bf16* QKV = (const bf16*)(ws + WS_QKV); bf16* Y = (bf16*)(ws + WS_B1);
    float* QR = (float*)(ws + WS_HST); float* KR = QR + (size_t)M * 256; bf16* V = (bf16*)(ws + WS_RST);
    const float* rcs = (const float*)(ws + WS_ROPE) + (size_t)M * 32; const float* rsn = rcs + (size_t)M * 32;
    int li = 0, lo = 0;
    for (int l = 0; l < DEPTH; ++l) {
        launch(lo, 1 + 10 * l + 3, li++);
#if !MIX_RET
        hipLaunchKernelGGL(nv_ret_prep, dim3(M * 128 / 256), dim3(256), 0, stream, Z, rcs, rsn, QR, KR);
        hipLaunchKernelGGL(nv_ret, dim3(M), dim3(256), 0, stream, Z, (const float*)QR, (const float*)KR, (const float*)d_in[IN_RETN] + l * 256, Y);
#endif
#if !MIX_HG
        hipLaunchKernelGGL(nv_hgrn, dim3(16), dim3(64), 0, stream, Z, (const float*)d_in[IN_HGLB], l, (const float*)d_in[IN_HGN] + l * 256, Y);
#endif
#if !MIX_SG
        hipLaunchKernelGGL(nv_sg_prep, dim3(M / 4), dim3(256), 0, stream, Z, (const float*)d_in[IN_SGLN] + l * 256, V);
        hipLaunchKernelGGL(nv_sg, dim3(M), dim3(256), 0, stream, Z, (const bf16*)V, (const float*)d_in[IN_SGW] + (size_t)l * 4 * 128 * 128, (const float*)d_in[IN_SGB] + l * 512, Y);
#endif
        launch(1 + 10 * l + 3, 1 + 10 * l + 6, li++);
#if !MIX_MLA
        hipLaunchKernelGGL(nv_mla, dim3(M), dim3(256), 0, stream, QKV, Y);
#endif
        lo = 1 + 10 * l + 6;
    }
    launch(lo, N_PHASES, li++);
#endif
}
```
